# Optimizing an MI355X kernel written in HIP

```python
import jax, jax.numpy as jnp
from jax import lax
import numpy as np

D_MODEL = 4096
BATCH = 4
SEQ = 2048
DEPTH = 1

CHUNK = 64
Q_BLOCK = 128
D_PLE = 256
A_HEADS = 16
A_HEAD_DIM = 128
A_LATENT = 256
IDX_HEADS = 32
IDX_DIM = 64
TOPK_MAX = 256
B_HEADS = 16
B_HEAD_DIM = 128
PEER_HEADS = 8
PEER_KEYS = 128
PEER_QDIM = 256
PEER_TOPK = 16
N_EXPERTS = PEER_KEYS * PEER_KEYS
PEER_TOKEN_BLOCK = 128
N_BRANCH = 2
LN_EPS = 1e-5
IN_WIDTHS = (
    A_HEADS * A_HEAD_DIM,
    A_LATENT,
    IDX_HEADS * IDX_DIM,
    IDX_DIM,
    IDX_HEADS,
    B_HEADS * B_HEAD_DIM,
    B_HEADS * B_HEAD_DIM,
    B_HEADS * B_HEAD_DIM,
    B_HEADS,
)
IN_WIDTH = sum(IN_WIDTHS)

kernel_name = "hybrid_dsa_fox_peer_block"


def layer_norm(x, g, b):
    xf = x.astype(jnp.float32)
    mu = jnp.mean(xf, axis=-1, keepdims=True)
    var = jnp.mean(jnp.square(xf - mu), axis=-1, keepdims=True)
    y = (xf - mu) * lax.rsqrt(var + LN_EPS) * g.astype(jnp.float32) + b.astype(jnp.float32)
    return y.astype(x.dtype)


def rms_norm(x, g):
    xf = x.astype(jnp.float32)
    y = xf * lax.rsqrt(jnp.mean(jnp.square(xf), axis=-1, keepdims=True) + LN_EPS) * g.astype(jnp.float32)
    return y.astype(x.dtype)


def alibi_slopes(n):
    return 2.0 ** (-8.0 * jnp.arange(1, n + 1, dtype=jnp.float32) / n)


def to_blocks(a, n_blocks):
    return a.reshape(a.shape[0], n_blocks, Q_BLOCK, *a.shape[2:]).swapaxes(0, 1)


def dsa_attention(q, c_kv, q_idx, k_idx, w_idx, w_uk, w_uv):
    bsz, seq = q.shape[0], q.shape[1]
    n_blocks = seq // Q_BLOCK
    k_sel = min(TOPK_MAX, seq // 4)
    pos = jnp.arange(seq, dtype=jnp.int32)
    slopes = alibi_slopes(A_HEADS)
    scale = A_HEAD_DIM ** -0.5
    idx_scale = (IDX_DIM ** -0.5) * (IDX_HEADS ** -0.5)

    def block(args):
        qb, qib, wib, tb = args
        rel = jax.nn.relu(jnp.einsum('bqhd,bsd->bqsh', qib, k_idx).astype(jnp.float32))
        score = jnp.einsum('bqsh,bqh->bqs', rel, wib.astype(jnp.float32)) * idx_scale
        chunk_end = (tb // CHUNK + 1) * CHUNK
        admissible = pos[None, :] < chunk_end[:, None]
        score = jnp.where(admissible[None], score, -jnp.inf)
        _, idx = lax.top_k(score, k_sel)
        valid = idx < chunk_end[None, :, None]
        c_sel = jax.vmap(lambda c, i: c[i])(c_kv, idx)
        q_lat = jnp.einsum('bqhd,chd->bqhc', qb, w_uk)
        logits = jnp.einsum('bqhc,bqkc->bqhk', q_lat, c_sel).astype(jnp.float32) * scale
        dist = jnp.abs(tb[None, :, None] - idx).astype(jnp.float32)
        logits = logits - slopes[None, None, :, None] * dist[:, :, None, :]
        logits = jnp.where(valid[:, :, None, :], logits, -jnp.inf)
        probs = jax.nn.softmax(logits, axis=-1).astype(c_sel.dtype)
        o_lat = jnp.einsum('bqhk,bqkc->bqhc', probs, c_sel)
        o = jnp.einsum('bqhc,chd->bqhd', o_lat, w_uv)
        return o.reshape(bsz, Q_BLOCK, A_HEADS * A_HEAD_DIM)

    out = lax.map(block, (to_blocks(q, n_blocks), to_blocks(q_idx, n_blocks),
                          to_blocks(w_idx, n_blocks), pos.reshape(n_blocks, Q_BLOCK)))
    return out.swapaxes(0, 1).reshape(bsz, seq, A_HEADS * A_HEAD_DIM)


def fox_attention(q, k, v, f_logit):
    bsz, seq = q.shape[0], q.shape[1]
    n_blocks = seq // Q_BLOCK
    pos = jnp.arange(seq, dtype=jnp.int32)
    scale = B_HEAD_DIM ** -0.5
    cum = jnp.cumsum(jax.nn.log_sigmoid(f_logit.astype(jnp.float32)), axis=1)
    cum_k = cum.transpose(0, 2, 1)

    def block(args):
        qb, cqb, tb = args
        logits = jnp.einsum('bqhd,bshd->bhqs', qb, k).astype(jnp.float32) * scale
        logits = logits + cqb.transpose(0, 2, 1)[..., None] - cum_k[:, :, None, :]
        causal = pos[None, :] <= tb[:, None]
        logits = jnp.where(causal[None, None], logits, -jnp.inf)
        probs = jax.nn.softmax(logits, axis=-1).astype(v.dtype)
        o = jnp.einsum('bhqs,bshd->bqhd', probs, v)
        return o.reshape(bsz, Q_BLOCK, B_HEADS * B_HEAD_DIM)

    out = lax.map(block, (to_blocks(q, n_blocks), to_blocks(cum, n_blocks),
                          pos.reshape(n_blocks, Q_BLOCK)))
    return out.swapaxes(0, 1).reshape(bsz, seq, B_HEADS * B_HEAD_DIM)


def peer_ffn(x, w_q, sub_keys, u_tab, v_tab):
    bsz, seq, d = x.shape
    half = PEER_QDIM // 2
    q = jnp.einsum('bsd,dhk->bshk', x, w_q)
    q1, q2 = q[..., :half], q[..., half:]
    s1 = jnp.einsum('bshk,hnk->bshn', q1, sub_keys[:, 0]).astype(jnp.float32)
    s2 = jnp.einsum('bshk,hnk->bshn', q2, sub_keys[:, 1]).astype(jnp.float32)
    v1, i1 = lax.top_k(s1, PEER_TOPK)
    v2, i2 = lax.top_k(s2, PEER_TOPK)
    cand = (v1[..., :, None] + v2[..., None, :]).reshape(bsz, seq, PEER_HEADS, PEER_TOPK * PEER_TOPK)
    vals, ci = lax.top_k(cand, PEER_TOPK)
    experts = (jnp.take_along_axis(i1, ci // PEER_TOPK, axis=-1) * PEER_KEYS
               + jnp.take_along_axis(i2, ci % PEER_TOPK, axis=-1))
    gates = jax.nn.softmax(vals, axis=-1)
    n_tok = bsz * seq
    m = PEER_HEADS * PEER_TOPK
    n_tb = n_tok // PEER_TOKEN_BLOCK
    xs = x.reshape(n_tb, PEER_TOKEN_BLOCK, d)
    es = experts.reshape(n_tb, PEER_TOKEN_BLOCK, m)
    gs = gates.reshape(n_tb, PEER_TOKEN_BLOCK, m).astype(x.dtype)

    def block(args):
        xb, eb, gb = args
        act = jax.nn.gelu(jnp.einsum('nd,nmd->nm', xb, u_tab[eb]), approximate=False)
        return jnp.einsum('nm,nmd->nd', gb * act, v_tab[eb])

    y = lax.map(block, (xs, es, gs))
    return y.reshape(bsz, seq, d)


def setup_inputs(seed: int = 0) -> dict:
    key = jax.random.key(seed)
    ks = jax.random.split(key, 24)
    f32 = jnp.float32
    beta = (8.0 * DEPTH) ** -0.25
    nrm = lambda k, shape, s: jax.random.normal(k, shape, f32) * s
    L = DEPTH
    return {
        "x": nrm(ks[0], (BATCH, SEQ, D_MODEL), 1.0),
        "p": nrm(ks[1], (DEPTH, BATCH, SEQ, D_PLE), 1.0),
        "w_in": nrm(ks[2], (L, D_MODEL, IN_WIDTH), D_MODEL ** -0.5),
        "b_forget": 1.0 + nrm(ks[3], (L, B_HEADS), 0.1),
        "g_latent": 1.0 + nrm(ks[4], (L, A_LATENT), 0.02),
        "w_uk": nrm(ks[5], (L, A_LATENT, A_HEADS, A_HEAD_DIM), A_LATENT ** -0.5),
        "w_uv": nrm(ks[6], (L, A_LATENT, A_HEADS, A_HEAD_DIM), A_LATENT ** -0.5),
        "w_branch_a": nrm(ks[7], (L, A_HEADS * A_HEAD_DIM, D_MODEL), (A_HEADS * A_HEAD_DIM) ** -0.5),
        "w_branch_b": nrm(ks[8], (L, B_HEADS * B_HEAD_DIM, D_MODEL), (B_HEADS * B_HEAD_DIM) ** -0.5),
        "w_gate": nrm(ks[9], (L, D_MODEL, N_BRANCH * D_MODEL), D_MODEL ** -0.5),
        "b_gate": nrm(ks[10], (L, N_BRANCH * D_MODEL), 0.02),
        "w_out": nrm(ks[11], (L, D_MODEL, D_MODEL), beta * D_MODEL ** -0.5),
        "ln1_g": 1.0 + nrm(ks[12], (L, D_MODEL), 0.02),
        "ln1_b": nrm(ks[13], (L, D_MODEL), 0.02),
        "peer_wq": nrm(ks[14], (L, D_MODEL, PEER_HEADS, PEER_QDIM), D_MODEL ** -0.5),
        "peer_subkeys": nrm(ks[15], (L, PEER_HEADS, 2, PEER_KEYS, PEER_QDIM // 2), (PEER_QDIM // 2) ** -0.5),
        "peer_u": nrm(ks[16], (L, N_EXPERTS, D_MODEL), D_MODEL ** -0.5),
        "peer_v": nrm(ks[17], (L, N_EXPERTS, D_MODEL), beta * PEER_HEADS ** -0.5),
        "w_ple": nrm(ks[18], (L, D_PLE, D_MODEL), D_PLE ** -0.5),
        "w_ple_gate": nrm(ks[19], (L, D_MODEL, D_MODEL), D_MODEL ** -0.5),
        "b_ple_gate": nrm(ks[20], (L, D_MODEL), 0.02),
        "ln2_g": 1.0 + nrm(ks[21], (L, D_MODEL), 0.02),
        "ln2_b": nrm(ks[22], (L, D_MODEL), 0.02),
    }


def reference(x, p, w_in, b_forget, g_latent, w_uk, w_uv, w_branch_a, w_branch_b,
              w_gate, b_gate, w_out, ln1_g, ln1_b, peer_wq, peer_subkeys, peer_u,
              peer_v, w_ple, w_ple_gate, b_ple_gate, ln2_g, ln2_b):
    bsz, seq, d = x.shape
    alpha = (2.0 * DEPTH) ** 0.25
    split_at = [int(o) for o in np.cumsum(IN_WIDTHS)[:-1]]
    h = x
    for i in range(DEPTH):
        u = h
        proj = u @ w_in[i]
        (qa, c_kv, q_idx, k_idx, w_idx, qb, kb, vb, f_logit) = jnp.split(proj, split_at, axis=-1)
        qa = qa.reshape(bsz, seq, A_HEADS, A_HEAD_DIM)
        c_kv = rms_norm(c_kv, g_latent[i])
        q_idx = q_idx.reshape(bsz, seq, IDX_HEADS, IDX_DIM)
        o_a = dsa_attention(qa, c_kv, q_idx, k_idx, w_idx, w_uk[i], w_uv[i])
        o_b = fox_attention(qb.reshape(bsz, seq, B_HEADS, B_HEAD_DIM),
                            kb.reshape(bsz, seq, B_HEADS, B_HEAD_DIM),
                            vb.reshape(bsz, seq, B_HEADS, B_HEAD_DIM),
                            f_logit + b_forget[i])
        gates = jax.nn.sigmoid(u @ w_gate[i] + b_gate[i]).reshape(bsz, seq, N_BRANCH, d)
        merged = gates[:, :, 0] * (o_a @ w_branch_a[i]) + gates[:, :, 1] * (o_b @ w_branch_b[i])
        h = layer_norm(alpha * h + merged @ w_out[i], ln1_g[i], ln1_b[i])
        ffn = peer_ffn(h, peer_wq[i], peer_subkeys[i], peer_u[i], peer_v[i])
        ple = jax.nn.sigmoid(h @ w_ple_gate[i] + b_ple_gate[i]) * (p[i] @ w_ple[i])
        h = layer_norm(alpha * h + ffn + ple, ln2_g[i], ln2_b[i])
    return h
```

```cpp
#include <hip/hip_runtime.h>
#include <cstdio>
#include <cstdint>

#ifndef MK_N_LAUNCHES
#define MK_N_LAUNCHES 1
#endif

#define GAS __attribute__((address_space(1)))
#define LAS __attribute__((address_space(3)))
typedef unsigned short bf16;
typedef float f32x4 __attribute__((ext_vector_type(4)));
typedef float f32x2 __attribute__((ext_vector_type(2)));
typedef unsigned u32x4 __attribute__((ext_vector_type(4)));
typedef unsigned u32x2 __attribute__((ext_vector_type(2)));
typedef short bf16x8 __attribute__((ext_vector_type(8)));

constexpr int D_MODEL = 4096, BATCH = 4, SEQ = 2048, NTOK = BATCH * SEQ;
constexpr int A_HEADS = 16, A_HD = 128, A_LAT = 256, IDX_HEADS = 32, IDX_DIM = 64, TOPK = 256, CHUNK = 64;
constexpr int B_HEADS = 16, B_HD = 128;
constexpr int PEER_HEADS = 8, PEER_KEYS = 128, PEER_QDIM = 256, PEER_TOPK = 16, N_EXPERTS = PEER_KEYS * PEER_KEYS, PEER_M = PEER_HEADS * PEER_TOPK;
constexpr int D_PLE = 256;
constexpr int IN_WIDTH = 10608;
constexpr int N1 = 18944;
constexpr int N1M = 18432;
constexpr int N4 = 6144;
constexpr float LN_EPS = 1e-5f;
constexpr float ALPHA = 1.18920711500272f;

__device__ __forceinline__ unsigned f2bf(float f) { unsigned u = __builtin_bit_cast(unsigned, f); return (u + 0x7fffu + ((u >> 16) & 1u)) >> 16; }
typedef __bf16 bf16x2_n __attribute__((ext_vector_type(2)));
__device__ __forceinline__ unsigned pk2(float lo, float hi) { const bf16x2_n b = __builtin_convertvector((f32x2){lo, hi}, bf16x2_n); return __builtin_bit_cast(unsigned, b); }
__device__ __forceinline__ float bflo(unsigned w) { return __builtin_bit_cast(float, w << 16); }
__device__ __forceinline__ float bfhi(unsigned w) { return __builtin_bit_cast(float, w & 0xffff0000u); }
__device__ __forceinline__ float bf2f(bf16 b) { return __builtin_bit_cast(float, (unsigned)b << 16); }
__device__ __forceinline__ float sigmoidf_(float x) { return __builtin_amdgcn_rcpf(1.0f + __expf(-x)); }
__device__ __forceinline__ float wave_sum(float v) {
#pragma unroll
    for (int o = 1; o < 64; o <<= 1) v += __shfl_xor(v, o);
    return v;
}
__device__ __forceinline__ float wave_max(float v) {
#pragma unroll
    for (int o = 1; o < 64; o <<= 1) v = fmaxf(v, __shfl_xor(v, o));
    return v;
}
__device__ __forceinline__ int fresh_lane() { int l; asm volatile("v_mbcnt_lo_u32_b32 %0, -1, 0\n\tv_mbcnt_hi_u32_b32 %0, -1, %0" : "=v"(l)); return l; }
constexpr float Q8_ACT = 30.0f, Q8_W = 1920.0f;
constexpr float Q8_O = 21.0f, Q8_WB = 1368.0f;
constexpr float Q8_MG = 32.0f, Q8_WO = 3250.0f;
__device__ __forceinline__ unsigned pk_q8x4(float a, float b, float c, float d, float sc) {
    const int i0 = __float2int_rn(fminf(fmaxf(a * sc, -127.f), 127.f)), i1 = __float2int_rn(fminf(fmaxf(b * sc, -127.f), 127.f));
    const int i2 = __float2int_rn(fminf(fmaxf(c * sc, -127.f), 127.f)), i3 = __float2int_rn(fminf(fmaxf(d * sc, -127.f), 127.f));
    return (unsigned)(i0 & 255) | ((unsigned)(i1 & 255) << 8) | ((unsigned)(i2 & 255) << 16) | ((unsigned)i3 << 24); }
#define LDS_WAIT() asm volatile("s_waitcnt lgkmcnt(0)" ::: "memory")
#define VM_WAIT() asm volatile("s_waitcnt vmcnt(0)" ::: "memory")
#define CFENCE() asm volatile("" ::: "memory")
namespace pg8 {
#define PG8_LAS __attribute__((address_space(3)))
typedef unsigned short bf16_t;
typedef short bf16x8 __attribute__((ext_vector_type(8)));
typedef float f32x4 __attribute__((ext_vector_type(4)));
typedef unsigned u32x4 __attribute__((ext_vector_type(4)));
constexpr int BM = 256, BK = 64, HALF = 128, HTB = HALF * BK * 2  , STAGE_BYTES = 8 * HTB, NXCD = 8, WGM = 8;

__host__ __device__ __forceinline__ int lds_byte(int r, int c) { const int st = (r >> 4) * 2 + (c >> 5), rr = r & 15, cc = c & 31, ob = rr * 64 + cc * 2; return st * 1024 + (ob ^ (((ob >> 9) & 1) << 5)); }
__host__ __device__ __forceinline__ void stage_rc(int b, int& R, int& C) { const int st = b / 1024, sb = b % 1024, swz = sb ^ (((sb >> 9) & 1) << 5); R = (st >> 1) * 16 + swz / 64; C = (st & 1) * 32 + (swz % 64) / 2; }
__host__ __device__ __forceinline__ int perm32(int rho) { const int n = rho >> 4, i = rho & 15; return 8 * (i >> 2) + 4 * n + (i & 3); }

struct Unit { int pm, pn; };
struct Gemm { const bf16_t* A; const bf16_t* Bt; int M, N, K, ld; };

struct StaticOrder {
    int nM, nN, nwg, G, c;
    __host__ __device__ void init(int M, int N, int G_, int c_) { nM = M / BM; nN = N / BM; nwg = nM * nN; G = G_; c = c_; }
    __host__ __device__ bool next(int i, Unit& u) const {
        const long L = (long)i * G + c; if (L >= nwg) return false;
        int wgid = (int)L; { const int q = nwg / NXCD, r = nwg % NXCD, xcd = wgid % NXCD, off = wgid / NXCD; wgid = (xcd < r ? xcd * (q + 1) : r * (q + 1) + (xcd - r) * q) + off; }
        const int nig = WGM * nN, gid = wgid / nig, fm = gid * WGM, gsz = (nM - fm) < WGM ? (nM - fm) : WGM;
        u.pm = fm + ((wgid % nig) % gsz); u.pn = (wgid % nig) / gsz; return true;
    }
    __device__ __forceinline__ void a_ready(const Unit&) const {}
    __device__ __forceinline__ void done(const Unit&) const {}
};
typedef __bf16 bf16x2_nat __attribute__((ext_vector_type(2)));
__device__ __forceinline__ unsigned cvt_pk_bf16(float lo, float hi) { typedef float f2_ __attribute__((ext_vector_type(2))); const bf16x2_nat b = __builtin_convertvector((f2_){lo, hi}, bf16x2_nat); return __builtin_bit_cast(unsigned, b); }
typedef unsigned u32x2 __attribute__((ext_vector_type(2)));
__device__ __forceinline__ unsigned q8x4(float a, float b, float c, float d, float sc) {
    const int i0 = __float2int_rn(fminf(fmaxf(a * sc, -127.f), 127.f)), i1 = __float2int_rn(fminf(fmaxf(b * sc, -127.f), 127.f));
    const int i2 = __float2int_rn(fminf(fmaxf(c * sc, -127.f), 127.f)), i3 = __float2int_rn(fminf(fmaxf(d * sc, -127.f), 127.f));
    return (unsigned)(i0 & 255) | ((unsigned)(i1 & 255) << 8) | ((unsigned)(i2 & 255) << 16) | ((unsigned)i3 << 24); }
__device__ __forceinline__ float sigm(float x) { return __builtin_amdgcn_rcpf(1.0f + __expf(-x)); }
__device__ __forceinline__ float blo(unsigned w) { return __builtin_bit_cast(float, w << 16); }
__device__ __forceinline__ float bhi(unsigned w) { return __builtin_bit_cast(float, w & 0xffff0000u); }

struct Epi1 {
    static constexpr bool PERM = true, AFTER_DRAIN = false;
    bf16_t *QA, *QIDX, *QB, *KB, *VB, *G; const float* b_gate; int pn_off;
    __device__ __forceinline__ void operator()(const f32x4 (&acc)[2][2][4][2], const Unit& u, int wr, int wc, int fr, int fq) const {
        const int pn = u.pn + pn_off, row0 = u.pm * BM + wr * 64 + fr, cl = wc * 32 + 8 * fq;
        if (pn >= 40) {
            const int gc = (pn - 40) * 256 + cl;
            f32x4 bv[2][2];
#pragma unroll
            for (int bj = 0; bj < 2; ++bj)
#pragma unroll
                for (int n = 0; n < 2; ++n) bv[bj][n] = *(const f32x4*)(b_gate + gc + bj * HALF + 4 * n);
#pragma unroll
            for (int ai = 0; ai < 2; ++ai)
#pragma unroll
                for (int m = 0; m < 4; ++m) { bf16_t* rowp = G + (size_t)(row0 + ai * HALF + m * 16) * 8192 + gc;
#pragma unroll
                    for (int bj = 0; bj < 2; ++bj) { const f32x4 v0 = acc[ai][bj][m][0] * (1.0f / 57600.0f) + bv[bj][0], v1 = acc[ai][bj][m][1] * (1.0f / 57600.0f) + bv[bj][1];
                        u32x4 w; w.x = cvt_pk_bf16(sigm(v0[0]), sigm(v0[1])); w.y = cvt_pk_bf16(sigm(v0[2]), sigm(v0[3])); w.z = cvt_pk_bf16(sigm(v1[0]), sigm(v1[1])); w.w = cvt_pk_bf16(sigm(v1[2]), sigm(v1[3]));
                        *(u32x4*)(rowp + bj * HALF) = w; } }
        } else {
            bf16_t* dst; int c0;
            if (pn < 8) { dst = QA; c0 = pn; } else if (pn < 16) { dst = QIDX; c0 = pn - 8; } else if (pn < 24) { dst = QB; c0 = pn - 16; } else if (pn < 32) { dst = KB; c0 = pn - 24; } else { dst = VB; c0 = pn - 32; }
            c0 = c0 * 256 + cl;
#pragma unroll
            for (int ai = 0; ai < 2; ++ai)
#pragma unroll
                for (int m = 0; m < 4; ++m) { bf16_t* rowp = dst + (size_t)(row0 + ai * HALF + m * 16) * 2048 + c0;
#pragma unroll
                    for (int bj = 0; bj < 2; ++bj) { const f32x4 v0 = acc[ai][bj][m][0] * (1.0f / 57600.0f), v1 = acc[ai][bj][m][1] * (1.0f / 57600.0f);
                        u32x4 w; w.x = cvt_pk_bf16(v0[0], v0[1]); w.y = cvt_pk_bf16(v0[2], v0[3]); w.z = cvt_pk_bf16(v1[0], v1[1]); w.w = cvt_pk_bf16(v1[2], v1[3]);
                        *(u32x4*)(rowp + bj * HALF) = w; } }
        }
    }
};
struct OneUnit {
    int pm, pn;
    __device__ bool next(int i, Unit& u) const { if (i) return false; u.pm = pm; u.pn = pn; return true; }
    __device__ __forceinline__ void a_ready(const Unit&) const {}
    __device__ __forceinline__ void done(const Unit&) const {}
};
struct EpiPart {
    static constexpr bool PERM = true, AFTER_DRAIN = false;
    float* P;
    __device__ __forceinline__ void operator()(const f32x4 (&acc)[2][2][4][2], const Unit& u, int wr, int wc, int fr, int fq) const {
        const int row0 = u.pm * BM + wr * 64 + fr, cl = wc * 32 + 8 * fq;
#pragma unroll
        for (int ai = 0; ai < 2; ++ai)
#pragma unroll
            for (int m = 0; m < 4; ++m) { float* rowp = P + (size_t)(row0 + ai * HALF + m * 16) * 256 + cl;
#pragma unroll
                for (int bj = 0; bj < 2; ++bj) { *(f32x4*)(rowp + bj * HALF) = acc[ai][bj][m][0]; *(f32x4*)(rowp + bj * HALF + 4) = acc[ai][bj][m][1]; } }
    }
};
struct EpiBf16P {
    static constexpr bool PERM = true, AFTER_DRAIN = false;
    bf16_t* C; int ldc;
    __device__ __forceinline__ void operator()(const f32x4 (&acc)[2][2][4][2], const Unit& u, int wr, int wc, int fr, int fq) const {
        const int row0 = u.pm * BM + wr * 64 + fr, col0 = u.pn * BM + wc * 32 + 8 * fq;
#pragma unroll
        for (int ai = 0; ai < 2; ++ai)
#pragma unroll
            for (int m = 0; m < 4; ++m) { bf16_t* rowp = C + (size_t)(row0 + ai * HALF + m * 16) * ldc + col0;
#pragma unroll
                for (int bj = 0; bj < 2; ++bj) { const f32x4 v0 = acc[ai][bj][m][0], v1 = acc[ai][bj][m][1];
                    u32x4 w; w.x = cvt_pk_bf16(v0[0], v0[1]); w.y = cvt_pk_bf16(v0[2], v0[3]); w.z = cvt_pk_bf16(v1[0], v1[1]); w.w = cvt_pk_bf16(v1[2], v1[3]);
                    *(u32x4*)(rowp + bj * HALF) = w; }
                asm volatile("" ::: "memory"); }
    }
};
struct EpiF32P {
    static constexpr bool PERM = true, AFTER_DRAIN = false;
    float* C; int ldc;
    __device__ __forceinline__ void operator()(const f32x4 (&acc)[2][2][4][2], const Unit& u, int wr, int wc, int fr, int fq) const {
        const int row0 = u.pm * BM + wr * 64 + fr, col0 = u.pn * BM + wc * 32 + 8 * fq;
#pragma unroll
        for (int ai = 0; ai < 2; ++ai)
#pragma unroll
            for (int m = 0; m < 4; ++m) { float* rowp = C + (size_t)(row0 + ai * HALF + m * 16) * ldc + col0;
#pragma unroll
                for (int bj = 0; bj < 2; ++bj) { *(f32x4*)(rowp + bj * HALF) = acc[ai][bj][m][0]; *(f32x4*)(rowp + bj * HALF + 4) = acc[ai][bj][m][1]; } }
    }
};
struct Epi2a {
    static constexpr bool PERM = true, AFTER_DRAIN = false;
    const bf16_t* G; bf16_t* MGT; float sacc;
    __device__ __forceinline__ void operator()(const f32x4 (&acc)[2][2][4][2], const Unit& u, int wr, int wc, int fr, int fq) const {
        const int row0 = u.pm * BM + wr * 64 + fr, col0 = u.pn * BM + wc * 32 + 8 * fq;
#pragma unroll
        for (int ai = 0; ai < 2; ++ai)
#pragma unroll
            for (int m = 0; m < 4; ++m) { const size_t r = (size_t)(row0 + ai * HALF + m * 16);
#pragma unroll
                for (int bj = 0; bj < 2; ++bj) { const u32x4 g = *(const u32x4*)(G + r * 8192 + col0 + bj * HALF); const f32x4 v0 = acc[ai][bj][m][0] * sacc, v1 = acc[ai][bj][m][1] * sacc;
                    u32x4 w; w.x = cvt_pk_bf16(v0[0] * blo(g.x), v0[1] * bhi(g.x)); w.y = cvt_pk_bf16(v0[2] * blo(g.y), v0[3] * bhi(g.y)); w.z = cvt_pk_bf16(v1[0] * blo(g.z), v1[1] * bhi(g.z)); w.w = cvt_pk_bf16(v1[2] * blo(g.w), v1[3] * bhi(g.w));
                    *(u32x4*)(MGT + r * 4096 + col0 + bj * HALF) = w; }
                asm volatile("" ::: "memory"); }
    }
};
struct Epi2b {
    static constexpr bool PERM = true, AFTER_DRAIN = false;
    const bf16_t* G; const bf16_t* MGT; bf16_t* MG; float sacc;
    __device__ __forceinline__ void operator()(const f32x4 (&acc)[2][2][4][2], const Unit& u, int wr, int wc, int fr, int fq) const {
        const int row0 = u.pm * BM + wr * 64 + fr, col0 = u.pn * BM + wc * 32 + 8 * fq;
#pragma unroll
        for (int ai = 0; ai < 2; ++ai)
#pragma unroll
            for (int m = 0; m < 4; ++m) { const size_t r = (size_t)(row0 + ai * HALF + m * 16);
#pragma unroll
                for (int bj = 0; bj < 2; ++bj) { const u32x4 g = *(const u32x4*)(G + r * 8192 + 4096 + col0 + bj * HALF); const f32x4 v0 = acc[ai][bj][m][0] * sacc, v1 = acc[ai][bj][m][1] * sacc;
                    const u32x4 t = *(const u32x4*)(MGT + r * 4096 + col0 + bj * HALF);
                    u32x2 w; w.x = q8x4(blo(t.x) + v0[0] * blo(g.x), bhi(t.x) + v0[1] * bhi(g.x), blo(t.y) + v0[2] * blo(g.y), bhi(t.y) + v0[3] * bhi(g.y), 32.0f);
                    w.y = q8x4(blo(t.z) + v1[0] * blo(g.z), bhi(t.z) + v1[1] * bhi(g.z), blo(t.w) + v1[2] * blo(g.w), bhi(t.w) + v1[3] * bhi(g.w), 32.0f);
                    *(u32x2*)((unsigned char*)MG + r * 4096 + col0 + bj * HALF) = w; }
                asm volatile("" ::: "memory"); }
    }
};
struct Epi3 {
    static constexpr bool PERM = true, AFTER_DRAIN = false;
    const float* X; bf16_t* Y; float alpha, sacc;
    __device__ __forceinline__ void operator()(const f32x4 (&acc)[2][2][4][2], const Unit& u, int wr, int wc, int fr, int fq) const {
        const int row0 = u.pm * BM + wr * 64 + fr, col0 = u.pn * BM + wc * 32 + 8 * fq;
#pragma unroll
        for (int ai = 0; ai < 2; ++ai)
#pragma unroll
            for (int m = 0; m < 4; ++m) { const size_t off = (size_t)(row0 + ai * HALF + m * 16) * 4096 + col0;
#pragma unroll
                for (int bj = 0; bj < 2; ++bj) { const f32x4 x0 = *(const f32x4*)(X + off + bj * HALF), x1 = *(const f32x4*)(X + off + bj * HALF + 4);
                    const f32x4 y0 = x0 * alpha + acc[ai][bj][m][0] * sacc, y1 = x1 * alpha + acc[ai][bj][m][1] * sacc;
                    u32x4 w; w.x = cvt_pk_bf16(y0[0], y0[1]); w.y = cvt_pk_bf16(y0[2], y0[3]); w.z = cvt_pk_bf16(y1[0], y1[1]); w.w = cvt_pk_bf16(y1[2], y1[3]);
                    *(u32x4*)(Y + off + bj * HALF) = w; }
                asm volatile("" ::: "memory"); }
    }
};
struct Epi4 {
    static constexpr bool PERM = true, AFTER_DRAIN = false;
    float* PQ; bf16_t* PL; const float* b_pg; int pn_off;
    __device__ __forceinline__ void operator()(const f32x4 (&acc)[2][2][4][2], const Unit& u, int wr, int wc, int fr, int fq) const {
        const int row0 = u.pm * BM + wr * 64 + fr, cl = wc * 32 + 8 * fq, pn = u.pn + pn_off;
        if (pn < 8) {
#pragma unroll
            for (int ai = 0; ai < 2; ++ai)
#pragma unroll
                for (int m = 0; m < 4; ++m) { float* rowp = PQ + (size_t)(row0 + ai * HALF + m * 16) * 2048 + pn * 256 + cl;
#pragma unroll
                    for (int bj = 0; bj < 2; ++bj) { *(f32x4*)(rowp + bj * HALF) = acc[ai][bj][m][0] * (1.0f / 57600.0f); *(f32x4*)(rowp + bj * HALF + 4) = acc[ai][bj][m][1] * (1.0f / 57600.0f); } }
        } else {
            const int c0 = (pn - 8) * 256 + cl;
            f32x4 bv[2][2];
#pragma unroll
            for (int bj = 0; bj < 2; ++bj)
#pragma unroll
                for (int n = 0; n < 2; ++n) bv[bj][n] = *(const f32x4*)(b_pg + c0 + bj * HALF + 4 * n);
#pragma unroll
            for (int ai = 0; ai < 2; ++ai)
#pragma unroll
                for (int m = 0; m < 4; ++m) { bf16_t* rowp = PL + (size_t)(row0 + ai * HALF + m * 16) * 4096 + c0;
#pragma unroll
                    for (int bj = 0; bj < 2; ++bj) { const u32x4 p = *(const u32x4*)(rowp + bj * HALF);
                        const f32x4 v0 = acc[ai][bj][m][0] * (1.0f / 57600.0f) + bv[bj][0], v1 = acc[ai][bj][m][1] * (1.0f / 57600.0f) + bv[bj][1];
                        u32x4 w; w.x = cvt_pk_bf16(sigm(v0[0]) * blo(p.x), sigm(v0[1]) * bhi(p.x)); w.y = cvt_pk_bf16(sigm(v0[2]) * blo(p.y), sigm(v0[3]) * bhi(p.y));
                        w.z = cvt_pk_bf16(sigm(v1[0]) * blo(p.z), sigm(v1[1]) * bhi(p.z)); w.w = cvt_pk_bf16(sigm(v1[2]) * blo(p.w), sigm(v1[3]) * bhi(p.w));
                        *(u32x4*)(rowp + bj * HALF) = w; }
                    asm volatile("" ::: "memory"); }
        }
    }
};
typedef int pg8_i32x4 __attribute__((ext_vector_type(4)));
typedef int pg8_i32x8 __attribute__((ext_vector_type(8)));
__device__ __forceinline__ pg8_i32x8 cat8(bf16x8 lo, bf16x8 hi) { const pg8_i32x4 a = __builtin_bit_cast(pg8_i32x4, lo), b = __builtin_bit_cast(pg8_i32x4, hi); return __builtin_shufflevector(a, b, 0, 1, 2, 3, 4, 5, 6, 7); }
template <class Epi, class Sched, bool ALIGN_EPI = false, bool SP2 = false, bool F8 = false>
__device__ __forceinline__ void gemm_phase(PG8_LAS unsigned char* lds, const Gemm g, const Sched& S, const Epi& E, const int wave_id) {
    int tid_ = wave_id * 64 + fresh_lane();
    const int tid = tid_, wid = __builtin_amdgcn_readfirstlane(tid >> 6), lane = tid & 63, wr = wid >> 2, wc = wid & 3, fr = lane & 15, fq = lane >> 4;
    const int K = g.K, nt = K / BK, LD = g.ld;
    unsigned voffA, voffB;
    { int R, C; stage_rc(tid * 16, R, C); const int Rb = Epi::PERM ? ((R & ~31) + perm32(R & 31)) : R; voffA = (unsigned)(R * LD + C) * 2u; voffB = (unsigned)(Rb * LD + C) * 2u; }
    const size_t rstep = (size_t)64 * LD * 2;
    const size_t kstep = (size_t)(BK * 2);
    const size_t hstep = (size_t)HALF * LD * 2;
    const size_t tstep = 2 * hstep;
    const unsigned ldsw = (unsigned)wid * 1024u;
    const int aoff = lds_byte(wr * 64 + fr, fq * 8), boff = lds_byte(wc * 32 + fr, fq * 8);
#define PG8_SA(b, h) (((b) * 2 + (h)) * HTB)
#define PG8_SB(b, h) ((4 + (b) * 2 + (h)) * HTB)
#define PG8_STAGE(bufoff, gbase, voff) do { _Pragma("unroll") for (int _i = 0; _i < 2; ++_i) \
        __builtin_amdgcn_global_load_lds((const unsigned*)((const char*)(gbase) + _i * rstep + (voff)), (PG8_LAS unsigned*)(lds + (bufoff) + ldsw + _i * 8192), 16, 0, 0); } while (0)
#define PG8_LDA(dst, b, h) do { _Pragma("unroll") for (int m = 0; m < 4; ++m) _Pragma("unroll") for (int k = 0; k < 2; ++k) dst[m][k] = *(const PG8_LAS bf16x8*)(lds + PG8_SA(b, h) + aoff + m * 2048 + k * 1024); } while (0)
#define PG8_LDB(dst, b, h) do { _Pragma("unroll") for (int n = 0; n < 2; ++n) _Pragma("unroll") for (int k = 0; k < 2; ++k) dst[n][k] = *(const PG8_LAS bf16x8*)(lds + PG8_SB(b, h) + boff + n * 2048 + k * 1024); } while (0)
#define PG8_MMA(ai, bj, At, Bt) do { __builtin_amdgcn_s_setprio(1); _Pragma("unroll") for (int m = 0; m < 4; ++m) _Pragma("unroll") for (int n = 0; n < 2; ++n) { \
        _Pragma("unroll") for (int k = 0; k < 2; ++k) { \
            if constexpr (F8) acc[ai][bj][m][n] = __builtin_bit_cast(f32x4, __builtin_amdgcn_mfma_i32_16x16x64_i8(__builtin_bit_cast(pg8_i32x4, Bt[n][k]), __builtin_bit_cast(pg8_i32x4, At[m][k]), __builtin_bit_cast(pg8_i32x4, acc[ai][bj][m][n]), 0, 0, 0)); \
            else acc[ai][bj][m][n] = __builtin_amdgcn_mfma_f32_16x16x32_bf16(Bt[n][k], At[m][k], acc[ai][bj][m][n], 0, 0, 0); } } __builtin_amdgcn_s_setprio(0); } while (0)
#define PG8_WAIT_V(n) asm volatile("s_waitcnt vmcnt(" #n ")" ::: "memory")
#define PG8_WAIT_L(n) asm volatile("s_waitcnt lgkmcnt(" #n ")" ::: "memory")
#define PG8_BAR __builtin_amdgcn_s_barrier()
#define PG8_SCHED __builtin_amdgcn_sched_barrier(0)
    Unit cur, nxt; int ui = 0;
    if (!S.next(0, cur)) return;
    f32x4 acc[2][2][4][2];
#pragma unroll
    for (int a = 0; a < 2; ++a)
#pragma unroll
        for (int b = 0; b < 2; ++b)
#pragma unroll
            for (int m = 0; m < 4; ++m)
#pragma unroll
                for (int n = 0; n < 2; ++n) acc[a][b][m][n] = (f32x4){0.f, 0.f, 0.f, 0.f};
    bf16x8 At[4][2], B0[2][2], B1[2][2];
    const char* cA = (const char*)g.A + (size_t)cur.pm * tstep; const char* cB = (const char*)g.Bt + (size_t)cur.pn * tstep;
    S.a_ready(cur);
    if constexpr (SP2) {
        PG8_STAGE(PG8_SB(0, 0), cB, voffB); PG8_STAGE(PG8_SB(0, 1), cB + hstep, voffB); PG8_STAGE(PG8_SA(0, 0), cA, voffA); PG8_STAGE(PG8_SA(0, 1), cA + hstep, voffA);
        if (wr == 1) PG8_BAR;
        PG8_WAIT_V(2); PG8_BAR;
        PG8_STAGE(PG8_SB(1, 0), cB + kstep, voffB); PG8_STAGE(PG8_SA(1, 0), cA + kstep, voffA); PG8_STAGE(PG8_SB(1, 1), cB + hstep + kstep, voffB);
        PG8_WAIT_V(6); PG8_BAR;
    } else {
        PG8_STAGE(PG8_SB(0, 0), cB, voffB); PG8_STAGE(PG8_SA(0, 0), cA, voffA); PG8_STAGE(PG8_SB(0, 1), cB + hstep, voffB); PG8_STAGE(PG8_SA(0, 1), cA + hstep, voffA);
        if (wr == 1) PG8_BAR;
        PG8_WAIT_V(4); PG8_BAR;
        PG8_STAGE(PG8_SB(1, 0), cB + kstep, voffB); PG8_STAGE(PG8_SA(1, 0), cA + kstep, voffA); PG8_STAGE(PG8_SB(1, 1), cB + hstep + kstep, voffB);
        PG8_WAIT_V(6); PG8_BAR;
    }
    for (;;) {
        const bool has_next = S.next(ui + 1, nxt);
        const char* nA = has_next ? (const char*)g.A + (size_t)nxt.pm * tstep : cA; const char* nB = has_next ? (const char*)g.Bt + (size_t)nxt.pn * tstep : cB;
#pragma unroll 1
        for (int t = 0; t < nt; t += 2) {
            const bool last = (t == nt - 2);
            const char* a1 = cA + (size_t)(t + 1) * kstep;
            const char* a2 = last ? nA : cA + (size_t)(t + 2) * kstep; const char* b2 = last ? nB : cB + (size_t)(t + 2) * kstep;
            const char* a3 = a2 + kstep; const char* b3 = b2 + kstep;
            if (last && has_next) S.a_ready(nxt);
            if constexpr (SP2) {
            PG8_LDB(B0, 0, 0); PG8_LDB(B1, 0, 1); PG8_SCHED; PG8_LDA(At, 0, 0); PG8_STAGE(PG8_SA(1, 1), a1 + hstep, voffA);
            PG8_WAIT_V(8); PG8_WAIT_L(0); PG8_BAR; PG8_MMA(0, 0, At, B0); PG8_MMA(0, 1, At, B1); PG8_BAR; PG8_SCHED;
            PG8_LDA(At, 0, 1); PG8_STAGE(PG8_SB(0, 0), b2, voffB); PG8_STAGE(PG8_SB(0, 1), b2 + hstep, voffB); PG8_STAGE(PG8_SA(0, 0), a2, voffA);
            PG8_WAIT_V(8); PG8_WAIT_L(0); PG8_BAR; PG8_MMA(1, 0, At, B0); PG8_MMA(1, 1, At, B1); PG8_BAR; PG8_SCHED;
            PG8_LDB(B0, 1, 0); PG8_LDB(B1, 1, 1); PG8_SCHED; PG8_LDA(At, 1, 0); PG8_STAGE(PG8_SA(0, 1), a2 + hstep, voffA);
            PG8_WAIT_V(8); PG8_WAIT_L(0); PG8_BAR; PG8_MMA(0, 0, At, B0); PG8_MMA(0, 1, At, B1); PG8_BAR; PG8_SCHED;
            PG8_LDA(At, 1, 1); PG8_STAGE(PG8_SB(1, 0), b3, voffB); PG8_STAGE(PG8_SB(1, 1), b3 + hstep, voffB); PG8_STAGE(PG8_SA(1, 0), a3, voffA);
            PG8_WAIT_V(8); PG8_WAIT_L(0); PG8_BAR; PG8_MMA(1, 0, At, B0); PG8_MMA(1, 1, At, B1); PG8_BAR; PG8_SCHED;
            } else {
            PG8_LDB(B0, 0, 0); PG8_SCHED; PG8_LDA(At, 0, 0); PG8_STAGE(PG8_SA(1, 1), a1 + hstep, voffA);
            PG8_WAIT_L(8); PG8_BAR; PG8_WAIT_L(0); PG8_MMA(0, 0, At, B0); PG8_BAR; PG8_SCHED;
            PG8_LDB(B1, 0, 1); PG8_STAGE(PG8_SB(0, 0), b2, voffB);
            PG8_BAR; PG8_WAIT_L(0); PG8_MMA(0, 1, At, B1); PG8_BAR;
            PG8_LDA(At, 0, 1); PG8_STAGE(PG8_SA(0, 0), a2, voffA);
            PG8_BAR; PG8_WAIT_L(0); PG8_MMA(1, 0, At, B0); PG8_BAR; PG8_SCHED;
            PG8_STAGE(PG8_SB(0, 1), b2 + hstep, voffB);
            PG8_WAIT_V(6); PG8_BAR; PG8_MMA(1, 1, At, B1); PG8_BAR;
            PG8_LDB(B0, 1, 0); PG8_SCHED; PG8_LDA(At, 1, 0); PG8_STAGE(PG8_SA(0, 1), a2 + hstep, voffA);
            PG8_WAIT_L(8); PG8_BAR; PG8_WAIT_L(0); PG8_MMA(0, 0, At, B0); PG8_BAR; PG8_SCHED;
            PG8_LDB(B1, 1, 1); PG8_STAGE(PG8_SB(1, 0), b3, voffB);
            PG8_BAR; PG8_WAIT_L(0); PG8_MMA(0, 1, At, B1); PG8_BAR;
            PG8_LDA(At, 1, 1); PG8_STAGE(PG8_SA(1, 0), a3, voffA);
            PG8_BAR; PG8_WAIT_L(0); PG8_MMA(1, 0, At, B0); PG8_BAR; PG8_SCHED;
            PG8_STAGE(PG8_SB(1, 1), b3 + hstep, voffB);
            PG8_WAIT_V(6); PG8_BAR; PG8_MMA(1, 1, At, B1); PG8_BAR;
            }
        }
        if constexpr (ALIGN_EPI) { if (wr == 0) PG8_BAR; }
        if constexpr (F8) {
#pragma unroll
            for (int a = 0; a < 2; ++a)
#pragma unroll
                for (int b = 0; b < 2; ++b)
#pragma unroll
                    for (int m = 0; m < 4; ++m)
#pragma unroll
                        for (int n = 0; n < 2; ++n) { const pg8_i32x4 iv = __builtin_bit_cast(pg8_i32x4, acc[a][b][m][n]); acc[a][b][m][n] = (f32x4){(float)iv[0], (float)iv[1], (float)iv[2], (float)iv[3]}; } }
        if constexpr (!Epi::AFTER_DRAIN) { const int le = fresh_lane(); E(acc, cur, wr, wc, le & 15, le >> 4); S.done(cur); }
        if (!has_next) break;
#pragma unroll
        for (int a = 0; a < 2; ++a)
#pragma unroll
            for (int b = 0; b < 2; ++b)
#pragma unroll
                for (int m = 0; m < 4; ++m)
#pragma unroll
                    for (int n = 0; n < 2; ++n) acc[a][b][m][n] = (f32x4){0.f, 0.f, 0.f, 0.f};
        cur = nxt; cA = nA; cB = nB; ++ui;
        if constexpr (ALIGN_EPI) { if (wr == 1) PG8_BAR; }
    }
    PG8_WAIT_V(0);
    if constexpr (!ALIGN_EPI) { if (wr == 0) PG8_BAR; }
    PG8_BAR;
    if constexpr (Epi::AFTER_DRAIN) { E.fused(acc, cur, wr, wc, fr, fq, lds, wid, lane); S.done(cur); }
#undef PG8_SA
#undef PG8_SB
#undef PG8_STAGE
#undef PG8_LDA
#undef PG8_LDB
#undef PG8_MMA
#undef PG8_WAIT_V
#undef PG8_WAIT_L
#undef PG8_BAR
#undef PG8_SCHED
}
}

#define XB_TMO      128
#define XB_XCNT(j)  (256  + 64 * (j))
#define XB_XSUB(j)  (1280 + 64 * (j))
#define XB_XGEN(j)  (2304 + 64 * (j))
#define XB_TOP      3328
#define XB_TOPGEN   3392
#define XCD_BAR_WORDS 3456
#define XB_SPIN_CAP (1u << 18)

__device__ __forceinline__ unsigned xb_ld(unsigned* p)              { return __hip_atomic_load(p, __ATOMIC_RELAXED, __HIP_MEMORY_SCOPE_AGENT); }
__device__ __forceinline__ unsigned xb_add(unsigned* p, unsigned v) { return __hip_atomic_fetch_add(p, v, __ATOMIC_RELAXED, __HIP_MEMORY_SCOPE_AGENT); }
__device__ __forceinline__ unsigned xb_xcc_id() { return (unsigned)__builtin_amdgcn_s_getreg((3 << 11) | 20) & 0xFu; }
#define XB_SPIN(cond, bar) do { unsigned _sp = 0; while (cond) { __builtin_amdgcn_s_sleep(1); \
    if ((++_sp & 255u) == 0u) { if (xb_ld(&(bar)[XB_TMO])) break; if (_sp > XB_SPIN_CAP) { atomicAdd(&(bar)[XB_TMO], 1u); break; } } } } while (0)

struct XcdBarrier {
    unsigned* bar; unsigned x; int wave;
    volatile LAS unsigned* st;
};

__device__ __forceinline__ XcdBarrier xcd_barrier_post(unsigned* bar, volatile LAS unsigned* st) {
    XcdBarrier b; b.bar = bar; b.x = xb_xcc_id(); b.st = st; b.wave = __builtin_amdgcn_readfirstlane(threadIdx.x >> 6);
    if (threadIdx.x == 0) (void)xb_add(&bar[XB_XCNT(b.x)], 1u);
    return b;
}
__device__ __forceinline__ void xcd_barrier_complete(unsigned* bar, unsigned x, unsigned& nloc, unsigned& nx) {
    const unsigned G = gridDim.x * gridDim.y * gridDim.z;
    unsigned sum, cnt, mine, sp = 0u;
    for (;;) {
        sum = 0u; cnt = 0u; mine = 0u;
#pragma unroll
        for (unsigned j = 0; j < 16; ++j) { const unsigned c = xb_ld(&bar[XB_XCNT(j)]); sum += c; cnt += (c > 0u) ? 1u : 0u; mine = (j == x) ? c : mine; }
        if (sum == G) break;
        __builtin_amdgcn_s_sleep(1);
        if ((++sp & 255u) == 0u) { if (xb_ld(&bar[XB_TMO])) break; if (sp > XB_SPIN_CAP) { atomicAdd(&bar[XB_TMO], 1u); break; } }
    }
    nloc = mine > 0u ? mine : 1u; nx = cnt > 0u ? cnt : 1u;
}

__device__ __forceinline__ void xcd_barrier(const XcdBarrier& b) {
    asm volatile("s_waitcnt vmcnt(0)" ::: "memory");
    __syncthreads();
    if (b.wave == 0 && fresh_lane() == 0) {
        unsigned* bar = b.bar;
        __builtin_amdgcn_s_waitcnt(0);
        unsigned nloc = b.st[0], nx = b.st[1];
        if (nloc == 0u) { xcd_barrier_complete(bar, b.x, nloc, nx); b.st[0] = nloc; b.st[1] = nx; }
        const unsigned old = xb_add(&bar[XB_XSUB(b.x)], 1u);
        const unsigned gen = old / nloc;
        if (old + 1u == (gen + 1u) * nloc) {
            __builtin_amdgcn_fence(__ATOMIC_RELEASE, "agent");
            asm volatile("s_waitcnt vmcnt(0)" ::: "memory");
            const unsigned og = xb_add(&bar[XB_TOP], 1u);
            const unsigned tg = og / nx;
            if (og + 1u == (tg + 1u) * nx) xb_add(&bar[XB_TOPGEN], 1u);
            else XB_SPIN(xb_ld(&bar[XB_TOPGEN]) == tg, bar);
            __builtin_amdgcn_fence(__ATOMIC_ACQUIRE, "agent");
            xb_add(&bar[XB_XGEN(b.x)], 1u);
            asm volatile("s_waitcnt vmcnt(0)" ::: "memory");
        } else {
            XB_SPIN(xb_ld(&bar[XB_XGEN(b.x)]) == gen, bar);
            __builtin_amdgcn_fence(__ATOMIC_ACQUIRE, "agent");
            asm volatile("s_waitcnt vmcnt(0)" ::: "memory");
        }
    }
    __syncthreads();
}

constexpr size_t MiB = 1u << 20;
constexpr size_t WS_CTL = 0, CTL_ZERO_BYTES = 1 * MiB;
constexpr size_t WS_UB   = 1 * MiB;
constexpr size_t WS_VT   = WS_UB + 128 * MiB;
constexpr size_t WS_WBAT = WS_VT + 128 * MiB;
constexpr size_t WS_WBBT = WS_WBAT + 16 * MiB;
constexpr size_t WS_WOT  = WS_WBBT + 16 * MiB;
constexpr size_t WS_W4T  = WS_WOT + 32 * MiB;
constexpr size_t WS_WPLT = WS_W4T + 48 * MiB;
constexpr size_t WS_PB   = WS_WPLT + 2 * MiB;
constexpr size_t WS_XB   = WS_PB + 4 * MiB;
constexpr size_t WS_E    = WS_XB + 64 * MiB;
constexpr size_t WS_F    = WS_E + 148 * MiB;
constexpr size_t WS_QA   = WS_F + 128 * MiB;
constexpr size_t WS_QIDX = WS_QA + 32 * MiB;
constexpr size_t WS_QB   = WS_QIDX + 32 * MiB;
constexpr size_t WS_KB   = WS_QB + 32 * MiB;
constexpr size_t WS_VB   = WS_KB + 32 * MiB;
constexpr size_t WS_OB   = WS_VB + 32 * MiB;
constexpr size_t WS_CKV  = WS_OB + 32 * MiB;
constexpr size_t WS_SM   = WS_CKV + 8 * MiB;
constexpr size_t WS_CKVN = WS_SM + 8 * MiB;
constexpr size_t WS_CUM  = WS_CKVN + 4 * MiB;
constexpr size_t WS_PL   = WS_CUM + 1 * MiB;
constexpr size_t WS_WUKB = WS_PL + 128 * MiB;
constexpr size_t WS_WUVT = WS_WUKB + 1 * MiB;
constexpr size_t WS_KIDXB = WS_WUVT + 1 * MiB;
constexpr size_t WS_SCL = WS_KIDXB + 1 * MiB;
constexpr size_t WS_END  = WS_SCL + 1 * MiB;
constexpr size_t WS_PART = WS_UB + 64 * MiB;
constexpr size_t WS_X8   = WS_VT + 32 * MiB;
constexpr size_t WS_W18  = WS_E;
constexpr size_t WS_W48  = WS_VT + 64 * MiB;
constexpr size_t WS_WIDX = WS_SM;
constexpr size_t WS_QLAT = WS_E, WS_OLAT = WS_E + 64 * MiB;
static_assert(WS_END <= (size_t)1174 * MiB, "d_ws map");
constexpr int CW_BAR = 4096;

constexpr int NWAVES = 8, NTHREADS = 512;
constexpr int LDS_BYTES = 147456;
constexpr int LDSCTL_OFF = LDS_BYTES - 256;

typedef float f32x16 __attribute__((ext_vector_type(16)));
typedef short s16x4 __attribute__((ext_vector_type(4)));
template <int K>
__device__ __forceinline__ void small_gemm_tile(const bf16* A, int lda, const bf16* Bt, int ldb, bf16* C, int ldc, int lane, unsigned char* C8 = nullptr, float sc8 = 1.0f) {
    const int r = lane & 15, g = lane >> 4;
    f32x4 acc[4][4];
#pragma unroll
    for (int a = 0; a < 4; ++a)
#pragma unroll
        for (int b = 0; b < 4; ++b) acc[a][b] = (f32x4){0.f, 0.f, 0.f, 0.f};
    const bf16* ap = A + (size_t)r * lda + 8 * g; const bf16* bp = Bt + (size_t)r * ldb + 8 * g;
#pragma unroll 2
    for (int s = 0; s < K / 32; ++s) {
        bf16x8 af[4], bfr[4];
#pragma unroll
        for (int i = 0; i < 4; ++i) { af[i] = *(const bf16x8*)(ap + (size_t)(16 * i) * lda + 32 * s); bfr[i] = *(const bf16x8*)(bp + (size_t)(16 * i) * ldb + 32 * s); }
#pragma unroll
        for (int ni = 0; ni < 4; ++ni)
#pragma unroll
            for (int ti = 0; ti < 4; ++ti) acc[ni][ti] = __builtin_amdgcn_mfma_f32_16x16x32_bf16(bfr[ni], af[ti], acc[ni][ti], 0, 0, 0);
    }
#pragma unroll
    for (int ni = 0; ni < 4; ++ni)
#pragma unroll
        for (int ti = 0; ti < 4; ++ti) {
            if (C8) { *(unsigned*)(C8 + (size_t)(16 * ti + r) * ldc + 16 * ni + 4 * g) = pk_q8x4(acc[ni][ti][0], acc[ni][ti][1], acc[ni][ti][2], acc[ni][ti][3], sc8); continue; }
            u32x2 wv; wv.x = pk2(acc[ni][ti][0], acc[ni][ti][1]); wv.y = pk2(acc[ni][ti][2], acc[ni][ti][3]);
            *(u32x2*)(C + (size_t)(16 * ti + r) * ldc + 16 * ni + 4 * g) = wv; }
}
__device__ __forceinline__ bf16x8 ld8_f32_bf16(const float* p) { const f32x4 a = *(const f32x4*)p, b = *(const f32x4*)(p + 4); union { bf16x8 v; unsigned u[4]; } r; r.u[0] = pk2(a[0], a[1]); r.u[1] = pk2(a[2], a[3]); r.u[2] = pk2(b[0], b[1]); r.u[3] = pk2(b[2], b[3]); return r.v; }
template <int K>
__device__ __forceinline__ void small_gemm_tile_f32(const float* A, int lda, const float* Bt, int ldb, bf16* C, int ldc, int lane, unsigned char* C8 = nullptr) {
    const int r = lane & 15, g = lane >> 4;
    f32x4 acc[4][4];
#pragma unroll
    for (int a = 0; a < 4; ++a)
#pragma unroll
        for (int b = 0; b < 4; ++b) acc[a][b] = (f32x4){0.f, 0.f, 0.f, 0.f};
    const float* ap = A + (size_t)r * lda + 8 * g; const float* bp = Bt + (size_t)r * ldb + 8 * g;
#pragma unroll 1
    for (int s = 0; s < K / 32; ++s) {
        bf16x8 af[4], bfr[4];
#pragma unroll
        for (int i = 0; i < 4; ++i) { af[i] = ld8_f32_bf16(ap + (size_t)(16 * i) * lda + 32 * s); bfr[i] = ld8_f32_bf16(bp + (size_t)(16 * i) * ldb + 32 * s); }
#pragma unroll
        for (int ni = 0; ni < 4; ++ni)
#pragma unroll
            for (int ti = 0; ti < 4; ++ti) acc[ni][ti] = __builtin_amdgcn_mfma_f32_16x16x32_bf16(bfr[ni], af[ti], acc[ni][ti], 0, 0, 0);
    }
#pragma unroll
    for (int ni = 0; ni < 4; ++ni)
#pragma unroll
        for (int ti = 0; ti < 4; ++ti) { u32x2 wv; wv.x = pk2(acc[ni][ti][0], acc[ni][ti][1]); wv.y = pk2(acc[ni][ti][2], acc[ni][ti][3]);
            *(u32x2*)(C + (size_t)(16 * ti + r) * ldc + 16 * ni + 4 * g) = wv;
            if (C8) *(unsigned*)(C8 + (size_t)(16 * ti + r) * ldc + 16 * ni + 4 * g) = pk_q8x4(acc[ni][ti][0], acc[ni][ti][1], acc[ni][ti][2], acc[ni][ti][3], Q8_W); }
}
struct Args { const float* in[23]; float* out; unsigned char* ws; int ph_lo, ph_hi, li, pad; };
enum InIdx { I_X = 0, I_P, I_WIN, I_BFORGET, I_GLAT, I_WUK, I_WUV, I_WBA, I_WBB, I_WGATE, I_BGATE, I_WOUT, I_LN1G, I_LN1B, I_PWQ, I_PSUB, I_PU, I_PV, I_WPLE, I_WPG, I_BPG, I_LN2G, I_LN2B };

struct Frame {
    LAS unsigned char* lds;
    int tid, lane, wave, G, bid;
};
#define KARGQ ((const __attribute__((address_space(4))) unsigned long long*)__builtin_amdgcn_kernarg_segment_ptr())
#define INP(i) ((const float*)(const GAS float*)KARGQ[(i)])
#define OUTP() ((float*)(GAS float*)KARGQ[23])
#define WSB() ((unsigned char*)(GAS unsigned char*)KARGQ[24])
#define WSP(T, off) ((T*)(WSB() + (off)))

__device__ __forceinline__ void transpose_item(const float* W, int ldw, int src_col, int ncols, int k0, bf16* WT, int K, int dst_row0, LAS float* scr, int lane) {
    const int c = lane & 31;
    float tmp[32];
    const float* wp = W + (size_t)(k0 + (lane >> 5)) * ldw + src_col + c;
#pragma unroll
    for (int i = 0; i < 32; ++i) tmp[i] = (c < ncols) ? wp[(size_t)(2 * i) * ldw] : 0.f;
#pragma unroll
    for (int i = 0; i < 32; ++i) scr[(2 * i + (lane >> 5)) * 33 + c] = tmp[i];
    LDS_WAIT();
    const int c8 = lane & 7;
#pragma unroll
    for (int j = 0; j < 4; ++j) { const int n = (lane >> 3) + 8 * j; const LAS float* s = scr + (8 * c8) * 33 + n;
        u32x4 o; o.x = pk2(s[0 * 33], s[1 * 33]); o.y = pk2(s[2 * 33], s[3 * 33]); o.z = pk2(s[4 * 33], s[5 * 33]); o.w = pk2(s[6 * 33], s[7 * 33]);
        *(u32x4*)(WT + (size_t)(dst_row0 + n) * K + k0 + 8 * c8) = o; }
    LDS_WAIT();
}
__device__ __forceinline__ void transpose_item_q8(const float* W, int ldw, int src_col, int k0, unsigned char* WT8, int K, int dst_row0, float sc, LAS float* scr, int lane) {
    const int c = lane & 31;
    float tmp[32];
    const float* wp = W + (size_t)(k0 + (lane >> 5)) * ldw + src_col + c;
#pragma unroll
    for (int i = 0; i < 32; ++i) tmp[i] = wp[(size_t)(2 * i) * ldw];
#pragma unroll
    for (int i = 0; i < 32; ++i) scr[(2 * i + (lane >> 5)) * 33 + c] = tmp[i];
    LDS_WAIT();
    const int c8 = lane & 7;
#pragma unroll
    for (int j = 0; j < 4; ++j) { const int n = (lane >> 3) + 8 * j; const LAS float* s = scr + (8 * c8) * 33 + n;
        u32x2 o; o.x = pk_q8x4(s[0 * 33], s[1 * 33], s[2 * 33], s[3 * 33], sc); o.y = pk_q8x4(s[4 * 33], s[5 * 33], s[6 * 33], s[7 * 33], sc);
        *(u32x2*)(WT8 + (size_t)(dst_row0 + n) * K + k0 + 8 * c8) = o; }
    LDS_WAIT();
}
__device__ __forceinline__ void cvt_bf16_stream(const float* src, bf16* dst, size_t n8, size_t gt, size_t gstride) {
    size_t i = gt;
    for (; i + 3 * gstride < n8; i += 4 * gstride) {
        f32x4 a[4], b[4];
#pragma unroll
        for (int u = 0; u < 4; ++u) { a[u] = *(const f32x4*)(src + (i + u * gstride) * 8); b[u] = *(const f32x4*)(src + (i + u * gstride) * 8 + 4); }
#pragma unroll
        for (int u = 0; u < 4; ++u) { u32x4 o; o.x = pk2(a[u][0], a[u][1]); o.y = pk2(a[u][2], a[u][3]); o.z = pk2(b[u][0], b[u][1]); o.w = pk2(b[u][2], b[u][3]); *(u32x4*)(dst + (i + u * gstride) * 8) = o; } }
    for (; i < n8; i += gstride) { const f32x4 a = *(const f32x4*)(src + i * 8), b = *(const f32x4*)(src + i * 8 + 4);
        u32x4 o; o.x = pk2(a[0], a[1]); o.y = pk2(a[2], a[3]); o.z = pk2(b[0], b[1]); o.w = pk2(b[2], b[3]); *(u32x4*)(dst + i * 8) = o; }
}
__device__ __forceinline__ void p0_prologue(Frame& F) {
    LAS float* scr = (LAS float*)(F.lds + F.wave * 16384);
    const int gw = F.bid * NWAVES + F.wave, NGW = F.G * NWAVES;
    const float* w_in = INP(I_WIN); const float* w_gate = INP(I_WGATE);
    constexpr int NDB1 = N1 / 32, I_1 = NDB1 * 64;
    constexpr int I_BA = 128 * 32, I_BB = I_BA, I_O = 128 * 64, I_4 = 128 * 64, I_PL = 128 * 4;
    constexpr int NITEMS = I_1 + I_BA + I_BB + I_O + I_4 + I_PL;
    for (int it = gw; it < NITEMS; it += NGW) {
        int r = it;
        if (r < I_1) { const int kb = r / NDB1, db = r % NDB1; const float* W; int ldw, col, nc;
            if (db < 576) {
                if (db < 64) { W = w_in; ldw = IN_WIDTH; col = db * 32; }
                else if (db < 128) { W = w_in; ldw = IN_WIDTH; col = 2304 + (db - 64) * 32; }
                else if (db < 320) { W = w_in; ldw = IN_WIDTH; col = 4448 + (db - 128) * 32; }
                else { W = w_gate; ldw = 8192; col = (db - 320) * 32; }
                transpose_item_q8(W, ldw, col, kb * 64, WSP(unsigned char, WS_W18), 4096, db * 32, Q8_W, scr, F.lane); continue; }
            else if (db < 584) { W = w_in; ldw = IN_WIDTH; col = 2048 + (db - 576) * 32; nc = 32; }
            else { const int j = db - 584; W = w_in; ldw = IN_WIDTH; col = (j < 2) ? 4352 + 32 * j : (j == 2 ? 4416 : 10592); nc = (j < 3) ? 32 : (j == 3 ? 16 : 0); }
            transpose_item(W, ldw, col, nc, kb * 64, WSP(bf16, WS_E), 4096, db * 32, scr, F.lane); continue; }
        r -= I_1;
        if (r < I_BA) { const int kb = r / 128, db = r % 128; transpose_item_q8(INP(I_WBA), 4096, db * 32, kb * 64, WSP(unsigned char, WS_WBAT), 2048, db * 32, Q8_WB, scr, F.lane); continue; }
        r -= I_BA;
        if (r < I_BB) { const int kb = r / 128, db = r % 128; transpose_item_q8(INP(I_WBB), 4096, db * 32, kb * 64, WSP(unsigned char, WS_WBBT), 2048, db * 32, Q8_WB, scr, F.lane); continue; }
        r -= I_BB;
        if (r < I_O) { const int kb = r / 128, db = r % 128; transpose_item_q8(INP(I_WOUT), 4096, db * 32, kb * 64, WSP(unsigned char, WS_WOT), 4096, db * 32, Q8_WO, scr, F.lane); continue; }
        r -= I_O;
        if (r < I_4) { const int kb = r / 128, db = r % 128;
            transpose_item_q8(INP(I_WPG), 4096, db * 32, kb * 64, WSP(unsigned char, WS_W48), 4096, 2048 + db * 32, Q8_W, scr, F.lane); continue; }
        r -= I_4;
        { const int kb = r / 128, db = r % 128; transpose_item(INP(I_WPLE), 4096, db * 32, 32, kb * 64, WSP(bf16, WS_WPLT), 256, db * 32, scr, F.lane); }
    }
    for (int it = gw; it < 16 * 2 * 64; it += NGW) { const int dt = it & 63, nt = (it >> 6) & 1, l = it >> 7;
        small_gemm_tile_f32<128>(INP(I_PSUB) + (size_t)(l * 128 + nt * 64) * 128, 128, INP(I_PWQ) + (size_t)(dt * 64) * 2048 + (l >> 1) * 256 + (l & 1) * 128, 2048,
                                 WSP(bf16, WS_W4T) + (size_t)(l * 128 + nt * 64) * 4096 + dt * 64, 4096, F.lane, WSP(unsigned char, WS_W48) + (size_t)(l * 128 + nt * 64) * 4096 + dt * 64); }
    const size_t gt = (size_t)F.bid * NTHREADS + F.tid, gs = (size_t)F.G * NTHREADS;
    { const float* src = INP(I_X); bf16* dst = WSP(bf16, WS_XB); unsigned char* d8 = WSP(unsigned char, WS_X8); const size_t n8 = (size_t)NTOK * D_MODEL / 8;
      for (size_t i = gt; i < n8; i += 4 * gs) {
          if (i + 3 * gs >= n8) { for (size_t j = i; j < n8; j += gs) { const f32x4 a = *(const f32x4*)(src + j * 8), b = *(const f32x4*)(src + j * 8 + 4);
                  u32x4 o; o.x = pk2(a[0], a[1]); o.y = pk2(a[2], a[3]); o.z = pk2(b[0], b[1]); o.w = pk2(b[2], b[3]); *(u32x4*)(dst + j * 8) = o;
                  u32x2 q; q.x = pk_q8x4(a[0], a[1], a[2], a[3], Q8_ACT); q.y = pk_q8x4(b[0], b[1], b[2], b[3], Q8_ACT); *(u32x2*)(d8 + j * 8) = q; } break; }
          f32x4 a[4], b[4];
#pragma unroll
          for (int u = 0; u < 4; ++u) { a[u] = *(const f32x4*)(src + (i + u * gs) * 8); b[u] = *(const f32x4*)(src + (i + u * gs) * 8 + 4); }
#pragma unroll
          for (int u = 0; u < 4; ++u) { u32x4 o; o.x = pk2(a[u][0], a[u][1]); o.y = pk2(a[u][2], a[u][3]); o.z = pk2(b[u][0], b[u][1]); o.w = pk2(b[u][2], b[u][3]); *(u32x4*)(dst + (i + u * gs) * 8) = o;
              u32x2 q; q.x = pk_q8x4(a[u][0], a[u][1], a[u][2], a[u][3], Q8_ACT); q.y = pk_q8x4(b[u][0], b[u][1], b[u][2], b[u][3], Q8_ACT); *(u32x2*)(d8 + (i + u * gs) * 8) = q; } } }
    cvt_bf16_stream(INP(I_P), WSP(bf16, WS_PB), (size_t)NTOK * D_PLE / 8, gt, gs);
    { float* SCL = WSP(float, WS_SCL);
#define TBL_SRC(row) (((row) >= N_EXPERTS ? INP(I_PV) + (size_t)((row) - N_EXPERTS) * 4096 : INP(I_PU) + (size_t)(row) * 4096))
#define TBL_LOAD(V, row) { const float* src_ = TBL_SRC(row); _Pragma("unroll") for (int jj = 0; jj < 2; ++jj) _Pragma("unroll") for (int q = 0; q < 8; ++q) V[8 * jj + q] = *(const f32x4*)(src_ + (jj * 64 + F.lane) * 32 + 4 * q); }
#define TBL_EMIT(V, row) { const int tb_ = (row) >= N_EXPERTS ? 1 : 0, e_ = (row) - tb_ * N_EXPERTS; unsigned char* dst_ = (tb_ ? WSP(unsigned char, WS_VT) : WSP(unsigned char, WS_UB)) + (size_t)e_ * 2048; float ssq = 0.f; \
          _Pragma("unroll") for (int i = 0; i < 16; ++i) ssq += (V[i][0] * V[i][0] + V[i][1] * V[i][1]) + (V[i][2] * V[i][2] + V[i][3] * V[i][3]); \
          const float sig = sqrtf(wave_sum(ssq) * (1.0f / 4096.0f)); const float inv = sig > 0.f ? 2.1f / sig : 0.f; \
          _Pragma("unroll") for (int jj = 0; jj < 2; ++jj) { u32x4 o; \
              _Pragma("unroll") for (int i = 0; i < 4; ++i) { const f32x4 a = V[8 * jj + 2 * i] * inv, b = V[8 * jj + 2 * i + 1] * inv; unsigned p = 0u; \
                  p = __builtin_amdgcn_cvt_scalef32_pk_fp4_f32(p, a[0], a[1], 1.0f, 0); p = __builtin_amdgcn_cvt_scalef32_pk_fp4_f32(p, a[2], a[3], 1.0f, 1); \
                  p = __builtin_amdgcn_cvt_scalef32_pk_fp4_f32(p, b[0], b[1], 1.0f, 2); p = __builtin_amdgcn_cvt_scalef32_pk_fp4_f32(p, b[2], b[3], 1.0f, 3); o[i] = p; } \
              *(u32x4*)(dst_ + (jj * 64 + F.lane) * 16) = o; } \
          if (F.lane == 0) SCL[row] = sig > 0.f ? sig * (1.0f / 2.1f) : 1.0f; }
      f32x4 va[16], vb[16];
      int row = gw;
      if (row < 2 * N_EXPERTS) TBL_LOAD(va, row)
      for (; row < 2 * N_EXPERTS; row += 2 * NGW) {
          const int r1 = row + NGW, r2 = row + 2 * NGW;
          if (r1 < 2 * N_EXPERTS) TBL_LOAD(vb, r1)
          __builtin_amdgcn_sched_barrier(0);
          TBL_EMIT(va, row)
          __builtin_amdgcn_sched_barrier(0);
          if (r2 < 2 * N_EXPERTS) TBL_LOAD(va, r2)
          __builtin_amdgcn_sched_barrier(0);
          if (r1 < 2 * N_EXPERTS) TBL_EMIT(vb, r1)
          __builtin_amdgcn_sched_barrier(0);
      }
#undef TBL_SRC
#undef TBL_LOAD
#undef TBL_EMIT
    }
    { const float* w_uk = INP(I_WUK); const float* w_uv = INP(I_WUV); bf16* WUKB = WSP(bf16, WS_WUKB); bf16* WUVT = WSP(bf16, WS_WUVT);
      for (size_t i = gt; i < 65536; i += gs) { const int d8 = (int)(i & 15), c = (int)(i >> 4) & 255, h = (int)(i >> 12);
          const float* src = w_uk + (size_t)c * 2048 + h * 128 + d8 * 8; const f32x4 a = *(const f32x4*)src, b = *(const f32x4*)(src + 4);
          u32x4 o; o.x = pk2(a[0], a[1]); o.y = pk2(a[2], a[3]); o.z = pk2(b[0], b[1]); o.w = pk2(b[2], b[3]); *(u32x4*)(WUKB + i * 8) = o; }
      for (size_t i = gt; i < 65536; i += gs) { const int c8 = (int)(i & 31), d = (int)(i >> 5) & 127, h = (int)(i >> 12);
          const float* src = w_uv + (size_t)(c8 * 8) * 2048 + h * 128 + d;
          u32x4 o; o.x = pk2(src[0], src[2048]); o.y = pk2(src[2 * 2048], src[3 * 2048]); o.z = pk2(src[4 * 2048], src[5 * 2048]); o.w = pk2(src[6 * 2048], src[7 * 2048]); *(u32x4*)(WUVT + i * 8) = o; } }
}

__device__ __forceinline__ f32x4 part_sum4(const float* PART, int tile, size_t off) { const size_t pl = (size_t)NTOK * 256; const float* p = PART + (size_t)tile * pl + off;
    return (*(const f32x4*)p + *(const f32x4*)(p + 2 * pl)) + (*(const f32x4*)(p + 4 * pl) + *(const f32x4*)(p + 6 * pl)); }
__device__ __forceinline__ float log_sigmoid(float z) { return fminf(z, 0.f) - log1pf(__expf(-fabsf(z))); }
__device__ __forceinline__ void p2_small(Frame& F) {
    const int gw = F.bid * NWAVES + F.wave, NGW = F.G * NWAVES, lane = F.lane;
    { const float* PART = WSP(float, WS_PART); bf16* CKVN = WSP(bf16, WS_CKVN); const f32x4 g = *(const f32x4*)(INP(I_GLAT) + 4 * lane);
      for (int t = gw; t < NTOK; t += NGW) { const f32x4 v = part_sum4(PART, 0, (size_t)t * 256 + 4 * lane);
          const float ss = wave_sum(v[0] * v[0] + v[1] * v[1] + v[2] * v[2] + v[3] * v[3]); const float r = 1.0f / sqrtf(ss * (1.0f / 256.0f) + LN_EPS);
          u32x2 o; o.x = pk2(v[0] * r * g[0], v[1] * r * g[1]); o.y = pk2(v[2] * r * g[2], v[3] * r * g[3]); *(u32x2*)(CKVN + (size_t)t * 256 + 4 * lane) = o; } }
    { const float* PART = WSP(float, WS_PART); float* CUML = WSP(float, WS_CUM); float* SEGT = WSP(float, WS_CUM + 512 * 1024); const float* bfp = INP(I_BFORGET);
      for (int it = gw; it < BATCH * (SEQ / 64); it += NGW) { const int b = it / (SEQ / 64), seg = it % (SEQ / 64), pos = seg * 64 + lane;
          f32x4 f[4];
#pragma unroll
          for (int q = 0; q < 4; ++q) f[q] = part_sum4(PART, 1, (size_t)(b * SEQ + pos) * 256 + 96 + 4 * q);
#pragma unroll
          for (int h = 0; h < B_HEADS; ++h) { float v = log_sigmoid(f[h >> 2][h & 3] + bfp[h]);
#pragma unroll
              for (int o = 1; o < 64; o <<= 1) { const float t = __shfl_up(v, o); if (lane >= o) v += t; }
              CUML[(size_t)(b * B_HEADS + h) * SEQ + pos] = v; if (lane == 63) SEGT[(b * B_HEADS + h) * (SEQ / 64) + seg] = v; } } }
    { const bf16* QA = WSP(bf16, WS_QA); bf16* QLAT = WSP(bf16, WS_QLAT); const bf16* WUKB = WSP(bf16, WS_WUKB);
      for (int it = gw; it < (NTOK / 64) * A_HEADS * 4; it += NGW) { const int ct = it & 3, h = (it >> 2) & 15, tt = it >> 6;
          small_gemm_tile<128>(QA + (size_t)tt * 64 * 2048 + h * 128, 2048, WUKB + (size_t)(h * 256 + ct * 64) * 128, 128, QLAT + (size_t)tt * 64 * 4096 + h * 256 + ct * 64, 4096, lane); } }
    { const float* PART = WSP(float, WS_PART); bf16* KIDXB = WSP(bf16, WS_KIDXB); float* WIDX = WSP(float, WS_WIDX); const size_t gt = (size_t)F.bid * NTHREADS + F.tid, gs = (size_t)F.G * NTHREADS;
      for (size_t i = gt; i < (size_t)NTOK * 8; i += gs) { const size_t t = i >> 3; const int q = (int)(i & 7); *(f32x4*)(WIDX + t * 32 + 4 * q) = part_sum4(PART, 1, t * 256 + 64 + 4 * q); }
      for (size_t i = gt; i < (size_t)NTOK * 8; i += gs) { const size_t t = i >> 3; const int c8 = (int)(i & 7); const f32x4 a = part_sum4(PART, 1, t * 256 + c8 * 8), b = part_sum4(PART, 1, t * 256 + c8 * 8 + 4);
          u32x4 o; o.x = pk2(a[0], a[1]); o.y = pk2(a[2], a[3]); o.z = pk2(b[0], b[1]); o.w = pk2(b[2], b[3]);
          const size_t tl = t & (SEQ - 1); *(u32x4*)(KIDXB + (t - tl) * 64 + (tl >> 5) * 2048 + (c8 >> 1) * 512 + (tl & 31) * 16 + (c8 & 1) * 8) = o; } }
}

__device__ __forceinline__ unsigned f2key(float f) { const unsigned b = __builtin_bit_cast(unsigned, f); return (b & 0x80000000u) ? ~b : (b | 0x80000000u); }
__device__ __forceinline__ int lanes_below(unsigned long long m) { return (int)__builtin_amdgcn_mbcnt_hi((unsigned)(m >> 32), __builtin_amdgcn_mbcnt_lo((unsigned)m, 0u)); }
__device__ __forceinline__ void p4_oa(Frame& F) {
    const int gw = F.bid * NWAVES + F.wave, NGW = F.G * NWAVES, lane = F.lane;
    const bf16* OLAT = WSP(bf16, WS_OLAT); bf16* OA = WSP(bf16, WS_QA); const bf16* WUVT = WSP(bf16, WS_WUVT);
    for (int it = gw; it < (NTOK / 64) * A_HEADS * 2; it += NGW) { const int dt = it & 1, h = (it >> 1) & 15, tt = it >> 5;
        small_gemm_tile<256>(OLAT + (size_t)tt * 64 * 4096 + h * 256, 4096, WUVT + (size_t)(h * 128 + dt * 64) * 256, 256, nullptr, 2048, lane, (unsigned char*)OA + (size_t)tt * 64 * 2048 + h * 128 + dt * 64, Q8_O); }
}
__device__ __forceinline__ void p7_ln1(Frame& F) {
    const int gw = F.bid * NWAVES + F.wave, NGW = F.G * NWAVES, lane = F.lane;
    const bf16* Y1 = WSP(bf16, WS_E); bf16* H1B = WSP(bf16, WS_XB); unsigned char* H18 = WSP(unsigned char, WS_X8); const float* g = INP(I_LN1G); const float* bb = INP(I_LN1B);
    for (int t = gw; t < NTOK; t += NGW) { const bf16* yr = Y1 + (size_t)t * 4096;
        f32x4 v[16]; float s = 0.f;
#pragma unroll
        for (int j = 0; j < 8; ++j) { const u32x4 w = *(const u32x4*)(yr + (j * 64 + lane) * 8); v[2 * j] = (f32x4){bflo(w.x), bfhi(w.x), bflo(w.y), bfhi(w.y)}; v[2 * j + 1] = (f32x4){bflo(w.z), bfhi(w.z), bflo(w.w), bfhi(w.w)};
            s += (v[2 * j][0] + v[2 * j][1]) + (v[2 * j][2] + v[2 * j][3]) + (v[2 * j + 1][0] + v[2 * j + 1][1]) + (v[2 * j + 1][2] + v[2 * j + 1][3]); }
        const float mean = wave_sum(s) * (1.0f / 4096.0f); float q = 0.f;
#pragma unroll
        for (int j = 0; j < 16; ++j) { v[j] = v[j] - mean; q += (v[j][0] * v[j][0] + v[j][1] * v[j][1]) + (v[j][2] * v[j][2] + v[j][3] * v[j][3]); }
        const float rstd = 1.0f / sqrtf(wave_sum(q) * (1.0f / 4096.0f) + LN_EPS);
#pragma unroll
        for (int j = 0; j < 8; ++j) { const int off = (j * 64 + lane) * 8; const f32x4 g0 = *(const f32x4*)(g + off), g1 = *(const f32x4*)(g + off + 4), b0 = *(const f32x4*)(bb + off), b1 = *(const f32x4*)(bb + off + 4);
            const f32x4 o0 = v[2 * j] * rstd * g0 + b0, o1 = v[2 * j + 1] * rstd * g1 + b1;
            u32x4 w; w.x = pk2(o0[0], o0[1]); w.y = pk2(o0[2], o0[3]); w.z = pk2(o1[0], o1[1]); w.w = pk2(o1[2], o1[3]); *(u32x4*)(H1B + (size_t)t * 4096 + off) = w;
            u32x2 q8; q8.x = pk_q8x4(o0[0], o0[1], o0[2], o0[3], Q8_ACT); q8.y = pk_q8x4(o1[0], o1[1], o1[2], o1[3], Q8_ACT); *(u32x2*)(H18 + (size_t)t * 4096 + off) = q8; } }
}
constexpr int FOX_KP = 272, FOX_VP = 320, FOX_VOFF = 17408, FOX_COFF = 37888;
__device__ __forceinline__ void fox_unit(Frame& F, int b, int h, int qb) {
    const int tid = F.tid, lane = F.lane, w = F.wave, r = lane & 31, hh = lane >> 5;
    LAS unsigned char* Ks = F.lds; LAS unsigned char* Vs = F.lds + FOX_VOFF; LAS float* cks = (LAS float*)(F.lds + FOX_COFF);
    const bf16* QB = WSP(bf16, WS_QB); const bf16* KB = WSP(bf16, WS_KB); const bf16* VB = WSP(bf16, WS_VB); bf16* OB = WSP(bf16, WS_OB);
    const float* cum = WSP(float, WS_CUM) + (size_t)(b * B_HEADS + h) * SEQ;
    LAS float* segp = (LAS float*)(F.lds + FOX_COFF + 256);
    const int Q0 = qb * 256, q0 = Q0 + 32 * w, ntiles = (Q0 + 256) / 64, tl = (q0 + 31) / 64;
    const float SC = 0.12751741614123135f, LOG2E = 1.4426950408889634f;
    bf16x8 qf[8];
    { const bf16* qp = QB + ((size_t)b * SEQ + q0 + r) * 2048 + h * 128 + 8 * hh;
#pragma unroll
      for (int s = 0; s < 8; ++s) qf[s] = *(const bf16x8*)(qp + 16 * s); }
    f32x16 o[4];
#pragma unroll
    for (int dt = 0; dt < 4; ++dt)
#pragma unroll
        for (int i = 0; i < 16; ++i) o[dt][i] = 0.f;
    float m = -1e30f, l = 0.f;
    const int pk0 = tid >> 4, pc0 = tid & 15;
    const bf16* kg = KB + ((size_t)b * SEQ + pk0) * 2048 + h * 128 + 8 * pc0; const bf16* vg = VB + ((size_t)b * SEQ + pk0) * 2048 + h * 128 + 8 * pc0;
    u32x4 kr0, kr1, vr0, vr1; float cr = 0.f;
#define FOX_LOAD(kt) do { const size_t go = (size_t)(kt) * 64 * 2048; kr0 = *(const u32x4*)(kg + go); kr1 = *(const u32x4*)(kg + go + 32 * 2048); vr0 = *(const u32x4*)(vg + go); vr1 = *(const u32x4*)(vg + go + 32 * 2048); \
        if (tid < 64) cr = (cum[(kt) * 64 + tid] + segp[(kt)]) * LOG2E; } while (0)
    if (tid < 64) { float v = (lane < 32) ? WSP(float, WS_CUM + 512 * 1024)[(b * B_HEADS + h) * (SEQ / 64) + lane] : 0.f; const float own = v;
#pragma unroll
        for (int o = 1; o < 32; o <<= 1) { const float t = __shfl_up(v, o); if (lane >= o) v += t; }
        if (lane < 32) segp[lane] = v - own;
        CFENCE(); LDS_WAIT(); }
    FOX_LOAD(0);
    const int ka_off = r * FOX_KP + 16 * hh;
    const int vt_off = (4 * hh + ((lane & 15) >> 2)) * FOX_VP + (16 * ((lane >> 4) & 1) + 4 * (lane & 3)) * 2;
    const int ck_off = 4 * hh;
    for (int kt = 0; kt < ntiles; ++kt) {
        __syncthreads();
        *(LAS u32x4*)(Ks + pk0 * FOX_KP + pc0 * 16) = kr0; *(LAS u32x4*)(Ks + (pk0 + 32) * FOX_KP + pc0 * 16) = kr1;
        *(LAS u32x4*)(Vs + pk0 * FOX_VP + pc0 * 16) = vr0; *(LAS u32x4*)(Vs + (pk0 + 32) * FOX_VP + pc0 * 16) = vr1;
        if (tid < 64) cks[tid] = cr;
        __syncthreads();
        if (kt + 1 < ntiles) FOX_LOAD(kt + 1);
        if (kt <= tl) {
            f32x16 s0, s1;
#pragma unroll
            for (int i = 0; i < 16; ++i) { s0[i] = 0.f; s1[i] = 0.f; }
#pragma unroll
            for (int s = 0; s < 8; ++s) { const bf16x8 a0 = *(const LAS bf16x8*)(Ks + ka_off + 32 * s), a1 = *(const LAS bf16x8*)(Ks + ka_off + 32 * FOX_KP + 32 * s);
                s0 = __builtin_amdgcn_mfma_f32_32x32x16_bf16(a0, qf[s], s0, 0, 0, 0); s1 = __builtin_amdgcn_mfma_f32_32x32x16_bf16(a1, qf[s], s1, 0, 0, 0); }
            const bool diag = (64 * kt + 63 > q0); const int qme = q0 + r - 64 * kt;
            float mx = m;
#pragma unroll
            for (int g4 = 0; g4 < 4; ++g4) { const f32x4 c0 = *(const LAS f32x4*)(cks + ck_off + 8 * g4), c1 = *(const LAS f32x4*)(cks + ck_off + 32 + 8 * g4);
#pragma unroll
                for (int i = 0; i < 4; ++i) { const int kl = 8 * g4 + 4 * hh + i; float t0 = s0[4 * g4 + i] * SC - c0[i], t1 = s1[4 * g4 + i] * SC - c1[i];
                    if (diag) { if (kl > qme) t0 = -INFINITY; if (kl + 32 > qme) t1 = -INFINITY; }
                    s0[4 * g4 + i] = t0; s1[4 * g4 + i] = t1; mx = fmaxf(mx, fmaxf(t0, t1)); } }
            mx = fmaxf(mx, __shfl_xor(mx, 32));
            if (__any(mx > m + 8.0f)) {
                const float alpha = __builtin_amdgcn_exp2f(m - mx); m = mx; l *= alpha;
#pragma unroll
                for (int dt = 0; dt < 4; ++dt)
#pragma unroll
                    for (int i = 0; i < 16; ++i) o[dt][i] *= alpha; }
            float ls = 0.f;
            union { bf16x8 v; unsigned u[4]; } pf[4];
#pragma unroll
            for (int ks = 0; ks < 2; ++ks)
#pragma unroll
                for (int j = 0; j < 4; ++j) { const float a0 = __builtin_amdgcn_exp2f(s0[8 * ks + 2 * j] - m), a1 = __builtin_amdgcn_exp2f(s0[8 * ks + 2 * j + 1] - m);
                    const float b0 = __builtin_amdgcn_exp2f(s1[8 * ks + 2 * j] - m), b1 = __builtin_amdgcn_exp2f(s1[8 * ks + 2 * j + 1] - m);
                    ls += (a0 + a1) + (b0 + b1); pf[ks].u[j] = pk2(a0, a1); pf[2 + ks].u[j] = pk2(b0, b1); }
            l += ls;
#pragma unroll
            for (int f = 0; f < 4; ++f) {
                const int vb = vt_off + 16 * f * FOX_VP;
#pragma unroll
                for (int dt = 0; dt < 4; ++dt) {
                    const s16x4 x0 = __builtin_amdgcn_ds_read_tr16_b64_v4i16((LAS s16x4*)(Vs + vb + 64 * dt)), x1 = __builtin_amdgcn_ds_read_tr16_b64_v4i16((LAS s16x4*)(Vs + vb + 8 * FOX_VP + 64 * dt));
                    const bf16x8 af = {x0[0], x0[1], x0[2], x0[3], x1[0], x1[1], x1[2], x1[3]};
                    o[dt] = __builtin_amdgcn_mfma_f32_32x32x16_bf16(af, pf[f].v, o[dt], 0, 0, 0); }
                __builtin_amdgcn_sched_barrier(0);
            }
        }
    }
#undef FOX_LOAD
    l += __shfl_xor(l, 32);
    const float inv = 1.0f / l;
    unsigned char* op = (unsigned char*)OB + ((size_t)b * SEQ + q0 + r) * 2048 + h * 128 + 4 * hh;
#pragma unroll
    for (int dt = 0; dt < 4; ++dt)
#pragma unroll
        for (int g4 = 0; g4 < 4; ++g4) *(unsigned*)(op + 32 * dt + 8 * g4) = pk_q8x4(o[dt][4 * g4] * inv, o[dt][4 * g4 + 1] * inv, o[dt][4 * g4 + 2] * inv, o[dt][4 * g4 + 3] * inv, Q8_O);
}
__device__ __forceinline__ void p3_fox(Frame& F) {
    for (int pr = F.bid; pr < BATCH * B_HEADS * 4; pr += F.G) { const int bh = pr >> 2, j = pr & 3, b = bh >> 4, h = bh & 15;
        fox_unit(F, b, h, 7 - j);
        fox_unit(F, b, h, j); }
}
constexpr int DSA_WLDS = 8704;
__device__ __forceinline__ void p3_dsa(Frame& F, int flags) {
    const int gw = F.bid * NWAVES + F.wave, NGW = F.G * NWAVES;
    LAS unsigned char* wb = F.lds + F.wave * DSA_WLDS;
    LAS float* SCb = (LAS float*)wb; LAS unsigned short* IDX = (LAS unsigned short*)(wb + 8192);
    const bf16* QIDX = WSP(bf16, WS_QIDX); const bf16* KIDXB = WSP(bf16, WS_KIDXB); const float* WIDX = WSP(float, WS_WIDX); const bf16* CKVN = WSP(bf16, WS_CKVN); const bf16* QLAT = WSP(bf16, WS_QLAT); bf16* OLAT = WSP(bf16, WS_OLAT);
    const float idx_scale = 0.022097086912079608f, SCL = 0.12751741614123135f  ;
    for (int it = gw; it < NTOK; it += NGW) {
        const int lane = fresh_lane(), r32 = lane & 31, hh = lane >> 5, r16 = lane & 15, g = lane >> 4;
        const int b = it / SEQ, tt = it % SEQ, t = (b & 1) ? (SEQ - 1 - tt) : tt; const size_t row = (size_t)b * SEQ + t; const int chunk_end = (t / CHUNK + 1) * CHUNK;
        if (!(flags & 4)) {
            bf16x8 qi[4];
#pragma unroll
            for (int s = 0; s < 4; ++s) qi[s] = *(const bf16x8*)(QIDX + row * 2048 + r32 * 64 + 16 * s + 8 * hh);
            f32x4 wv[4];
#pragma unroll
            for (int g4 = 0; g4 < 4; ++g4) wv[g4] = *(const f32x4*)(WIDX + row * 32 + 8 * g4 + 4 * hh);
            const bf16* kp = KIDXB + (size_t)b * SEQ * 64 + r32 * 16 + 8 * hh;
            bf16x8 kb[8][4];
#define DSA_SCORE(kbt, tile) do { f32x16 acc; _Pragma("unroll") for (int i = 0; i < 16; ++i) acc[i] = 0.f; \
                _Pragma("unroll") for (int s = 0; s < 4; ++s) acc = __builtin_amdgcn_mfma_f32_32x32x16_bf16(qi[s], kbt[s], acc, 0, 0, 0); \
                float sc = 0.f; _Pragma("unroll") for (int g4 = 0; g4 < 4; ++g4) _Pragma("unroll") for (int i = 0; i < 4; ++i) sc += fmaxf(acc[4 * g4 + i], 0.f) * wv[g4][i]; \
                sc += __shfl_xor(sc, 32); if (lane < 32) SCb[(tile) * 32 + lane] = sc * idx_scale; } while (0)
            const int ntile8 = ((chunk_end + 255) >> 8) << 3;
            for (int t0 = 0; t0 < ntile8; t0 += 8) {
#pragma unroll
                for (int u = 0; u < 8; ++u)
#pragma unroll
                    for (int s = 0; s < 4; ++s) kb[u][s] = *(const bf16x8*)(kp + (size_t)(t0 + u) * 2048 + 512 * s);
#pragma unroll
                for (int u = 0; u < 8; ++u) { DSA_SCORE(kb[u], t0 + u); __builtin_amdgcn_sched_barrier(0); }
            }
#undef DSA_SCORE
        }
        CFENCE(); LDS_WAIT();
        const int nsel = chunk_end < TOPK ? chunk_end : TOPK;
        if (chunk_end <= TOPK || (flags & 8)) { for (int s = lane; s < nsel; s += 64) IDX[s] = (unsigned short)s; }
        else {
            unsigned key[32]; const int nreg = chunk_end >> 6;
#pragma unroll
            for (int i = 0; i < 32; ++i) key[i] = (i < nreg) ? f2key(SCb[i * 64 + lane]) : 0u;
            unsigned T = 0u;
            for (int bit = 31; bit >= 0; --bit) { const unsigned cand = T | (1u << bit); int cnt = 0;
#pragma unroll
                for (int i = 0; i < 32; ++i) cnt += __builtin_popcountll(__ballot(key[i] >= cand));
                if (cnt >= TOPK) { T = cand; if (cnt == TOPK) break; } }
            int cgt = 0;
#pragma unroll
            for (int i = 0; i < 32; ++i) cgt += __builtin_popcountll(__ballot(key[i] > T));
            int rem = TOPK - cgt, base = 0;
#pragma unroll
            for (int i = 0; i < 32; ++i) { const bool gt = key[i] > T, eq = key[i] == T; const unsigned long long meq = __ballot(eq); const bool take = gt || (eq && lanes_below(meq) < rem);
                const unsigned long long msel = __ballot(take); if (take) IDX[base + lanes_below(msel)] = (unsigned short)(i * 64 + lane);
                base += __builtin_popcountll(msel); const int ne = __builtin_popcountll(meq); rem -= (ne < rem ? ne : rem); }
        }
        CFENCE(); LDS_WAIT();
        if (!(flags & 16)) {
            int r16l = r16; asm volatile("" : "+v"(r16l));
            union { bf16x8 v; unsigned short e[8]; } sel0, sel1;
#pragma unroll
            for (int j = 0; j < 8; ++j) { sel0.e[j] = (8 * g + j == r16l) ? 0x3F80 : 0; sel1.e[j] = (8 * g + j == 16 + r16l) ? 0x3F80 : 0; }
            const float slope2 = exp2f(-0.5f * (float)(r16l + 1)) * 1.4426950408889634f;
            bf16x8 ql[8];
#pragma unroll
            for (int s = 0; s < 8; ++s) ql[s] = *(const bf16x8*)(QLAT + row * 4096 + r16 * 256 + 32 * s + 8 * g);
            f32x4 o[16];
#pragma unroll
            for (int ct = 0; ct < 16; ++ct) o[ct] = (f32x4){0.f, 0.f, 0.f, 0.f};
            float m = -1e30f, l = 0.f;
            const bf16* cbase = CKVN + (size_t)b * SEQ * 256 + 8 * g;
            const int nstep = nsel >> 5;
            for (int st = 0; st < nstep; ++st) {
                const int ia = IDX[32 * st + r16], ib = IDX[32 * st + 16 + r16];
                bf16x8 ca[8], cb[8];
#pragma unroll
                for (int s = 0; s < 8; ++s) { ca[s] = *(const bf16x8*)(cbase + (size_t)ia * 256 + 32 * s); cb[s] = *(const bf16x8*)(cbase + (size_t)ib * 256 + 32 * s); }
                f32x4 sa = (f32x4){0.f, 0.f, 0.f, 0.f}, sb = sa;
#pragma unroll
                for (int s = 0; s < 8; ++s) { sa = __builtin_amdgcn_mfma_f32_16x16x32_bf16(ca[s], ql[s], sa, 0, 0, 0); sb = __builtin_amdgcn_mfma_f32_16x16x32_bf16(cb[s], ql[s], sb, 0, 0, 0); }
                const u32x2 ja = *(const LAS u32x2*)(IDX + 32 * st + 4 * g), jb = *(const LAS u32x2*)(IDX + 32 * st + 16 + 4 * g);
                const int da0 = t - (int)(ja.x & 0xffff), da1 = t - (int)(ja.x >> 16), da2 = t - (int)(ja.y & 0xffff), da3 = t - (int)(ja.y >> 16);
                const int db0 = t - (int)(jb.x & 0xffff), db1 = t - (int)(jb.x >> 16), db2 = t - (int)(jb.y & 0xffff), db3 = t - (int)(jb.y >> 16);
                sa[0] = sa[0] * SCL - slope2 * (float)(da0 < 0 ? -da0 : da0); sa[1] = sa[1] * SCL - slope2 * (float)(da1 < 0 ? -da1 : da1);
                sa[2] = sa[2] * SCL - slope2 * (float)(da2 < 0 ? -da2 : da2); sa[3] = sa[3] * SCL - slope2 * (float)(da3 < 0 ? -da3 : da3);
                sb[0] = sb[0] * SCL - slope2 * (float)(db0 < 0 ? -db0 : db0); sb[1] = sb[1] * SCL - slope2 * (float)(db1 < 0 ? -db1 : db1);
                sb[2] = sb[2] * SCL - slope2 * (float)(db2 < 0 ? -db2 : db2); sb[3] = sb[3] * SCL - slope2 * (float)(db3 < 0 ? -db3 : db3);
                float mx = fmaxf(fmaxf(fmaxf(sa[0], sa[1]), fmaxf(sa[2], sa[3])), fmaxf(fmaxf(sb[0], sb[1]), fmaxf(sb[2], sb[3])));
                mx = fmaxf(mx, __shfl_xor(mx, 16)); mx = fmaxf(mx, __shfl_xor(mx, 32));
                float alpha = 1.0f;
                if (__any(mx > m + 8.0f)) { mx = fmaxf(mx, m); alpha = __builtin_amdgcn_exp2f(m - mx); m = mx;
#pragma unroll
                    for (int ct = 0; ct < 16; ++ct) o[ct] *= alpha; }
#pragma unroll
                for (int i = 0; i < 4; ++i) { sa[i] = __builtin_amdgcn_exp2f(sa[i] - m); sb[i] = __builtin_amdgcn_exp2f(sb[i] - m); }
                l = l * alpha + ((sa[0] + sa[1]) + (sa[2] + sa[3])) + ((sb[0] + sb[1]) + (sb[2] + sb[3]));
                union { bf16x8 v; unsigned u[4]; } pf;
                pf.u[0] = pk2(sa[0], sa[1]); pf.u[1] = pk2(sa[2], sa[3]); pf.u[2] = pk2(sb[0], sb[1]); pf.u[3] = pk2(sb[2], sb[3]);
#pragma unroll
                for (int s = 0; s < 8; ++s) {
                    const f32x4 z = (f32x4){0.f, 0.f, 0.f, 0.f};
                    const f32x4 ta0 = __builtin_amdgcn_mfma_f32_16x16x32_bf16(ca[s], sel0.v, z, 0, 0, 0), ta1 = __builtin_amdgcn_mfma_f32_16x16x32_bf16(ca[s], sel1.v, z, 0, 0, 0);
                    const f32x4 tb0 = __builtin_amdgcn_mfma_f32_16x16x32_bf16(cb[s], sel0.v, z, 0, 0, 0), tb1 = __builtin_amdgcn_mfma_f32_16x16x32_bf16(cb[s], sel1.v, z, 0, 0, 0);
                    union { bf16x8 v; unsigned u[4]; } v0, v1;
                    v0.u[0] = pk2(ta0[0], ta0[1]); v0.u[1] = pk2(ta0[2], ta0[3]); v0.u[2] = pk2(tb0[0], tb0[1]); v0.u[3] = pk2(tb0[2], tb0[3]);
                    v1.u[0] = pk2(ta1[0], ta1[1]); v1.u[1] = pk2(ta1[2], ta1[3]); v1.u[2] = pk2(tb1[0], tb1[1]); v1.u[3] = pk2(tb1[2], tb1[3]);
                    o[2 * s] = __builtin_amdgcn_mfma_f32_16x16x32_bf16(v0.v, pf.v, o[2 * s], 0, 0, 0);
                    o[2 * s + 1] = __builtin_amdgcn_mfma_f32_16x16x32_bf16(v1.v, pf.v, o[2 * s + 1], 0, 0, 0);
                }
            }
            l += __shfl_xor(l, 16); l += __shfl_xor(l, 32);
            const float inv = 1.0f / l;
            bf16* op = OLAT + row * 4096 + r16 * 256 + 4 * g;
#pragma unroll
            for (int ct = 0; ct < 16; ++ct) { u32x2 wv; wv.x = pk2(o[ct][0] * inv, o[ct][1] * inv); wv.y = pk2(o[ct][2] * inv, o[ct][3] * inv); *(u32x2*)(op + 16 * ct) = wv; }
        }
        CFENCE(); LDS_WAIT();
    }
}
constexpr int PEER_WLDS = 2048;
typedef int i32x8 __attribute__((ext_vector_type(8)));
typedef __bf16 bf16x2_d __attribute__((ext_vector_type(2)));
__device__ __forceinline__ float dot2bf(unsigned a, unsigned b, float c) { return __builtin_amdgcn_fdot2_f32_bf16(__builtin_bit_cast(bf16x2_d, a), __builtin_bit_cast(bf16x2_d, b), c, false); }
__device__ __forceinline__ f32x4 fp8x4(unsigned w) { const f32x2 lo = __builtin_amdgcn_cvt_pk_f32_fp8((int)w, false), hi = __builtin_amdgcn_cvt_pk_f32_fp8((int)w, true); return (f32x4){lo[0], lo[1], hi[0], hi[1]}; }
__device__ __forceinline__ float fp8dot4(unsigned w, f32x4 x) { const f32x4 f = fp8x4(w); return (f[0] * x[0] + f[1] * x[1]) + (f[2] * x[2] + f[3] * x[3]); }
#define DPPF(v, ctrl, rmask) __builtin_bit_cast(float, __builtin_amdgcn_update_dpp(0, __builtin_bit_cast(int, (v)), (ctrl), (rmask), 0xf, false))
__device__ __forceinline__ float wave_sum_u(float v) {
    v += DPPF(v, 0xB1, 0xf); v += DPPF(v, 0x4E, 0xf); v += DPPF(v, 0x141, 0xf); v += DPPF(v, 0x140, 0xf);
    v += DPPF(v, 0x142, 0xa); v += DPPF(v, 0x143, 0xc);
    return __builtin_bit_cast(float, __builtin_amdgcn_readlane(__builtin_bit_cast(int, v), 63));
}
template <int NV>
__device__ __forceinline__ void select16(const unsigned (&key)[NV], bool (&sel)[NV], int (&pos)[NV]) {
    unsigned T = 0u;
    for (int bit = 31; bit >= 0; --bit) { const unsigned cand = T | (1u << bit); int cnt = 0;
#pragma unroll
        for (int r = 0; r < NV; ++r) cnt += __builtin_popcountll(__ballot(key[r] >= cand));
        if (cnt >= PEER_TOPK) { T = cand; if (cnt == PEER_TOPK) break; } }
    int cgt = 0;
#pragma unroll
    for (int r = 0; r < NV; ++r) cgt += __builtin_popcountll(__ballot(key[r] > T));
    int rem = PEER_TOPK - cgt, base = 0;
#pragma unroll
    for (int r = 0; r < NV; ++r) { const bool gt = key[r] > T, eq = key[r] == T; const unsigned long long meq = __ballot(eq); const bool take = gt || (eq && lanes_below(meq) < rem);
        const unsigned long long msel = __ballot(take); sel[r] = take; pos[r] = base + lanes_below(msel);
        base += __builtin_popcountll(msel); const int ne = __builtin_popcountll(meq); rem -= (ne < rem ? ne : rem); }
}
__device__ __forceinline__ void p9_peer(Frame& F) {
    const int gw = F.bid * NWAVES + F.wave, NGW = F.G * NWAVES, lane = F.lane;
    LAS unsigned char* wb = F.lds + F.wave * PEER_WLDS;
    LAS float* tv = (LAS float*)wb; LAS int* ti = (LAS int*)(wb + 128); LAS float* cv = (LAS float*)(wb + 256); LAS int* cc = (LAS int*)(wb + 320); LAS int* eidx = (LAS int*)(wb + 512); LAS float* coef = (LAS float*)(wb + 1024); LAS float* su = (LAS float*)(wb + 1536);
    const float* S = WSP(float, WS_E); const bf16* H1B = WSP(bf16, WS_XB); const bf16* PLE = WSP(bf16, WS_PL); const unsigned char* UB = WSP(unsigned char, WS_UB); const unsigned char* VT = WSP(unsigned char, WS_VT); const float* SCL = WSP(float, WS_SCL);
    const float* g2 = INP(I_LN2G); const float* b2 = INP(I_LN2B);
    for (int tok = gw; tok < NTOK; tok += NGW) {
        const float* srow = S + (size_t)tok * 2048;
#pragma unroll 1
        for (int h = 0; h < PEER_HEADS; ++h) {
#pragma unroll
            for (int side = 0; side < 2; ++side) { const float v0 = srow[(2 * h + side) * 128 + lane], v1 = srow[(2 * h + side) * 128 + 64 + lane];
                const unsigned key[2] = {f2key(v0), f2key(v1)}; bool sel[2]; int pos[2]; select16<2>(key, sel, pos);
                if (sel[0]) { tv[side * 16 + pos[0]] = v0; ti[side * 16 + pos[0]] = lane; }
                if (sel[1]) { tv[side * 16 + pos[1]] = v1; ti[side * 16 + pos[1]] = lane + 64; } }
            CFENCE(); LDS_WAIT();
            { const int i0 = lane >> 4, j = lane & 15; const float vj = tv[16 + j];
              const float c0 = tv[i0] + vj, c1 = tv[i0 + 4] + vj, c2 = tv[i0 + 8] + vj, c3 = tv[i0 + 12] + vj;
              const unsigned key[4] = {f2key(c0), f2key(c1), f2key(c2), f2key(c3)}; bool sel[4]; int pos[4]; select16<4>(key, sel, pos);
              if (sel[0]) { cv[pos[0]] = c0; cc[pos[0]] = lane; } if (sel[1]) { cv[pos[1]] = c1; cc[pos[1]] = lane + 64; }
              if (sel[2]) { cv[pos[2]] = c2; cc[pos[2]] = lane + 128; } if (sel[3]) { cv[pos[3]] = c3; cc[pos[3]] = lane + 192; } }
            CFENCE(); LDS_WAIT();
            { const float val = cv[lane & 15]; const int ci = cc[lane & 15]; float mx = val;
#pragma unroll
              for (int o = 1; o < 16; o <<= 1) mx = fmaxf(mx, __shfl_xor(mx, o));
              const float e = __expf(val - mx); float sm = e;
#pragma unroll
              for (int o = 1; o < 16; o <<= 1) sm += __shfl_xor(sm, o);
              if (lane < 16) { eidx[h * 16 + lane] = ti[ci >> 4] * 128 + ti[16 + (ci & 15)]; coef[h * 16 + lane] = e / sm; } }
            CFENCE(); LDS_WAIT();
        }
        { const int e0 = eidx[lane], e1 = eidx[lane + 64];
          const float s0 = SCL[e0], s1 = SCL[e1], t0 = SCL[N_EXPERTS + e0], t1 = SCL[N_EXPERTS + e1];
          su[lane] = s0; su[lane + 64] = s1; coef[lane] *= t0; coef[lane + 64] *= t1; }
        CFENCE(); LDS_WAIT();
        {
            u32x4 hb[2][3];
            u32x4 hx[2][4]; float mx = 0.f;
#pragma unroll
            for (int jj = 0; jj < 2; ++jj)
#pragma unroll
                for (int i = 0; i < 4; ++i) { hx[jj][i] = *(const u32x4*)(H1B + (size_t)tok * 4096 + (jj * 64 + lane) * 32 + 8 * i);
#pragma unroll
                    for (int k = 0; k < 4; ++k) mx = fmaxf(mx, fmaxf(fabsf(bflo(hx[jj][i][k])), fabsf(bfhi(hx[jj][i][k])))); }
            mx = wave_max(mx) * (1.0f / 6.0f);
            int eb = (int)((__builtin_bit_cast(unsigned, mx) + 0x007fffffu) >> 23); eb = eb < 1 ? 1 : (eb > 253 ? 253 : eb);
            const float sup = __builtin_bit_cast(float, (unsigned)(254 - eb) << 23), sdn = __builtin_bit_cast(float, (unsigned)eb << 23);
#pragma unroll
            for (int jj = 0; jj < 2; ++jj)
#pragma unroll
                for (int i = 0; i < 4; ++i) { unsigned w0 = 0u, w1 = 0u, w2 = 0u;
#define HDIG(k) { float x0 = bflo(hx[jj][i][k]) * sup, x1 = bfhi(hx[jj][i][k]) * sup; \
                      w0 = __builtin_amdgcn_cvt_scalef32_pk_fp4_f32(w0, x0, x1, 1.0f, k); f32x2 dq = __builtin_amdgcn_cvt_scalef32_pk_f32_fp4(w0, 1.0f, k); x0 = (x0 - dq[0]) * 4.0f; x1 = (x1 - dq[1]) * 4.0f; \
                      w1 = __builtin_amdgcn_cvt_scalef32_pk_fp4_f32(w1, x0, x1, 1.0f, k); dq = __builtin_amdgcn_cvt_scalef32_pk_f32_fp4(w1, 1.0f, k); x0 = (x0 - dq[0]) * 8.0f; x1 = (x1 - dq[1]) * 8.0f; \
                      w2 = __builtin_amdgcn_cvt_scalef32_pk_fp4_f32(w2, x0, x1, 1.0f, k); }
                    HDIG(0) HDIG(1) HDIG(2) HDIG(3)
#undef HDIG
                    hb[jj][0][i] = w0; hb[jj][1][i] = w1; hb[jj][2][i] = w2; }
            const int dsel = ((lane >> 4) == ((lane & 15) >> 2)) ? (lane & 3) : 4;
#define U_LOAD(R, MB) { _Pragma("unroll") for (int q = 0; q < 8; ++q) { const int e_ = __builtin_amdgcn_readfirstlane(eidx[8 * (MB) + q]); const u32x4* p = (const u32x4*)(UB + (size_t)e_ * 2048) + lane; R[q][0] = p[0]; R[q][1] = p[64]; } }
#define HB8(d) (i32x8){(int)hb[jj][d].x, (int)hb[jj][d].y, (int)hb[jj][d].z, (int)hb[jj][d].w, 0, 0, 0, 0}
#define U_COMP(R, MB) { float a[8]; const float sq = su[8 * (MB) + (lane & 7)]; \
                _Pragma("unroll") for (int q = 0; q < 8; ++q) { f32x4 c = (f32x4){0.f, 0.f, 0.f, 0.f}; \
                    _Pragma("unroll") for (int jj = 0; jj < 2; ++jj) { const i32x8 av = (i32x8){(int)R[q][jj].x, (int)R[q][jj].y, (int)R[q][jj].z, (int)R[q][jj].w, 0, 0, 0, 0}; \
                        c = __builtin_amdgcn_mfma_scale_f32_16x16x128_f8f6f4(av, HB8(0), c, 4, 4, 0, 0x7f7f7f7f, 0, 0x7f7f7f7f);     \
                        c = __builtin_amdgcn_mfma_scale_f32_16x16x128_f8f6f4(av, HB8(1), c, 4, 4, 0, 0x7f7f7f7f, 0, 0x7d7d7d7d);     \
                        c = __builtin_amdgcn_mfma_scale_f32_16x16x128_f8f6f4(av, HB8(2), c, 4, 4, 0, 0x7f7f7f7f, 0, 0x7a7a7a7a); }   \
                    float d = (dsel == 0) ? c[0] : 0.f; d = (dsel == 1) ? c[1] : d; d = (dsel == 2) ? c[2] : d; d = (dsel == 3) ? c[3] : d; \
                    a[q] = wave_sum_u(d); } \
                float z = a[0]; \
                _Pragma("unroll") for (int q = 1; q < 8; ++q) z = (lane == q) ? a[q] : z; \
                z *= sdn * sq; \
                const float act = 0.5f * z * (1.0f + erff(z * 0.70710678118654752f)); \
                if (lane < 8) coef[8 * (MB) + lane] *= act; }
            u32x4 ra[8][2], rb[8][2];
            U_LOAD(ra, 0)
#pragma unroll 1
            for (int mb = 0; mb < PEER_M / 8 - 2; mb += 2) {
                U_LOAD(rb, mb + 1)
                __builtin_amdgcn_sched_barrier(0);
                U_COMP(ra, mb)
                __builtin_amdgcn_sched_barrier(0);
                U_LOAD(ra, mb + 2)
                __builtin_amdgcn_sched_barrier(0);
                U_COMP(rb, mb + 1)
                __builtin_amdgcn_sched_barrier(0);
            }
            U_LOAD(rb, PEER_M / 8 - 1)
            __builtin_amdgcn_sched_barrier(0);
            U_COMP(ra, PEER_M / 8 - 2)
            __builtin_amdgcn_sched_barrier(0);
            U_COMP(rb, PEER_M / 8 - 1)
#undef U_LOAD
#undef U_COMP
#undef HB8
        }
        CFENCE(); LDS_WAIT();
        f32x2 y[32];
#pragma unroll
        for (int i = 0; i < 32; ++i) y[i] = (f32x2){0.f, 0.f};
#pragma unroll 1
        for (int mb = 0; mb < PEER_M / 8; ++mb) {
            u32x4 r[8][2]; float c[8];
#pragma unroll
            for (int q = 0; q < 8; ++q) { const int e = __builtin_amdgcn_readfirstlane(eidx[8 * mb + q]); c[q] = coef[8 * mb + q];
                const u32x4* p = (const u32x4*)(VT + (size_t)e * 2048) + lane; r[q][0] = p[0]; r[q][1] = p[64]; }
#pragma unroll
            for (int q = 0; q < 8; ++q)
#pragma unroll
                for (int jj = 0; jj < 2; ++jj)
#pragma unroll
                    for (int i = 0; i < 4; ++i) { const unsigned w = r[q][jj][i];
                        y[(4 * jj + i) * 4 + 0] += __builtin_amdgcn_cvt_scalef32_pk_f32_fp4(w, 1.0f, 0) * c[q]; y[(4 * jj + i) * 4 + 1] += __builtin_amdgcn_cvt_scalef32_pk_f32_fp4(w, 1.0f, 1) * c[q];
                        y[(4 * jj + i) * 4 + 2] += __builtin_amdgcn_cvt_scalef32_pk_f32_fp4(w, 1.0f, 2) * c[q]; y[(4 * jj + i) * 4 + 3] += __builtin_amdgcn_cvt_scalef32_pk_f32_fp4(w, 1.0f, 3) * c[q]; }
        }
        { const bf16* hr = H1B + (size_t)tok * 4096; const bf16* pr = PLE + (size_t)tok * 4096; float s = 0.f;
#pragma unroll
          for (int jj = 0; jj < 2; ++jj) {
#pragma unroll
              for (int i = 0; i < 4; ++i) { const int off = (jj * 64 + lane) * 32 + 8 * i; const int yb = (4 * jj + i) * 4;
                  const u32x4 hw = *(const u32x4*)(hr + off), pw = *(const u32x4*)(pr + off); const f32x4 h0 = (f32x4){bflo(hw.x), bfhi(hw.x), bflo(hw.y), bfhi(hw.y)}, h1 = (f32x4){bflo(hw.z), bfhi(hw.z), bflo(hw.w), bfhi(hw.w)}, p0 = (f32x4){bflo(pw.x), bfhi(pw.x), bflo(pw.y), bfhi(pw.y)}, p1 = (f32x4){bflo(pw.z), bfhi(pw.z), bflo(pw.w), bfhi(pw.w)};
                  y[yb][0] += h0[0] * ALPHA + p0[0]; y[yb][1] += h0[1] * ALPHA + p0[1]; y[yb + 1][0] += h0[2] * ALPHA + p0[2]; y[yb + 1][1] += h0[3] * ALPHA + p0[3];
                  y[yb + 2][0] += h1[0] * ALPHA + p1[0]; y[yb + 2][1] += h1[1] * ALPHA + p1[1]; y[yb + 3][0] += h1[2] * ALPHA + p1[2]; y[yb + 3][1] += h1[3] * ALPHA + p1[3];
                  s += (y[yb][0] + y[yb][1]) + (y[yb + 1][0] + y[yb + 1][1]) + (y[yb + 2][0] + y[yb + 2][1]) + (y[yb + 3][0] + y[yb + 3][1]); }
              CFENCE(); }
          const float mean = wave_sum(s) * (1.0f / 4096.0f); float q = 0.f;
#pragma unroll
          for (int i = 0; i < 32; ++i) { y[i] = y[i] - mean; q += y[i][0] * y[i][0] + y[i][1] * y[i][1]; }
          const float rstd = 1.0f / sqrtf(wave_sum(q) * (1.0f / 4096.0f) + LN_EPS);
          float* orow = OUTP() + (size_t)tok * 4096;
#pragma unroll
          for (int jj = 0; jj < 2; ++jj) {
#pragma unroll
              for (int i = 0; i < 4; ++i) { const int off = (jj * 64 + lane) * 32 + 8 * i; const int yb = (4 * jj + i) * 4;
                  const f32x4 g0 = *(const f32x4*)(g2 + off), g1 = *(const f32x4*)(g2 + off + 4), c0 = *(const f32x4*)(b2 + off), c1 = *(const f32x4*)(b2 + off + 4);
                  *(f32x4*)(orow + off) = (f32x4){y[yb][0] * rstd * g0[0] + c0[0], y[yb][1] * rstd * g0[1] + c0[1], y[yb + 1][0] * rstd * g0[2] + c0[2], y[yb + 1][1] * rstd * g0[3] + c0[3]};
                  *(f32x4*)(orow + off + 4) = (f32x4){y[yb + 2][0] * rstd * g1[0] + c1[0], y[yb + 2][1] * rstd * g1[1] + c1[1], y[yb + 3][0] * rstd * g1[2] + c1[2], y[yb + 3][1] * rstd * g1[3] + c1[3]}; }
              CFENCE(); } }
        CFENCE(); LDS_WAIT();
    }
}
#ifndef DBG_OUT
#define DBG_OUT 0
#endif
__device__ __forceinline__ void dbg_copy(Frame& F, int which) {
    const size_t gt = (size_t)F.bid * NTHREADS + F.tid, gs = (size_t)F.G * NTHREADS, n = (size_t)NTOK * 4096;
    for (size_t i = gt; i < n; i += gs) { const size_t t = i >> 12; const int c = (int)(i & 4095); float v = 0.f;
        if (which == 1) v = WSP(float, WS_F)[i];
        else if (which == 2) v = WSP(float, WS_E)[i];
        else if (which == 3) v = bf2f(WSP(bf16, WS_XB)[i]);
        else if (which == 4) v = (c < 2048) ? bf2f(WSP(bf16, WS_QA)[t * 2048 + c]) : bf2f(WSP(bf16, WS_OB)[t * 2048 + c - 2048]);
        else if (which == 5) v = bf2f(WSP(bf16, WS_OLAT)[i]);
        else if (which == 6) v = bf2f(WSP(bf16, WS_QLAT)[i]);
        else if (which == 7) v = (c < 2048) ? bf2f(WSP(bf16, WS_QIDX)[t * 2048 + c]) : bf2f(WSP(bf16, WS_KB)[t * 2048 + c - 2048]);
        else if (which == 8) v = bf2f(WSP(bf16, WS_F)[t * 8192 + c]);
        else if (which == 9) v = (c < 2048) ? WSP(float, WS_E)[t * 2048 + c] : bf2f(WSP(bf16, WS_PL)[t * 4096 + c]);
        OUTP()[i] = v; }
}

constexpr int N_PHASES = 10;
__global__ void __launch_bounds__(NTHREADS, 2) mk_fwd(Args args) {
    extern __shared__ __attribute__((aligned(16))) unsigned char lds_raw[];
    Frame F;
    F.lds = (LAS unsigned char*)lds_raw; F.tid = threadIdx.x; F.lane = F.tid & 63; F.wave = __builtin_amdgcn_readfirstlane(F.tid >> 6); F.G = gridDim.x; F.bid = blockIdx.x;
    unsigned* ctl = (unsigned*)(WSB() + WS_CTL);
    if (F.tid < 64) ((LAS unsigned*)(F.lds + LDSCTL_OFF))[F.tid] = 0u;
    __syncthreads();
    XcdBarrier bar; bar.bar = ctl + CW_BAR; bar.x = 0; bar.st = nullptr; bar.wave = F.wave;
    if (MK_N_LAUNCHES == 1) bar = xcd_barrier_post(ctl + CW_BAR, (volatile LAS unsigned*)(F.lds + LDSCTL_OFF));
    const int lo = args.ph_lo, hi = args.ph_hi;
#ifndef PROBE_DUP
#define PROBE_DUP -1
#endif
#define IN(k) (lo <= (k) && (k) < hi)
#define REP(k) for (int rep_ = 0; rep_ < ((k) == PROBE_DUP ? 2 : 1); ++rep_)
#define SEAM(k) do { if (IN(k) && IN((k) + 1)) xcd_barrier(bar); } while (0)
    LAS unsigned char* const ldsg = F.lds;
#define RELANE() do { const int l_ = fresh_lane(); F.lane = l_; F.tid = F.wave * 64 + l_; } while (0)

    if (IN(0)) { RELANE(); REP(0) p0_prologue(F); SEAM(0); }
    if (IN(1)) {
        { pg8::Gemm g{WSP(bf16, WS_X8), WSP(bf16, WS_W18), NTOK, N1M, D_MODEL / 2, D_MODEL / 2}; pg8::StaticOrder S; S.init(NTOK, N1M, F.G, F.bid);
          pg8::Epi1 E{WSP(bf16, WS_QA), WSP(bf16, WS_QIDX), WSP(bf16, WS_QB), WSP(bf16, WS_KB), WSP(bf16, WS_VB), WSP(bf16, WS_F), INP(I_BGATE), 0};
          pg8::gemm_phase<pg8::Epi1, pg8::StaticOrder, true, true, true>(ldsg, g, S, E, F.wave); }
        if (F.bid < 256) {
          const int ks = F.bid & 3, sp = (F.bid >> 2) & 1, spm = F.bid >> 3;
          pg8::Gemm g{WSP(bf16, WS_XB) + ks * 1024, WSP(bf16, WS_E) + (size_t)N1M * D_MODEL + ks * 1024, NTOK, 512, 1024, D_MODEL}; pg8::OneUnit S{spm, sp};
          pg8::EpiPart E{WSP(float, WS_PART) + (size_t)(ks * 2 + sp) * NTOK * 256};
          pg8::gemm_phase<pg8::EpiPart, pg8::OneUnit, true, true>(ldsg, g, S, E, F.wave); }
        { pg8::Gemm g{WSP(bf16, WS_PB), WSP(bf16, WS_WPLT), NTOK, D_MODEL, D_PLE, D_PLE}; pg8::StaticOrder S; S.init(NTOK, D_MODEL, F.G, F.bid);
          pg8::EpiBf16P E{WSP(bf16, WS_PL), D_MODEL};
          pg8::gemm_phase<pg8::EpiBf16P, pg8::StaticOrder, true, true>(ldsg, g, S, E, F.wave); }
        SEAM(1);
    }
    if (IN(2)) { RELANE(); REP(2) p2_small(F); SEAM(2); }
    if (IN(3)) { REP(3) { if (!(args.pad & 2)) p3_fox(F); __syncthreads(); if (!(args.pad & 1)) p3_dsa(F, args.pad); __syncthreads(); } SEAM(3); }
    if (IN(4)) { RELANE(); REP(4) p4_oa(F); SEAM(4); }
    if (IN(5)) {
        { pg8::Gemm g{WSP(bf16, WS_QA), WSP(bf16, WS_WBAT), NTOK, D_MODEL, 1024, 1024}; pg8::StaticOrder S; S.init(NTOK, D_MODEL, F.G, F.bid);
          pg8::Epi2a E{WSP(bf16, WS_F), WSP(bf16, WS_E), 1.0f / (Q8_O * Q8_WB)};
          pg8::gemm_phase<pg8::Epi2a, pg8::StaticOrder, true, true, true>(ldsg, g, S, E, F.wave); }
        { pg8::Gemm g{WSP(bf16, WS_OB), WSP(bf16, WS_WBBT), NTOK, D_MODEL, 1024, 1024}; pg8::StaticOrder S; S.init(NTOK, D_MODEL, F.G, F.bid);
          pg8::Epi2b E{WSP(bf16, WS_F), WSP(bf16, WS_E), WSP(bf16, WS_XB), 1.0f / (Q8_O * Q8_WB)};
          pg8::gemm_phase<pg8::Epi2b, pg8::StaticOrder, true, true, true>(ldsg, g, S, E, F.wave); }
        SEAM(5);
    }
    if (IN(6)) {
        pg8::Gemm g{WSP(bf16, WS_XB), WSP(bf16, WS_WOT), NTOK, D_MODEL, D_MODEL / 2, D_MODEL / 2}; pg8::StaticOrder S; S.init(NTOK, D_MODEL, F.G, F.bid);
        pg8::Epi3 E{INP(I_X), WSP(bf16, WS_E), ALPHA, 1.0f / (Q8_MG * Q8_WO)};
        pg8::gemm_phase<pg8::Epi3, pg8::StaticOrder, true, true, true>(ldsg, g, S, E, F.wave);
        SEAM(6);
    }
    if (IN(7)) { RELANE(); REP(7) p7_ln1(F); SEAM(7); }
    if (IN(8)) {
        { pg8::Gemm g{WSP(bf16, WS_X8), WSP(bf16, WS_W48), NTOK, N4, D_MODEL / 2, D_MODEL / 2}; pg8::StaticOrder S; S.init(NTOK, N4, F.G, F.bid);
          pg8::Epi4 E{WSP(float, WS_E), WSP(bf16, WS_PL), INP(I_BPG), 0};
          pg8::gemm_phase<pg8::Epi4, pg8::StaticOrder, true, true, true>(ldsg, g, S, E, F.wave); }
        SEAM(8);
    }
    if (IN(9)) { if (DBG_OUT) dbg_copy(F, DBG_OUT); else { RELANE(); REP(9) p9_peer(F); } }
#undef IN
#undef SEAM
}

extern "C" void kernel_launch(void* const* d_in, const int* in_sizes, int n_in, void* d_out, int out_size, void* d_ws, size_t ws_size, hipStream_t stream) {
    static int grid = 0;
    if (grid == 0) {
        if (n_in != 23 || out_size != NTOK * D_MODEL || ws_size < WS_END) { fprintf(stderr, "kernel_launch: unexpected problem (n_in %d, out %d, ws %zu); nothing launched\n", n_in, out_size, ws_size); grid = -1; return; }
        int dev = 0, cus = 0, per_cu = 0;
        if (hipGetDevice(&dev) != hipSuccess || hipDeviceGetAttribute(&cus, hipDeviceAttributeMultiprocessorCount, dev) != hipSuccess) { grid = -1; return; }
        if (hipFuncSetAttribute((const void*)mk_fwd, hipFuncAttributeMaxDynamicSharedMemorySize, LDS_BYTES) != hipSuccess) { fprintf(stderr, "kernel_launch: hipFuncSetAttribute failed\n"); grid = -1; return; }
        if (hipOccupancyMaxActiveBlocksPerMultiprocessor(&per_cu, (const void*)mk_fwd, NTHREADS, LDS_BYTES) != hipSuccess || per_cu < 1) { fprintf(stderr, "kernel_launch: occupancy query says %d\n", per_cu); (void)hipGetLastError(); grid = -1; return; }
        grid = cus;
    }
    if (grid < 0) return;
    if (hipMemsetAsync((char*)d_ws + WS_CTL, 0, CTL_ZERO_BYTES, stream) != hipSuccess) return;
    Args a{};
    for (int i = 0; i < 23; ++i) a.in[i] = (const float*)d_in[i];
    a.out = (float*)d_out; a.ws = (unsigned char*)d_ws;
    for (int li = 0; li < MK_N_LAUNCHES; ++li) {
#if DBG_OUT
        { const int lastp[10] = {9, 7, 6, 5, 4, 3, 2, 1, 1, 8}; if (MK_N_LAUNCHES > 1 && li > lastp[DBG_OUT] && li != 9) continue; }
#endif
        a.ph_lo = (MK_N_LAUNCHES == 1) ? 0 : li; a.ph_hi = (MK_N_LAUNCHES == 1) ? N_PHASES : li + 1; a.li = li; a.pad = 0;
#ifdef HOST_DUP
        if (MK_N_LAUNCHES > 1 && li == HOST_DUP) {
#ifdef HOST_DUP_PAD
            a.pad = HOST_DUP_PAD;
#endif
            hipLaunchKernelGGL(mk_fwd, dim3(grid), dim3(NTHREADS), LDS_BYTES, stream, a); a.pad = 0; }
#endif
        hipLaunchKernelGGL(mk_fwd, dim3(grid), dim3(NTHREADS), LDS_BYTES, stream, a);
    }
}
```

```cpp
#include <hip/hip_runtime.h>
#include <cstdio>
#include <cstdint>

#ifndef MK_N_LAUNCHES
#define MK_N_LAUNCHES 1
#endif

#define GAS __attribute__((address_space(1)))
#define LAS __attribute__((address_space(3)))
typedef unsigned short bf16;
typedef float f32x4 __attribute__((ext_vector_type(4)));
typedef float f32x2 __attribute__((ext_vector_type(2)));
typedef unsigned u32x4 __attribute__((ext_vector_type(4)));
typedef unsigned u32x2 __attribute__((ext_vector_type(2)));
typedef short bf16x8 __attribute__((ext_vector_type(8)));

constexpr int D_MODEL = 4096, BATCH = 4, SEQ = 2048, NTOK = BATCH * SEQ;
constexpr int A_HEADS = 16, A_HD = 128, A_LAT = 256, IDX_HEADS = 32, IDX_DIM = 64, TOPK = 256, CHUNK = 64;
constexpr int B_HEADS = 16, B_HD = 128;
constexpr int PEER_HEADS = 8, PEER_KEYS = 128, PEER_QDIM = 256, PEER_TOPK = 16, N_EXPERTS = PEER_KEYS * PEER_KEYS, PEER_M = PEER_HEADS * PEER_TOPK;
constexpr int D_PLE = 256;
constexpr int IN_WIDTH = 10608;
constexpr int N1 = 18944;
constexpr int N1M = 18432;
constexpr int N4 = 6144;
constexpr float LN_EPS = 1e-5f;
constexpr float ALPHA = 1.18920711500272f;

__device__ __forceinline__ unsigned f2bf(float f) { unsigned u = __builtin_bit_cast(unsigned, f); return (u + 0x7fffu + ((u >> 16) & 1u)) >> 16; }
typedef __bf16 bf16x2_n __attribute__((ext_vector_type(2)));
__device__ __forceinline__ unsigned pk2(float lo, float hi) { const bf16x2_n b = __builtin_convertvector((f32x2){lo, hi}, bf16x2_n); return __builtin_bit_cast(unsigned, b); }
__device__ __forceinline__ float bflo(unsigned w) { return __builtin_bit_cast(float, w << 16); }
__device__ __forceinline__ float bfhi(unsigned w) { return __builtin_bit_cast(float, w & 0xffff0000u); }
__device__ __forceinline__ float bf2f(bf16 b) { return __builtin_bit_cast(float, (unsigned)b << 16); }
__device__ __forceinline__ float sigmoidf_(float x) { return __builtin_amdgcn_rcpf(1.0f + __expf(-x)); }
__device__ __forceinline__ float wave_sum(float v) {
#pragma unroll
    for (int o = 1; o < 64; o <<= 1) v += __shfl_xor(v, o);
    return v;
}
__device__ __forceinline__ float wave_max(float v) {
#pragma unroll
    for (int o = 1; o < 64; o <<= 1) v = fmaxf(v, __shfl_xor(v, o));
    return v;
}
__device__ __forceinline__ int fresh_lane() { int l; asm volatile("v_mbcnt_lo_u32_b32 %0, -1, 0\n\tv_mbcnt_hi_u32_b32 %0, -1, %0" : "=v"(l)); return l; }
constexpr float Q8_ACT = 30.0f, Q8_W = 1920.0f;
constexpr float Q8_O = 21.0f, Q8_WB = 1368.0f;
constexpr float Q8_MG = 32.0f, Q8_WO = 3250.0f;
__device__ __forceinline__ unsigned pk_q8x4(float a, float b, float c, float d, float sc) {
    const int i0 = __float2int_rn(fminf(fmaxf(a * sc, -127.f), 127.f)), i1 = __float2int_rn(fminf(fmaxf(b * sc, -127.f), 127.f));
    const int i2 = __float2int_rn(fminf(fmaxf(c * sc, -127.f), 127.f)), i3 = __float2int_rn(fminf(fmaxf(d * sc, -127.f), 127.f));
    return (unsigned)(i0 & 255) | ((unsigned)(i1 & 255) << 8) | ((unsigned)(i2 & 255) << 16) | ((unsigned)i3 << 24); }
#define LDS_WAIT() asm volatile("s_waitcnt lgkmcnt(0)" ::: "memory")
#define VM_WAIT() asm volatile("s_waitcnt vmcnt(0)" ::: "memory")
#define CFENCE() asm volatile("" ::: "memory")
namespace pg8 {
#define PG8_LAS __attribute__((address_space(3)))
typedef unsigned short bf16_t;
typedef short bf16x8 __attribute__((ext_vector_type(8)));
typedef float f32x4 __attribute__((ext_vector_type(4)));
typedef unsigned u32x4 __attribute__((ext_vector_type(4)));
constexpr int BM = 256, BK = 64, HALF = 128, HTB = HALF * BK * 2  , STAGE_BYTES = 8 * HTB, NXCD = 8, WGM = 8;

__host__ __device__ __forceinline__ int lds_byte(int r, int c) { const int st = (r >> 4) * 2 + (c >> 5), rr = r & 15, cc = c & 31, ob = rr * 64 + cc * 2; return st * 1024 + (ob ^ (((ob >> 9) & 1) << 5)); }
__host__ __device__ __forceinline__ void stage_rc(int b, int& R, int& C) { const int st = b / 1024, sb = b % 1024, swz = sb ^ (((sb >> 9) & 1) << 5); R = (st >> 1) * 16 + swz / 64; C = (st & 1) * 32 + (swz % 64) / 2; }
__host__ __device__ __forceinline__ int perm32(int rho) { const int n = rho >> 4, i = rho & 15; return 8 * (i >> 2) + 4 * n + (i & 3); }

struct Unit { int pm, pn; };
struct Gemm { const bf16_t* A; const bf16_t* Bt; int M, N, K, ld; };

struct StaticOrder {
    int nM, nN, nwg, G, c;
    __host__ __device__ void init(int M, int N, int G_, int c_) { nM = M / BM; nN = N / BM; nwg = nM * nN; G = G_; c = c_; }
    __host__ __device__ bool next(int i, Unit& u) const {
        const long L = (long)i * G + c; if (L >= nwg) return false;
        int wgid = (int)L; { const int q = nwg / NXCD, r = nwg % NXCD, xcd = wgid % NXCD, off = wgid / NXCD; wgid = (xcd < r ? xcd * (q + 1) : r * (q + 1) + (xcd - r) * q) + off; }
        const int nig = WGM * nN, gid = wgid / nig, fm = gid * WGM, gsz = (nM - fm) < WGM ? (nM - fm) : WGM;
        u.pm = fm + ((wgid % nig) % gsz); u.pn = (wgid % nig) / gsz; return true;
    }
    __device__ __forceinline__ void a_ready(const Unit&) const {}
    __device__ __forceinline__ void done(const Unit&) const {}
};
typedef __bf16 bf16x2_nat __attribute__((ext_vector_type(2)));
__device__ __forceinline__ unsigned cvt_pk_bf16(float lo, float hi) { typedef float f2_ __attribute__((ext_vector_type(2))); const bf16x2_nat b = __builtin_convertvector((f2_){lo, hi}, bf16x2_nat); return __builtin_bit_cast(unsigned, b); }
typedef unsigned u32x2 __attribute__((ext_vector_type(2)));
__device__ __forceinline__ unsigned q8x4(float a, float b, float c, float d, float sc) {
    const int i0 = __float2int_rn(fminf(fmaxf(a * sc, -127.f), 127.f)), i1 = __float2int_rn(fminf(fmaxf(b * sc, -127.f), 127.f));
    const int i2 = __float2int_rn(fminf(fmaxf(c * sc, -127.f), 127.f)), i3 = __float2int_rn(fminf(fmaxf(d * sc, -127.f), 127.f));
    return (unsigned)(i0 & 255) | ((unsigned)(i1 & 255) << 8) | ((unsigned)(i2 & 255) << 16) | ((unsigned)i3 << 24); }
__device__ __forceinline__ float sigm(float x) { return __builtin_amdgcn_rcpf(1.0f + __expf(-x)); }
__device__ __forceinline__ float blo(unsigned w) { return __builtin_bit_cast(float, w << 16); }
__device__ __forceinline__ float bhi(unsigned w) { return __builtin_bit_cast(float, w & 0xffff0000u); }

struct Epi1 {
    static constexpr bool PERM = true, AFTER_DRAIN = false;
    bf16_t *QA, *QIDX, *QB, *KB, *VB, *G; const float* b_gate; int pn_off;
    __device__ __forceinline__ void operator()(const f32x4 (&acc)[2][2][4][2], const Unit& u, int wr, int wc, int fr, int fq) const {
        const int pn = u.pn + pn_off, row0 = u.pm * BM + wr * 64 + fr, cl = wc * 32 + 8 * fq;
        if (pn >= 40) {
            const int gc = (pn - 40) * 256 + cl;
            f32x4 bv[2][2];
#pragma unroll
            for (int bj = 0; bj < 2; ++bj)
#pragma unroll
                for (int n = 0; n < 2; ++n) bv[bj][n] = *(const f32x4*)(b_gate + gc + bj * HALF + 4 * n);
#pragma unroll
            for (int ai = 0; ai < 2; ++ai)
#pragma unroll
                for (int m = 0; m < 4; ++m) { bf16_t* rowp = G + (size_t)(row0 + ai * HALF + m * 16) * 8192 + gc;
#pragma unroll
                    for (int bj = 0; bj < 2; ++bj) { const f32x4 v0 = acc[ai][bj][m][0] * (1.0f / 57600.0f) + bv[bj][0], v1 = acc[ai][bj][m][1] * (1.0f / 57600.0f) + bv[bj][1];
                        u32x4 w; w.x = cvt_pk_bf16(sigm(v0[0]), sigm(v0[1])); w.y = cvt_pk_bf16(sigm(v0[2]), sigm(v0[3])); w.z = cvt_pk_bf16(sigm(v1[0]), sigm(v1[1])); w.w = cvt_pk_bf16(sigm(v1[2]), sigm(v1[3]));
                        *(u32x4*)(rowp + bj * HALF) = w; } }
        } else {
            bf16_t* dst; int c0;
            if (pn < 8) { dst = QA; c0 = pn; } else if (pn < 16) { dst = QIDX; c0 = pn - 8; } else if (pn < 24) { dst = QB; c0 = pn - 16; } else if (pn < 32) { dst = KB; c0 = pn - 24; } else { dst = VB; c0 = pn - 32; }
            c0 = c0 * 256 + cl;
#pragma unroll
            for (int ai = 0; ai < 2; ++ai)
#pragma unroll
                for (int m = 0; m < 4; ++m) { bf16_t* rowp = dst + (size_t)(row0 + ai * HALF + m * 16) * 2048 + c0;
#pragma unroll
                    for (int bj = 0; bj < 2; ++bj) { const f32x4 v0 = acc[ai][bj][m][0] * (1.0f / 57600.0f), v1 = acc[ai][bj][m][1] * (1.0f / 57600.0f);
                        u32x4 w; w.x = cvt_pk_bf16(v0[0], v0[1]); w.y = cvt_pk_bf16(v0[2], v0[3]); w.z = cvt_pk_bf16(v1[0], v1[1]); w.w = cvt_pk_bf16(v1[2], v1[3]);
                        *(u32x4*)(rowp + bj * HALF) = w; } }
        }
    }
};
struct OneUnit {
    int pm, pn;
    __device__ bool next(int i, Unit& u) const { if (i) return false; u.pm = pm; u.pn = pn; return true; }
    __device__ __forceinline__ void a_ready(const Unit&) const {}
    __device__ __forceinline__ void done(const Unit&) const {}
};
struct EpiPart {
    static constexpr bool PERM = true, AFTER_DRAIN = false;
    float* P;
    __device__ __forceinline__ void operator()(const f32x4 (&acc)[2][2][4][2], const Unit& u, int wr, int wc, int fr, int fq) const {
        const int row0 = u.pm * BM + wr * 64 + fr, cl = wc * 32 + 8 * fq;
#pragma unroll
        for (int ai = 0; ai < 2; ++ai)
#pragma unroll
            for (int m = 0; m < 4; ++m) { float* rowp = P + (size_t)(row0 + ai * HALF + m * 16) * 256 + cl;
#pragma unroll
                for (int bj = 0; bj < 2; ++bj) { *(f32x4*)(rowp + bj * HALF) = acc[ai][bj][m][0]; *(f32x4*)(rowp + bj * HALF + 4) = acc[ai][bj][m][1]; } }
    }
};
struct EpiBf16P {
    static constexpr bool PERM = true, AFTER_DRAIN = false;
    bf16_t* C; int ldc;
    __device__ __forceinline__ void operator()(const f32x4 (&acc)[2][2][4][2], const Unit& u, int wr, int wc, int fr, int fq) const {
        const int row0 = u.pm * BM + wr * 64 + fr, col0 = u.pn * BM + wc * 32 + 8 * fq;
#pragma unroll
        for (int ai = 0; ai < 2; ++ai)
#pragma unroll
            for (int m = 0; m < 4; ++m) { bf16_t* rowp = C + (size_t)(row0 + ai * HALF + m * 16) * ldc + col0;
#pragma unroll
                for (int bj = 0; bj < 2; ++bj) { const f32x4 v0 = acc[ai][bj][m][0], v1 = acc[ai][bj][m][1];
                    u32x4 w; w.x = cvt_pk_bf16(v0[0], v0[1]); w.y = cvt_pk_bf16(v0[2], v0[3]); w.z = cvt_pk_bf16(v1[0], v1[1]); w.w = cvt_pk_bf16(v1[2], v1[3]);
                    *(u32x4*)(rowp + bj * HALF) = w; }
                asm volatile("" ::: "memory"); }
    }
};
struct EpiF32P {
    static constexpr bool PERM = true, AFTER_DRAIN = false;
    float* C; int ldc;
    __device__ __forceinline__ void operator()(const f32x4 (&acc)[2][2][4][2], const Unit& u, int wr, int wc, int fr, int fq) const {
        const int row0 = u.pm * BM + wr * 64 + fr, col0 = u.pn * BM + wc * 32 + 8 * fq;
#pragma unroll
        for (int ai = 0; ai < 2; ++ai)
#pragma unroll
            for (int m = 0; m < 4; ++m) { float* rowp = C + (size_t)(row0 + ai * HALF + m * 16) * ldc + col0;
#pragma unroll
                for (int bj = 0; bj < 2; ++bj) { *(f32x4*)(rowp + bj * HALF) = acc[ai][bj][m][0]; *(f32x4*)(rowp + bj * HALF + 4) = acc[ai][bj][m][1]; } }
    }
};
struct Epi2a {
    static constexpr bool PERM = true, AFTER_DRAIN = false;
    const bf16_t* G; bf16_t* MGT; float sacc;
    __device__ __forceinline__ void operator()(const f32x4 (&acc)[2][2][4][2], const Unit& u, int wr, int wc, int fr, int fq) const {
        const int row0 = u.pm * BM + wr * 64 + fr, col0 = u.pn * BM + wc * 32 + 8 * fq;
#pragma unroll
        for (int ai = 0; ai < 2; ++ai)
#pragma unroll
            for (int m = 0; m < 4; ++m) { const size_t r = (size_t)(row0 + ai * HALF + m * 16);
#pragma unroll
                for (int bj = 0; bj < 2; ++bj) { const u32x4 g = *(const u32x4*)(G + r * 8192 + col0 + bj * HALF); const f32x4 v0 = acc[ai][bj][m][0] * sacc, v1 = acc[ai][bj][m][1] * sacc;
                    u32x4 w; w.x = cvt_pk_bf16(v0[0] * blo(g.x), v0[1] * bhi(g.x)); w.y = cvt_pk_bf16(v0[2] * blo(g.y), v0[3] * bhi(g.y)); w.z = cvt_pk_bf16(v1[0] * blo(g.z), v1[1] * bhi(g.z)); w.w = cvt_pk_bf16(v1[2] * blo(g.w), v1[3] * bhi(g.w));
                    *(u32x4*)(MGT + r * 4096 + col0 + bj * HALF) = w; }
                asm volatile("" ::: "memory"); }
    }
};
struct Epi2b {
    static constexpr bool PERM = true, AFTER_DRAIN = false;
    const bf16_t* G; const bf16_t* MGT; bf16_t* MG; float sacc;
    __device__ __forceinline__ void operator()(const f32x4 (&acc)[2][2][4][2], const Unit& u, int wr, int wc, int fr, int fq) const {
        const int row0 = u.pm * BM + wr * 64 + fr, col0 = u.pn * BM + wc * 32 + 8 * fq;
#pragma unroll
        for (int ai = 0; ai < 2; ++ai)
#pragma unroll
            for (int m = 0; m < 4; ++m) { const size_t r = (size_t)(row0 + ai * HALF + m * 16);
#pragma unroll
                for (int bj = 0; bj < 2; ++bj) { const u32x4 g = *(const u32x4*)(G + r * 8192 + 4096 + col0 + bj * HALF); const f32x4 v0 = acc[ai][bj][m][0] * sacc, v1 = acc[ai][bj][m][1] * sacc;
                    const u32x4 t = *(const u32x4*)(MGT + r * 4096 + col0 + bj * HALF);
                    u32x2 w; w.x = q8x4(blo(t.x) + v0[0] * blo(g.x), bhi(t.x) + v0[1] * bhi(g.x), blo(t.y) + v0[2] * blo(g.y), bhi(t.y) + v0[3] * bhi(g.y), 32.0f);
                    w.y = q8x4(blo(t.z) + v1[0] * blo(g.z), bhi(t.z) + v1[1] * bhi(g.z), blo(t.w) + v1[2] * blo(g.w), bhi(t.w) + v1[3] * bhi(g.w), 32.0f);
                    *(u32x2*)((unsigned char*)MG + r * 4096 + col0 + bj * HALF) = w; }
                asm volatile("" ::: "memory"); }
    }
};
struct Epi3 {
    static constexpr bool PERM = true, AFTER_DRAIN = false;
    const float* X; bf16_t* Y; float alpha, sacc;
    __device__ __forceinline__ void operator()(const f32x4 (&acc)[2][2][4][2], const Unit& u, int wr, int wc, int fr, int fq) const {
        const int row0 = u.pm * BM + wr * 64 + fr, col0 = u.pn * BM + wc * 32 + 8 * fq;
#pragma unroll
        for (int ai = 0; ai < 2; ++ai)
#pragma unroll
            for (int m = 0; m < 4; ++m) { const size_t off = (size_t)(row0 + ai * HALF + m * 16) * 4096 + col0;
#pragma unroll
                for (int bj = 0; bj < 2; ++bj) { const f32x4 x0 = *(const f32x4*)(X + off + bj * HALF), x1 = *(const f32x4*)(X + off + bj * HALF + 4);
                    const f32x4 y0 = x0 * alpha + acc[ai][bj][m][0] * sacc, y1 = x1 * alpha + acc[ai][bj][m][1] * sacc;
                    u32x4 w; w.x = cvt_pk_bf16(y0[0], y0[1]); w.y = cvt_pk_bf16(y0[2], y0[3]); w.z = cvt_pk_bf16(y1[0], y1[1]); w.w = cvt_pk_bf16(y1[2], y1[3]);
                    *(u32x4*)(Y + off + bj * HALF) = w; }
                asm volatile("" ::: "memory"); }
    }
};
struct Epi4 {
    static constexpr bool PERM = true, AFTER_DRAIN = false;
    float* PQ; bf16_t* PL; const float* b_pg; int pn_off;
    __device__ __forceinline__ void operator()(const f32x4 (&acc)[2][2][4][2], const Unit& u, int wr, int wc, int fr, int fq) const {
        const int row0 = u.pm * BM + wr * 64 + fr, cl = wc * 32 + 8 * fq, pn = u.pn + pn_off;
        if (pn < 8) {
#pragma unroll
            for (int ai = 0; ai < 2; ++ai)
#pragma unroll
                for (int m = 0; m < 4; ++m) { float* rowp = PQ + (size_t)(row0 + ai * HALF + m * 16) * 2048 + pn * 256 + cl;
#pragma unroll
                    for (int bj = 0; bj < 2; ++bj) { *(f32x4*)(rowp + bj * HALF) = acc[ai][bj][m][0] * (1.0f / 57600.0f); *(f32x4*)(rowp + bj * HALF + 4) = acc[ai][bj][m][1] * (1.0f / 57600.0f); } }
        } else {
            const int c0 = (pn - 8) * 256 + cl;
            f32x4 bv[2][2];
#pragma unroll
            for (int bj = 0; bj < 2; ++bj)
#pragma unroll
                for (int n = 0; n < 2; ++n) bv[bj][n] = *(const f32x4*)(b_pg + c0 + bj * HALF + 4 * n);
#pragma unroll
            for (int ai = 0; ai < 2; ++ai)
#pragma unroll
                for (int m = 0; m < 4; ++m) { bf16_t* rowp = PL + (size_t)(row0 + ai * HALF + m * 16) * 4096 + c0;
#pragma unroll
                    for (int bj = 0; bj < 2; ++bj) { const u32x4 p = *(const u32x4*)(rowp + bj * HALF);
                        const f32x4 v0 = acc[ai][bj][m][0] * (1.0f / 57600.0f) + bv[bj][0], v1 = acc[ai][bj][m][1] * (1.0f / 57600.0f) + bv[bj][1];
                        u32x4 w; w.x = cvt_pk_bf16(sigm(v0[0]) * blo(p.x), sigm(v0[1]) * bhi(p.x)); w.y = cvt_pk_bf16(sigm(v0[2]) * blo(p.y), sigm(v0[3]) * bhi(p.y));
                        w.z = cvt_pk_bf16(sigm(v1[0]) * blo(p.z), sigm(v1[1]) * bhi(p.z)); w.w = cvt_pk_bf16(sigm(v1[2]) * blo(p.w), sigm(v1[3]) * bhi(p.w));
                        *(u32x4*)(rowp + bj * HALF) = w; }
                    asm volatile("" ::: "memory"); }
        }
    }
};
typedef int pg8_i32x4 __attribute__((ext_vector_type(4)));
typedef int pg8_i32x8 __attribute__((ext_vector_type(8)));
__device__ __forceinline__ pg8_i32x8 cat8(bf16x8 lo, bf16x8 hi) { const pg8_i32x4 a = __builtin_bit_cast(pg8_i32x4, lo), b = __builtin_bit_cast(pg8_i32x4, hi); return __builtin_shufflevector(a, b, 0, 1, 2, 3, 4, 5, 6, 7); }
template <class Epi, class Sched, bool ALIGN_EPI = false, bool SP2 = false, bool F8 = false>
__device__ __forceinline__ void gemm_phase(PG8_LAS unsigned char* lds, const Gemm g, const Sched& S, const Epi& E, const int wave_id) {
    int tid_ = wave_id * 64 + fresh_lane();
    const int tid = tid_, wid = __builtin_amdgcn_readfirstlane(tid >> 6), lane = tid & 63, wr = wid >> 2, wc = wid & 3, fr = lane & 15, fq = lane >> 4;
    const int K = g.K, nt = K / BK, LD = g.ld;
    unsigned voffA, voffB;
    { int R, C; stage_rc(tid * 16, R, C); const int Rb = Epi::PERM ? ((R & ~31) + perm32(R & 31)) : R; voffA = (unsigned)(R * LD + C) * 2u; voffB = (unsigned)(Rb * LD + C) * 2u; }
    const size_t rstep = (size_t)64 * LD * 2;
    const size_t kstep = (size_t)(BK * 2);
    const size_t hstep = (size_t)HALF * LD * 2;
    const size_t tstep = 2 * hstep;
    const unsigned ldsw = (unsigned)wid * 1024u;
    const int aoff = lds_byte(wr * 64 + fr, fq * 8), boff = lds_byte(wc * 32 + fr, fq * 8);
#define PG8_SA(b, h) (((b) * 2 + (h)) * HTB)
#define PG8_SB(b, h) ((4 + (b) * 2 + (h)) * HTB)
#define PG8_STAGE(bufoff, gbase, voff) do { _Pragma("unroll") for (int _i = 0; _i < 2; ++_i) \
        __builtin_amdgcn_global_load_lds((const unsigned*)((const char*)(gbase) + _i * rstep + (voff)), (PG8_LAS unsigned*)(lds + (bufoff) + ldsw + _i * 8192), 16, 0, 0); } while (0)
#define PG8_LDA(dst, b, h) do { _Pragma("unroll") for (int m = 0; m < 4; ++m) _Pragma("unroll") for (int k = 0; k < 2; ++k) dst[m][k] = *(const PG8_LAS bf16x8*)(lds + PG8_SA(b, h) + aoff + m * 2048 + k * 1024); } while (0)
#define PG8_LDB(dst, b, h) do { _Pragma("unroll") for (int n = 0; n < 2; ++n) _Pragma("unroll") for (int k = 0; k < 2; ++k) dst[n][k] = *(const PG8_LAS bf16x8*)(lds + PG8_SB(b, h) + boff + n * 2048 + k * 1024); } while (0)
#define PG8_MMA(ai, bj, At, Bt) do { __builtin_amdgcn_s_setprio(1); _Pragma("unroll") for (int m = 0; m < 4; ++m) _Pragma("unroll") for (int n = 0; n < 2; ++n) { \
        _Pragma("unroll") for (int k = 0; k < 2; ++k) { \
            if constexpr (F8) acc[ai][bj][m][n] = __builtin_bit_cast(f32x4, __builtin_amdgcn_mfma_i32_16x16x64_i8(__builtin_bit_cast(pg8_i32x4, Bt[n][k]), __builtin_bit_cast(pg8_i32x4, At[m][k]), __builtin_bit_cast(pg8_i32x4, acc[ai][bj][m][n]), 0, 0, 0)); \
            else acc[ai][bj][m][n] = __builtin_amdgcn_mfma_f32_16x16x32_bf16(Bt[n][k], At[m][k], acc[ai][bj][m][n], 0, 0, 0); } } __builtin_amdgcn_s_setprio(0); } while (0)
#define PG8_WAIT_V(n) asm volatile("s_waitcnt vmcnt(" #n ")" ::: "memory")
#define PG8_WAIT_L(n) asm volatile("s_waitcnt lgkmcnt(" #n ")" ::: "memory")
#define PG8_BAR __builtin_amdgcn_s_barrier()
#define PG8_SCHED __builtin_amdgcn_sched_barrier(0)
    Unit cur, nxt; int ui = 0;
    if (!S.next(0, cur)) return;
    f32x4 acc[2][2][4][2];
#pragma unroll
    for (int a = 0; a < 2; ++a)
#pragma unroll
        for (int b = 0; b < 2; ++b)
#pragma unroll
            for (int m = 0; m < 4; ++m)
#pragma unroll
                for (int n = 0; n < 2; ++n) acc[a][b][m][n] = (f32x4){0.f, 0.f, 0.f, 0.f};
    bf16x8 At[4][2], B0[2][2], B1[2][2];
    const char* cA = (const char*)g.A + (size_t)cur.pm * tstep; const char* cB = (const char*)g.Bt + (size_t)cur.pn * tstep;
    S.a_ready(cur);
    if constexpr (SP2) {
        PG8_STAGE(PG8_SB(0, 0), cB, voffB); PG8_STAGE(PG8_SB(0, 1), cB + hstep, voffB); PG8_STAGE(PG8_SA(0, 0), cA, voffA); PG8_STAGE(PG8_SA(0, 1), cA + hstep, voffA);
        if (wr == 1) PG8_BAR;
        PG8_WAIT_V(2); PG8_BAR;
        PG8_STAGE(PG8_SB(1, 0), cB + kstep, voffB); PG8_STAGE(PG8_SA(1, 0), cA + kstep, voffA); PG8_STAGE(PG8_SB(1, 1), cB + hstep + kstep, voffB);
        PG8_WAIT_V(6); PG8_BAR;
    } else {
        PG8_STAGE(PG8_SB(0, 0), cB, voffB); PG8_STAGE(PG8_SA(0, 0), cA, voffA); PG8_STAGE(PG8_SB(0, 1), cB + hstep, voffB); PG8_STAGE(PG8_SA(0, 1), cA + hstep, voffA);
        if (wr == 1) PG8_BAR;
        PG8_WAIT_V(4); PG8_BAR;
        PG8_STAGE(PG8_SB(1, 0), cB + kstep, voffB); PG8_STAGE(PG8_SA(1, 0), cA + kstep, voffA); PG8_STAGE(PG8_SB(1, 1), cB + hstep + kstep, voffB);
        PG8_WAIT_V(6); PG8_BAR;
    }
    for (;;) {
        const bool has_next = S.next(ui + 1, nxt);
        const char* nA = has_next ? (const char*)g.A + (size_t)nxt.pm * tstep : cA; const char* nB = has_next ? (const char*)g.Bt + (size_t)nxt.pn * tstep : cB;
#pragma unroll 1
        for (int t = 0; t < nt; t += 2) {
            const bool last = (t == nt - 2);
            const char* a1 = cA + (size_t)(t + 1) * kstep;
            const char* a2 = last ? nA : cA + (size_t)(t + 2) * kstep; const char* b2 = last ? nB : cB + (size_t)(t + 2) * kstep;
            const char* a3 = a2 + kstep; const char* b3 = b2 + kstep;
            if (last && has_next) S.a_ready(nxt);
            if constexpr (SP2) {
            PG8_LDB(B0, 0, 0); PG8_LDB(B1, 0, 1); PG8_SCHED; PG8_LDA(At, 0, 0); PG8_STAGE(PG8_SA(1, 1), a1 + hstep, voffA);
            PG8_WAIT_V(8); PG8_WAIT_L(0); PG8_BAR; PG8_MMA(0, 0, At, B0); PG8_MMA(0, 1, At, B1); PG8_BAR; PG8_SCHED;
            PG8_LDA(At, 0, 1); PG8_STAGE(PG8_SB(0, 0), b2, voffB); PG8_STAGE(PG8_SB(0, 1), b2 + hstep, voffB); PG8_STAGE(PG8_SA(0, 0), a2, voffA);
            PG8_WAIT_V(8); PG8_WAIT_L(0); PG8_BAR; PG8_MMA(1, 0, At, B0); PG8_MMA(1, 1, At, B1); PG8_BAR; PG8_SCHED;
            PG8_LDB(B0, 1, 0); PG8_LDB(B1, 1, 1); PG8_SCHED; PG8_LDA(At, 1, 0); PG8_STAGE(PG8_SA(0, 1), a2 + hstep, voffA);
            PG8_WAIT_V(8); PG8_WAIT_L(0); PG8_BAR; PG8_MMA(0, 0, At, B0); PG8_MMA(0, 1, At, B1); PG8_BAR; PG8_SCHED;
            PG8_LDA(At, 1, 1); PG8_STAGE(PG8_SB(1, 0), b3, voffB); PG8_STAGE(PG8_SB(1, 1), b3 + hstep, voffB); PG8_STAGE(PG8_SA(1, 0), a3, voffA);
            PG8_WAIT_V(8); PG8_WAIT_L(0); PG8_BAR; PG8_MMA(1, 0, At, B0); PG8_MMA(1, 1, At, B1); PG8_BAR; PG8_SCHED;
            } else {
            PG8_LDB(B0, 0, 0); PG8_SCHED; PG8_LDA(At, 0, 0); PG8_STAGE(PG8_SA(1, 1), a1 + hstep, voffA);
            PG8_WAIT_L(8); PG8_BAR; PG8_WAIT_L(0); PG8_MMA(0, 0, At, B0); PG8_BAR; PG8_SCHED;
            PG8_LDB(B1, 0, 1); PG8_STAGE(PG8_SB(0, 0), b2, voffB);
            PG8_BAR; PG8_WAIT_L(0); PG8_MMA(0, 1, At, B1); PG8_BAR;
            PG8_LDA(At, 0, 1); PG8_STAGE(PG8_SA(0, 0), a2, voffA);
            PG8_BAR; PG8_WAIT_L(0); PG8_MMA(1, 0, At, B0); PG8_BAR; PG8_SCHED;
            PG8_STAGE(PG8_SB(0, 1), b2 + hstep, voffB);
            PG8_WAIT_V(6); PG8_BAR; PG8_MMA(1, 1, At, B1); PG8_BAR;
            PG8_LDB(B0, 1, 0); PG8_SCHED; PG8_LDA(At, 1, 0); PG8_STAGE(PG8_SA(0, 1), a2 + hstep, voffA);
            PG8_WAIT_L(8); PG8_BAR; PG8_WAIT_L(0); PG8_MMA(0, 0, At, B0); PG8_BAR; PG8_SCHED;
            PG8_LDB(B1, 1, 1); PG8_STAGE(PG8_SB(1, 0), b3, voffB);
            PG8_BAR; PG8_WAIT_L(0); PG8_MMA(0, 1, At, B1); PG8_BAR;
            PG8_LDA(At, 1, 1); PG8_STAGE(PG8_SA(1, 0), a3, voffA);
            PG8_BAR; PG8_WAIT_L(0); PG8_MMA(1, 0, At, B0); PG8_BAR; PG8_SCHED;
            PG8_STAGE(PG8_SB(1, 1), b3 + hstep, voffB);
            PG8_WAIT_V(6); PG8_BAR; PG8_MMA(1, 1, At, B1); PG8_BAR;
            }
        }
        if constexpr (ALIGN_EPI) { if (wr == 0) PG8_BAR; }
        if constexpr (F8) {
#pragma unroll
            for (int a = 0; a < 2; ++a)
#pragma unroll
                for (int b = 0; b < 2; ++b)
#pragma unroll
                    for (int m = 0; m < 4; ++m)
#pragma unroll
                        for (int n = 0; n < 2; ++n) { const pg8_i32x4 iv = __builtin_bit_cast(pg8_i32x4, acc[a][b][m][n]); acc[a][b][m][n] = (f32x4){(float)iv[0], (float)iv[1], (float)iv[2], (float)iv[3]}; } }
        if constexpr (!Epi::AFTER_DRAIN) { const int le = fresh_lane(); E(acc, cur, wr, wc, le & 15, le >> 4); S.done(cur); }
        if (!has_next) break;
#pragma unroll
        for (int a = 0; a < 2; ++a)
#pragma unroll
            for (int b = 0; b < 2; ++b)
#pragma unroll
                for (int m = 0; m < 4; ++m)
#pragma unroll
                    for (int n = 0; n < 2; ++n) acc[a][b][m][n] = (f32x4){0.f, 0.f, 0.f, 0.f};
        cur = nxt; cA = nA; cB = nB; ++ui;
        if constexpr (ALIGN_EPI) { if (wr == 1) PG8_BAR; }
    }
    PG8_WAIT_V(0);
    if constexpr (!ALIGN_EPI) { if (wr == 0) PG8_BAR; }
    PG8_BAR;
    if constexpr (Epi::AFTER_DRAIN) { E.fused(acc, cur, wr, wc, fr, fq, lds, wid, lane); S.done(cur); }
#undef PG8_SA
#undef PG8_SB
#undef PG8_STAGE
#undef PG8_LDA
#undef PG8_LDB
#undef PG8_MMA
#undef PG8_WAIT_V
#undef PG8_WAIT_L
#undef PG8_BAR
#undef PG8_SCHED
}
}

#define XB_TMO      128
#define XB_XCNT(j)  (256  + 64 * (j))
#define XB_XSUB(j)  (1280 + 64 * (j))
#define XB_XGEN(j)  (2304 + 64 * (j))
#define XB_TOP      3328
#define XB_TOPGEN   3392
#define XCD_BAR_WORDS 3456
#define XB_SPIN_CAP (1u << 18)

__device__ __forceinline__ unsigned xb_ld(unsigned* p)              { return __hip_atomic_load(p, __ATOMIC_RELAXED, __HIP_MEMORY_SCOPE_AGENT); }
__device__ __forceinline__ unsigned xb_add(unsigned* p, unsigned v) { return __hip_atomic_fetch_add(p, v, __ATOMIC_RELAXED, __HIP_MEMORY_SCOPE_AGENT); }
__device__ __forceinline__ unsigned xb_xcc_id() { return (unsigned)__builtin_amdgcn_s_getreg((3 << 11) | 20) & 0xFu; }
#define XB_SPIN(cond, bar) do { unsigned _sp = 0; while (cond) { __builtin_amdgcn_s_sleep(1); \
    if ((++_sp & 255u) == 0u) { if (xb_ld(&(bar)[XB_TMO])) break; if (_sp > XB_SPIN_CAP) { atomicAdd(&(bar)[XB_TMO], 1u); break; } } } } while (0)

struct XcdBarrier {
    unsigned* bar; unsigned x; int wave;
    volatile LAS unsigned* st;
};

__device__ __forceinline__ XcdBarrier xcd_barrier_post(unsigned* bar, volatile LAS unsigned* st) {
    XcdBarrier b; b.bar = bar; b.x = xb_xcc_id(); b.st = st; b.wave = __builtin_amdgcn_readfirstlane(threadIdx.x >> 6);
    if (threadIdx.x == 0) (void)xb_add(&bar[XB_XCNT(b.x)], 1u);
    return b;
}
__device__ __forceinline__ void xcd_barrier_complete(unsigned* bar, unsigned x, unsigned& nloc, unsigned& nx) {
    const unsigned G = gridDim.x * gridDim.y * gridDim.z;
    unsigned sum, cnt, mine, sp = 0u;
    for (;;) {
        sum = 0u; cnt = 0u; mine = 0u;
#pragma unroll
        for (unsigned j = 0; j < 16; ++j) { const unsigned c = xb_ld(&bar[XB_XCNT(j)]); sum += c; cnt += (c > 0u) ? 1u : 0u; mine = (j == x) ? c : mine; }
        if (sum == G) break;
        __builtin_amdgcn_s_sleep(1);
        if ((++sp & 255u) == 0u) { if (xb_ld(&bar[XB_TMO])) break; if (sp > XB_SPIN_CAP) { atomicAdd(&bar[XB_TMO], 1u); break; } }
    }
    nloc = mine > 0u ? mine : 1u; nx = cnt > 0u ? cnt : 1u;
}

__device__ __forceinline__ void xcd_barrier(const XcdBarrier& b) {
    asm volatile("s_waitcnt vmcnt(0)" ::: "memory");
    __syncthreads();
    if (b.wave == 0 && fresh_lane() == 0) {
        unsigned* bar = b.bar;
        __builtin_amdgcn_s_waitcnt(0);
        unsigned nloc = b.st[0], nx = b.st[1];
        if (nloc == 0u) { xcd_barrier_complete(bar, b.x, nloc, nx); b.st[0] = nloc; b.st[1] = nx; }
        const unsigned old = xb_add(&bar[XB_XSUB(b.x)], 1u);
        const unsigned gen = old / nloc;
        if (old + 1u == (gen + 1u) * nloc) {
            __builtin_amdgcn_fence(__ATOMIC_RELEASE, "agent");
            asm volatile("s_waitcnt vmcnt(0)" ::: "memory");
            const unsigned og = xb_add(&bar[XB_TOP], 1u);
            const unsigned tg = og / nx;
            if (og + 1u == (tg + 1u) * nx) xb_add(&bar[XB_TOPGEN], 1u);
            else XB_SPIN(xb_ld(&bar[XB_TOPGEN]) == tg, bar);
            __builtin_amdgcn_fence(__ATOMIC_ACQUIRE, "agent");
            xb_add(&bar[XB_XGEN(b.x)], 1u);
            asm volatile("s_waitcnt vmcnt(0)" ::: "memory");
        } else {
            XB_SPIN(xb_ld(&bar[XB_XGEN(b.x)]) == gen, bar);
            __builtin_amdgcn_fence(__ATOMIC_ACQUIRE, "agent");
            asm volatile("s_waitcnt vmcnt(0)" ::: "memory");
        }
    }
    __syncthreads();
}

constexpr size_t MiB = 1u << 20;
constexpr size_t WS_CTL = 0, CTL_ZERO_BYTES = 1 * MiB;
constexpr size_t WS_UB   = 1 * MiB;
constexpr size_t WS_VT   = WS_UB + 128 * MiB;
constexpr size_t WS_WBAT = WS_VT + 128 * MiB;
constexpr size_t WS_WBBT = WS_WBAT + 16 * MiB;
constexpr size_t WS_WOT  = WS_WBBT + 16 * MiB;
constexpr size_t WS_W4T  = WS_WOT + 32 * MiB;
constexpr size_t WS_WPLT = WS_W4T + 48 * MiB;
constexpr size_t WS_PB   = WS_WPLT + 2 * MiB;
constexpr size_t WS_XB   = WS_PB + 4 * MiB;
constexpr size_t WS_E    = WS_XB + 64 * MiB;
constexpr size_t WS_F    = WS_E + 148 * MiB;
constexpr size_t WS_QA   = WS_F + 128 * MiB;
constexpr size_t WS_QIDX = WS_QA + 32 * MiB;
constexpr size_t WS_QB   = WS_QIDX + 32 * MiB;
constexpr size_t WS_KB   = WS_QB + 32 * MiB;
constexpr size_t WS_VB   = WS_KB + 32 * MiB;
constexpr size_t WS_OB   = WS_VB + 32 * MiB;
constexpr size_t WS_CKV  = WS_OB + 32 * MiB;
constexpr size_t WS_SM   = WS_CKV + 8 * MiB;
constexpr size_t WS_CKVN = WS_SM + 8 * MiB;
constexpr size_t WS_CUM  = WS_CKVN + 4 * MiB;
constexpr size_t WS_PL   = WS_CUM + 1 * MiB;
constexpr size_t WS_WUKB = WS_PL + 128 * MiB;
constexpr size_t WS_WUVT = WS_WUKB + 1 * MiB;
constexpr size_t WS_KIDXB = WS_WUVT + 1 * MiB;
constexpr size_t WS_SCL = WS_KIDXB + 1 * MiB;
constexpr size_t WS_END  = WS_SCL + 1 * MiB;
constexpr size_t WS_PART = WS_UB + 64 * MiB;
constexpr size_t WS_X8   = WS_VT + 32 * MiB;
constexpr size_t WS_W18  = WS_E;
constexpr size_t WS_W48  = WS_VT + 64 * MiB;
constexpr size_t WS_WIDX = WS_SM;
constexpr size_t WS_QLAT = WS_E, WS_OLAT = WS_E + 64 * MiB;
static_assert(WS_END <= (size_t)1174 * MiB, "d_ws map");
constexpr int CW_BAR = 4096;

constexpr int NWAVES = 8, NTHREADS = 512;
constexpr int LDS_BYTES = 147456;
constexpr int LDSCTL_OFF = LDS_BYTES - 256;

typedef float f32x16 __attribute__((ext_vector_type(16)));
typedef short s16x4 __attribute__((ext_vector_type(4)));
template <int K>
__device__ __forceinline__ void small_gemm_tile(const bf16* A, int lda, const bf16* Bt, int ldb, bf16* C, int ldc, int lane, unsigned char* C8 = nullptr, float sc8 = 1.0f) {
    const int r = lane & 15, g = lane >> 4;
    f32x4 acc[4][4];
#pragma unroll
    for (int a = 0; a < 4; ++a)
#pragma unroll
        for (int b = 0; b < 4; ++b) acc[a][b] = (f32x4){0.f, 0.f, 0.f, 0.f};
    const bf16* ap = A + (size_t)r * lda + 8 * g; const bf16* bp = Bt + (size_t)r * ldb + 8 * g;
#pragma unroll 2
    for (int s = 0; s < K / 32; ++s) {
        bf16x8 af[4], bfr[4];
#pragma unroll
        for (int i = 0; i < 4; ++i) { af[i] = *(const bf16x8*)(ap + (size_t)(16 * i) * lda + 32 * s); bfr[i] = *(const bf16x8*)(bp + (size_t)(16 * i) * ldb + 32 * s); }
#pragma unroll
        for (int ni = 0; ni < 4; ++ni)
#pragma unroll
            for (int ti = 0; ti < 4; ++ti) acc[ni][ti] = __builtin_amdgcn_mfma_f32_16x16x32_bf16(bfr[ni], af[ti], acc[ni][ti], 0, 0, 0);
    }
#pragma unroll
    for (int ni = 0; ni < 4; ++ni)
#pragma unroll
        for (int ti = 0; ti < 4; ++ti) {
            if (C8) { *(unsigned*)(C8 + (size_t)(16 * ti + r) * ldc + 16 * ni + 4 * g) = pk_q8x4(acc[ni][ti][0], acc[ni][ti][1], acc[ni][ti][2], acc[ni][ti][3], sc8); continue; }
            u32x2 wv; wv.x = pk2(acc[ni][ti][0], acc[ni][ti][1]); wv.y = pk2(acc[ni][ti][2], acc[ni][ti][3]);
            *(u32x2*)(C + (size_t)(16 * ti + r) * ldc + 16 * ni + 4 * g) = wv; }
}
__device__ __forceinline__ bf16x8 ld8_f32_bf16(const float* p) { const f32x4 a = *(const f32x4*)p, b = *(const f32x4*)(p + 4); union { bf16x8 v; unsigned u[4]; } r; r.u[0] = pk2(a[0], a[1]); r.u[1] = pk2(a[2], a[3]); r.u[2] = pk2(b[0], b[1]); r.u[3] = pk2(b[2], b[3]); return r.v; }
template <int K>
__device__ __forceinline__ void small_gemm_tile_f32(const float* A, int lda, const float* Bt, int ldb, bf16* C, int ldc, int lane, unsigned char* C8 = nullptr) {
    const int r = lane & 15, g = lane >> 4;
    f32x4 acc[4][4];
#pragma unroll
    for (int a = 0; a < 4; ++a)
#pragma unroll
        for (int b = 0; b < 4; ++b) acc[a][b] = (f32x4){0.f, 0.f, 0.f, 0.f};
    const float* ap = A + (size_t)r * lda + 8 * g; const float* bp = Bt + (size_t)r * ldb + 8 * g;
#pragma unroll 1
    for (int s = 0; s < K / 32; ++s) {
        bf16x8 af[4], bfr[4];
#pragma unroll
        for (int i = 0; i < 4; ++i) { af[i] = ld8_f32_bf16(ap + (size_t)(16 * i) * lda + 32 * s); bfr[i] = ld8_f32_bf16(bp + (size_t)(16 * i) * ldb + 32 * s); }
#pragma unroll
        for (int ni = 0; ni < 4; ++ni)
#pragma unroll
            for (int ti = 0; ti < 4; ++ti) acc[ni][ti] = __builtin_amdgcn_mfma_f32_16x16x32_bf16(bfr[ni], af[ti], acc[ni][ti], 0, 0, 0);
    }
#pragma unroll
    for (int ni = 0; ni < 4; ++ni)
#pragma unroll
        for (int ti = 0; ti < 4; ++ti) { u32x2 wv; wv.x = pk2(acc[ni][ti][0], acc[ni][ti][1]); wv.y = pk2(acc[ni][ti][2], acc[ni][ti][3]);
            *(u32x2*)(C + (size_t)(16 * ti + r) * ldc + 16 * ni + 4 * g) = wv;
            if (C8) *(unsigned*)(C8 + (size_t)(16 * ti + r) * ldc + 16 * ni + 4 * g) = pk_q8x4(acc[ni][ti][0], acc[ni][ti][1], acc[ni][ti][2], acc[ni][ti][3], Q8_W); }
}
struct Args { const float* in[23]; float* out; unsigned char* ws; int ph_lo, ph_hi, li, pad; };
enum InIdx { I_X = 0, I_P, I_WIN, I_BFORGET, I_GLAT, I_WUK, I_WUV, I_WBA, I_WBB, I_WGATE, I_BGATE, I_WOUT, I_LN1G, I_LN1B, I_PWQ, I_PSUB, I_PU, I_PV, I_WPLE, I_WPG, I_BPG, I_LN2G, I_LN2B };

struct Frame {
    LAS unsigned char* lds;
    int tid, lane, wave, G, bid;
};
#define KARGQ ((const __attribute__((address_space(4))) unsigned long long*)__builtin_amdgcn_kernarg_segment_ptr())
#define INP(i) ((const float*)(const GAS float*)KARGQ[(i)])
#define OUTP() ((float*)(GAS float*)KARGQ[23])
#define WSB() ((unsigned char*)(GAS unsigned char*)KARGQ[24])
#define WSP(T, off) ((T*)(WSB() + (off)))

__device__ __forceinline__ void transpose_item(const float* W, int ldw, int src_col, int ncols, int k0, bf16* WT, int K, int dst_row0, LAS float* scr, int lane) {
    const int c = lane & 31;
    float tmp[32];
    const float* wp = W + (size_t)(k0 + (lane >> 5)) * ldw + src_col + c;
#pragma unroll
    for (int i = 0; i < 32; ++i) tmp[i] = (c < ncols) ? wp[(size_t)(2 * i) * ldw] : 0.f;
#pragma unroll
    for (int i = 0; i < 32; ++i) scr[(2 * i + (lane >> 5)) * 33 + c] = tmp[i];
    LDS_WAIT();
    const int c8 = lane & 7;
#pragma unroll
    for (int j = 0; j < 4; ++j) { const int n = (lane >> 3) + 8 * j; const LAS float* s = scr + (8 * c8) * 33 + n;
        u32x4 o; o.x = pk2(s[0 * 33], s[1 * 33]); o.y = pk2(s[2 * 33], s[3 * 33]); o.z = pk2(s[4 * 33], s[5 * 33]); o.w = pk2(s[6 * 33], s[7 * 33]);
        *(u32x4*)(WT + (size_t)(dst_row0 + n) * K + k0 + 8 * c8) = o; }
    LDS_WAIT();
}
__device__ __forceinline__ void transpose_item_q8(const float* W, int ldw, int src_col, int k0, unsigned char* WT8, int K, int dst_row0, float sc, LAS float* scr, int lane) {
    const int c = lane & 31;
    float tmp[32];
    const float* wp = W + (size_t)(k0 + (lane >> 5)) * ldw + src_col + c;
#pragma unroll
    for (int i = 0; i < 32; ++i) tmp[i] = wp[(size_t)(2 * i) * ldw];
#pragma unroll
    for (int i = 0; i < 32; ++i) scr[(2 * i + (lane >> 5)) * 33 + c] = tmp[i];
    LDS_WAIT();
    const int c8 = lane & 7;
#pragma unroll
    for (int j = 0; j < 4; ++j) { const int n = (lane >> 3) + 8 * j; const LAS float* s = scr + (8 * c8) * 33 + n;
        u32x2 o; o.x = pk_q8x4(s[0 * 33], s[1 * 33], s[2 * 33], s[3 * 33], sc); o.y = pk_q8x4(s[4 * 33], s[5 * 33], s[6 * 33], s[7 * 33], sc);
        *(u32x2*)(WT8 + (size_t)(dst_row0 + n) * K + k0 + 8 * c8) = o; }
    LDS_WAIT();
}
__device__ __forceinline__ void cvt_bf16_stream(const float* src, bf16* dst, size_t n8, size_t gt, size_t gstride) {
    size_t i = gt;
    for (; i + 3 * gstride < n8; i += 4 * gstride) {
        f32x4 a[4], b[4];
#pragma unroll
        for (int u = 0; u < 4; ++u) { a[u] = *(const f32x4*)(src + (i + u * gstride) * 8); b[u] = *(const f32x4*)(src + (i + u * gstride) * 8 + 4); }
#pragma unroll
        for (int u = 0; u < 4; ++u) { u32x4 o; o.x = pk2(a[u][0], a[u][1]); o.y = pk2(a[u][2], a[u][3]); o.z = pk2(b[u][0], b[u][1]); o.w = pk2(b[u][2], b[u][3]); *(u32x4*)(dst + (i + u * gstride) * 8) = o; } }
    for (; i < n8; i += gstride) { const f32x4 a = *(const f32x4*)(src + i * 8), b = *(const f32x4*)(src + i * 8 + 4);
        u32x4 o; o.x = pk2(a[0], a[1]); o.y = pk2(a[2], a[3]); o.z = pk2(b[0], b[1]); o.w = pk2(b[2], b[3]); *(u32x4*)(dst + i * 8) = o; }
}
__device__ __forceinline__ void p0_prologue(Frame& F) {
    LAS float* scr = (LAS float*)(F.lds + F.wave * 16384);
    const int gw = F.bid * NWAVES + F.wave, NGW = F.G * NWAVES;
    const float* w_in = INP(I_WIN); const float* w_gate = INP(I_WGATE);
    constexpr int NDB1 = N1 / 32, I_1 = NDB1 * 64;
    constexpr int I_BA = 128 * 32, I_BB = I_BA, I_O = 128 * 64, I_4 = 128 * 64, I_PL = 128 * 4;
    constexpr int NITEMS = I_1 + I_BA + I_BB + I_O + I_4 + I_PL;
    for (int it = gw; it < NITEMS; it += NGW) {
        int r = it;
        if (r < I_1) { const int kb = r / NDB1, db = r % NDB1; const float* W; int ldw, col, nc;
            if (db < 576) {
                if (db < 64) { W = w_in; ldw = IN_WIDTH; col = db * 32; }
                else if (db < 128) { W = w_in; ldw = IN_WIDTH; col = 2304 + (db - 64) * 32; }
                else if (db < 320) { W = w_in; ldw = IN_WIDTH; col = 4448 + (db - 128) * 32; }
                else { W = w_gate; ldw = 8192; col = (db - 320) * 32; }
                transpose_item_q8(W, ldw, col, kb * 64, WSP(unsigned char, WS_W18), 4096, db * 32, Q8_W, scr, F.lane); continue; }
            else if (db < 584) { W = w_in; ldw = IN_WIDTH; col = 2048 + (db - 576) * 32; nc = 32; }
            else { const int j = db - 584; W = w_in; ldw = IN_WIDTH; col = (j < 2) ? 4352 + 32 * j : (j == 2 ? 4416 : 10592); nc = (j < 3) ? 32 : (j == 3 ? 16 : 0); }
            transpose_item(W, ldw, col, nc, kb * 64, WSP(bf16, WS_E), 4096, db * 32, scr, F.lane); continue; }
        r -= I_1;
        if (r < I_BA) { const int kb = r / 128, db = r % 128; transpose_item_q8(INP(I_WBA), 4096, db * 32, kb * 64, WSP(unsigned char, WS_WBAT), 2048, db * 32, Q8_WB, scr, F.lane); continue; }
        r -= I_BA;
        if (r < I_BB) { const int kb = r / 128, db = r % 128; transpose_item_q8(INP(I_WBB), 4096, db * 32, kb * 64, WSP(unsigned char, WS_WBBT), 2048, db * 32, Q8_WB, scr, F.lane); continue; }
        r -= I_BB;
        if (r < I_O) { const int kb = r / 128, db = r % 128; transpose_item_q8(INP(I_WOUT), 4096, db * 32, kb * 64, WSP(unsigned char, WS_WOT), 4096, db * 32, Q8_WO, scr, F.lane); continue; }
        r -= I_O;
        if (r < I_4) { const int kb = r / 128, db = r % 128;
            transpose_item_q8(INP(I_WPG), 4096, db * 32, kb * 64, WSP(unsigned char, WS_W48), 4096, 2048 + db * 32, Q8_W, scr, F.lane); continue; }
        r -= I_4;
        { const int kb = r / 128, db = r % 128; transpose_item(INP(I_WPLE), 4096, db * 32, 32, kb * 64, WSP(bf16, WS_WPLT), 256, db * 32, scr, F.lane); }
    }
    for (int it = gw; it < 16 * 2 * 64; it += NGW) { const int dt = it & 63, nt = (it >> 6) & 1, l = it >> 7;
        small_gemm_tile_f32<128>(INP(I_PSUB) + (size_t)(l * 128 + nt * 64) * 128, 128, INP(I_PWQ) + (size_t)(dt * 64) * 2048 + (l >> 1) * 256 + (l & 1) * 128, 2048,
                                 WSP(bf16, WS_W4T) + (size_t)(l * 128 + nt * 64) * 4096 + dt * 64, 4096, F.lane, WSP(unsigned char, WS_W48) + (size_t)(l * 128 + nt * 64) * 4096 + dt * 64); }
    const size_t gt = (size_t)F.bid * NTHREADS + F.tid, gs = (size_t)F.G * NTHREADS;
    { const float* src = INP(I_X); bf16* dst = WSP(bf16, WS_XB); unsigned char* d8 = WSP(unsigned char, WS_X8); const size_t n8 = (size_t)NTOK * D_MODEL / 8;
      for (size_t i = gt; i < n8; i += 4 * gs) {
          if (i + 3 * gs >= n8) { for (size_t j = i; j < n8; j += gs) { const f32x4 a = *(const f32x4*)(src + j * 8), b = *(const f32x4*)(src + j * 8 + 4);
                  u32x4 o; o.x = pk2(a[0], a[1]); o.y = pk2(a[2], a[3]); o.z = pk2(b[0], b[1]); o.w = pk2(b[2], b[3]); *(u32x4*)(dst + j * 8) = o;
                  u32x2 q; q.x = pk_q8x4(a[0], a[1], a[2], a[3], Q8_ACT); q.y = pk_q8x4(b[0], b[1], b[2], b[3], Q8_ACT); *(u32x2*)(d8 + j * 8) = q; } break; }
          f32x4 a[4], b[4];
#pragma unroll
          for (int u = 0; u < 4; ++u) { a[u] = *(const f32x4*)(src + (i + u * gs) * 8); b[u] = *(const f32x4*)(src + (i + u * gs) * 8 + 4); }
#pragma unroll
          for (int u = 0; u < 4; ++u) { u32x4 o; o.x = pk2(a[u][0], a[u][1]); o.y = pk2(a[u][2], a[u][3]); o.z = pk2(b[u][0], b[u][1]); o.w = pk2(b[u][2], b[u][3]); *(u32x4*)(dst + (i + u * gs) * 8) = o;
              u32x2 q; q.x = pk_q8x4(a[u][0], a[u][1], a[u][2], a[u][3], Q8_ACT); q.y = pk_q8x4(b[u][0], b[u][1], b[u][2], b[u][3], Q8_ACT); *(u32x2*)(d8 + (i + u * gs) * 8) = q; } } }
    cvt_bf16_stream(INP(I_P), WSP(bf16, WS_PB), (size_t)NTOK * D_PLE / 8, gt, gs);
    { float* SCL = WSP(float, WS_SCL);
      for (int row = gw; row < 2 * N_EXPERTS; row += NGW) { const int tb = row >= N_EXPERTS ? 1 : 0, e = row - tb * N_EXPERTS;
          const float* src = (tb ? INP(I_PV) : INP(I_PU)) + (size_t)e * 4096; unsigned char* dst = (tb ? WSP(unsigned char, WS_VT) : WSP(unsigned char, WS_UB)) + (size_t)e * 2048;
          f32x4 v[16]; float ssq = 0.f;
#pragma unroll
          for (int jj = 0; jj < 2; ++jj)
#pragma unroll
              for (int q = 0; q < 8; ++q) { const f32x4 x = *(const f32x4*)(src + (jj * 64 + F.lane) * 32 + 4 * q); v[8 * jj + q] = x; ssq += (x[0] * x[0] + x[1] * x[1]) + (x[2] * x[2] + x[3] * x[3]); }
          const float sig = sqrtf(wave_sum(ssq) * (1.0f / 4096.0f)); const float inv = sig > 0.f ? 2.1f / sig : 0.f;
#pragma unroll
          for (int jj = 0; jj < 2; ++jj) { u32x4 o;
#pragma unroll
              for (int i = 0; i < 4; ++i) { const f32x4 a = v[8 * jj + 2 * i] * inv, b = v[8 * jj + 2 * i + 1] * inv; unsigned p = 0u;
                  p = __builtin_amdgcn_cvt_scalef32_pk_fp4_f32(p, a[0], a[1], 1.0f, 0); p = __builtin_amdgcn_cvt_scalef32_pk_fp4_f32(p, a[2], a[3], 1.0f, 1);
                  p = __builtin_amdgcn_cvt_scalef32_pk_fp4_f32(p, b[0], b[1], 1.0f, 2); p = __builtin_amdgcn_cvt_scalef32_pk_fp4_f32(p, b[2], b[3], 1.0f, 3); o[i] = p; }
              *(u32x4*)(dst + (jj * 64 + F.lane) * 16) = o; }
          if (F.lane == 0) SCL[row] = sig > 0.f ? sig * (1.0f / 2.1f) : 1.0f; } }
    { const float* w_uk = INP(I_WUK); const float* w_uv = INP(I_WUV); bf16* WUKB = WSP(bf16, WS_WUKB); bf16* WUVT = WSP(bf16, WS_WUVT);
      for (size_t i = gt; i < 65536; i += gs) { const int d8 = (int)(i & 15), c = (int)(i >> 4) & 255, h = (int)(i >> 12);
          const float* src = w_uk + (size_t)c * 2048 + h * 128 + d8 * 8; const f32x4 a = *(const f32x4*)src, b = *(const f32x4*)(src + 4);
          u32x4 o; o.x = pk2(a[0], a[1]); o.y = pk2(a[2], a[3]); o.z = pk2(b[0], b[1]); o.w = pk2(b[2], b[3]); *(u32x4*)(WUKB + i * 8) = o; }
      for (size_t i = gt; i < 65536; i += gs) { const int c8 = (int)(i & 31), d = (int)(i >> 5) & 127, h = (int)(i >> 12);
          const float* src = w_uv + (size_t)(c8 * 8) * 2048 + h * 128 + d;
          u32x4 o; o.x = pk2(src[0], src[2048]); o.y = pk2(src[2 * 2048], src[3 * 2048]); o.z = pk2(src[4 * 2048], src[5 * 2048]); o.w = pk2(src[6 * 2048], src[7 * 2048]); *(u32x4*)(WUVT + i * 8) = o; } }
}

__device__ __forceinline__ f32x4 part_sum4(const float* PART, int tile, size_t off) { const size_t pl = (size_t)NTOK * 256; const float* p = PART + (size_t)tile * pl + off;
    return (*(const f32x4*)p + *(const f32x4*)(p + 2 * pl)) + (*(const f32x4*)(p + 4 * pl) + *(const f32x4*)(p + 6 * pl)); }
__device__ __forceinline__ float log_sigmoid(float z) { return fminf(z, 0.f) - log1pf(__expf(-fabsf(z))); }
__device__ __forceinline__ void p2_small(Frame& F) {
    const int gw = F.bid * NWAVES + F.wave, NGW = F.G * NWAVES, lane = F.lane;
    { const float* PART = WSP(float, WS_PART); bf16* CKVN = WSP(bf16, WS_CKVN); const f32x4 g = *(const f32x4*)(INP(I_GLAT) + 4 * lane);
      for (int t = gw; t < NTOK; t += NGW) { const f32x4 v = part_sum4(PART, 0, (size_t)t * 256 + 4 * lane);
          const float ss = wave_sum(v[0] * v[0] + v[1] * v[1] + v[2] * v[2] + v[3] * v[3]); const float r = 1.0f / sqrtf(ss * (1.0f / 256.0f) + LN_EPS);
          u32x2 o; o.x = pk2(v[0] * r * g[0], v[1] * r * g[1]); o.y = pk2(v[2] * r * g[2], v[3] * r * g[3]); *(u32x2*)(CKVN + (size_t)t * 256 + 4 * lane) = o; } }
    { const float* PART = WSP(float, WS_PART); float* CUML = WSP(float, WS_CUM); float* SEGT = WSP(float, WS_CUM + 512 * 1024); const float* bfp = INP(I_BFORGET);
      for (int it = gw; it < BATCH * (SEQ / 64); it += NGW) { const int b = it / (SEQ / 64), seg = it % (SEQ / 64), pos = seg * 64 + lane;
          f32x4 f[4];
#pragma unroll
          for (int q = 0; q < 4; ++q) f[q] = part_sum4(PART, 1, (size_t)(b * SEQ + pos) * 256 + 96 + 4 * q);
#pragma unroll
          for (int h = 0; h < B_HEADS; ++h) { float v = log_sigmoid(f[h >> 2][h & 3] + bfp[h]);
#pragma unroll
              for (int o = 1; o < 64; o <<= 1) { const float t = __shfl_up(v, o); if (lane >= o) v += t; }
              CUML[(size_t)(b * B_HEADS + h) * SEQ + pos] = v; if (lane == 63) SEGT[(b * B_HEADS + h) * (SEQ / 64) + seg] = v; } } }
    { const bf16* QA = WSP(bf16, WS_QA); bf16* QLAT = WSP(bf16, WS_QLAT); const bf16* WUKB = WSP(bf16, WS_WUKB);
      for (int it = gw; it < (NTOK / 64) * A_HEADS * 4; it += NGW) { const int ct = it & 3, h = (it >> 2) & 15, tt = it >> 6;
          small_gemm_tile<128>(QA + (size_t)tt * 64 * 2048 + h * 128, 2048, WUKB + (size_t)(h * 256 + ct * 64) * 128, 128, QLAT + (size_t)tt * 64 * 4096 + h * 256 + ct * 64, 4096, lane); } }
    { const float* PART = WSP(float, WS_PART); bf16* KIDXB = WSP(bf16, WS_KIDXB); float* WIDX = WSP(float, WS_WIDX); const size_t gt = (size_t)F.bid * NTHREADS + F.tid, gs = (size_t)F.G * NTHREADS;
      for (size_t i = gt; i < (size_t)NTOK * 8; i += gs) { const size_t t = i >> 3; const int q = (int)(i & 7); *(f32x4*)(WIDX + t * 32 + 4 * q) = part_sum4(PART, 1, t * 256 + 64 + 4 * q); }
      for (size_t i = gt; i < (size_t)NTOK * 8; i += gs) { const size_t t = i >> 3; const int c8 = (int)(i & 7); const f32x4 a = part_sum4(PART, 1, t * 256 + c8 * 8), b = part_sum4(PART, 1, t * 256 + c8 * 8 + 4);
          u32x4 o; o.x = pk2(a[0], a[1]); o.y = pk2(a[2], a[3]); o.z = pk2(b[0], b[1]); o.w = pk2(b[2], b[3]);
          const size_t tl = t & (SEQ - 1); *(u32x4*)(KIDXB + (t - tl) * 64 + (tl >> 5) * 2048 + (c8 >> 1) * 512 + (tl & 31) * 16 + (c8 & 1) * 8) = o; } }
}

__device__ __forceinline__ unsigned f2key(float f) { const unsigned b = __builtin_bit_cast(unsigned, f); return (b & 0x80000000u) ? ~b : (b | 0x80000000u); }
__device__ __forceinline__ int lanes_below(unsigned long long m) { return (int)__builtin_amdgcn_mbcnt_hi((unsigned)(m >> 32), __builtin_amdgcn_mbcnt_lo((unsigned)m, 0u)); }
__device__ __forceinline__ void p4_oa(Frame& F) {
    const int gw = F.bid * NWAVES + F.wave, NGW = F.G * NWAVES, lane = F.lane;
    const bf16* OLAT = WSP(bf16, WS_OLAT); bf16* OA = WSP(bf16, WS_QA); const bf16* WUVT = WSP(bf16, WS_WUVT);
    for (int it = gw; it < (NTOK / 64) * A_HEADS * 2; it += NGW) { const int dt = it & 1, h = (it >> 1) & 15, tt = it >> 5;
        small_gemm_tile<256>(OLAT + (size_t)tt * 64 * 4096 + h * 256, 4096, WUVT + (size_t)(h * 128 + dt * 64) * 256, 256, nullptr, 2048, lane, (unsigned char*)OA + (size_t)tt * 64 * 2048 + h * 128 + dt * 64, Q8_O); }
}
__device__ __forceinline__ void p7_ln1(Frame& F) {
    const int gw = F.bid * NWAVES + F.wave, NGW = F.G * NWAVES, lane = F.lane;
    const bf16* Y1 = WSP(bf16, WS_E); bf16* H1B = WSP(bf16, WS_XB); unsigned char* H18 = WSP(unsigned char, WS_X8); const float* g = INP(I_LN1G); const float* bb = INP(I_LN1B);
    for (int t = gw; t < NTOK; t += NGW) { const bf16* yr = Y1 + (size_t)t * 4096;
        f32x4 v[16]; float s = 0.f;
#pragma unroll
        for (int j = 0; j < 8; ++j) { const u32x4 w = *(const u32x4*)(yr + (j * 64 + lane) * 8); v[2 * j] = (f32x4){bflo(w.x), bfhi(w.x), bflo(w.y), bfhi(w.y)}; v[2 * j + 1] = (f32x4){bflo(w.z), bfhi(w.z), bflo(w.w), bfhi(w.w)};
            s += (v[2 * j][0] + v[2 * j][1]) + (v[2 * j][2] + v[2 * j][3]) + (v[2 * j + 1][0] + v[2 * j + 1][1]) + (v[2 * j + 1][2] + v[2 * j + 1][3]); }
        const float mean = wave_sum(s) * (1.0f / 4096.0f); float q = 0.f;
#pragma unroll
        for (int j = 0; j < 16; ++j) { v[j] = v[j] - mean; q += (v[j][0] * v[j][0] + v[j][1] * v[j][1]) + (v[j][2] * v[j][2] + v[j][3] * v[j][3]); }
        const float rstd = 1.0f / sqrtf(wave_sum(q) * (1.0f / 4096.0f) + LN_EPS);
#pragma unroll
        for (int j = 0; j < 8; ++j) { const int off = (j * 64 + lane) * 8; const f32x4 g0 = *(const f32x4*)(g + off), g1 = *(const f32x4*)(g + off + 4), b0 = *(const f32x4*)(bb + off), b1 = *(const f32x4*)(bb + off + 4);
            const f32x4 o0 = v[2 * j] * rstd * g0 + b0, o1 = v[2 * j + 1] * rstd * g1 + b1;
            u32x4 w; w.x = pk2(o0[0], o0[1]); w.y = pk2(o0[2], o0[3]); w.z = pk2(o1[0], o1[1]); w.w = pk2(o1[2], o1[3]); *(u32x4*)(H1B + (size_t)t * 4096 + off) = w;
            u32x2 q8; q8.x = pk_q8x4(o0[0], o0[1], o0[2], o0[3], Q8_ACT); q8.y = pk_q8x4(o1[0], o1[1], o1[2], o1[3], Q8_ACT); *(u32x2*)(H18 + (size_t)t * 4096 + off) = q8; } }
}
constexpr int FOX_KP = 272, FOX_VP = 320, FOX_VOFF = 17408, FOX_COFF = 37888;
__device__ __forceinline__ void fox_unit(Frame& F, int b, int h, int qb) {
    const int tid = F.tid, lane = F.lane, w = F.wave, r = lane & 31, hh = lane >> 5;
    LAS unsigned char* Ks = F.lds; LAS unsigned char* Vs = F.lds + FOX_VOFF; LAS float* cks = (LAS float*)(F.lds + FOX_COFF);
    const bf16* QB = WSP(bf16, WS_QB); const bf16* KB = WSP(bf16, WS_KB); const bf16* VB = WSP(bf16, WS_VB); bf16* OB = WSP(bf16, WS_OB);
    const float* cum = WSP(float, WS_CUM) + (size_t)(b * B_HEADS + h) * SEQ;
    LAS float* segp = (LAS float*)(F.lds + FOX_COFF + 256);
    const int Q0 = qb * 256, q0 = Q0 + 32 * w, ntiles = (Q0 + 256) / 64, tl = (q0 + 31) / 64;
    const float SC = 0.12751741614123135f, LOG2E = 1.4426950408889634f;
    bf16x8 qf[8];
    { const bf16* qp = QB + ((size_t)b * SEQ + q0 + r) * 2048 + h * 128 + 8 * hh;
#pragma unroll
      for (int s = 0; s < 8; ++s) qf[s] = *(const bf16x8*)(qp + 16 * s); }
    f32x16 o[4];
#pragma unroll
    for (int dt = 0; dt < 4; ++dt)
#pragma unroll
        for (int i = 0; i < 16; ++i) o[dt][i] = 0.f;
    float m = -1e30f, l = 0.f;
    const int pk0 = tid >> 4, pc0 = tid & 15;
    const bf16* kg = KB + ((size_t)b * SEQ + pk0) * 2048 + h * 128 + 8 * pc0; const bf16* vg = VB + ((size_t)b * SEQ + pk0) * 2048 + h * 128 + 8 * pc0;
    u32x4 kr0, kr1, vr0, vr1; float cr = 0.f;
#define FOX_LOAD(kt) do { const size_t go = (size_t)(kt) * 64 * 2048; kr0 = *(const u32x4*)(kg + go); kr1 = *(const u32x4*)(kg + go + 32 * 2048); vr0 = *(const u32x4*)(vg + go); vr1 = *(const u32x4*)(vg + go + 32 * 2048); \
        if (tid < 64) cr = (cum[(kt) * 64 + tid] + segp[(kt)]) * LOG2E; } while (0)
    if (tid < 64) { float v = (lane < 32) ? WSP(float, WS_CUM + 512 * 1024)[(b * B_HEADS + h) * (SEQ / 64) + lane] : 0.f; const float own = v;
#pragma unroll
        for (int o = 1; o < 32; o <<= 1) { const float t = __shfl_up(v, o); if (lane >= o) v += t; }
        if (lane < 32) segp[lane] = v - own;
        CFENCE(); LDS_WAIT(); }
    FOX_LOAD(0);
    const int ka_off = r * FOX_KP + 16 * hh;
    const int vt_off = (4 * hh + ((lane & 15) >> 2)) * FOX_VP + (16 * ((lane >> 4) & 1) + 4 * (lane & 3)) * 2;
    const int ck_off = 4 * hh;
    for (int kt = 0; kt < ntiles; ++kt) {
        __syncthreads();
        *(LAS u32x4*)(Ks + pk0 * FOX_KP + pc0 * 16) = kr0; *(LAS u32x4*)(Ks + (pk0 + 32) * FOX_KP + pc0 * 16) = kr1;
        *(LAS u32x4*)(Vs + pk0 * FOX_VP + pc0 * 16) = vr0; *(LAS u32x4*)(Vs + (pk0 + 32) * FOX_VP + pc0 * 16) = vr1;
        if (tid < 64) cks[tid] = cr;
        __syncthreads();
        if (kt + 1 < ntiles) FOX_LOAD(kt + 1);
        if (kt <= tl) {
            f32x16 s0, s1;
#pragma unroll
            for (int i = 0; i < 16; ++i) { s0[i] = 0.f; s1[i] = 0.f; }
#pragma unroll
            for (int s = 0; s < 8; ++s) { const bf16x8 a0 = *(const LAS bf16x8*)(Ks + ka_off + 32 * s), a1 = *(const LAS bf16x8*)(Ks + ka_off + 32 * FOX_KP + 32 * s);
                s0 = __builtin_amdgcn_mfma_f32_32x32x16_bf16(a0, qf[s], s0, 0, 0, 0); s1 = __builtin_amdgcn_mfma_f32_32x32x16_bf16(a1, qf[s], s1, 0, 0, 0); }
            const bool diag = (64 * kt + 63 > q0); const int qme = q0 + r - 64 * kt;
            float mx = m;
#pragma unroll
            for (int g4 = 0; g4 < 4; ++g4) { const f32x4 c0 = *(const LAS f32x4*)(cks + ck_off + 8 * g4), c1 = *(const LAS f32x4*)(cks + ck_off + 32 + 8 * g4);
#pragma unroll
                for (int i = 0; i < 4; ++i) { const int kl = 8 * g4 + 4 * hh + i; float t0 = s0[4 * g4 + i] * SC - c0[i], t1 = s1[4 * g4 + i] * SC - c1[i];
                    if (diag) { if (kl > qme) t0 = -INFINITY; if (kl + 32 > qme) t1 = -INFINITY; }
                    s0[4 * g4 + i] = t0; s1[4 * g4 + i] = t1; mx = fmaxf(mx, fmaxf(t0, t1)); } }
            mx = fmaxf(mx, __shfl_xor(mx, 32));
            if (__any(mx > m + 8.0f)) {
                const float alpha = __builtin_amdgcn_exp2f(m - mx); m = mx; l *= alpha;
#pragma unroll
                for (int dt = 0; dt < 4; ++dt)
#pragma unroll
                    for (int i = 0; i < 16; ++i) o[dt][i] *= alpha; }
            float ls = 0.f;
            union { bf16x8 v; unsigned u[4]; } pf[4];
#pragma unroll
            for (int ks = 0; ks < 2; ++ks)
#pragma unroll
                for (int j = 0; j < 4; ++j) { const float a0 = __builtin_amdgcn_exp2f(s0[8 * ks + 2 * j] - m), a1 = __builtin_amdgcn_exp2f(s0[8 * ks + 2 * j + 1] - m);
                    const float b0 = __builtin_amdgcn_exp2f(s1[8 * ks + 2 * j] - m), b1 = __builtin_amdgcn_exp2f(s1[8 * ks + 2 * j + 1] - m);
                    ls += (a0 + a1) + (b0 + b1); pf[ks].u[j] = pk2(a0, a1); pf[2 + ks].u[j] = pk2(b0, b1); }
            l += ls;
#pragma unroll
            for (int f = 0; f < 4; ++f) {
                const int vb = vt_off + 16 * f * FOX_VP;
#pragma unroll
                for (int dt = 0; dt < 4; ++dt) {
                    const s16x4 x0 = __builtin_amdgcn_ds_read_tr16_b64_v4i16((LAS s16x4*)(Vs + vb + 64 * dt)), x1 = __builtin_amdgcn_ds_read_tr16_b64_v4i16((LAS s16x4*)(Vs + vb + 8 * FOX_VP + 64 * dt));
                    const bf16x8 af = {x0[0], x0[1], x0[2], x0[3], x1[0], x1[1], x1[2], x1[3]};
                    o[dt] = __builtin_amdgcn_mfma_f32_32x32x16_bf16(af, pf[f].v, o[dt], 0, 0, 0); }
                __builtin_amdgcn_sched_barrier(0);
            }
        }
    }
#undef FOX_LOAD
    l += __shfl_xor(l, 32);
    const float inv = 1.0f / l;
    unsigned char* op = (unsigned char*)OB + ((size_t)b * SEQ + q0 + r) * 2048 + h * 128 + 4 * hh;
#pragma unroll
    for (int dt = 0; dt < 4; ++dt)
#pragma unroll
        for (int g4 = 0; g4 < 4; ++g4) *(unsigned*)(op + 32 * dt + 8 * g4) = pk_q8x4(o[dt][4 * g4] * inv, o[dt][4 * g4 + 1] * inv, o[dt][4 * g4 + 2] * inv, o[dt][4 * g4 + 3] * inv, Q8_O);
}
__device__ __forceinline__ void p3_fox(Frame& F) {
    for (int pr = F.bid; pr < BATCH * B_HEADS * 4; pr += F.G) { const int bh = pr >> 2, j = pr & 3, b = bh >> 4, h = bh & 15;
        fox_unit(F, b, h, 7 - j);
        fox_unit(F, b, h, j); }
}
constexpr int DSA_WLDS = 8704;
__device__ __forceinline__ void p3_dsa(Frame& F, int flags) {
    const int gw = F.bid * NWAVES + F.wave, NGW = F.G * NWAVES;
    LAS unsigned char* wb = F.lds + F.wave * DSA_WLDS;
    LAS float* SCb = (LAS float*)wb; LAS unsigned short* IDX = (LAS unsigned short*)(wb + 8192);
    const bf16* QIDX = WSP(bf16, WS_QIDX); const bf16* KIDXB = WSP(bf16, WS_KIDXB); const float* WIDX = WSP(float, WS_WIDX); const bf16* CKVN = WSP(bf16, WS_CKVN); const bf16* QLAT = WSP(bf16, WS_QLAT); bf16* OLAT = WSP(bf16, WS_OLAT);
    const float idx_scale = 0.022097086912079608f, SCL = 0.12751741614123135f  ;
    for (int it = gw; it < NTOK; it += NGW) {
        const int lane = fresh_lane(), r32 = lane & 31, hh = lane >> 5, r16 = lane & 15, g = lane >> 4;
        const int b = it / SEQ, tt = it % SEQ, t = (b & 1) ? (SEQ - 1 - tt) : tt; const size_t row = (size_t)b * SEQ + t; const int chunk_end = (t / CHUNK + 1) * CHUNK;
        if (!(flags & 4)) {
            bf16x8 qi[4];
#pragma unroll
            for (int s = 0; s < 4; ++s) qi[s] = *(const bf16x8*)(QIDX + row * 2048 + r32 * 64 + 16 * s + 8 * hh);
            f32x4 wv[4];
#pragma unroll
            for (int g4 = 0; g4 < 4; ++g4) wv[g4] = *(const f32x4*)(WIDX + row * 32 + 8 * g4 + 4 * hh);
            const bf16* kp = KIDXB + (size_t)b * SEQ * 64 + r32 * 16 + 8 * hh;
            bf16x8 kb[8][4];
#define DSA_SCORE(kbt, tile) do { f32x16 acc; _Pragma("unroll") for (int i = 0; i < 16; ++i) acc[i] = 0.f; \
                _Pragma("unroll") for (int s = 0; s < 4; ++s) acc = __builtin_amdgcn_mfma_f32_32x32x16_bf16(qi[s], kbt[s], acc, 0, 0, 0); \
                float sc = 0.f; _Pragma("unroll") for (int g4 = 0; g4 < 4; ++g4) _Pragma("unroll") for (int i = 0; i < 4; ++i) sc += fmaxf(acc[4 * g4 + i], 0.f) * wv[g4][i]; \
                sc += __shfl_xor(sc, 32); if (lane < 32) SCb[(tile) * 32 + lane] = sc * idx_scale; } while (0)
            const int ntile8 = ((chunk_end + 255) >> 8) << 3;
            for (int t0 = 0; t0 < ntile8; t0 += 8) {
#pragma unroll
                for (int u = 0; u < 8; ++u)
#pragma unroll
                    for (int s = 0; s < 4; ++s) kb[u][s] = *(const bf16x8*)(kp + (size_t)(t0 + u) * 2048 + 512 * s);
#pragma unroll
                for (int u = 0; u < 8; ++u) { DSA_SCORE(kb[u], t0 + u); __builtin_amdgcn_sched_barrier(0); }
            }
#undef DSA_SCORE
        }
        CFENCE(); LDS_WAIT();
        const int nsel = chunk_end < TOPK ? chunk_end : TOPK;
        if (chunk_end <= TOPK || (flags & 8)) { for (int s = lane; s < nsel; s += 64) IDX[s] = (unsigned short)s; }
        else {
            unsigned key[32]; const int nreg = chunk_end >> 6;
#pragma unroll
            for (int i = 0; i < 32; ++i) key[i] = (i < nreg) ? f2key(SCb[i * 64 + lane]) : 0u;
            unsigned T = 0u;
            for (int bit = 31; bit >= 0; --bit) { const unsigned cand = T | (1u << bit); int cnt = 0;
#pragma unroll
                for (int i = 0; i < 32; ++i) cnt += __builtin_popcountll(__ballot(key[i] >= cand));
                if (cnt >= TOPK) { T = cand; if (cnt == TOPK) break; } }
            int cgt = 0;
#pragma unroll
            for (int i = 0; i < 32; ++i) cgt += __builtin_popcountll(__ballot(key[i] > T));
            int rem = TOPK - cgt, base = 0;
#pragma unroll
            for (int i = 0; i < 32; ++i) { const bool gt = key[i] > T, eq = key[i] == T; const unsigned long long meq = __ballot(eq); const bool take = gt || (eq && lanes_below(meq) < rem);
                const unsigned long long msel = __ballot(take); if (take) IDX[base + lanes_below(msel)] = (unsigned short)(i * 64 + lane);
                base += __builtin_popcountll(msel); const int ne = __builtin_popcountll(meq); rem -= (ne < rem ? ne : rem); }
        }
        CFENCE(); LDS_WAIT();
        if (!(flags & 16)) {
            int r16l = r16; asm volatile("" : "+v"(r16l));
            union { bf16x8 v; unsigned short e[8]; } sel0, sel1;
#pragma unroll
            for (int j = 0; j < 8; ++j) { sel0.e[j] = (8 * g + j == r16l) ? 0x3F80 : 0; sel1.e[j] = (8 * g + j == 16 + r16l) ? 0x3F80 : 0; }
            const float slope2 = exp2f(-0.5f * (float)(r16l + 1)) * 1.4426950408889634f;
            bf16x8 ql[8];
#pragma unroll
            for (int s = 0; s < 8; ++s) ql[s] = *(const bf16x8*)(QLAT + row * 4096 + r16 * 256 + 32 * s + 8 * g);
            f32x4 o[16];
#pragma unroll
            for (int ct = 0; ct < 16; ++ct) o[ct] = (f32x4){0.f, 0.f, 0.f, 0.f};
            float m = -1e30f, l = 0.f;
            const bf16* cbase = CKVN + (size_t)b * SEQ * 256 + 8 * g;
            const int nstep = nsel >> 5;
            for (int st = 0; st < nstep; ++st) {
                const int ia = IDX[32 * st + r16], ib = IDX[32 * st + 16 + r16];
                bf16x8 ca[8], cb[8];
#pragma unroll
                for (int s = 0; s < 8; ++s) { ca[s] = *(const bf16x8*)(cbase + (size_t)ia * 256 + 32 * s); cb[s] = *(const bf16x8*)(cbase + (size_t)ib * 256 + 32 * s); }
                f32x4 sa = (f32x4){0.f, 0.f, 0.f, 0.f}, sb = sa;
#pragma unroll
                for (int s = 0; s < 8; ++s) { sa = __builtin_amdgcn_mfma_f32_16x16x32_bf16(ca[s], ql[s], sa, 0, 0, 0); sb = __builtin_amdgcn_mfma_f32_16x16x32_bf16(cb[s], ql[s], sb, 0, 0, 0); }
                const u32x2 ja = *(const LAS u32x2*)(IDX + 32 * st + 4 * g), jb = *(const LAS u32x2*)(IDX + 32 * st + 16 + 4 * g);
                const int da0 = t - (int)(ja.x & 0xffff), da1 = t - (int)(ja.x >> 16), da2 = t - (int)(ja.y & 0xffff), da3 = t - (int)(ja.y >> 16);
                const int db0 = t - (int)(jb.x & 0xffff), db1 = t - (int)(jb.x >> 16), db2 = t - (int)(jb.y & 0xffff), db3 = t - (int)(jb.y >> 16);
                sa[0] = sa[0] * SCL - slope2 * (float)(da0 < 0 ? -da0 : da0); sa[1] = sa[1] * SCL - slope2 * (float)(da1 < 0 ? -da1 : da1);
                sa[2] = sa[2] * SCL - slope2 * (float)(da2 < 0 ? -da2 : da2); sa[3] = sa[3] * SCL - slope2 * (float)(da3 < 0 ? -da3 : da3);
                sb[0] = sb[0] * SCL - slope2 * (float)(db0 < 0 ? -db0 : db0); sb[1] = sb[1] * SCL - slope2 * (float)(db1 < 0 ? -db1 : db1);
                sb[2] = sb[2] * SCL - slope2 * (float)(db2 < 0 ? -db2 : db2); sb[3] = sb[3] * SCL - slope2 * (float)(db3 < 0 ? -db3 : db3);
                float mx = fmaxf(fmaxf(fmaxf(sa[0], sa[1]), fmaxf(sa[2], sa[3])), fmaxf(fmaxf(sb[0], sb[1]), fmaxf(sb[2], sb[3])));
                mx = fmaxf(mx, __shfl_xor(mx, 16)); mx = fmaxf(mx, __shfl_xor(mx, 32));
                float alpha = 1.0f;
                if (__any(mx > m + 8.0f)) { mx = fmaxf(mx, m); alpha = __builtin_amdgcn_exp2f(m - mx); m = mx;
#pragma unroll
                    for (int ct = 0; ct < 16; ++ct) o[ct] *= alpha; }
#pragma unroll
                for (int i = 0; i < 4; ++i) { sa[i] = __builtin_amdgcn_exp2f(sa[i] - m); sb[i] = __builtin_amdgcn_exp2f(sb[i] - m); }
                l = l * alpha + ((sa[0] + sa[1]) + (sa[2] + sa[3])) + ((sb[0] + sb[1]) + (sb[2] + sb[3]));
                union { bf16x8 v; unsigned u[4]; } pf;
                pf.u[0] = pk2(sa[0], sa[1]); pf.u[1] = pk2(sa[2], sa[3]); pf.u[2] = pk2(sb[0], sb[1]); pf.u[3] = pk2(sb[2], sb[3]);
#pragma unroll
                for (int s = 0; s < 8; ++s) {
                    const f32x4 z = (f32x4){0.f, 0.f, 0.f, 0.f};
                    const f32x4 ta0 = __builtin_amdgcn_mfma_f32_16x16x32_bf16(ca[s], sel0.v, z, 0, 0, 0), ta1 = __builtin_amdgcn_mfma_f32_16x16x32_bf16(ca[s], sel1.v, z, 0, 0, 0);
                    const f32x4 tb0 = __builtin_amdgcn_mfma_f32_16x16x32_bf16(cb[s], sel0.v, z, 0, 0, 0), tb1 = __builtin_amdgcn_mfma_f32_16x16x32_bf16(cb[s], sel1.v, z, 0, 0, 0);
                    union { bf16x8 v; unsigned u[4]; } v0, v1;
                    v0.u[0] = pk2(ta0[0], ta0[1]); v0.u[1] = pk2(ta0[2], ta0[3]); v0.u[2] = pk2(tb0[0], tb0[1]); v0.u[3] = pk2(tb0[2], tb0[3]);
                    v1.u[0] = pk2(ta1[0], ta1[1]); v1.u[1] = pk2(ta1[2], ta1[3]); v1.u[2] = pk2(tb1[0], tb1[1]); v1.u[3] = pk2(tb1[2], tb1[3]);
                    o[2 * s] = __builtin_amdgcn_mfma_f32_16x16x32_bf16(v0.v, pf.v, o[2 * s], 0, 0, 0);
                    o[2 * s + 1] = __builtin_amdgcn_mfma_f32_16x16x32_bf16(v1.v, pf.v, o[2 * s + 1], 0, 0, 0);
                }
            }
            l += __shfl_xor(l, 16); l += __shfl_xor(l, 32);
            const float inv = 1.0f / l;
            bf16* op = OLAT + row * 4096 + r16 * 256 + 4 * g;
#pragma unroll
            for (int ct = 0; ct < 16; ++ct) { u32x2 wv; wv.x = pk2(o[ct][0] * inv, o[ct][1] * inv); wv.y = pk2(o[ct][2] * inv, o[ct][3] * inv); *(u32x2*)(op + 16 * ct) = wv; }
        }
        CFENCE(); LDS_WAIT();
    }
}
constexpr int PEER_WLDS = 2048;
typedef int i32x8 __attribute__((ext_vector_type(8)));
typedef __bf16 bf16x2_d __attribute__((ext_vector_type(2)));
__device__ __forceinline__ float dot2bf(unsigned a, unsigned b, float c) { return __builtin_amdgcn_fdot2_f32_bf16(__builtin_bit_cast(bf16x2_d, a), __builtin_bit_cast(bf16x2_d, b), c, false); }
__device__ __forceinline__ f32x4 fp8x4(unsigned w) { const f32x2 lo = __builtin_amdgcn_cvt_pk_f32_fp8((int)w, false), hi = __builtin_amdgcn_cvt_pk_f32_fp8((int)w, true); return (f32x4){lo[0], lo[1], hi[0], hi[1]}; }
__device__ __forceinline__ float fp8dot4(unsigned w, f32x4 x) { const f32x4 f = fp8x4(w); return (f[0] * x[0] + f[1] * x[1]) + (f[2] * x[2] + f[3] * x[3]); }
#define DPPF(v, ctrl, rmask) __builtin_bit_cast(float, __builtin_amdgcn_update_dpp(0, __builtin_bit_cast(int, (v)), (ctrl), (rmask), 0xf, false))
__device__ __forceinline__ float wave_sum_u(float v) {
    v += DPPF(v, 0xB1, 0xf); v += DPPF(v, 0x4E, 0xf); v += DPPF(v, 0x141, 0xf); v += DPPF(v, 0x140, 0xf);
    v += DPPF(v, 0x142, 0xa); v += DPPF(v, 0x143, 0xc);
    return __builtin_bit_cast(float, __builtin_amdgcn_readlane(__builtin_bit_cast(int, v), 63));
}
template <int NV>
__device__ __forceinline__ void select16(const unsigned (&key)[NV], bool (&sel)[NV], int (&pos)[NV]) {
    unsigned T = 0u;
    for (int bit = 31; bit >= 0; --bit) { const unsigned cand = T | (1u << bit); int cnt = 0;
#pragma unroll
        for (int r = 0; r < NV; ++r) cnt += __builtin_popcountll(__ballot(key[r] >= cand));
        if (cnt >= PEER_TOPK) { T = cand; if (cnt == PEER_TOPK) break; } }
    int cgt = 0;
#pragma unroll
    for (int r = 0; r < NV; ++r) cgt += __builtin_popcountll(__ballot(key[r] > T));
    int rem = PEER_TOPK - cgt, base = 0;
#pragma unroll
    for (int r = 0; r < NV; ++r) { const bool gt = key[r] > T, eq = key[r] == T; const unsigned long long meq = __ballot(eq); const bool take = gt || (eq && lanes_below(meq) < rem);
        const unsigned long long msel = __ballot(take); sel[r] = take; pos[r] = base + lanes_below(msel);
        base += __builtin_popcountll(msel); const int ne = __builtin_popcountll(meq); rem -= (ne < rem ? ne : rem); }
}
__device__ __forceinline__ void p9_peer(Frame& F) {
    const int gw = F.bid * NWAVES + F.wave, NGW = F.G * NWAVES, lane = F.lane;
    LAS unsigned char* wb = F.lds + F.wave * PEER_WLDS;
    LAS float* tv = (LAS float*)wb; LAS int* ti = (LAS int*)(wb + 128); LAS float* cv = (LAS float*)(wb + 256); LAS int* cc = (LAS int*)(wb + 320); LAS int* eidx = (LAS int*)(wb + 512); LAS float* coef = (LAS float*)(wb + 1024); LAS float* su = (LAS float*)(wb + 1536);
    const float* S = WSP(float, WS_E); const bf16* H1B = WSP(bf16, WS_XB); const bf16* PLE = WSP(bf16, WS_PL); const unsigned char* UB = WSP(unsigned char, WS_UB); const unsigned char* VT = WSP(unsigned char, WS_VT); const float* SCL = WSP(float, WS_SCL);
    const float* g2 = INP(I_LN2G); const float* b2 = INP(I_LN2B);
    for (int tok = gw; tok < NTOK; tok += NGW) {
        const float* srow = S + (size_t)tok * 2048;
#pragma unroll 1
        for (int h = 0; h < PEER_HEADS; ++h) {
#pragma unroll
            for (int side = 0; side < 2; ++side) { const float v0 = srow[(2 * h + side) * 128 + lane], v1 = srow[(2 * h + side) * 128 + 64 + lane];
                const unsigned key[2] = {f2key(v0), f2key(v1)}; bool sel[2]; int pos[2]; select16<2>(key, sel, pos);
                if (sel[0]) { tv[side * 16 + pos[0]] = v0; ti[side * 16 + pos[0]] = lane; }
                if (sel[1]) { tv[side * 16 + pos[1]] = v1; ti[side * 16 + pos[1]] = lane + 64; } }
            CFENCE(); LDS_WAIT();
            { const int i0 = lane >> 4, j = lane & 15; const float vj = tv[16 + j];
              const float c0 = tv[i0] + vj, c1 = tv[i0 + 4] + vj, c2 = tv[i0 + 8] + vj, c3 = tv[i0 + 12] + vj;
              const unsigned key[4] = {f2key(c0), f2key(c1), f2key(c2), f2key(c3)}; bool sel[4]; int pos[4]; select16<4>(key, sel, pos);
              if (sel[0]) { cv[pos[0]] = c0; cc[pos[0]] = lane; } if (sel[1]) { cv[pos[1]] = c1; cc[pos[1]] = lane + 64; }
              if (sel[2]) { cv[pos[2]] = c2; cc[pos[2]] = lane + 128; } if (sel[3]) { cv[pos[3]] = c3; cc[pos[3]] = lane + 192; } }
            CFENCE(); LDS_WAIT();
            { const float val = cv[lane & 15]; const int ci = cc[lane & 15]; float mx = val;
#pragma unroll
              for (int o = 1; o < 16; o <<= 1) mx = fmaxf(mx, __shfl_xor(mx, o));
              const float e = __expf(val - mx); float sm = e;
#pragma unroll
              for (int o = 1; o < 16; o <<= 1) sm += __shfl_xor(sm, o);
              if (lane < 16) { eidx[h * 16 + lane] = ti[ci >> 4] * 128 + ti[16 + (ci & 15)]; coef[h * 16 + lane] = e / sm; } }
            CFENCE(); LDS_WAIT();
        }
        { const int e0 = eidx[lane], e1 = eidx[lane + 64];
          const float s0 = SCL[e0], s1 = SCL[e1], t0 = SCL[N_EXPERTS + e0], t1 = SCL[N_EXPERTS + e1];
          su[lane] = s0; su[lane + 64] = s1; coef[lane] *= t0; coef[lane + 64] *= t1; }
        CFENCE(); LDS_WAIT();
        {
            u32x4 hb[2][3];
            u32x4 hx[2][4]; float mx = 0.f;
#pragma unroll
            for (int jj = 0; jj < 2; ++jj)
#pragma unroll
                for (int i = 0; i < 4; ++i) { hx[jj][i] = *(const u32x4*)(H1B + (size_t)tok * 4096 + (jj * 64 + lane) * 32 + 8 * i);
#pragma unroll
                    for (int k = 0; k < 4; ++k) mx = fmaxf(mx, fmaxf(fabsf(bflo(hx[jj][i][k])), fabsf(bfhi(hx[jj][i][k])))); }
            mx = wave_max(mx) * (1.0f / 6.0f);
            int eb = (int)((__builtin_bit_cast(unsigned, mx) + 0x007fffffu) >> 23); eb = eb < 1 ? 1 : (eb > 253 ? 253 : eb);
            const float sup = __builtin_bit_cast(float, (unsigned)(254 - eb) << 23), sdn = __builtin_bit_cast(float, (unsigned)eb << 23);
#pragma unroll
            for (int jj = 0; jj < 2; ++jj)
#pragma unroll
                for (int i = 0; i < 4; ++i) { unsigned w0 = 0u, w1 = 0u, w2 = 0u;
#define HDIG(k) { float x0 = bflo(hx[jj][i][k]) * sup, x1 = bfhi(hx[jj][i][k]) * sup; \
                      w0 = __builtin_amdgcn_cvt_scalef32_pk_fp4_f32(w0, x0, x1, 1.0f, k); f32x2 dq = __builtin_amdgcn_cvt_scalef32_pk_f32_fp4(w0, 1.0f, k); x0 = (x0 - dq[0]) * 4.0f; x1 = (x1 - dq[1]) * 4.0f; \
                      w1 = __builtin_amdgcn_cvt_scalef32_pk_fp4_f32(w1, x0, x1, 1.0f, k); dq = __builtin_amdgcn_cvt_scalef32_pk_f32_fp4(w1, 1.0f, k); x0 = (x0 - dq[0]) * 8.0f; x1 = (x1 - dq[1]) * 8.0f; \
                      w2 = __builtin_amdgcn_cvt_scalef32_pk_fp4_f32(w2, x0, x1, 1.0f, k); }
                    HDIG(0) HDIG(1) HDIG(2) HDIG(3)
#undef HDIG
                    hb[jj][0][i] = w0; hb[jj][1][i] = w1; hb[jj][2][i] = w2; }
            const int dsel = ((lane >> 4) == ((lane & 15) >> 2)) ? (lane & 3) : 4;
#define U_LOAD(R, MB) { _Pragma("unroll") for (int q = 0; q < 8; ++q) { const int e_ = __builtin_amdgcn_readfirstlane(eidx[8 * (MB) + q]); const u32x4* p = (const u32x4*)(UB + (size_t)e_ * 2048) + lane; R[q][0] = p[0]; R[q][1] = p[64]; } }
#define HB8(d) (i32x8){(int)hb[jj][d].x, (int)hb[jj][d].y, (int)hb[jj][d].z, (int)hb[jj][d].w, 0, 0, 0, 0}
#define U_COMP(R, MB) { float a[8]; const float sq = su[8 * (MB) + (lane & 7)]; \
                _Pragma("unroll") for (int q = 0; q < 8; ++q) { f32x4 c = (f32x4){0.f, 0.f, 0.f, 0.f}; \
                    _Pragma("unroll") for (int jj = 0; jj < 2; ++jj) { const i32x8 av = (i32x8){(int)R[q][jj].x, (int)R[q][jj].y, (int)R[q][jj].z, (int)R[q][jj].w, 0, 0, 0, 0}; \
                        c = __builtin_amdgcn_mfma_scale_f32_16x16x128_f8f6f4(av, HB8(0), c, 4, 4, 0, 0x7f7f7f7f, 0, 0x7f7f7f7f);     \
                        c = __builtin_amdgcn_mfma_scale_f32_16x16x128_f8f6f4(av, HB8(1), c, 4, 4, 0, 0x7f7f7f7f, 0, 0x7d7d7d7d);     \
                        c = __builtin_amdgcn_mfma_scale_f32_16x16x128_f8f6f4(av, HB8(2), c, 4, 4, 0, 0x7f7f7f7f, 0, 0x7a7a7a7a); }   \
                    float d = (dsel == 0) ? c[0] : 0.f; d = (dsel == 1) ? c[1] : d; d = (dsel == 2) ? c[2] : d; d = (dsel == 3) ? c[3] : d; \
                    a[q] = wave_sum_u(d); } \
                float z = a[0]; \
                _Pragma("unroll") for (int q = 1; q < 8; ++q) z = (lane == q) ? a[q] : z; \
                z *= sdn * sq; \
                const float act = 0.5f * z * (1.0f + erff(z * 0.70710678118654752f)); \
                if (lane < 8) coef[8 * (MB) + lane] *= act; }
            u32x4 ra[8][2], rb[8][2];
            U_LOAD(ra, 0)
#pragma unroll 1
            for (int mb = 0; mb < PEER_M / 8 - 2; mb += 2) {
                U_LOAD(rb, mb + 1)
                __builtin_amdgcn_sched_barrier(0);
                U_COMP(ra, mb)
                __builtin_amdgcn_sched_barrier(0);
                U_LOAD(ra, mb + 2)
                __builtin_amdgcn_sched_barrier(0);
                U_COMP(rb, mb + 1)
                __builtin_amdgcn_sched_barrier(0);
            }
            U_LOAD(rb, PEER_M / 8 - 1)
            __builtin_amdgcn_sched_barrier(0);
            U_COMP(ra, PEER_M / 8 - 2)
            __builtin_amdgcn_sched_barrier(0);
            U_COMP(rb, PEER_M / 8 - 1)
#undef U_LOAD
#undef U_COMP
#undef HB8
        }
        CFENCE(); LDS_WAIT();
        f32x2 y[32];
#pragma unroll
        for (int i = 0; i < 32; ++i) y[i] = (f32x2){0.f, 0.f};
#define V_LOAD4(R, SB) { _Pragma("unroll") for (int q = 0; q < 4; ++q) { const int e_ = __builtin_amdgcn_readfirstlane(eidx[4 * (SB) + q]); const u32x4* p = (const u32x4*)(VT + (size_t)e_ * 2048) + lane; R[q][0] = p[0]; R[q][1] = p[64]; } }
#define V_COMP4(R, SB) { float c[4]; _Pragma("unroll") for (int q = 0; q < 4; ++q) c[q] = coef[4 * (SB) + q]; \
            _Pragma("unroll") for (int q = 0; q < 4; ++q) _Pragma("unroll") for (int jj = 0; jj < 2; ++jj) _Pragma("unroll") for (int i = 0; i < 4; ++i) { const unsigned w = R[q][jj][i]; \
                y[(4 * jj + i) * 4 + 0] += __builtin_amdgcn_cvt_scalef32_pk_f32_fp4(w, 1.0f, 0) * c[q]; y[(4 * jj + i) * 4 + 1] += __builtin_amdgcn_cvt_scalef32_pk_f32_fp4(w, 1.0f, 1) * c[q]; \
                y[(4 * jj + i) * 4 + 2] += __builtin_amdgcn_cvt_scalef32_pk_f32_fp4(w, 1.0f, 2) * c[q]; y[(4 * jj + i) * 4 + 3] += __builtin_amdgcn_cvt_scalef32_pk_f32_fp4(w, 1.0f, 3) * c[q]; } }
#define V_SB __builtin_amdgcn_sched_barrier(0);
        {
            u32x4 b0[4][2], b1[4][2], b2[4][2];
            V_LOAD4(b0, 0) V_LOAD4(b1, 1)
#pragma unroll 1
            for (int sb = 0; sb < PEER_M / 4 - 2; sb += 3) {
                V_LOAD4(b2, sb + 2) V_SB V_COMP4(b0, sb) V_SB
                V_LOAD4(b0, sb + 3) V_SB V_COMP4(b1, sb + 1) V_SB
                V_LOAD4(b1, sb + 4) V_SB V_COMP4(b2, sb + 2) V_SB
            }
            V_COMP4(b0, PEER_M / 4 - 2) V_SB V_COMP4(b1, PEER_M / 4 - 1)
        }
#undef V_LOAD4
#undef V_COMP4
#undef V_SB
        { const bf16* hr = H1B + (size_t)tok * 4096; const bf16* pr = PLE + (size_t)tok * 4096; float s = 0.f;
#pragma unroll
          for (int jj = 0; jj < 2; ++jj) {
#pragma unroll
              for (int i = 0; i < 4; ++i) { const int off = (jj * 64 + lane) * 32 + 8 * i; const int yb = (4 * jj + i) * 4;
                  const u32x4 hw = *(const u32x4*)(hr + off), pw = *(const u32x4*)(pr + off); const f32x4 h0 = (f32x4){bflo(hw.x), bfhi(hw.x), bflo(hw.y), bfhi(hw.y)}, h1 = (f32x4){bflo(hw.z), bfhi(hw.z), bflo(hw.w), bfhi(hw.w)}, p0 = (f32x4){bflo(pw.x), bfhi(pw.x), bflo(pw.y), bfhi(pw.y)}, p1 = (f32x4){bflo(pw.z), bfhi(pw.z), bflo(pw.w), bfhi(pw.w)};
                  y[yb][0] += h0[0] * ALPHA + p0[0]; y[yb][1] += h0[1] * ALPHA + p0[1]; y[yb + 1][0] += h0[2] * ALPHA + p0[2]; y[yb + 1][1] += h0[3] * ALPHA + p0[3];
                  y[yb + 2][0] += h1[0] * ALPHA + p1[0]; y[yb + 2][1] += h1[1] * ALPHA + p1[1]; y[yb + 3][0] += h1[2] * ALPHA + p1[2]; y[yb + 3][1] += h1[3] * ALPHA + p1[3];
                  s += (y[yb][0] + y[yb][1]) + (y[yb + 1][0] + y[yb + 1][1]) + (y[yb + 2][0] + y[yb + 2][1]) + (y[yb + 3][0] + y[yb + 3][1]); }
              CFENCE(); }
          const float mean = wave_sum(s) * (1.0f / 4096.0f); float q = 0.f;
#pragma unroll
          for (int i = 0; i < 32; ++i) { y[i] = y[i] - mean; q += y[i][0] * y[i][0] + y[i][1] * y[i][1]; }
          const float rstd = 1.0f / sqrtf(wave_sum(q) * (1.0f / 4096.0f) + LN_EPS);
          float* orow = OUTP() + (size_t)tok * 4096;
#pragma unroll
          for (int jj = 0; jj < 2; ++jj) {
#pragma unroll
              for (int i = 0; i < 4; ++i) { const int off = (jj * 64 + lane) * 32 + 8 * i; const int yb = (4 * jj + i) * 4;
                  const f32x4 g0 = *(const f32x4*)(g2 + off), g1 = *(const f32x4*)(g2 + off + 4), c0 = *(const f32x4*)(b2 + off), c1 = *(const f32x4*)(b2 + off + 4);
                  *(f32x4*)(orow + off) = (f32x4){y[yb][0] * rstd * g0[0] + c0[0], y[yb][1] * rstd * g0[1] + c0[1], y[yb + 1][0] * rstd * g0[2] + c0[2], y[yb + 1][1] * rstd * g0[3] + c0[3]};
                  *(f32x4*)(orow + off + 4) = (f32x4){y[yb + 2][0] * rstd * g1[0] + c1[0], y[yb + 2][1] * rstd * g1[1] + c1[1], y[yb + 3][0] * rstd * g1[2] + c1[2], y[yb + 3][1] * rstd * g1[3] + c1[3]}; }
              CFENCE(); } }
        CFENCE(); LDS_WAIT();
    }
}
#ifndef DBG_OUT
#define DBG_OUT 0
#endif
__device__ __forceinline__ void dbg_copy(Frame& F, int which) {
    const size_t gt = (size_t)F.bid * NTHREADS + F.tid, gs = (size_t)F.G * NTHREADS, n = (size_t)NTOK * 4096;
    for (size_t i = gt; i < n; i += gs) { const size_t t = i >> 12; const int c = (int)(i & 4095); float v = 0.f;
        if (which == 1) v = WSP(float, WS_F)[i];
        else if (which == 2) v = WSP(float, WS_E)[i];
        else if (which == 3) v = bf2f(WSP(bf16, WS_XB)[i]);
        else if (which == 4) v = (c < 2048) ? bf2f(WSP(bf16, WS_QA)[t * 2048 + c]) : bf2f(WSP(bf16, WS_OB)[t * 2048 + c - 2048]);
        else if (which == 5) v = bf2f(WSP(bf16, WS_OLAT)[i]);
        else if (which == 6) v = bf2f(WSP(bf16, WS_QLAT)[i]);
        else if (which == 7) v = (c < 2048) ? bf2f(WSP(bf16, WS_QIDX)[t * 2048 + c]) : bf2f(WSP(bf16, WS_KB)[t * 2048 + c - 2048]);
        else if (which == 8) v = bf2f(WSP(bf16, WS_F)[t * 8192 + c]);
        else if (which == 9) v = (c < 2048) ? WSP(float, WS_E)[t * 2048 + c] : bf2f(WSP(bf16, WS_PL)[t * 4096 + c]);
        OUTP()[i] = v; }
}

constexpr int N_PHASES = 10;
__global__ void __launch_bounds__(NTHREADS, 2) mk_fwd(Args args) {
    extern __shared__ __attribute__((aligned(16))) unsigned char lds_raw[];
    Frame F;
    F.lds = (LAS unsigned char*)lds_raw; F.tid = threadIdx.x; F.lane = F.tid & 63; F.wave = __builtin_amdgcn_readfirstlane(F.tid >> 6); F.G = gridDim.x; F.bid = blockIdx.x;
    unsigned* ctl = (unsigned*)(WSB() + WS_CTL);
    if (F.tid < 64) ((LAS unsigned*)(F.lds + LDSCTL_OFF))[F.tid] = 0u;
    __syncthreads();
    XcdBarrier bar; bar.bar = ctl + CW_BAR; bar.x = 0; bar.st = nullptr; bar.wave = F.wave;
    if (MK_N_LAUNCHES == 1) bar = xcd_barrier_post(ctl + CW_BAR, (volatile LAS unsigned*)(F.lds + LDSCTL_OFF));
    const int lo = args.ph_lo, hi = args.ph_hi;
#ifndef PROBE_DUP
#define PROBE_DUP -1
#endif
#define IN(k) (lo <= (k) && (k) < hi)
#define REP(k) for (int rep_ = 0; rep_ < ((k) == PROBE_DUP ? 2 : 1); ++rep_)
#define SEAM(k) do { if (IN(k) && IN((k) + 1)) xcd_barrier(bar); } while (0)
    LAS unsigned char* const ldsg = F.lds;
#define RELANE() do { const int l_ = fresh_lane(); F.lane = l_; F.tid = F.wave * 64 + l_; } while (0)

    if (IN(0)) { RELANE(); REP(0) p0_prologue(F); SEAM(0); }
    if (IN(1)) {
        { pg8::Gemm g{WSP(bf16, WS_X8), WSP(bf16, WS_W18), NTOK, N1M, D_MODEL / 2, D_MODEL / 2}; pg8::StaticOrder S; S.init(NTOK, N1M, F.G, F.bid);
          pg8::Epi1 E{WSP(bf16, WS_QA), WSP(bf16, WS_QIDX), WSP(bf16, WS_QB), WSP(bf16, WS_KB), WSP(bf16, WS_VB), WSP(bf16, WS_F), INP(I_BGATE), 0};
          pg8::gemm_phase<pg8::Epi1, pg8::StaticOrder, true, true, true>(ldsg, g, S, E, F.wave); }
        if (F.bid < 256) {
          const int ks = F.bid & 3, sp = (F.bid >> 2) & 1, spm = F.bid >> 3;
          pg8::Gemm g{WSP(bf16, WS_XB) + ks * 1024, WSP(bf16, WS_E) + (size_t)N1M * D_MODEL + ks * 1024, NTOK, 512, 1024, D_MODEL}; pg8::OneUnit S{spm, sp};
          pg8::EpiPart E{WSP(float, WS_PART) + (size_t)(ks * 2 + sp) * NTOK * 256};
          pg8::gemm_phase<pg8::EpiPart, pg8::OneUnit, true, true>(ldsg, g, S, E, F.wave); }
        { pg8::Gemm g{WSP(bf16, WS_PB), WSP(bf16, WS_WPLT), NTOK, D_MODEL, D_PLE, D_PLE}; pg8::StaticOrder S; S.init(NTOK, D_MODEL, F.G, F.bid);
          pg8::EpiBf16P E{WSP(bf16, WS_PL), D_MODEL};
          pg8::gemm_phase<pg8::EpiBf16P, pg8::StaticOrder, true, true>(ldsg, g, S, E, F.wave); }
        SEAM(1);
    }
    if (IN(2)) { RELANE(); REP(2) p2_small(F); SEAM(2); }
    if (IN(3)) { REP(3) { if (!(args.pad & 2)) p3_fox(F); __syncthreads(); if (!(args.pad & 1)) p3_dsa(F, args.pad); __syncthreads(); } SEAM(3); }
    if (IN(4)) { RELANE(); REP(4) p4_oa(F); SEAM(4); }
    if (IN(5)) {
        { pg8::Gemm g{WSP(bf16, WS_QA), WSP(bf16, WS_WBAT), NTOK, D_MODEL, 1024, 1024}; pg8::StaticOrder S; S.init(NTOK, D_MODEL, F.G, F.bid);
          pg8::Epi2a E{WSP(bf16, WS_F), WSP(bf16, WS_E), 1.0f / (Q8_O * Q8_WB)};
          pg8::gemm_phase<pg8::Epi2a, pg8::StaticOrder, true, true, true>(ldsg, g, S, E, F.wave); }
        { pg8::Gemm g{WSP(bf16, WS_OB), WSP(bf16, WS_WBBT), NTOK, D_MODEL, 1024, 1024}; pg8::StaticOrder S; S.init(NTOK, D_MODEL, F.G, F.bid);
          pg8::Epi2b E{WSP(bf16, WS_F), WSP(bf16, WS_E), WSP(bf16, WS_XB), 1.0f / (Q8_O * Q8_WB)};
          pg8::gemm_phase<pg8::Epi2b, pg8::StaticOrder, true, true, true>(ldsg, g, S, E, F.wave); }
        SEAM(5);
    }
    if (IN(6)) {
        pg8::Gemm g{WSP(bf16, WS_XB), WSP(bf16, WS_WOT), NTOK, D_MODEL, D_MODEL / 2, D_MODEL / 2}; pg8::StaticOrder S; S.init(NTOK, D_MODEL, F.G, F.bid);
        pg8::Epi3 E{INP(I_X), WSP(bf16, WS_E), ALPHA, 1.0f / (Q8_MG * Q8_WO)};
        pg8::gemm_phase<pg8::Epi3, pg8::StaticOrder, true, true, true>(ldsg, g, S, E, F.wave);
        SEAM(6);
    }
    if (IN(7)) { RELANE(); REP(7) p7_ln1(F); SEAM(7); }
    if (IN(8)) {
        { pg8::Gemm g{WSP(bf16, WS_X8), WSP(bf16, WS_W48), NTOK, N4, D_MODEL / 2, D_MODEL / 2}; pg8::StaticOrder S; S.init(NTOK, N4, F.G, F.bid);
          pg8::Epi4 E{WSP(float, WS_E), WSP(bf16, WS_PL), INP(I_BPG), 0};
          pg8::gemm_phase<pg8::Epi4, pg8::StaticOrder, true, true, true>(ldsg, g, S, E, F.wave); }
        SEAM(8);
    }
    if (IN(9)) { if (DBG_OUT) dbg_copy(F, DBG_OUT); else { RELANE(); REP(9) p9_peer(F); } }
#undef IN
#undef SEAM
}

extern "C" void kernel_launch(void* const* d_in, const int* in_sizes, int n_in, void* d_out, int out_size, void* d_ws, size_t ws_size, hipStream_t stream) {
    static int grid = 0;
    if (grid == 0) {
        if (n_in != 23 || out_size != NTOK * D_MODEL || ws_size < WS_END) { fprintf(stderr, "kernel_launch: unexpected problem (n_in %d, out %d, ws %zu); nothing launched\n", n_in, out_size, ws_size); grid = -1; return; }
        int dev = 0, cus = 0, per_cu = 0;
        if (hipGetDevice(&dev) != hipSuccess || hipDeviceGetAttribute(&cus, hipDeviceAttributeMultiprocessorCount, dev) != hipSuccess) { grid = -1; return; }
        if (hipFuncSetAttribute((const void*)mk_fwd, hipFuncAttributeMaxDynamicSharedMemorySize, LDS_BYTES) != hipSuccess) { fprintf(stderr, "kernel_launch: hipFuncSetAttribute failed\n"); grid = -1; return; }
        if (hipOccupancyMaxActiveBlocksPerMultiprocessor(&per_cu, (const void*)mk_fwd, NTHREADS, LDS_BYTES) != hipSuccess || per_cu < 1) { fprintf(stderr, "kernel_launch: occupancy query says %d\n", per_cu); (void)hipGetLastError(); grid = -1; return; }
        grid = cus;
    }
    if (grid < 0) return;
    if (hipMemsetAsync((char*)d_ws + WS_CTL, 0, CTL_ZERO_BYTES, stream) != hipSuccess) return;
    Args a{};
    for (int i = 0; i < 23; ++i) a.in[i] = (const float*)d_in[i];
    a.out = (float*)d_out; a.ws = (unsigned char*)d_ws;
    for (int li = 0; li < MK_N_LAUNCHES; ++li) {
#if DBG_OUT
        { const int lastp[10] = {9, 7, 6, 5, 4, 3, 2, 1, 1, 8}; if (MK_N_LAUNCHES > 1 && li > lastp[DBG_OUT] && li != 9) continue; }
#endif
        a.ph_lo = (MK_N_LAUNCHES == 1) ? 0 : li; a.ph_hi = (MK_N_LAUNCHES == 1) ? N_PHASES : li + 1; a.li = li; a.pad = 0;
#ifdef HOST_DUP
        if (MK_N_LAUNCHES > 1 && li == HOST_DUP) {
#ifdef HOST_DUP_PAD
            a.pad = HOST_DUP_PAD;
#endif
            hipLaunchKernelGGL(mk_fwd, dim3(grid), dim3(NTHREADS), LDS_BYTES, stream, a); a.pad = 0; }
#endif
        hipLaunchKernelGGL(mk_fwd, dim3(grid), dim3(NTHREADS), LDS_BYTES, stream, a);
    }
}
```

```cpp
#include <hip/hip_runtime.h>
#include <cstdio>
#include <cstdint>

#ifndef MK_N_LAUNCHES
#define MK_N_LAUNCHES 1
#endif

#define GAS __attribute__((address_space(1)))
#define LAS __attribute__((address_space(3)))
typedef unsigned short bf16;
typedef float f32x4 __attribute__((ext_vector_type(4)));
typedef float f32x2 __attribute__((ext_vector_type(2)));
typedef unsigned u32x4 __attribute__((ext_vector_type(4)));
typedef unsigned u32x2 __attribute__((ext_vector_type(2)));
typedef short bf16x8 __attribute__((ext_vector_type(8)));

constexpr int D_MODEL = 4096, BATCH = 4, SEQ = 2048, NTOK = BATCH * SEQ;
constexpr int A_HEADS = 16, A_HD = 128, A_LAT = 256, IDX_HEADS = 32, IDX_DIM = 64, TOPK = 256, CHUNK = 64;
constexpr int B_HEADS = 16, B_HD = 128;
constexpr int PEER_HEADS = 8, PEER_KEYS = 128, PEER_QDIM = 256, PEER_TOPK = 16, N_EXPERTS = PEER_KEYS * PEER_KEYS, PEER_M = PEER_HEADS * PEER_TOPK;
constexpr int D_PLE = 256;
constexpr int IN_WIDTH = 10608;
constexpr int N1 = 18944;
constexpr int N1M = 18432;
constexpr int N4 = 6144;
constexpr float LN_EPS = 1e-5f;
constexpr float ALPHA = 1.18920711500272f;

__device__ __forceinline__ unsigned f2bf(float f) { unsigned u = __builtin_bit_cast(unsigned, f); return (u + 0x7fffu + ((u >> 16) & 1u)) >> 16; }
typedef __bf16 bf16x2_n __attribute__((ext_vector_type(2)));
__device__ __forceinline__ unsigned pk2(float lo, float hi) { const bf16x2_n b = __builtin_convertvector((f32x2){lo, hi}, bf16x2_n); return __builtin_bit_cast(unsigned, b); }
__device__ __forceinline__ float bflo(unsigned w) { return __builtin_bit_cast(float, w << 16); }
__device__ __forceinline__ float bfhi(unsigned w) { return __builtin_bit_cast(float, w & 0xffff0000u); }
__device__ __forceinline__ float bf2f(bf16 b) { return __builtin_bit_cast(float, (unsigned)b << 16); }
__device__ __forceinline__ float sigmoidf_(float x) { return __builtin_amdgcn_rcpf(1.0f + __expf(-x)); }
__device__ __forceinline__ float wave_sum(float v) {
#pragma unroll
    for (int o = 1; o < 64; o <<= 1) v += __shfl_xor(v, o);
    return v;
}
__device__ __forceinline__ float wave_max(float v) {
#pragma unroll
    for (int o = 1; o < 64; o <<= 1) v = fmaxf(v, __shfl_xor(v, o));
    return v;
}
__device__ __forceinline__ int fresh_lane() { int l; asm volatile("v_mbcnt_lo_u32_b32 %0, -1, 0\n\tv_mbcnt_hi_u32_b32 %0, -1, %0" : "=v"(l)); return l; }
constexpr float Q8_ACT = 30.0f, Q8_W = 1920.0f;
constexpr float Q8_O = 21.0f, Q8_WB = 1368.0f;
constexpr float Q8_MG = 32.0f, Q8_WO = 3250.0f;
__device__ __forceinline__ unsigned pk_q8x4(float a, float b, float c, float d, float sc) {
    const int i0 = __float2int_rn(fminf(fmaxf(a * sc, -127.f), 127.f)), i1 = __float2int_rn(fminf(fmaxf(b * sc, -127.f), 127.f));
    const int i2 = __float2int_rn(fminf(fmaxf(c * sc, -127.f), 127.f)), i3 = __float2int_rn(fminf(fmaxf(d * sc, -127.f), 127.f));
    return (unsigned)(i0 & 255) | ((unsigned)(i1 & 255) << 8) | ((unsigned)(i2 & 255) << 16) | ((unsigned)i3 << 24); }
#define LDS_WAIT() asm volatile("s_waitcnt lgkmcnt(0)" ::: "memory")
#define VM_WAIT() asm volatile("s_waitcnt vmcnt(0)" ::: "memory")
#define CFENCE() asm volatile("" ::: "memory")
namespace pg8 {
#define PG8_LAS __attribute__((address_space(3)))
typedef unsigned short bf16_t;
typedef short bf16x8 __attribute__((ext_vector_type(8)));
typedef float f32x4 __attribute__((ext_vector_type(4)));
typedef unsigned u32x4 __attribute__((ext_vector_type(4)));
constexpr int BM = 256, BK = 64, HALF = 128, HTB = HALF * BK * 2  , STAGE_BYTES = 8 * HTB, NXCD = 8, WGM = 8;

__host__ __device__ __forceinline__ int lds_byte(int r, int c) { const int st = (r >> 4) * 2 + (c >> 5), rr = r & 15, cc = c & 31, ob = rr * 64 + cc * 2; return st * 1024 + (ob ^ (((ob >> 9) & 1) << 5)); }
__host__ __device__ __forceinline__ void stage_rc(int b, int& R, int& C) { const int st = b / 1024, sb = b % 1024, swz = sb ^ (((sb >> 9) & 1) << 5); R = (st >> 1) * 16 + swz / 64; C = (st & 1) * 32 + (swz % 64) / 2; }
__host__ __device__ __forceinline__ int perm32(int rho) { const int n = rho >> 4, i = rho & 15; return 8 * (i >> 2) + 4 * n + (i & 3); }

struct Unit { int pm, pn; };
struct Gemm { const bf16_t* A; const bf16_t* Bt; int M, N, K, ld; };

struct StaticOrder {
    int nM, nN, nwg, G, c;
    __host__ __device__ void init(int M, int N, int G_, int c_) { nM = M / BM; nN = N / BM; nwg = nM * nN; G = G_; c = c_; }
    __host__ __device__ bool next(int i, Unit& u) const {
        const long L = (long)i * G + c; if (L >= nwg) return false;
        int wgid = (int)L; { const int q = nwg / NXCD, r = nwg % NXCD, xcd = wgid % NXCD, off = wgid / NXCD; wgid = (xcd < r ? xcd * (q + 1) : r * (q + 1) + (xcd - r) * q) + off; }
        const int nig = WGM * nN, gid = wgid / nig, fm = gid * WGM, gsz = (nM - fm) < WGM ? (nM - fm) : WGM;
        u.pm = fm + ((wgid % nig) % gsz); u.pn = (wgid % nig) / gsz; return true;
    }
    __device__ __forceinline__ void a_ready(const Unit&) const {}
    __device__ __forceinline__ void done(const Unit&) const {}
};
typedef __bf16 bf16x2_nat __attribute__((ext_vector_type(2)));
__device__ __forceinline__ unsigned cvt_pk_bf16(float lo, float hi) { typedef float f2_ __attribute__((ext_vector_type(2))); const bf16x2_nat b = __builtin_convertvector((f2_){lo, hi}, bf16x2_nat); return __builtin_bit_cast(unsigned, b); }
typedef unsigned u32x2 __attribute__((ext_vector_type(2)));
__device__ __forceinline__ unsigned q8x4(float a, float b, float c, float d, float sc) {
    const int i0 = __float2int_rn(fminf(fmaxf(a * sc, -127.f), 127.f)), i1 = __float2int_rn(fminf(fmaxf(b * sc, -127.f), 127.f));
    const int i2 = __float2int_rn(fminf(fmaxf(c * sc, -127.f), 127.f)), i3 = __float2int_rn(fminf(fmaxf(d * sc, -127.f), 127.f));
    return (unsigned)(i0 & 255) | ((unsigned)(i1 & 255) << 8) | ((unsigned)(i2 & 255) << 16) | ((unsigned)i3 << 24); }
__device__ __forceinline__ float sigm(float x) { return __builtin_amdgcn_rcpf(1.0f + __expf(-x)); }
__device__ __forceinline__ float blo(unsigned w) { return __builtin_bit_cast(float, w << 16); }
__device__ __forceinline__ float bhi(unsigned w) { return __builtin_bit_cast(float, w & 0xffff0000u); }

struct Epi1 {
    static constexpr bool PERM = true, AFTER_DRAIN = false;
    bf16_t *QA, *QIDX, *QB, *KB, *VB, *G; const float* b_gate; int pn_off;
    __device__ __forceinline__ void operator()(const f32x4 (&acc)[2][2][4][2], const Unit& u, int wr, int wc, int fr, int fq) const {
        const int pn = u.pn + pn_off, row0 = u.pm * BM + wr * 64 + fr, cl = wc * 32 + 8 * fq;
        if (pn >= 40) {
            const int gc = (pn - 40) * 256 + cl;
            f32x4 bv[2][2];
#pragma unroll
            for (int bj = 0; bj < 2; ++bj)
#pragma unroll
                for (int n = 0; n < 2; ++n) bv[bj][n] = *(const f32x4*)(b_gate + gc + bj * HALF + 4 * n);
#pragma unroll
            for (int ai = 0; ai < 2; ++ai)
#pragma unroll
                for (int m = 0; m < 4; ++m) { bf16_t* rowp = G + (size_t)(row0 + ai * HALF + m * 16) * 8192 + gc;
#pragma unroll
                    for (int bj = 0; bj < 2; ++bj) { const f32x4 v0 = acc[ai][bj][m][0] * (1.0f / 57600.0f) + bv[bj][0], v1 = acc[ai][bj][m][1] * (1.0f / 57600.0f) + bv[bj][1];
                        u32x4 w; w.x = cvt_pk_bf16(sigm(v0[0]), sigm(v0[1])); w.y = cvt_pk_bf16(sigm(v0[2]), sigm(v0[3])); w.z = cvt_pk_bf16(sigm(v1[0]), sigm(v1[1])); w.w = cvt_pk_bf16(sigm(v1[2]), sigm(v1[3]));
                        *(u32x4*)(rowp + bj * HALF) = w; } }
        } else {
            bf16_t* dst; int c0;
            if (pn < 8) { dst = QA; c0 = pn; } else if (pn < 16) { dst = QIDX; c0 = pn - 8; } else if (pn < 24) { dst = QB; c0 = pn - 16; } else if (pn < 32) { dst = KB; c0 = pn - 24; } else { dst = VB; c0 = pn - 32; }
            c0 = c0 * 256 + cl;
#pragma unroll
            for (int ai = 0; ai < 2; ++ai)
#pragma unroll
                for (int m = 0; m < 4; ++m) { bf16_t* rowp = dst + (size_t)(row0 + ai * HALF + m * 16) * 2048 + c0;
#pragma unroll
                    for (int bj = 0; bj < 2; ++bj) { const f32x4 v0 = acc[ai][bj][m][0] * (1.0f / 57600.0f), v1 = acc[ai][bj][m][1] * (1.0f / 57600.0f);
                        u32x4 w; w.x = cvt_pk_bf16(v0[0], v0[1]); w.y = cvt_pk_bf16(v0[2], v0[3]); w.z = cvt_pk_bf16(v1[0], v1[1]); w.w = cvt_pk_bf16(v1[2], v1[3]);
                        *(u32x4*)(rowp + bj * HALF) = w; } }
        }
    }
};
struct OneUnit {
    int pm, pn;
    __device__ bool next(int i, Unit& u) const { if (i) return false; u.pm = pm; u.pn = pn; return true; }
    __device__ __forceinline__ void a_ready(const Unit&) const {}
    __device__ __forceinline__ void done(const Unit&) const {}
};
struct EpiPart {
    static constexpr bool PERM = true, AFTER_DRAIN = false;
    float* P;
    __device__ __forceinline__ void operator()(const f32x4 (&acc)[2][2][4][2], const Unit& u, int wr, int wc, int fr, int fq) const {
        const int row0 = u.pm * BM + wr * 64 + fr, cl = wc * 32 + 8 * fq;
#pragma unroll
        for (int ai = 0; ai < 2; ++ai)
#pragma unroll
            for (int m = 0; m < 4; ++m) { float* rowp = P + (size_t)(row0 + ai * HALF + m * 16) * 256 + cl;
#pragma unroll
                for (int bj = 0; bj < 2; ++bj) { *(f32x4*)(rowp + bj * HALF) = acc[ai][bj][m][0]; *(f32x4*)(rowp + bj * HALF + 4) = acc[ai][bj][m][1]; } }
    }
};
struct EpiBf16P {
    static constexpr bool PERM = true, AFTER_DRAIN = false;
    bf16_t* C; int ldc;
    __device__ __forceinline__ void operator()(const f32x4 (&acc)[2][2][4][2], const Unit& u, int wr, int wc, int fr, int fq) const {
        const int row0 = u.pm * BM + wr * 64 + fr, col0 = u.pn * BM + wc * 32 + 8 * fq;
#pragma unroll
        for (int ai = 0; ai < 2; ++ai)
#pragma unroll
            for (int m = 0; m < 4; ++m) { bf16_t* rowp = C + (size_t)(row0 + ai * HALF + m * 16) * ldc + col0;
#pragma unroll
                for (int bj = 0; bj < 2; ++bj) { const f32x4 v0 = acc[ai][bj][m][0], v1 = acc[ai][bj][m][1];
                    u32x4 w; w.x = cvt_pk_bf16(v0[0], v0[1]); w.y = cvt_pk_bf16(v0[2], v0[3]); w.z = cvt_pk_bf16(v1[0], v1[1]); w.w = cvt_pk_bf16(v1[2], v1[3]);
                    *(u32x4*)(rowp + bj * HALF) = w; }
                asm volatile("" ::: "memory"); }
    }
};
struct EpiF32P {
    static constexpr bool PERM = true, AFTER_DRAIN = false;
    float* C; int ldc;
    __device__ __forceinline__ void operator()(const f32x4 (&acc)[2][2][4][2], const Unit& u, int wr, int wc, int fr, int fq) const {
        const int row0 = u.pm * BM + wr * 64 + fr, col0 = u.pn * BM + wc * 32 + 8 * fq;
#pragma unroll
        for (int ai = 0; ai < 2; ++ai)
#pragma unroll
            for (int m = 0; m < 4; ++m) { float* rowp = C + (size_t)(row0 + ai * HALF + m * 16) * ldc + col0;
#pragma unroll
                for (int bj = 0; bj < 2; ++bj) { *(f32x4*)(rowp + bj * HALF) = acc[ai][bj][m][0]; *(f32x4*)(rowp + bj * HALF + 4) = acc[ai][bj][m][1]; } }
    }
};
struct Epi2a {
    static constexpr bool PERM = true, AFTER_DRAIN = false;
    const bf16_t* G; bf16_t* MGT; float sacc;
    __device__ __forceinline__ void operator()(const f32x4 (&acc)[2][2][4][2], const Unit& u, int wr, int wc, int fr, int fq) const {
        const int row0 = u.pm * BM + wr * 64 + fr, col0 = u.pn * BM + wc * 32 + 8 * fq;
#pragma unroll
        for (int ai = 0; ai < 2; ++ai)
#pragma unroll
            for (int m = 0; m < 4; ++m) { const size_t r = (size_t)(row0 + ai * HALF + m * 16);
#pragma unroll
                for (int bj = 0; bj < 2; ++bj) { const u32x4 g = *(const u32x4*)(G + r * 8192 + col0 + bj * HALF); const f32x4 v0 = acc[ai][bj][m][0] * sacc, v1 = acc[ai][bj][m][1] * sacc;
                    u32x4 w; w.x = cvt_pk_bf16(v0[0] * blo(g.x), v0[1] * bhi(g.x)); w.y = cvt_pk_bf16(v0[2] * blo(g.y), v0[3] * bhi(g.y)); w.z = cvt_pk_bf16(v1[0] * blo(g.z), v1[1] * bhi(g.z)); w.w = cvt_pk_bf16(v1[2] * blo(g.w), v1[3] * bhi(g.w));
                    *(u32x4*)(MGT + r * 4096 + col0 + bj * HALF) = w; }
                asm volatile("" ::: "memory"); }
    }
};
struct Epi2b {
    static constexpr bool PERM = true, AFTER_DRAIN = false;
    const bf16_t* G; const bf16_t* MGT; bf16_t* MG; float sacc;
    __device__ __forceinline__ void operator()(const f32x4 (&acc)[2][2][4][2], const Unit& u, int wr, int wc, int fr, int fq) const {
        const int row0 = u.pm * BM + wr * 64 + fr, col0 = u.pn * BM + wc * 32 + 8 * fq;
#pragma unroll
        for (int ai = 0; ai < 2; ++ai)
#pragma unroll
            for (int m = 0; m < 4; ++m) { const size_t r = (size_t)(row0 + ai * HALF + m * 16);
#pragma unroll
                for (int bj = 0; bj < 2; ++bj) { const u32x4 g = *(const u32x4*)(G + r * 8192 + 4096 + col0 + bj * HALF); const f32x4 v0 = acc[ai][bj][m][0] * sacc, v1 = acc[ai][bj][m][1] * sacc;
                    const u32x4 t = *(const u32x4*)(MGT + r * 4096 + col0 + bj * HALF);
                    u32x2 w; w.x = q8x4(blo(t.x) + v0[0] * blo(g.x), bhi(t.x) + v0[1] * bhi(g.x), blo(t.y) + v0[2] * blo(g.y), bhi(t.y) + v0[3] * bhi(g.y), 32.0f);
                    w.y = q8x4(blo(t.z) + v1[0] * blo(g.z), bhi(t.z) + v1[1] * bhi(g.z), blo(t.w) + v1[2] * blo(g.w), bhi(t.w) + v1[3] * bhi(g.w), 32.0f);
                    *(u32x2*)((unsigned char*)MG + r * 4096 + col0 + bj * HALF) = w; }
                asm volatile("" ::: "memory"); }
    }
};
struct Epi3 {
    static constexpr bool PERM = true, AFTER_DRAIN = false;
    const float* X; bf16_t* Y; float alpha, sacc;
    __device__ __forceinline__ void operator()(const f32x4 (&acc)[2][2][4][2], const Unit& u, int wr, int wc, int fr, int fq) const {
        const int row0 = u.pm * BM + wr * 64 + fr, col0 = u.pn * BM + wc * 32 + 8 * fq;
#pragma unroll
        for (int ai = 0; ai < 2; ++ai)
#pragma unroll
            for (int m = 0; m < 4; ++m) { const size_t off = (size_t)(row0 + ai * HALF + m * 16) * 4096 + col0;
#pragma unroll
                for (int bj = 0; bj < 2; ++bj) { const f32x4 x0 = *(const f32x4*)(X + off + bj * HALF), x1 = *(const f32x4*)(X + off + bj * HALF + 4);
                    const f32x4 y0 = x0 * alpha + acc[ai][bj][m][0] * sacc, y1 = x1 * alpha + acc[ai][bj][m][1] * sacc;
                    u32x4 w; w.x = cvt_pk_bf16(y0[0], y0[1]); w.y = cvt_pk_bf16(y0[2], y0[3]); w.z = cvt_pk_bf16(y1[0], y1[1]); w.w = cvt_pk_bf16(y1[2], y1[3]);
                    *(u32x4*)(Y + off + bj * HALF) = w; }
                asm volatile("" ::: "memory"); }
    }
};
struct Epi4 {
    static constexpr bool PERM = true, AFTER_DRAIN = false;
    float* PQ; bf16_t* PL; const float* b_pg; int pn_off;
    __device__ __forceinline__ void operator()(const f32x4 (&acc)[2][2][4][2], const Unit& u, int wr, int wc, int fr, int fq) const {
        const int row0 = u.pm * BM + wr * 64 + fr, cl = wc * 32 + 8 * fq, pn = u.pn + pn_off;
        if (pn < 8) {
#pragma unroll
            for (int ai = 0; ai < 2; ++ai)
#pragma unroll
                for (int m = 0; m < 4; ++m) { float* rowp = PQ + (size_t)(row0 + ai * HALF + m * 16) * 2048 + pn * 256 + cl;
#pragma unroll
                    for (int bj = 0; bj < 2; ++bj) { *(f32x4*)(rowp + bj * HALF) = acc[ai][bj][m][0] * (1.0f / 57600.0f); *(f32x4*)(rowp + bj * HALF + 4) = acc[ai][bj][m][1] * (1.0f / 57600.0f); } }
        } else {
            const int c0 = (pn - 8) * 256 + cl;
            f32x4 bv[2][2];
#pragma unroll
            for (int bj = 0; bj < 2; ++bj)
#pragma unroll
                for (int n = 0; n < 2; ++n) bv[bj][n] = *(const f32x4*)(b_pg + c0 + bj * HALF + 4 * n);
#pragma unroll
            for (int ai = 0; ai < 2; ++ai)
#pragma unroll
                for (int m = 0; m < 4; ++m) { bf16_t* rowp = PL + (size_t)(row0 + ai * HALF + m * 16) * 4096 + c0;
#pragma unroll
                    for (int bj = 0; bj < 2; ++bj) { const u32x4 p = *(const u32x4*)(rowp + bj * HALF);
                        const f32x4 v0 = acc[ai][bj][m][0] * (1.0f / 57600.0f) + bv[bj][0], v1 = acc[ai][bj][m][1] * (1.0f / 57600.0f) + bv[bj][1];
                        u32x4 w; w.x = cvt_pk_bf16(sigm(v0[0]) * blo(p.x), sigm(v0[1]) * bhi(p.x)); w.y = cvt_pk_bf16(sigm(v0[2]) * blo(p.y), sigm(v0[3]) * bhi(p.y));
                        w.z = cvt_pk_bf16(sigm(v1[0]) * blo(p.z), sigm(v1[1]) * bhi(p.z)); w.w = cvt_pk_bf16(sigm(v1[2]) * blo(p.w), sigm(v1[3]) * bhi(p.w));
                        *(u32x4*)(rowp + bj * HALF) = w; }
                    asm volatile("" ::: "memory"); }
        }
    }
};
typedef int pg8_i32x4 __attribute__((ext_vector_type(4)));
typedef int pg8_i32x8 __attribute__((ext_vector_type(8)));
__device__ __forceinline__ pg8_i32x8 cat8(bf16x8 lo, bf16x8 hi) { const pg8_i32x4 a = __builtin_bit_cast(pg8_i32x4, lo), b = __builtin_bit_cast(pg8_i32x4, hi); return __builtin_shufflevector(a, b, 0, 1, 2, 3, 4, 5, 6, 7); }
template <class Epi, class Sched, bool ALIGN_EPI = false, bool SP2 = false, bool F8 = false>
__device__ __forceinline__ void gemm_phase(PG8_LAS unsigned char* lds, const Gemm g, const Sched& S, const Epi& E, const int wave_id) {
    int tid_ = wave_id * 64 + fresh_lane();
    const int tid = tid_, wid = __builtin_amdgcn_readfirstlane(tid >> 6), lane = tid & 63, wr = wid >> 2, wc = wid & 3, fr = lane & 15, fq = lane >> 4;
    const int K = g.K, nt = K / BK, LD = g.ld;
    unsigned voffA, voffB;
    { int R, C; stage_rc(tid * 16, R, C); const int Rb = Epi::PERM ? ((R & ~31) + perm32(R & 31)) : R; voffA = (unsigned)(R * LD + C) * 2u; voffB = (unsigned)(Rb * LD + C) * 2u; }
    const size_t rstep = (size_t)64 * LD * 2;
    const size_t kstep = (size_t)(BK * 2);
    const size_t hstep = (size_t)HALF * LD * 2;
    const size_t tstep = 2 * hstep;
    const unsigned ldsw = (unsigned)wid * 1024u;
    const int aoff = lds_byte(wr * 64 + fr, fq * 8), boff = lds_byte(wc * 32 + fr, fq * 8);
#define PG8_SA(b, h) (((b) * 2 + (h)) * HTB)
#define PG8_SB(b, h) ((4 + (b) * 2 + (h)) * HTB)
#define PG8_STAGE(bufoff, gbase, voff) do { _Pragma("unroll") for (int _i = 0; _i < 2; ++_i) \
        __builtin_amdgcn_global_load_lds((const unsigned*)((const char*)(gbase) + _i * rstep + (voff)), (PG8_LAS unsigned*)(lds + (bufoff) + ldsw + _i * 8192), 16, 0, 0); } while (0)
#define PG8_LDA(dst, b, h) do { _Pragma("unroll") for (int m = 0; m < 4; ++m) _Pragma("unroll") for (int k = 0; k < 2; ++k) dst[m][k] = *(const PG8_LAS bf16x8*)(lds + PG8_SA(b, h) + aoff + m * 2048 + k * 1024); } while (0)
#define PG8_LDB(dst, b, h) do { _Pragma("unroll") for (int n = 0; n < 2; ++n) _Pragma("unroll") for (int k = 0; k < 2; ++k) dst[n][k] = *(const PG8_LAS bf16x8*)(lds + PG8_SB(b, h) + boff + n * 2048 + k * 1024); } while (0)
#define PG8_MMA(ai, bj, At, Bt) do { __builtin_amdgcn_s_setprio(1); _Pragma("unroll") for (int m = 0; m < 4; ++m) _Pragma("unroll") for (int n = 0; n < 2; ++n) { \
        _Pragma("unroll") for (int k = 0; k < 2; ++k) { \
            if constexpr (F8) acc[ai][bj][m][n] = __builtin_bit_cast(f32x4, __builtin_amdgcn_mfma_i32_16x16x64_i8(__builtin_bit_cast(pg8_i32x4, Bt[n][k]), __builtin_bit_cast(pg8_i32x4, At[m][k]), __builtin_bit_cast(pg8_i32x4, acc[ai][bj][m][n]), 0, 0, 0)); \
            else acc[ai][bj][m][n] = __builtin_amdgcn_mfma_f32_16x16x32_bf16(Bt[n][k], At[m][k], acc[ai][bj][m][n], 0, 0, 0); } } __builtin_amdgcn_s_setprio(0); } while (0)
#define PG8_WAIT_V(n) asm volatile("s_waitcnt vmcnt(" #n ")" ::: "memory")
#define PG8_WAIT_L(n) asm volatile("s_waitcnt lgkmcnt(" #n ")" ::: "memory")
#define PG8_BAR __builtin_amdgcn_s_barrier()
#define PG8_SCHED __builtin_amdgcn_sched_barrier(0)
    Unit cur, nxt; int ui = 0;
    if (!S.next(0, cur)) return;
    f32x4 acc[2][2][4][2];
#pragma unroll
    for (int a = 0; a < 2; ++a)
#pragma unroll
        for (int b = 0; b < 2; ++b)
#pragma unroll
            for (int m = 0; m < 4; ++m)
#pragma unroll
                for (int n = 0; n < 2; ++n) acc[a][b][m][n] = (f32x4){0.f, 0.f, 0.f, 0.f};
    bf16x8 At[4][2], B0[2][2], B1[2][2];
    const char* cA = (const char*)g.A + (size_t)cur.pm * tstep; const char* cB = (const char*)g.Bt + (size_t)cur.pn * tstep;
    S.a_ready(cur);
    if constexpr (SP2) {
        PG8_STAGE(PG8_SB(0, 0), cB, voffB); PG8_STAGE(PG8_SB(0, 1), cB + hstep, voffB); PG8_STAGE(PG8_SA(0, 0), cA, voffA); PG8_STAGE(PG8_SA(0, 1), cA + hstep, voffA);
        if (wr == 1) PG8_BAR;
        PG8_WAIT_V(2); PG8_BAR;
        PG8_STAGE(PG8_SB(1, 0), cB + kstep, voffB); PG8_STAGE(PG8_SA(1, 0), cA + kstep, voffA); PG8_STAGE(PG8_SB(1, 1), cB + hstep + kstep, voffB);
        PG8_WAIT_V(6); PG8_BAR;
    } else {
        PG8_STAGE(PG8_SB(0, 0), cB, voffB); PG8_STAGE(PG8_SA(0, 0), cA, voffA); PG8_STAGE(PG8_SB(0, 1), cB + hstep, voffB); PG8_STAGE(PG8_SA(0, 1), cA + hstep, voffA);
        if (wr == 1) PG8_BAR;
        PG8_WAIT_V(4); PG8_BAR;
        PG8_STAGE(PG8_SB(1, 0), cB + kstep, voffB); PG8_STAGE(PG8_SA(1, 0), cA + kstep, voffA); PG8_STAGE(PG8_SB(1, 1), cB + hstep + kstep, voffB);
        PG8_WAIT_V(6); PG8_BAR;
    }
    for (;;) {
        const bool has_next = S.next(ui + 1, nxt);
        const char* nA = has_next ? (const char*)g.A + (size_t)nxt.pm * tstep : cA; const char* nB = has_next ? (const char*)g.Bt + (size_t)nxt.pn * tstep : cB;
#pragma unroll 1
        for (int t = 0; t < nt; t += 2) {
            const bool last = (t == nt - 2);
            const char* a1 = cA + (size_t)(t + 1) * kstep;
            const char* a2 = last ? nA : cA + (size_t)(t + 2) * kstep; const char* b2 = last ? nB : cB + (size_t)(t + 2) * kstep;
            const char* a3 = a2 + kstep; const char* b3 = b2 + kstep;
            if (last && has_next) S.a_ready(nxt);
            if constexpr (SP2) {
            PG8_LDB(B0, 0, 0); PG8_LDB(B1, 0, 1); PG8_SCHED; PG8_LDA(At, 0, 0); PG8_STAGE(PG8_SA(1, 1), a1 + hstep, voffA);
            PG8_WAIT_V(8); PG8_WAIT_L(0); PG8_BAR; PG8_MMA(0, 0, At, B0); PG8_MMA(0, 1, At, B1); PG8_BAR; PG8_SCHED;
            PG8_LDA(At, 0, 1); PG8_STAGE(PG8_SB(0, 0), b2, voffB); PG8_STAGE(PG8_SB(0, 1), b2 + hstep, voffB); PG8_STAGE(PG8_SA(0, 0), a2, voffA);
            PG8_WAIT_V(8); PG8_WAIT_L(0); PG8_BAR; PG8_MMA(1, 0, At, B0); PG8_MMA(1, 1, At, B1); PG8_BAR; PG8_SCHED;
            PG8_LDB(B0, 1, 0); PG8_LDB(B1, 1, 1); PG8_SCHED; PG8_LDA(At, 1, 0); PG8_STAGE(PG8_SA(0, 1), a2 + hstep, voffA);
            PG8_WAIT_V(8); PG8_WAIT_L(0); PG8_BAR; PG8_MMA(0, 0, At, B0); PG8_MMA(0, 1, At, B1); PG8_BAR; PG8_SCHED;
            PG8_LDA(At, 1, 1); PG8_STAGE(PG8_SB(1, 0), b3, voffB); PG8_STAGE(PG8_SB(1, 1), b3 + hstep, voffB); PG8_STAGE(PG8_SA(1, 0), a3, voffA);
            PG8_WAIT_V(8); PG8_WAIT_L(0); PG8_BAR; PG8_MMA(1, 0, At, B0); PG8_MMA(1, 1, At, B1); PG8_BAR; PG8_SCHED;
            } else {
            PG8_LDB(B0, 0, 0); PG8_SCHED; PG8_LDA(At, 0, 0); PG8_STAGE(PG8_SA(1, 1), a1 + hstep, voffA);
            PG8_WAIT_L(8); PG8_BAR; PG8_WAIT_L(0); PG8_MMA(0, 0, At, B0); PG8_BAR; PG8_SCHED;
            PG8_LDB(B1, 0, 1); PG8_STAGE(PG8_SB(0, 0), b2, voffB);
            PG8_BAR; PG8_WAIT_L(0); PG8_MMA(0, 1, At, B1); PG8_BAR;
            PG8_LDA(At, 0, 1); PG8_STAGE(PG8_SA(0, 0), a2, voffA);
            PG8_BAR; PG8_WAIT_L(0); PG8_MMA(1, 0, At, B0); PG8_BAR; PG8_SCHED;
            PG8_STAGE(PG8_SB(0, 1), b2 + hstep, voffB);
            PG8_WAIT_V(6); PG8_BAR; PG8_MMA(1, 1, At, B1); PG8_BAR;
            PG8_LDB(B0, 1, 0); PG8_SCHED; PG8_LDA(At, 1, 0); PG8_STAGE(PG8_SA(0, 1), a2 + hstep, voffA);
            PG8_WAIT_L(8); PG8_BAR; PG8_WAIT_L(0); PG8_MMA(0, 0, At, B0); PG8_BAR; PG8_SCHED;
            PG8_LDB(B1, 1, 1); PG8_STAGE(PG8_SB(1, 0), b3, voffB);
            PG8_BAR; PG8_WAIT_L(0); PG8_MMA(0, 1, At, B1); PG8_BAR;
            PG8_LDA(At, 1, 1); PG8_STAGE(PG8_SA(1, 0), a3, voffA);
            PG8_BAR; PG8_WAIT_L(0); PG8_MMA(1, 0, At, B0); PG8_BAR; PG8_SCHED;
            PG8_STAGE(PG8_SB(1, 1), b3 + hstep, voffB);
            PG8_WAIT_V(6); PG8_BAR; PG8_MMA(1, 1, At, B1); PG8_BAR;
            }
        }
        if constexpr (ALIGN_EPI) { if (wr == 0) PG8_BAR; }
        if constexpr (F8) {
#pragma unroll
            for (int a = 0; a < 2; ++a)
#pragma unroll
                for (int b = 0; b < 2; ++b)
#pragma unroll
                    for (int m = 0; m < 4; ++m)
#pragma unroll
                        for (int n = 0; n < 2; ++n) { const pg8_i32x4 iv = __builtin_bit_cast(pg8_i32x4, acc[a][b][m][n]); acc[a][b][m][n] = (f32x4){(float)iv[0], (float)iv[1], (float)iv[2], (float)iv[3]}; } }
        if constexpr (!Epi::AFTER_DRAIN) { const int le = fresh_lane(); E(acc, cur, wr, wc, le & 15, le >> 4); S.done(cur); }
        if (!has_next) break;
#pragma unroll
        for (int a = 0; a < 2; ++a)
#pragma unroll
            for (int b = 0; b < 2; ++b)
#pragma unroll
                for (int m = 0; m < 4; ++m)
#pragma unroll
                    for (int n = 0; n < 2; ++n) acc[a][b][m][n] = (f32x4){0.f, 0.f, 0.f, 0.f};
        cur = nxt; cA = nA; cB = nB; ++ui;
        if constexpr (ALIGN_EPI) { if (wr == 1) PG8_BAR; }
    }
    PG8_WAIT_V(0);
    if constexpr (!ALIGN_EPI) { if (wr == 0) PG8_BAR; }
    PG8_BAR;
    if constexpr (Epi::AFTER_DRAIN) { E.fused(acc, cur, wr, wc, fr, fq, lds, wid, lane); S.done(cur); }
#undef PG8_SA
#undef PG8_SB
#undef PG8_STAGE
#undef PG8_LDA
#undef PG8_LDB
#undef PG8_MMA
#undef PG8_WAIT_V
#undef PG8_WAIT_L
#undef PG8_BAR
#undef PG8_SCHED
}
}

#define XB_TMO      128
#define XB_XCNT(j)  (256  + 64 * (j))
#define XB_XSUB(j)  (1280 + 64 * (j))
#define XB_XGEN(j)  (2304 + 64 * (j))
#define XB_TOP      3328
#define XB_TOPGEN   3392
#define XCD_BAR_WORDS 3456
#define XB_SPIN_CAP (1u << 18)

__device__ __forceinline__ unsigned xb_ld(unsigned* p)              { return __hip_atomic_load(p, __ATOMIC_RELAXED, __HIP_MEMORY_SCOPE_AGENT); }
__device__ __forceinline__ unsigned xb_add(unsigned* p, unsigned v) { return __hip_atomic_fetch_add(p, v, __ATOMIC_RELAXED, __HIP_MEMORY_SCOPE_AGENT); }
__device__ __forceinline__ unsigned xb_xcc_id() { return (unsigned)__builtin_amdgcn_s_getreg((3 << 11) | 20) & 0xFu; }
#define XB_SPIN(cond, bar) do { unsigned _sp = 0; while (cond) { __builtin_amdgcn_s_sleep(1); \
    if ((++_sp & 255u) == 0u) { if (xb_ld(&(bar)[XB_TMO])) break; if (_sp > XB_SPIN_CAP) { atomicAdd(&(bar)[XB_TMO], 1u); break; } } } } while (0)

struct XcdBarrier {
    unsigned* bar; unsigned x; int wave;
    volatile LAS unsigned* st;
};

__device__ __forceinline__ XcdBarrier xcd_barrier_post(unsigned* bar, volatile LAS unsigned* st) {
    XcdBarrier b; b.bar = bar; b.x = xb_xcc_id(); b.st = st; b.wave = __builtin_amdgcn_readfirstlane(threadIdx.x >> 6);
    if (threadIdx.x == 0) (void)xb_add(&bar[XB_XCNT(b.x)], 1u);
    return b;
}
__device__ __forceinline__ void xcd_barrier_complete(unsigned* bar, unsigned x, unsigned& nloc, unsigned& nx) {
    const unsigned G = gridDim.x * gridDim.y * gridDim.z;
    unsigned sum, cnt, mine, sp = 0u;
    for (;;) {
        sum = 0u; cnt = 0u; mine = 0u;
#pragma unroll
        for (unsigned j = 0; j < 16; ++j) { const unsigned c = xb_ld(&bar[XB_XCNT(j)]); sum += c; cnt += (c > 0u) ? 1u : 0u; mine = (j == x) ? c : mine; }
        if (sum == G) break;
        __builtin_amdgcn_s_sleep(1);
        if ((++sp & 255u) == 0u) { if (xb_ld(&bar[XB_TMO])) break; if (sp > XB_SPIN_CAP) { atomicAdd(&bar[XB_TMO], 1u); break; } }
    }
    nloc = mine > 0u ? mine : 1u; nx = cnt > 0u ? cnt : 1u;
}

__device__ __forceinline__ void xcd_barrier(const XcdBarrier& b) {
    asm volatile("s_waitcnt vmcnt(0)" ::: "memory");
    __syncthreads();
    if (b.wave == 0 && fresh_lane() == 0) {
        unsigned* bar = b.bar;
        __builtin_amdgcn_s_waitcnt(0);
        unsigned nloc = b.st[0], nx = b.st[1];
        if (nloc == 0u) { xcd_barrier_complete(bar, b.x, nloc, nx); b.st[0] = nloc; b.st[1] = nx; }
        const unsigned old = xb_add(&bar[XB_XSUB(b.x)], 1u);
        const unsigned gen = old / nloc;
        if (old + 1u == (gen + 1u) * nloc) {
            __builtin_amdgcn_fence(__ATOMIC_RELEASE, "agent");
            asm volatile("s_waitcnt vmcnt(0)" ::: "memory");
            const unsigned og = xb_add(&bar[XB_TOP], 1u);
            const unsigned tg = og / nx;
            if (og + 1u == (tg + 1u) * nx) xb_add(&bar[XB_TOPGEN], 1u);
            else XB_SPIN(xb_ld(&bar[XB_TOPGEN]) == tg, bar);
            __builtin_amdgcn_fence(__ATOMIC_ACQUIRE, "agent");
            xb_add(&bar[XB_XGEN(b.x)], 1u);
            asm volatile("s_waitcnt vmcnt(0)" ::: "memory");
        } else {
            XB_SPIN(xb_ld(&bar[XB_XGEN(b.x)]) == gen, bar);
            __builtin_amdgcn_fence(__ATOMIC_ACQUIRE, "agent");
            asm volatile("s_waitcnt vmcnt(0)" ::: "memory");
        }
    }
    __syncthreads();
}

constexpr size_t MiB = 1u << 20;
constexpr size_t WS_CTL = 0, CTL_ZERO_BYTES = 1 * MiB;
constexpr size_t WS_UB   = 1 * MiB;
constexpr size_t WS_VT   = WS_UB + 128 * MiB;
constexpr size_t WS_WBAT = WS_VT + 128 * MiB;
constexpr size_t WS_WBBT = WS_WBAT + 16 * MiB;
constexpr size_t WS_WOT  = WS_WBBT + 16 * MiB;
constexpr size_t WS_W4T  = WS_WOT + 32 * MiB;
constexpr size_t WS_WPLT = WS_W4T + 48 * MiB;
constexpr size_t WS_PB   = WS_WPLT + 2 * MiB;
constexpr size_t WS_XB   = WS_PB + 4 * MiB;
constexpr size_t WS_E    = WS_XB + 64 * MiB;
constexpr size_t WS_F    = WS_E + 148 * MiB;
constexpr size_t WS_QA   = WS_F + 128 * MiB;
constexpr size_t WS_QIDX = WS_QA + 32 * MiB;
constexpr size_t WS_QB   = WS_QIDX + 32 * MiB;
constexpr size_t WS_KB   = WS_QB + 32 * MiB;
constexpr size_t WS_VB   = WS_KB + 32 * MiB;
constexpr size_t WS_OB   = WS_VB + 32 * MiB;
constexpr size_t WS_CKV  = WS_OB + 32 * MiB;
constexpr size_t WS_SM   = WS_CKV + 8 * MiB;
constexpr size_t WS_CKVN = WS_SM + 8 * MiB;
constexpr size_t WS_CUM  = WS_CKVN + 4 * MiB;
constexpr size_t WS_PL   = WS_CUM + 1 * MiB;
constexpr size_t WS_WUKB = WS_PL + 128 * MiB;
constexpr size_t WS_WUVT = WS_WUKB + 1 * MiB;
constexpr size_t WS_KIDXB = WS_WUVT + 1 * MiB;
constexpr size_t WS_SCL = WS_KIDXB + 1 * MiB;
constexpr size_t WS_END  = WS_SCL + 1 * MiB;
constexpr size_t WS_PART = WS_UB + 64 * MiB;
constexpr size_t WS_X8   = WS_VT + 32 * MiB;
constexpr size_t WS_W18  = WS_E;
constexpr size_t WS_W48  = WS_VT + 64 * MiB;
constexpr size_t WS_WIDX = WS_SM;
constexpr size_t WS_QLAT = WS_E, WS_OLAT = WS_E + 64 * MiB;
static_assert(WS_END <= (size_t)1174 * MiB, "d_ws map");
constexpr int CW_BAR = 4096;

constexpr int NWAVES = 8, NTHREADS = 512;
constexpr int LDS_BYTES = 147456;
constexpr int LDSCTL_OFF = LDS_BYTES - 256;

typedef float f32x16 __attribute__((ext_vector_type(16)));
typedef short s16x4 __attribute__((ext_vector_type(4)));
template <int K>
__device__ __forceinline__ void small_gemm_tile(const bf16* A, int lda, const bf16* Bt, int ldb, bf16* C, int ldc, int lane, unsigned char* C8 = nullptr, float sc8 = 1.0f) {
    const int r = lane & 15, g = lane >> 4;
    f32x4 acc[4][4];
#pragma unroll
    for (int a = 0; a < 4; ++a)
#pragma unroll
        for (int b = 0; b < 4; ++b) acc[a][b] = (f32x4){0.f, 0.f, 0.f, 0.f};
    const bf16* ap = A + (size_t)r * lda + 8 * g; const bf16* bp = Bt + (size_t)r * ldb + 8 * g;
#pragma unroll 2
    for (int s = 0; s < K / 32; ++s) {
        bf16x8 af[4], bfr[4];
#pragma unroll
        for (int i = 0; i < 4; ++i) { af[i] = *(const bf16x8*)(ap + (size_t)(16 * i) * lda + 32 * s); bfr[i] = *(const bf16x8*)(bp + (size_t)(16 * i) * ldb + 32 * s); }
#pragma unroll
        for (int ni = 0; ni < 4; ++ni)
#pragma unroll
            for (int ti = 0; ti < 4; ++ti) acc[ni][ti] = __builtin_amdgcn_mfma_f32_16x16x32_bf16(bfr[ni], af[ti], acc[ni][ti], 0, 0, 0);
    }
#pragma unroll
    for (int ni = 0; ni < 4; ++ni)
#pragma unroll
        for (int ti = 0; ti < 4; ++ti) {
            if (C8) { *(unsigned*)(C8 + (size_t)(16 * ti + r) * ldc + 16 * ni + 4 * g) = pk_q8x4(acc[ni][ti][0], acc[ni][ti][1], acc[ni][ti][2], acc[ni][ti][3], sc8); continue; }
            u32x2 wv; wv.x = pk2(acc[ni][ti][0], acc[ni][ti][1]); wv.y = pk2(acc[ni][ti][2], acc[ni][ti][3]);
            *(u32x2*)(C + (size_t)(16 * ti + r) * ldc + 16 * ni + 4 * g) = wv; }
}
__device__ __forceinline__ bf16x8 ld8_f32_bf16(const float* p) { const f32x4 a = *(const f32x4*)p, b = *(const f32x4*)(p + 4); union { bf16x8 v; unsigned u[4]; } r; r.u[0] = pk2(a[0], a[1]); r.u[1] = pk2(a[2], a[3]); r.u[2] = pk2(b[0], b[1]); r.u[3] = pk2(b[2], b[3]); return r.v; }
template <int K>
__device__ __forceinline__ void small_gemm_tile_f32(const float* A, int lda, const float* Bt, int ldb, bf16* C, int ldc, int lane, unsigned char* C8 = nullptr) {
    const int r = lane & 15, g = lane >> 4;
    f32x4 acc[4][4];
#pragma unroll
    for (int a = 0; a < 4; ++a)
#pragma unroll
        for (int b = 0; b < 4; ++b) acc[a][b] = (f32x4){0.f, 0.f, 0.f, 0.f};
    const float* ap = A + (size_t)r * lda + 8 * g; const float* bp = Bt + (size_t)r * ldb + 8 * g;
#pragma unroll 1
    for (int s = 0; s < K / 32; ++s) {
        bf16x8 af[4], bfr[4];
#pragma unroll
        for (int i = 0; i < 4; ++i) { af[i] = ld8_f32_bf16(ap + (size_t)(16 * i) * lda + 32 * s); bfr[i] = ld8_f32_bf16(bp + (size_t)(16 * i) * ldb + 32 * s); }
#pragma unroll
        for (int ni = 0; ni < 4; ++ni)
#pragma unroll
            for (int ti = 0; ti < 4; ++ti) acc[ni][ti] = __builtin_amdgcn_mfma_f32_16x16x32_bf16(bfr[ni], af[ti], acc[ni][ti], 0, 0, 0);
    }
#pragma unroll
    for (int ni = 0; ni < 4; ++ni)
#pragma unroll
        for (int ti = 0; ti < 4; ++ti) { u32x2 wv; wv.x = pk2(acc[ni][ti][0], acc[ni][ti][1]); wv.y = pk2(acc[ni][ti][2], acc[ni][ti][3]);
            *(u32x2*)(C + (size_t)(16 * ti + r) * ldc + 16 * ni + 4 * g) = wv;
            if (C8) *(unsigned*)(C8 + (size_t)(16 * ti + r) * ldc + 16 * ni + 4 * g) = pk_q8x4(acc[ni][ti][0], acc[ni][ti][1], acc[ni][ti][2], acc[ni][ti][3], Q8_W); }
}
struct Args { const float* in[23]; float* out; unsigned char* ws; int ph_lo, ph_hi, li, pad; };
enum InIdx { I_X = 0, I_P, I_WIN, I_BFORGET, I_GLAT, I_WUK, I_WUV, I_WBA, I_WBB, I_WGATE, I_BGATE, I_WOUT, I_LN1G, I_LN1B, I_PWQ, I_PSUB, I_PU, I_PV, I_WPLE, I_WPG, I_BPG, I_LN2G, I_LN2B };

struct Frame {
    LAS unsigned char* lds;
    int tid, lane, wave, G, bid;
};
#define KARGQ ((const __attribute__((address_space(4))) unsigned long long*)__builtin_amdgcn_kernarg_segment_ptr())
#define INP(i) ((const float*)(const GAS float*)KARGQ[(i)])
#define OUTP() ((float*)(GAS float*)KARGQ[23])
#define WSB() ((unsigned char*)(GAS unsigned char*)KARGQ[24])
#define WSP(T, off) ((T*)(WSB() + (off)))

__device__ __forceinline__ void transpose_item(const float* W, int ldw, int src_col, int ncols, int k0, bf16* WT, int K, int dst_row0, LAS float* scr, int lane) {
    const int c = lane & 31;
    float tmp[32];
    const float* wp = W + (size_t)(k0 + (lane >> 5)) * ldw + src_col + c;
#pragma unroll
    for (int i = 0; i < 32; ++i) tmp[i] = (c < ncols) ? wp[(size_t)(2 * i) * ldw] : 0.f;
#pragma unroll
    for (int i = 0; i < 32; ++i) scr[(2 * i + (lane >> 5)) * 33 + c] = tmp[i];
    LDS_WAIT();
    const int c8 = lane & 7;
#pragma unroll
    for (int j = 0; j < 4; ++j) { const int n = (lane >> 3) + 8 * j; const LAS float* s = scr + (8 * c8) * 33 + n;
        u32x4 o; o.x = pk2(s[0 * 33], s[1 * 33]); o.y = pk2(s[2 * 33], s[3 * 33]); o.z = pk2(s[4 * 33], s[5 * 33]); o.w = pk2(s[6 * 33], s[7 * 33]);
        *(u32x4*)(WT + (size_t)(dst_row0 + n) * K + k0 + 8 * c8) = o; }
    LDS_WAIT();
}
__device__ __forceinline__ void transpose_item_q8(const float* W, int ldw, int src_col, int k0, unsigned char* WT8, int K, int dst_row0, float sc, LAS float* scr, int lane) {
    const int c = lane & 31;
    float tmp[32];
    const float* wp = W + (size_t)(k0 + (lane >> 5)) * ldw + src_col + c;
#pragma unroll
    for (int i = 0; i < 32; ++i) tmp[i] = wp[(size_t)(2 * i) * ldw];
#pragma unroll
    for (int i = 0; i < 32; ++i) scr[(2 * i + (lane >> 5)) * 33 + c] = tmp[i];
    LDS_WAIT();
    const int c8 = lane & 7;
#pragma unroll
    for (int j = 0; j < 4; ++j) { const int n = (lane >> 3) + 8 * j; const LAS float* s = scr + (8 * c8) * 33 + n;
        u32x2 o; o.x = pk_q8x4(s[0 * 33], s[1 * 33], s[2 * 33], s[3 * 33], sc); o.y = pk_q8x4(s[4 * 33], s[5 * 33], s[6 * 33], s[7 * 33], sc);
        *(u32x2*)(WT8 + (size_t)(dst_row0 + n) * K + k0 + 8 * c8) = o; }
    LDS_WAIT();
}
__device__ __forceinline__ void cvt_bf16_stream(const float* src, bf16* dst, size_t n8, size_t gt, size_t gstride) {
    size_t i = gt;
    for (; i + 3 * gstride < n8; i += 4 * gstride) {
        f32x4 a[4], b[4];
#pragma unroll
        for (int u = 0; u < 4; ++u) { a[u] = *(const f32x4*)(src + (i + u * gstride) * 8); b[u] = *(const f32x4*)(src + (i + u * gstride) * 8 + 4); }
#pragma unroll
        for (int u = 0; u < 4; ++u) { u32x4 o; o.x = pk2(a[u][0], a[u][1]); o.y = pk2(a[u][2], a[u][3]); o.z = pk2(b[u][0], b[u][1]); o.w = pk2(b[u][2], b[u][3]); *(u32x4*)(dst + (i + u * gstride) * 8) = o; } }
    for (; i < n8; i += gstride) { const f32x4 a = *(const f32x4*)(src + i * 8), b = *(const f32x4*)(src + i * 8 + 4);
        u32x4 o; o.x = pk2(a[0], a[1]); o.y = pk2(a[2], a[3]); o.z = pk2(b[0], b[1]); o.w = pk2(b[2], b[3]); *(u32x4*)(dst + i * 8) = o; }
}
__device__ __forceinline__ void p0_prologue(Frame& F) {
    LAS float* scr = (LAS float*)(F.lds + F.wave * 16384);
    const int gw = F.bid * NWAVES + F.wave, NGW = F.G * NWAVES;
    const float* w_in = INP(I_WIN); const float* w_gate = INP(I_WGATE);
    constexpr int NDB1 = N1 / 32, I_1 = NDB1 * 64;
    constexpr int I_BA = 128 * 32, I_BB = I_BA, I_O = 128 * 64, I_4 = 128 * 64, I_PL = 128 * 4;
    constexpr int NITEMS = I_1 + I_BA + I_BB + I_O + I_4 + I_PL;
    for (int it = gw; it < NITEMS; it += NGW) {
        int r = it;
        if (r < I_1) { const int kb = r / NDB1, db = r % NDB1; const float* W; int ldw, col, nc;
            if (db < 576) {
                if (db < 64) { W = w_in; ldw = IN_WIDTH; col = db * 32; }
                else if (db < 128) { W = w_in; ldw = IN_WIDTH; col = 2304 + (db - 64) * 32; }
                else if (db < 320) { W = w_in; ldw = IN_WIDTH; col = 4448 + (db - 128) * 32; }
                else { W = w_gate; ldw = 8192; col = (db - 320) * 32; }
                transpose_item_q8(W, ldw, col, kb * 64, WSP(unsigned char, WS_W18), 4096, db * 32, Q8_W, scr, F.lane); continue; }
            else if (db < 584) { W = w_in; ldw = IN_WIDTH; col = 2048 + (db - 576) * 32; nc = 32; }
            else { const int j = db - 584; W = w_in; ldw = IN_WIDTH; col = (j < 2) ? 4352 + 32 * j : (j == 2 ? 4416 : 10592); nc = (j < 3) ? 32 : (j == 3 ? 16 : 0); }
            transpose_item(W, ldw, col, nc, kb * 64, WSP(bf16, WS_E), 4096, db * 32, scr, F.lane); continue; }
        r -= I_1;
        if (r < I_BA) { const int kb = r / 128, db = r % 128; transpose_item_q8(INP(I_WBA), 4096, db * 32, kb * 64, WSP(unsigned char, WS_WBAT), 2048, db * 32, Q8_WB, scr, F.lane); continue; }
        r -= I_BA;
        if (r < I_BB) { const int kb = r / 128, db = r % 128; transpose_item_q8(INP(I_WBB), 4096, db * 32, kb * 64, WSP(unsigned char, WS_WBBT), 2048, db * 32, Q8_WB, scr, F.lane); continue; }
        r -= I_BB;
        if (r < I_O) { const int kb = r / 128, db = r % 128; transpose_item_q8(INP(I_WOUT), 4096, db * 32, kb * 64, WSP(unsigned char, WS_WOT), 4096, db * 32, Q8_WO, scr, F.lane); continue; }
        r -= I_O;
        if (r < I_4) { const int kb = r / 128, db = r % 128;
            transpose_item_q8(INP(I_WPG), 4096, db * 32, kb * 64, WSP(unsigned char, WS_W48), 4096, 2048 + db * 32, Q8_W, scr, F.lane); continue; }
        r -= I_4;
        { const int kb = r / 128, db = r % 128; transpose_item(INP(I_WPLE), 4096, db * 32, 32, kb * 64, WSP(bf16, WS_WPLT), 256, db * 32, scr, F.lane); }
    }
    for (int it = gw; it < 16 * 2 * 64; it += NGW) { const int dt = it & 63, nt = (it >> 6) & 1, l = it >> 7;
        small_gemm_tile_f32<128>(INP(I_PSUB) + (size_t)(l * 128 + nt * 64) * 128, 128, INP(I_PWQ) + (size_t)(dt * 64) * 2048 + (l >> 1) * 256 + (l & 1) * 128, 2048,
                                 WSP(bf16, WS_W4T) + (size_t)(l * 128 + nt * 64) * 4096 + dt * 64, 4096, F.lane, WSP(unsigned char, WS_W48) + (size_t)(l * 128 + nt * 64) * 4096 + dt * 64); }
    const size_t gt = (size_t)F.bid * NTHREADS + F.tid, gs = (size_t)F.G * NTHREADS;
    { const float* src = INP(I_X); bf16* dst = WSP(bf16, WS_XB); unsigned char* d8 = WSP(unsigned char, WS_X8); const size_t n8 = (size_t)NTOK * D_MODEL / 8;
      for (size_t i = gt; i < n8; i += 4 * gs) {
          if (i + 3 * gs >= n8) { for (size_t j = i; j < n8; j += gs) { const f32x4 a = *(const f32x4*)(src + j * 8), b = *(const f32x4*)(src + j * 8 + 4);
                  u32x4 o; o.x = pk2(a[0], a[1]); o.y = pk2(a[2], a[3]); o.z = pk2(b[0], b[1]); o.w = pk2(b[2], b[3]); *(u32x4*)(dst + j * 8) = o;
                  u32x2 q; q.x = pk_q8x4(a[0], a[1], a[2], a[3], Q8_ACT); q.y = pk_q8x4(b[0], b[1], b[2], b[3], Q8_ACT); *(u32x2*)(d8 + j * 8) = q; } break; }
          f32x4 a[4], b[4];
#pragma unroll
          for (int u = 0; u < 4; ++u) { a[u] = *(const f32x4*)(src + (i + u * gs) * 8); b[u] = *(const f32x4*)(src + (i + u * gs) * 8 + 4); }
#pragma unroll
          for (int u = 0; u < 4; ++u) { u32x4 o; o.x = pk2(a[u][0], a[u][1]); o.y = pk2(a[u][2], a[u][3]); o.z = pk2(b[u][0], b[u][1]); o.w = pk2(b[u][2], b[u][3]); *(u32x4*)(dst + (i + u * gs) * 8) = o;
              u32x2 q; q.x = pk_q8x4(a[u][0], a[u][1], a[u][2], a[u][3], Q8_ACT); q.y = pk_q8x4(b[u][0], b[u][1], b[u][2], b[u][3], Q8_ACT); *(u32x2*)(d8 + (i + u * gs) * 8) = q; } } }
    cvt_bf16_stream(INP(I_P), WSP(bf16, WS_PB), (size_t)NTOK * D_PLE / 8, gt, gs);
    { float* SCL = WSP(float, WS_SCL);
      for (int row = gw; row < 2 * N_EXPERTS; row += NGW) { const int tb = row >= N_EXPERTS ? 1 : 0, e = row - tb * N_EXPERTS;
          const float* src = (tb ? INP(I_PV) : INP(I_PU)) + (size_t)e * 4096; unsigned char* dst = (tb ? WSP(unsigned char, WS_VT) : WSP(unsigned char, WS_UB)) + (size_t)e * 2048;
          f32x4 v[16]; float ssq = 0.f;
#pragma unroll
          for (int jj = 0; jj < 2; ++jj)
#pragma unroll
              for (int q = 0; q < 8; ++q) { const f32x4 x = *(const f32x4*)(src + (jj * 64 + F.lane) * 32 + 4 * q); v[8 * jj + q] = x; ssq += (x[0] * x[0] + x[1] * x[1]) + (x[2] * x[2] + x[3] * x[3]); }
          const float sig = sqrtf(wave_sum(ssq) * (1.0f / 4096.0f)); const float inv = sig > 0.f ? 2.1f / sig : 0.f;
#pragma unroll
          for (int jj = 0; jj < 2; ++jj) { u32x4 o;
#pragma unroll
              for (int i = 0; i < 4; ++i) { const f32x4 a = v[8 * jj + 2 * i] * inv, b = v[8 * jj + 2 * i + 1] * inv; unsigned p = 0u;
                  p = __builtin_amdgcn_cvt_scalef32_pk_fp4_f32(p, a[0], a[1], 1.0f, 0); p = __builtin_amdgcn_cvt_scalef32_pk_fp4_f32(p, a[2], a[3], 1.0f, 1);
                  p = __builtin_amdgcn_cvt_scalef32_pk_fp4_f32(p, b[0], b[1], 1.0f, 2); p = __builtin_amdgcn_cvt_scalef32_pk_fp4_f32(p, b[2], b[3], 1.0f, 3); o[i] = p; }
              *(u32x4*)(dst + (jj * 64 + F.lane) * 16) = o; }
          if (F.lane == 0) SCL[row] = sig > 0.f ? sig * (1.0f / 2.1f) : 1.0f; } }
    { const float* w_uk = INP(I_WUK); const float* w_uv = INP(I_WUV); bf16* WUKB = WSP(bf16, WS_WUKB); bf16* WUVT = WSP(bf16, WS_WUVT);
      for (size_t i = gt; i < 65536; i += gs) { const int d8 = (int)(i & 15), c = (int)(i >> 4) & 255, h = (int)(i >> 12);
          const float* src = w_uk + (size_t)c * 2048 + h * 128 + d8 * 8; const f32x4 a = *(const f32x4*)src, b = *(const f32x4*)(src + 4);
          u32x4 o; o.x = pk2(a[0], a[1]); o.y = pk2(a[2], a[3]); o.z = pk2(b[0], b[1]); o.w = pk2(b[2], b[3]); *(u32x4*)(WUKB + i * 8) = o; }
      for (size_t i = gt; i < 65536; i += gs) { const int c8 = (int)(i & 31), d = (int)(i >> 5) & 127, h = (int)(i >> 12);
          const float* src = w_uv + (size_t)(c8 * 8) * 2048 + h * 128 + d;
          u32x4 o; o.x = pk2(src[0], src[2048]); o.y = pk2(src[2 * 2048], src[3 * 2048]); o.z = pk2(src[4 * 2048], src[5 * 2048]); o.w = pk2(src[6 * 2048], src[7 * 2048]); *(u32x4*)(WUVT + i * 8) = o; } }
}

__device__ __forceinline__ f32x4 part_sum4(const float* PART, int tile, size_t off) { const size_t pl = (size_t)NTOK * 256; const float* p = PART + (size_t)tile * pl + off;
    return (*(const f32x4*)p + *(const f32x4*)(p + 2 * pl)) + (*(const f32x4*)(p + 4 * pl) + *(const f32x4*)(p + 6 * pl)); }
__device__ __forceinline__ float log_sigmoid(float z) { return fminf(z, 0.f) - log1pf(__expf(-fabsf(z))); }
__device__ __forceinline__ void p2_small(Frame& F) {
    const int gw = F.bid * NWAVES + F.wave, NGW = F.G * NWAVES, lane = F.lane;
    { const float* PART = WSP(float, WS_PART); bf16* CKVN = WSP(bf16, WS_CKVN); const f32x4 g = *(const f32x4*)(INP(I_GLAT) + 4 * lane);
      for (int t = gw; t < NTOK; t += NGW) { const f32x4 v = part_sum4(PART, 0, (size_t)t * 256 + 4 * lane);
          const float ss = wave_sum(v[0] * v[0] + v[1] * v[1] + v[2] * v[2] + v[3] * v[3]); const float r = 1.0f / sqrtf(ss * (1.0f / 256.0f) + LN_EPS);
          u32x2 o; o.x = pk2(v[0] * r * g[0], v[1] * r * g[1]); o.y = pk2(v[2] * r * g[2], v[3] * r * g[3]); *(u32x2*)(CKVN + (size_t)t * 256 + 4 * lane) = o; } }
    { const float* PART = WSP(float, WS_PART); float* CUML = WSP(float, WS_CUM); float* SEGT = WSP(float, WS_CUM + 512 * 1024); const float* bfp = INP(I_BFORGET);
      for (int it = gw; it < BATCH * (SEQ / 64); it += NGW) { const int b = it / (SEQ / 64), seg = it % (SEQ / 64), pos = seg * 64 + lane;
          f32x4 f[4];
#pragma unroll
          for (int q = 0; q < 4; ++q) f[q] = part_sum4(PART, 1, (size_t)(b * SEQ + pos) * 256 + 96 + 4 * q);
#pragma unroll
          for (int h = 0; h < B_HEADS; ++h) { float v = log_sigmoid(f[h >> 2][h & 3] + bfp[h]);
#pragma unroll
              for (int o = 1; o < 64; o <<= 1) { const float t = __shfl_up(v, o); if (lane >= o) v += t; }
              CUML[(size_t)(b * B_HEADS + h) * SEQ + pos] = v; if (lane == 63) SEGT[(b * B_HEADS + h) * (SEQ / 64) + seg] = v; } } }
    { const bf16* QA = WSP(bf16, WS_QA); bf16* QLAT = WSP(bf16, WS_QLAT); const bf16* WUKB = WSP(bf16, WS_WUKB);
      for (int it = gw; it < (NTOK / 64) * A_HEADS * 4; it += NGW) { const int ct = it & 3, h = (it >> 2) & 15, tt = it >> 6;
          small_gemm_tile<128>(QA + (size_t)tt * 64 * 2048 + h * 128, 2048, WUKB + (size_t)(h * 256 + ct * 64) * 128, 128, QLAT + (size_t)tt * 64 * 4096 + h * 256 + ct * 64, 4096, lane); } }
    { const float* PART = WSP(float, WS_PART); bf16* KIDXB = WSP(bf16, WS_KIDXB); float* WIDX = WSP(float, WS_WIDX); const size_t gt = (size_t)F.bid * NTHREADS + F.tid, gs = (size_t)F.G * NTHREADS;
      for (size_t i = gt; i < (size_t)NTOK * 8; i += gs) { const size_t t = i >> 3; const int q = (int)(i & 7); *(f32x4*)(WIDX + t * 32 + 4 * q) = part_sum4(PART, 1, t * 256 + 64 + 4 * q); }
      for (size_t i = gt; i < (size_t)NTOK * 8; i += gs) { const size_t t = i >> 3; const int c8 = (int)(i & 7); const f32x4 a = part_sum4(PART, 1, t * 256 + c8 * 8), b = part_sum4(PART, 1, t * 256 + c8 * 8 + 4);
          u32x4 o; o.x = pk2(a[0], a[1]); o.y = pk2(a[2], a[3]); o.z = pk2(b[0], b[1]); o.w = pk2(b[2], b[3]);
          const size_t tl = t & (SEQ - 1); *(u32x4*)(KIDXB + (t - tl) * 64 + (tl >> 5) * 2048 + (c8 >> 1) * 512 + (tl & 31) * 16 + (c8 & 1) * 8) = o; } }
}

__device__ __forceinline__ unsigned f2key(float f) { const unsigned b = __builtin_bit_cast(unsigned, f); return (b & 0x80000000u) ? ~b : (b | 0x80000000u); }
__device__ __forceinline__ int lanes_below(unsigned long long m) { return (int)__builtin_amdgcn_mbcnt_hi((unsigned)(m >> 32), __builtin_amdgcn_mbcnt_lo((unsigned)m, 0u)); }
__device__ __forceinline__ void p4_oa(Frame& F) {
    const int gw = F.bid * NWAVES + F.wave, NGW = F.G * NWAVES, lane = F.lane;
    const bf16* OLAT = WSP(bf16, WS_OLAT); bf16* OA = WSP(bf16, WS_QA); const bf16* WUVT = WSP(bf16, WS_WUVT);
    for (int it = gw; it < (NTOK / 64) * A_HEADS * 2; it += NGW) { const int dt = it & 1, h = (it >> 1) & 15, tt = it >> 5;
        small_gemm_tile<256>(OLAT + (size_t)tt * 64 * 4096 + h * 256, 4096, WUVT + (size_t)(h * 128 + dt * 64) * 256, 256, nullptr, 2048, lane, (unsigned char*)OA + (size_t)tt * 64 * 2048 + h * 128 + dt * 64, Q8_O); }
}
__device__ __forceinline__ void p7_ln1(Frame& F) {
    const int gw = F.bid * NWAVES + F.wave, NGW = F.G * NWAVES, lane = F.lane;
    const bf16* Y1 = WSP(bf16, WS_E); bf16* H1B = WSP(bf16, WS_XB); unsigned char* H18 = WSP(unsigned char, WS_X8); const float* g = INP(I_LN1G); const float* bb = INP(I_LN1B);
    for (int t = gw; t < NTOK; t += NGW) { const bf16* yr = Y1 + (size_t)t * 4096;
        f32x4 v[16]; float s = 0.f;
#pragma unroll
        for (int j = 0; j < 8; ++j) { const u32x4 w = *(const u32x4*)(yr + (j * 64 + lane) * 8); v[2 * j] = (f32x4){bflo(w.x), bfhi(w.x), bflo(w.y), bfhi(w.y)}; v[2 * j + 1] = (f32x4){bflo(w.z), bfhi(w.z), bflo(w.w), bfhi(w.w)};
            s += (v[2 * j][0] + v[2 * j][1]) + (v[2 * j][2] + v[2 * j][3]) + (v[2 * j + 1][0] + v[2 * j + 1][1]) + (v[2 * j + 1][2] + v[2 * j + 1][3]); }
        const float mean = wave_sum(s) * (1.0f / 4096.0f); float q = 0.f;
#pragma unroll
        for (int j = 0; j < 16; ++j) { v[j] = v[j] - mean; q += (v[j][0] * v[j][0] + v[j][1] * v[j][1]) + (v[j][2] * v[j][2] + v[j][3] * v[j][3]); }
        const float rstd = 1.0f / sqrtf(wave_sum(q) * (1.0f / 4096.0f) + LN_EPS);
#pragma unroll
        for (int j = 0; j < 8; ++j) { const int off = (j * 64 + lane) * 8; const f32x4 g0 = *(const f32x4*)(g + off), g1 = *(const f32x4*)(g + off + 4), b0 = *(const f32x4*)(bb + off), b1 = *(const f32x4*)(bb + off + 4);
            const f32x4 o0 = v[2 * j] * rstd * g0 + b0, o1 = v[2 * j + 1] * rstd * g1 + b1;
            u32x4 w; w.x = pk2(o0[0], o0[1]); w.y = pk2(o0[2], o0[3]); w.z = pk2(o1[0], o1[1]); w.w = pk2(o1[2], o1[3]); *(u32x4*)(H1B + (size_t)t * 4096 + off) = w;
            u32x2 q8; q8.x = pk_q8x4(o0[0], o0[1], o0[2], o0[3], Q8_ACT); q8.y = pk_q8x4(o1[0], o1[1], o1[2], o1[3], Q8_ACT); *(u32x2*)(H18 + (size_t)t * 4096 + off) = q8; } }
}
constexpr int FOX_KP = 272, FOX_VP = 320, FOX_VOFF = 17408, FOX_COFF = 37888;
__device__ __forceinline__ void fox_unit(Frame& F, int b, int h, int qb) {
    const int tid = F.tid, lane = F.lane, w = F.wave, r = lane & 31, hh = lane >> 5;
    LAS unsigned char* Ks = F.lds; LAS unsigned char* Vs = F.lds + FOX_VOFF; LAS float* cks = (LAS float*)(F.lds + FOX_COFF);
    const bf16* QB = WSP(bf16, WS_QB); const bf16* KB = WSP(bf16, WS_KB); const bf16* VB = WSP(bf16, WS_VB); bf16* OB = WSP(bf16, WS_OB);
    const float* cum = WSP(float, WS_CUM) + (size_t)(b * B_HEADS + h) * SEQ;
    LAS float* segp = (LAS float*)(F.lds + FOX_COFF + 256);
    const int Q0 = qb * 256, q0 = Q0 + 32 * w, ntiles = (Q0 + 256) / 64, tl = (q0 + 31) / 64;
    const float SC = 0.12751741614123135f, LOG2E = 1.4426950408889634f;
    bf16x8 qf[8];
    { const bf16* qp = QB + ((size_t)b * SEQ + q0 + r) * 2048 + h * 128 + 8 * hh;
#pragma unroll
      for (int s = 0; s < 8; ++s) qf[s] = *(const bf16x8*)(qp + 16 * s); }
    f32x16 o[4];
#pragma unroll
    for (int dt = 0; dt < 4; ++dt)
#pragma unroll
        for (int i = 0; i < 16; ++i) o[dt][i] = 0.f;
    float m = -1e30f, l = 0.f;
    const int pk0 = tid >> 4, pc0 = tid & 15;
    const bf16* kg = KB + ((size_t)b * SEQ + pk0) * 2048 + h * 128 + 8 * pc0; const bf16* vg = VB + ((size_t)b * SEQ + pk0) * 2048 + h * 128 + 8 * pc0;
    u32x4 kr0, kr1, vr0, vr1; float cr = 0.f;
#define FOX_LOAD(kt) do { const size_t go = (size_t)(kt) * 64 * 2048; kr0 = *(const u32x4*)(kg + go); kr1 = *(const u32x4*)(kg + go + 32 * 2048); vr0 = *(const u32x4*)(vg + go); vr1 = *(const u32x4*)(vg + go + 32 * 2048); \
        if (tid < 64) cr = (cum[(kt) * 64 + tid] + segp[(kt)]) * LOG2E; } while (0)
    if (tid < 64) { float v = (lane < 32) ? WSP(float, WS_CUM + 512 * 1024)[(b * B_HEADS + h) * (SEQ / 64) + lane] : 0.f; const float own = v;
#pragma unroll
        for (int o = 1; o < 32; o <<= 1) { const float t = __shfl_up(v, o); if (lane >= o) v += t; }
        if (lane < 32) segp[lane] = v - own;
        CFENCE(); LDS_WAIT(); }
    FOX_LOAD(0);
    const int ka_off = r * FOX_KP + 16 * hh;
    const int vt_off = (4 * hh + ((lane & 15) >> 2)) * FOX_VP + (16 * ((lane >> 4) & 1) + 4 * (lane & 3)) * 2;
    const int ck_off = 4 * hh;
    for (int kt = 0; kt < ntiles; ++kt) {
        __syncthreads();
        *(LAS u32x4*)(Ks + pk0 * FOX_KP + pc0 * 16) = kr0; *(LAS u32x4*)(Ks + (pk0 + 32) * FOX_KP + pc0 * 16) = kr1;
        *(LAS u32x4*)(Vs + pk0 * FOX_VP + pc0 * 16) = vr0; *(LAS u32x4*)(Vs + (pk0 + 32) * FOX_VP + pc0 * 16) = vr1;
        if (tid < 64) cks[tid] = cr;
        __syncthreads();
        if (kt + 1 < ntiles) FOX_LOAD(kt + 1);
        if (kt <= tl) {
            f32x16 s0, s1;
#pragma unroll
            for (int i = 0; i < 16; ++i) { s0[i] = 0.f; s1[i] = 0.f; }
#pragma unroll
            for (int s = 0; s < 8; ++s) { const bf16x8 a0 = *(const LAS bf16x8*)(Ks + ka_off + 32 * s), a1 = *(const LAS bf16x8*)(Ks + ka_off + 32 * FOX_KP + 32 * s);
                s0 = __builtin_amdgcn_mfma_f32_32x32x16_bf16(a0, qf[s], s0, 0, 0, 0); s1 = __builtin_amdgcn_mfma_f32_32x32x16_bf16(a1, qf[s], s1, 0, 0, 0); }
            const bool diag = (64 * kt + 63 > q0); const int qme = q0 + r - 64 * kt;
            float mx = m;
#pragma unroll
            for (int g4 = 0; g4 < 4; ++g4) { const f32x4 c0 = *(const LAS f32x4*)(cks + ck_off + 8 * g4), c1 = *(const LAS f32x4*)(cks + ck_off + 32 + 8 * g4);
#pragma unroll
                for (int i = 0; i < 4; ++i) { const int kl = 8 * g4 + 4 * hh + i; float t0 = s0[4 * g4 + i] * SC - c0[i], t1 = s1[4 * g4 + i] * SC - c1[i];
                    if (diag) { if (kl > qme) t0 = -INFINITY; if (kl + 32 > qme) t1 = -INFINITY; }
                    s0[4 * g4 + i] = t0; s1[4 * g4 + i] = t1; mx = fmaxf(mx, fmaxf(t0, t1)); } }
            mx = fmaxf(mx, __shfl_xor(mx, 32));
            if (__any(mx > m + 8.0f)) {
                const float alpha = __builtin_amdgcn_exp2f(m - mx); m = mx; l *= alpha;
#pragma unroll
                for (int dt = 0; dt < 4; ++dt)
#pragma unroll
                    for (int i = 0; i < 16; ++i) o[dt][i] *= alpha; }
            float ls = 0.f;
            union { bf16x8 v; unsigned u[4]; } pf[4];
#pragma unroll
            for (int ks = 0; ks < 2; ++ks)
#pragma unroll
                for (int j = 0; j < 4; ++j) { const float a0 = __builtin_amdgcn_exp2f(s0[8 * ks + 2 * j] - m), a1 = __builtin_amdgcn_exp2f(s0[8 * ks + 2 * j + 1] - m);
                    const float b0 = __builtin_amdgcn_exp2f(s1[8 * ks + 2 * j] - m), b1 = __builtin_amdgcn_exp2f(s1[8 * ks + 2 * j + 1] - m);
                    ls += (a0 + a1) + (b0 + b1); pf[ks].u[j] = pk2(a0, a1); pf[2 + ks].u[j] = pk2(b0, b1); }
            l += ls;
#pragma unroll
            for (int f = 0; f < 4; ++f) {
                const int vb = vt_off + 16 * f * FOX_VP;
#pragma unroll
                for (int dt = 0; dt < 4; ++dt) {
                    const s16x4 x0 = __builtin_amdgcn_ds_read_tr16_b64_v4i16((LAS s16x4*)(Vs + vb + 64 * dt)), x1 = __builtin_amdgcn_ds_read_tr16_b64_v4i16((LAS s16x4*)(Vs + vb + 8 * FOX_VP + 64 * dt));
                    const bf16x8 af = {x0[0], x0[1], x0[2], x0[3], x1[0], x1[1], x1[2], x1[3]};
                    o[dt] = __builtin_amdgcn_mfma_f32_32x32x16_bf16(af, pf[f].v, o[dt], 0, 0, 0); }
                __builtin_amdgcn_sched_barrier(0);
            }
        }
    }
#undef FOX_LOAD
    l += __shfl_xor(l, 32);
    const float inv = 1.0f / l;
    unsigned char* op = (unsigned char*)OB + ((size_t)b * SEQ + q0 + r) * 2048 + h * 128 + 4 * hh;
#pragma unroll
    for (int dt = 0; dt < 4; ++dt)
#pragma unroll
        for (int g4 = 0; g4 < 4; ++g4) *(unsigned*)(op + 32 * dt + 8 * g4) = pk_q8x4(o[dt][4 * g4] * inv, o[dt][4 * g4 + 1] * inv, o[dt][4 * g4 + 2] * inv, o[dt][4 * g4 + 3] * inv, Q8_O);
}
__device__ __forceinline__ void p3_fox(Frame& F) {
    for (int pr = F.bid; pr < BATCH * B_HEADS * 4; pr += F.G) { const int bh = pr >> 2, j = pr & 3, b = bh >> 4, h = bh & 15;
        fox_unit(F, b, h, 7 - j);
        fox_unit(F, b, h, j); }
}
constexpr int DSA_WLDS = 16896;
__device__ __forceinline__ void p3_dsa(Frame& F, int flags) {
    const int gw = F.bid * NWAVES + F.wave, NGW = F.G * NWAVES;
    LAS unsigned char* wb = F.lds + F.wave * DSA_WLDS;
    LAS float* SCb2 = (LAS float*)wb; LAS unsigned short* IDX = (LAS unsigned short*)(wb + 16384);
    const bf16* QIDX = WSP(bf16, WS_QIDX); const bf16* KIDXB = WSP(bf16, WS_KIDXB); const float* WIDX = WSP(float, WS_WIDX); const bf16* CKVN = WSP(bf16, WS_CKVN); const bf16* QLAT = WSP(bf16, WS_QLAT); bf16* OLAT = WSP(bf16, WS_OLAT);
    const float idx_scale = 0.022097086912079608f, SCL = 0.12751741614123135f  ;
    for (int ip = gw; ip < NTOK / 2; ip += NGW) {
        const int b = (2 * ip) / SEQ, ttp = (2 * ip) % SEQ, tp0 = (b & 2) ? (SEQ - 2 - ttp) : ttp;
         const size_t rowp = (size_t)b * SEQ + tp0; const int chunk_end = (tp0 / CHUNK + 1) * CHUNK;
        {
        const int lane = fresh_lane(), r32 = lane & 31, hh = lane >> 5;
        if (!(flags & 4)) {
            bf16x8 qi[2][4]; f32x4 wv[2][4];
#pragma unroll
            for (int q2 = 0; q2 < 2; ++q2) {
#pragma unroll
                for (int s = 0; s < 4; ++s) qi[q2][s] = *(const bf16x8*)(QIDX + (rowp + q2) * 2048 + r32 * 64 + 16 * s + 8 * hh);
#pragma unroll
                for (int g4 = 0; g4 < 4; ++g4) wv[q2][g4] = *(const f32x4*)(WIDX + (rowp + q2) * 32 + 8 * g4 + 4 * hh); }
            const bf16* kp = KIDXB + (size_t)b * SEQ * 64 + r32 * 16 + 8 * hh;
            bf16x8 kb[8][4];
#define DSA_SCORE(kbt, tile, q2) do { f32x16 acc; _Pragma("unroll") for (int i = 0; i < 16; ++i) acc[i] = 0.f; \
                _Pragma("unroll") for (int s = 0; s < 4; ++s) acc = __builtin_amdgcn_mfma_f32_32x32x16_bf16(qi[q2][s], kbt[s], acc, 0, 0, 0); \
                float sc = 0.f; _Pragma("unroll") for (int g4 = 0; g4 < 4; ++g4) _Pragma("unroll") for (int i = 0; i < 4; ++i) sc += fmaxf(acc[4 * g4 + i], 0.f) * wv[q2][g4][i]; \
                sc += __shfl_xor(sc, 32); if (lane < 32) SCb2[(q2) * 2048 + (tile) * 32 + lane] = sc * idx_scale; } while (0)
            const int ntile8 = ((chunk_end + 255) >> 8) << 3;
            for (int t0 = 0; t0 < ntile8; t0 += 8) {
#pragma unroll
                for (int u = 0; u < 8; ++u)
#pragma unroll
                    for (int s = 0; s < 4; ++s) kb[u][s] = *(const bf16x8*)(kp + (size_t)(t0 + u) * 2048 + 512 * s);
#pragma unroll
                for (int u = 0; u < 8; ++u) { DSA_SCORE(kb[u], t0 + u, 0); DSA_SCORE(kb[u], t0 + u, 1); __builtin_amdgcn_sched_barrier(0); }
            }
#undef DSA_SCORE
        }
        }
        CFENCE(); LDS_WAIT();
#pragma unroll 1
        for (int q2 = 0; q2 < 2; ++q2) {
        const int lane = fresh_lane(), r16 = lane & 15, g = lane >> 4;
        const int t = tp0 + q2; const size_t row = rowp + q2; LAS float* SCb = SCb2 + q2 * 2048;
        const int nsel = chunk_end < TOPK ? chunk_end : TOPK;
        if (chunk_end <= TOPK || (flags & 8)) { for (int s = lane; s < nsel; s += 64) IDX[s] = (unsigned short)s; }
        else {
            unsigned key[32]; const int nreg = chunk_end >> 6;
#pragma unroll
            for (int i = 0; i < 32; ++i) key[i] = (i < nreg) ? f2key(SCb[i * 64 + lane]) : 0u;
            unsigned T = 0u;
            for (int bit = 31; bit >= 0; --bit) { const unsigned cand = T | (1u << bit); int cnt = 0;
#pragma unroll
                for (int i = 0; i < 32; ++i) cnt += __builtin_popcountll(__ballot(key[i] >= cand));
                if (cnt >= TOPK) { T = cand; if (cnt == TOPK) break; } }
            int cgt = 0;
#pragma unroll
            for (int i = 0; i < 32; ++i) cgt += __builtin_popcountll(__ballot(key[i] > T));
            int rem = TOPK - cgt, base = 0;
#pragma unroll
            for (int i = 0; i < 32; ++i) { const bool gt = key[i] > T, eq = key[i] == T; const unsigned long long meq = __ballot(eq); const bool take = gt || (eq && lanes_below(meq) < rem);
                const unsigned long long msel = __ballot(take); if (take) IDX[base + lanes_below(msel)] = (unsigned short)(i * 64 + lane);
                base += __builtin_popcountll(msel); const int ne = __builtin_popcountll(meq); rem -= (ne < rem ? ne : rem); }
        }
        CFENCE(); LDS_WAIT();
        if (!(flags & 16)) {
            int r16l = r16; asm volatile("" : "+v"(r16l));
            union { bf16x8 v; unsigned short e[8]; } sel0, sel1;
#pragma unroll
            for (int j = 0; j < 8; ++j) { sel0.e[j] = (8 * g + j == r16l) ? 0x3F80 : 0; sel1.e[j] = (8 * g + j == 16 + r16l) ? 0x3F80 : 0; }
            const float slope2 = exp2f(-0.5f * (float)(r16l + 1)) * 1.4426950408889634f;
            bf16x8 ql[8];
#pragma unroll
            for (int s = 0; s < 8; ++s) ql[s] = *(const bf16x8*)(QLAT + row * 4096 + r16 * 256 + 32 * s + 8 * g);
            f32x4 o[16];
#pragma unroll
            for (int ct = 0; ct < 16; ++ct) o[ct] = (f32x4){0.f, 0.f, 0.f, 0.f};
            float m = -1e30f, l = 0.f;
            const bf16* cbase = CKVN + (size_t)b * SEQ * 256 + 8 * g;
            const int nstep = nsel >> 5;
            for (int st = 0; st < nstep; ++st) {
                const int ia = IDX[32 * st + r16], ib = IDX[32 * st + 16 + r16];
                bf16x8 ca[8], cb[8];
#pragma unroll
                for (int s = 0; s < 8; ++s) { ca[s] = *(const bf16x8*)(cbase + (size_t)ia * 256 + 32 * s); cb[s] = *(const bf16x8*)(cbase + (size_t)ib * 256 + 32 * s); }
                f32x4 sa = (f32x4){0.f, 0.f, 0.f, 0.f}, sb = sa;
#pragma unroll
                for (int s = 0; s < 8; ++s) { sa = __builtin_amdgcn_mfma_f32_16x16x32_bf16(ca[s], ql[s], sa, 0, 0, 0); sb = __builtin_amdgcn_mfma_f32_16x16x32_bf16(cb[s], ql[s], sb, 0, 0, 0); }
                const u32x2 ja = *(const LAS u32x2*)(IDX + 32 * st + 4 * g), jb = *(const LAS u32x2*)(IDX + 32 * st + 16 + 4 * g);
                const int da0 = t - (int)(ja.x & 0xffff), da1 = t - (int)(ja.x >> 16), da2 = t - (int)(ja.y & 0xffff), da3 = t - (int)(ja.y >> 16);
                const int db0 = t - (int)(jb.x & 0xffff), db1 = t - (int)(jb.x >> 16), db2 = t - (int)(jb.y & 0xffff), db3 = t - (int)(jb.y >> 16);
                sa[0] = sa[0] * SCL - slope2 * (float)(da0 < 0 ? -da0 : da0); sa[1] = sa[1] * SCL - slope2 * (float)(da1 < 0 ? -da1 : da1);
                sa[2] = sa[2] * SCL - slope2 * (float)(da2 < 0 ? -da2 : da2); sa[3] = sa[3] * SCL - slope2 * (float)(da3 < 0 ? -da3 : da3);
                sb[0] = sb[0] * SCL - slope2 * (float)(db0 < 0 ? -db0 : db0); sb[1] = sb[1] * SCL - slope2 * (float)(db1 < 0 ? -db1 : db1);
                sb[2] = sb[2] * SCL - slope2 * (float)(db2 < 0 ? -db2 : db2); sb[3] = sb[3] * SCL - slope2 * (float)(db3 < 0 ? -db3 : db3);
                float mx = fmaxf(fmaxf(fmaxf(sa[0], sa[1]), fmaxf(sa[2], sa[3])), fmaxf(fmaxf(sb[0], sb[1]), fmaxf(sb[2], sb[3])));
                mx = fmaxf(mx, __shfl_xor(mx, 16)); mx = fmaxf(mx, __shfl_xor(mx, 32));
                float alpha = 1.0f;
                if (__any(mx > m + 8.0f)) { mx = fmaxf(mx, m); alpha = __builtin_amdgcn_exp2f(m - mx); m = mx;
#pragma unroll
                    for (int ct = 0; ct < 16; ++ct) o[ct] *= alpha; }
#pragma unroll
                for (int i = 0; i < 4; ++i) { sa[i] = __builtin_amdgcn_exp2f(sa[i] - m); sb[i] = __builtin_amdgcn_exp2f(sb[i] - m); }
                l = l * alpha + ((sa[0] + sa[1]) + (sa[2] + sa[3])) + ((sb[0] + sb[1]) + (sb[2] + sb[3]));
                union { bf16x8 v; unsigned u[4]; } pf;
                pf.u[0] = pk2(sa[0], sa[1]); pf.u[1] = pk2(sa[2], sa[3]); pf.u[2] = pk2(sb[0], sb[1]); pf.u[3] = pk2(sb[2], sb[3]);
#pragma unroll
                for (int s = 0; s < 8; ++s) {
                    const f32x4 z = (f32x4){0.f, 0.f, 0.f, 0.f};
                    const f32x4 ta0 = __builtin_amdgcn_mfma_f32_16x16x32_bf16(ca[s], sel0.v, z, 0, 0, 0), ta1 = __builtin_amdgcn_mfma_f32_16x16x32_bf16(ca[s], sel1.v, z, 0, 0, 0);
                    const f32x4 tb0 = __builtin_amdgcn_mfma_f32_16x16x32_bf16(cb[s], sel0.v, z, 0, 0, 0), tb1 = __builtin_amdgcn_mfma_f32_16x16x32_bf16(cb[s], sel1.v, z, 0, 0, 0);
                    union { bf16x8 v; unsigned u[4]; } v0, v1;
                    v0.u[0] = pk2(ta0[0], ta0[1]); v0.u[1] = pk2(ta0[2], ta0[3]); v0.u[2] = pk2(tb0[0], tb0[1]); v0.u[3] = pk2(tb0[2], tb0[3]);
                    v1.u[0] = pk2(ta1[0], ta1[1]); v1.u[1] = pk2(ta1[2], ta1[3]); v1.u[2] = pk2(tb1[0], tb1[1]); v1.u[3] = pk2(tb1[2], tb1[3]);
                    o[2 * s] = __builtin_amdgcn_mfma_f32_16x16x32_bf16(v0.v, pf.v, o[2 * s], 0, 0, 0);
                    o[2 * s + 1] = __builtin_amdgcn_mfma_f32_16x16x32_bf16(v1.v, pf.v, o[2 * s + 1], 0, 0, 0);
                }
            }
            l += __shfl_xor(l, 16); l += __shfl_xor(l, 32);
            const float inv = 1.0f / l;
            bf16* op = OLAT + row * 4096 + r16 * 256 + 4 * g;
#pragma unroll
            for (int ct = 0; ct < 16; ++ct) { u32x2 wv; wv.x = pk2(o[ct][0] * inv, o[ct][1] * inv); wv.y = pk2(o[ct][2] * inv, o[ct][3] * inv); *(u32x2*)(op + 16 * ct) = wv; }
        }
        CFENCE(); LDS_WAIT();
        }
    }
}
constexpr int PEER_WLDS = 2048;
typedef int i32x8 __attribute__((ext_vector_type(8)));
typedef __bf16 bf16x2_d __attribute__((ext_vector_type(2)));
__device__ __forceinline__ float dot2bf(unsigned a, unsigned b, float c) { return __builtin_amdgcn_fdot2_f32_bf16(__builtin_bit_cast(bf16x2_d, a), __builtin_bit_cast(bf16x2_d, b), c, false); }
__device__ __forceinline__ f32x4 fp8x4(unsigned w) { const f32x2 lo = __builtin_amdgcn_cvt_pk_f32_fp8((int)w, false), hi = __builtin_amdgcn_cvt_pk_f32_fp8((int)w, true); return (f32x4){lo[0], lo[1], hi[0], hi[1]}; }
__device__ __forceinline__ float fp8dot4(unsigned w, f32x4 x) { const f32x4 f = fp8x4(w); return (f[0] * x[0] + f[1] * x[1]) + (f[2] * x[2] + f[3] * x[3]); }
#define DPPF(v, ctrl, rmask) __builtin_bit_cast(float, __builtin_amdgcn_update_dpp(0, __builtin_bit_cast(int, (v)), (ctrl), (rmask), 0xf, false))
__device__ __forceinline__ float wave_sum_u(float v) {
    v += DPPF(v, 0xB1, 0xf); v += DPPF(v, 0x4E, 0xf); v += DPPF(v, 0x141, 0xf); v += DPPF(v, 0x140, 0xf);
    v += DPPF(v, 0x142, 0xa); v += DPPF(v, 0x143, 0xc);
    return __builtin_bit_cast(float, __builtin_amdgcn_readlane(__builtin_bit_cast(int, v), 63));
}
template <int NV>
__device__ __forceinline__ void select16(const unsigned (&key)[NV], bool (&sel)[NV], int (&pos)[NV]) {
    unsigned T = 0u;
    for (int bit = 31; bit >= 0; --bit) { const unsigned cand = T | (1u << bit); int cnt = 0;
#pragma unroll
        for (int r = 0; r < NV; ++r) cnt += __builtin_popcountll(__ballot(key[r] >= cand));
        if (cnt >= PEER_TOPK) { T = cand; if (cnt == PEER_TOPK) break; } }
    int cgt = 0;
#pragma unroll
    for (int r = 0; r < NV; ++r) cgt += __builtin_popcountll(__ballot(key[r] > T));
    int rem = PEER_TOPK - cgt, base = 0;
#pragma unroll
    for (int r = 0; r < NV; ++r) { const bool gt = key[r] > T, eq = key[r] == T; const unsigned long long meq = __ballot(eq); const bool take = gt || (eq && lanes_below(meq) < rem);
        const unsigned long long msel = __ballot(take); sel[r] = take; pos[r] = base + lanes_below(msel);
        base += __builtin_popcountll(msel); const int ne = __builtin_popcountll(meq); rem -= (ne < rem ? ne : rem); }
}
__device__ __forceinline__ void p9_peer(Frame& F) {
    const int gw = F.bid * NWAVES + F.wave, NGW = F.G * NWAVES, lane = F.lane;
    LAS unsigned char* wb = F.lds + F.wave * PEER_WLDS;
    LAS float* tv = (LAS float*)wb; LAS int* ti = (LAS int*)(wb + 128); LAS float* cv = (LAS float*)(wb + 256); LAS int* cc = (LAS int*)(wb + 320); LAS int* eidx = (LAS int*)(wb + 512); LAS float* coef = (LAS float*)(wb + 1024); LAS float* su = (LAS float*)(wb + 1536);
    const float* S = WSP(float, WS_E); const bf16* H1B = WSP(bf16, WS_XB); const bf16* PLE = WSP(bf16, WS_PL); const unsigned char* UB = WSP(unsigned char, WS_UB); const unsigned char* VT = WSP(unsigned char, WS_VT); const float* SCL = WSP(float, WS_SCL);
    const float* g2 = INP(I_LN2G); const float* b2 = INP(I_LN2B);
    for (int tok = gw; tok < NTOK; tok += NGW) {
        const float* srow = S + (size_t)tok * 2048;
#pragma unroll 1
        for (int h = 0; h < PEER_HEADS; ++h) {
#pragma unroll
            for (int side = 0; side < 2; ++side) { const float v0 = srow[(2 * h + side) * 128 + lane], v1 = srow[(2 * h + side) * 128 + 64 + lane];
                const unsigned key[2] = {f2key(v0), f2key(v1)}; bool sel[2]; int pos[2]; select16<2>(key, sel, pos);
                if (sel[0]) { tv[side * 16 + pos[0]] = v0; ti[side * 16 + pos[0]] = lane; }
                if (sel[1]) { tv[side * 16 + pos[1]] = v1; ti[side * 16 + pos[1]] = lane + 64; } }
            CFENCE(); LDS_WAIT();
            { const int i0 = lane >> 4, j = lane & 15; const float vj = tv[16 + j];
              const float c0 = tv[i0] + vj, c1 = tv[i0 + 4] + vj, c2 = tv[i0 + 8] + vj, c3 = tv[i0 + 12] + vj;
              const unsigned key[4] = {f2key(c0), f2key(c1), f2key(c2), f2key(c3)}; bool sel[4]; int pos[4]; select16<4>(key, sel, pos);
              if (sel[0]) { cv[pos[0]] = c0; cc[pos[0]] = lane; } if (sel[1]) { cv[pos[1]] = c1; cc[pos[1]] = lane + 64; }
              if (sel[2]) { cv[pos[2]] = c2; cc[pos[2]] = lane + 128; } if (sel[3]) { cv[pos[3]] = c3; cc[pos[3]] = lane + 192; } }
            CFENCE(); LDS_WAIT();
            { const float val = cv[lane & 15]; const int ci = cc[lane & 15]; float mx = val;
#pragma unroll
              for (int o = 1; o < 16; o <<= 1) mx = fmaxf(mx, __shfl_xor(mx, o));
              const float e = __expf(val - mx); float sm = e;
#pragma unroll
              for (int o = 1; o < 16; o <<= 1) sm += __shfl_xor(sm, o);
              if (lane < 16) { eidx[h * 16 + lane] = ti[ci >> 4] * 128 + ti[16 + (ci & 15)]; coef[h * 16 + lane] = e / sm; } }
            CFENCE(); LDS_WAIT();
        }
        { const int e0 = eidx[lane], e1 = eidx[lane + 64];
          const float s0 = SCL[e0], s1 = SCL[e1], t0 = SCL[N_EXPERTS + e0], t1 = SCL[N_EXPERTS + e1];
          su[lane] = s0; su[lane + 64] = s1; coef[lane] *= t0; coef[lane + 64] *= t1; }
        CFENCE(); LDS_WAIT();
        {
            u32x4 hb[2][3];
            u32x4 hx[2][4]; float mx = 0.f;
#pragma unroll
            for (int jj = 0; jj < 2; ++jj)
#pragma unroll
                for (int i = 0; i < 4; ++i) { hx[jj][i] = *(const u32x4*)(H1B + (size_t)tok * 4096 + (jj * 64 + lane) * 32 + 8 * i);
#pragma unroll
                    for (int k = 0; k < 4; ++k) mx = fmaxf(mx, fmaxf(fabsf(bflo(hx[jj][i][k])), fabsf(bfhi(hx[jj][i][k])))); }
            mx = wave_max(mx) * (1.0f / 6.0f);
            int eb = (int)((__builtin_bit_cast(unsigned, mx) + 0x007fffffu) >> 23); eb = eb < 1 ? 1 : (eb > 253 ? 253 : eb);
            const float sup = __builtin_bit_cast(float, (unsigned)(254 - eb) << 23), sdn = __builtin_bit_cast(float, (unsigned)eb << 23);
#pragma unroll
            for (int jj = 0; jj < 2; ++jj)
#pragma unroll
                for (int i = 0; i < 4; ++i) { unsigned w0 = 0u, w1 = 0u, w2 = 0u;
#define HDIG(k) { float x0 = bflo(hx[jj][i][k]) * sup, x1 = bfhi(hx[jj][i][k]) * sup; \
                      w0 = __builtin_amdgcn_cvt_scalef32_pk_fp4_f32(w0, x0, x1, 1.0f, k); f32x2 dq = __builtin_amdgcn_cvt_scalef32_pk_f32_fp4(w0, 1.0f, k); x0 = (x0 - dq[0]) * 4.0f; x1 = (x1 - dq[1]) * 4.0f; \
                      w1 = __builtin_amdgcn_cvt_scalef32_pk_fp4_f32(w1, x0, x1, 1.0f, k); dq = __builtin_amdgcn_cvt_scalef32_pk_f32_fp4(w1, 1.0f, k); x0 = (x0 - dq[0]) * 8.0f; x1 = (x1 - dq[1]) * 8.0f; \
                      w2 = __builtin_amdgcn_cvt_scalef32_pk_fp4_f32(w2, x0, x1, 1.0f, k); }
                    HDIG(0) HDIG(1) HDIG(2) HDIG(3)
#undef HDIG
                    hb[jj][0][i] = w0; hb[jj][1][i] = w1; hb[jj][2][i] = w2; }
            const int dsel = ((lane >> 4) == ((lane & 15) >> 2)) ? (lane & 3) : 4;
#define U_LOAD(R, MB) { _Pragma("unroll") for (int q = 0; q < 8; ++q) { const int e_ = __builtin_amdgcn_readfirstlane(eidx[8 * (MB) + q]); const u32x4* p = (const u32x4*)(UB + (size_t)e_ * 2048) + lane; R[q][0] = p[0]; R[q][1] = p[64]; } }
#define HB8(d) (i32x8){(int)hb[jj][d].x, (int)hb[jj][d].y, (int)hb[jj][d].z, (int)hb[jj][d].w, 0, 0, 0, 0}
#define U_COMP(R, MB) { float a[8]; const float sq = su[8 * (MB) + (lane & 7)]; \
                _Pragma("unroll") for (int q = 0; q < 8; ++q) { f32x4 c = (f32x4){0.f, 0.f, 0.f, 0.f}; \
                    _Pragma("unroll") for (int jj = 0; jj < 2; ++jj) { const i32x8 av = (i32x8){(int)R[q][jj].x, (int)R[q][jj].y, (int)R[q][jj].z, (int)R[q][jj].w, 0, 0, 0, 0}; \
                        c = __builtin_amdgcn_mfma_scale_f32_16x16x128_f8f6f4(av, HB8(0), c, 4, 4, 0, 0x7f7f7f7f, 0, 0x7f7f7f7f);     \
                        c = __builtin_amdgcn_mfma_scale_f32_16x16x128_f8f6f4(av, HB8(1), c, 4, 4, 0, 0x7f7f7f7f, 0, 0x7d7d7d7d);     \
                        c = __builtin_amdgcn_mfma_scale_f32_16x16x128_f8f6f4(av, HB8(2), c, 4, 4, 0, 0x7f7f7f7f, 0, 0x7a7a7a7a); }   \
                    float d = (dsel == 0) ? c[0] : 0.f; d = (dsel == 1) ? c[1] : d; d = (dsel == 2) ? c[2] : d; d = (dsel == 3) ? c[3] : d; \
                    a[q] = wave_sum_u(d); } \
                float z = a[0]; \
                _Pragma("unroll") for (int q = 1; q < 8; ++q) z = (lane == q) ? a[q] : z; \
                z *= sdn * sq; \
                const float act = 0.5f * z * (1.0f + erff(z * 0.70710678118654752f)); \
                if (lane < 8) coef[8 * (MB) + lane] *= act; }
            u32x4 ra[8][2], rb[8][2];
            U_LOAD(ra, 0)
#pragma unroll 1
            for (int mb = 0; mb < PEER_M / 8 - 2; mb += 2) {
                U_LOAD(rb, mb + 1)
                __builtin_amdgcn_sched_barrier(0);
                U_COMP(ra, mb)
                __builtin_amdgcn_sched_barrier(0);
                U_LOAD(ra, mb + 2)
                __builtin_amdgcn_sched_barrier(0);
                U_COMP(rb, mb + 1)
                __builtin_amdgcn_sched_barrier(0);
            }
            U_LOAD(rb, PEER_M / 8 - 1)
            __builtin_amdgcn_sched_barrier(0);
            U_COMP(ra, PEER_M / 8 - 2)
            __builtin_amdgcn_sched_barrier(0);
            U_COMP(rb, PEER_M / 8 - 1)
#undef U_LOAD
#undef U_COMP
#undef HB8
        }
        CFENCE(); LDS_WAIT();
        f32x2 y[32];
#pragma unroll
        for (int i = 0; i < 32; ++i) y[i] = (f32x2){0.f, 0.f};
#pragma unroll 1
        for (int mb = 0; mb < PEER_M / 8; ++mb) {
            u32x4 r[8][2]; float c[8];
#pragma unroll
            for (int q = 0; q < 8; ++q) { const int e = __builtin_amdgcn_readfirstlane(eidx[8 * mb + q]); c[q] = coef[8 * mb + q];
                const u32x4* p = (const u32x4*)(VT + (size_t)e * 2048) + lane; r[q][0] = p[0]; r[q][1] = p[64]; }
#pragma unroll
            for (int q = 0; q < 8; ++q)
#pragma unroll
                for (int jj = 0; jj < 2; ++jj)
#pragma unroll
                    for (int i = 0; i < 4; ++i) { const unsigned w = r[q][jj][i];
                        y[(4 * jj + i) * 4 + 0] += __builtin_amdgcn_cvt_scalef32_pk_f32_fp4(w, 1.0f, 0) * c[q]; y[(4 * jj + i) * 4 + 1] += __builtin_amdgcn_cvt_scalef32_pk_f32_fp4(w, 1.0f, 1) * c[q];
                        y[(4 * jj + i) * 4 + 2] += __builtin_amdgcn_cvt_scalef32_pk_f32_fp4(w, 1.0f, 2) * c[q]; y[(4 * jj + i) * 4 + 3] += __builtin_amdgcn_cvt_scalef32_pk_f32_fp4(w, 1.0f, 3) * c[q]; }
        }
        { const bf16* hr = H1B + (size_t)tok * 4096; const bf16* pr = PLE + (size_t)tok * 4096; float s = 0.f;
#pragma unroll
          for (int jj = 0; jj < 2; ++jj) {
#pragma unroll
              for (int i = 0; i < 4; ++i) { const int off = (jj * 64 + lane) * 32 + 8 * i; const int yb = (4 * jj + i) * 4;
                  const u32x4 hw = *(const u32x4*)(hr + off), pw = *(const u32x4*)(pr + off); const f32x4 h0 = (f32x4){bflo(hw.x), bfhi(hw.x), bflo(hw.y), bfhi(hw.y)}, h1 = (f32x4){bflo(hw.z), bfhi(hw.z), bflo(hw.w), bfhi(hw.w)}, p0 = (f32x4){bflo(pw.x), bfhi(pw.x), bflo(pw.y), bfhi(pw.y)}, p1 = (f32x4){bflo(pw.z), bfhi(pw.z), bflo(pw.w), bfhi(pw.w)};
                  y[yb][0] += h0[0] * ALPHA + p0[0]; y[yb][1] += h0[1] * ALPHA + p0[1]; y[yb + 1][0] += h0[2] * ALPHA + p0[2]; y[yb + 1][1] += h0[3] * ALPHA + p0[3];
                  y[yb + 2][0] += h1[0] * ALPHA + p1[0]; y[yb + 2][1] += h1[1] * ALPHA + p1[1]; y[yb + 3][0] += h1[2] * ALPHA + p1[2]; y[yb + 3][1] += h1[3] * ALPHA + p1[3];
                  s += (y[yb][0] + y[yb][1]) + (y[yb + 1][0] + y[yb + 1][1]) + (y[yb + 2][0] + y[yb + 2][1]) + (y[yb + 3][0] + y[yb + 3][1]); }
              CFENCE(); }
          const float mean = wave_sum(s) * (1.0f / 4096.0f); float q = 0.f;
#pragma unroll
          for (int i = 0; i < 32; ++i) { y[i] = y[i] - mean; q += y[i][0] * y[i][0] + y[i][1] * y[i][1]; }
          const float rstd = 1.0f / sqrtf(wave_sum(q) * (1.0f / 4096.0f) + LN_EPS);
          float* orow = OUTP() + (size_t)tok * 4096;
#pragma unroll
          for (int jj = 0; jj < 2; ++jj) {
#pragma unroll
              for (int i = 0; i < 4; ++i) { const int off = (jj * 64 + lane) * 32 + 8 * i; const int yb = (4 * jj + i) * 4;
                  const f32x4 g0 = *(const f32x4*)(g2 + off), g1 = *(const f32x4*)(g2 + off + 4), c0 = *(const f32x4*)(b2 + off), c1 = *(const f32x4*)(b2 + off + 4);
                  *(f32x4*)(orow + off) = (f32x4){y[yb][0] * rstd * g0[0] + c0[0], y[yb][1] * rstd * g0[1] + c0[1], y[yb + 1][0] * rstd * g0[2] + c0[2], y[yb + 1][1] * rstd * g0[3] + c0[3]};
                  *(f32x4*)(orow + off + 4) = (f32x4){y[yb + 2][0] * rstd * g1[0] + c1[0], y[yb + 2][1] * rstd * g1[1] + c1[1], y[yb + 3][0] * rstd * g1[2] + c1[2], y[yb + 3][1] * rstd * g1[3] + c1[3]}; }
              CFENCE(); } }
        CFENCE(); LDS_WAIT();
    }
}
#ifndef DBG_OUT
#define DBG_OUT 0
#endif
__device__ __forceinline__ void dbg_copy(Frame& F, int which) {
    const size_t gt = (size_t)F.bid * NTHREADS + F.tid, gs = (size_t)F.G * NTHREADS, n = (size_t)NTOK * 4096;
    for (size_t i = gt; i < n; i += gs) { const size_t t = i >> 12; const int c = (int)(i & 4095); float v = 0.f;
        if (which == 1) v = WSP(float, WS_F)[i];
        else if (which == 2) v = WSP(float, WS_E)[i];
        else if (which == 3) v = bf2f(WSP(bf16, WS_XB)[i]);
        else if (which == 4) v = (c < 2048) ? bf2f(WSP(bf16, WS_QA)[t * 2048 + c]) : bf2f(WSP(bf16, WS_OB)[t * 2048 + c - 2048]);
        else if (which == 5) v = bf2f(WSP(bf16, WS_OLAT)[i]);
        else if (which == 6) v = bf2f(WSP(bf16, WS_QLAT)[i]);
        else if (which == 7) v = (c < 2048) ? bf2f(WSP(bf16, WS_QIDX)[t * 2048 + c]) : bf2f(WSP(bf16, WS_KB)[t * 2048 + c - 2048]);
        else if (which == 8) v = bf2f(WSP(bf16, WS_F)[t * 8192 + c]);
        else if (which == 9) v = (c < 2048) ? WSP(float, WS_E)[t * 2048 + c] : bf2f(WSP(bf16, WS_PL)[t * 4096 + c]);
        OUTP()[i] = v; }
}

constexpr int N_PHASES = 10;
__global__ void __launch_bounds__(NTHREADS, 2) mk_fwd(Args args) {
    extern __shared__ __attribute__((aligned(16))) unsigned char lds_raw[];
    Frame F;
    F.lds = (LAS unsigned char*)lds_raw; F.tid = threadIdx.x; F.lane = F.tid & 63; F.wave = __builtin_amdgcn_readfirstlane(F.tid >> 6); F.G = gridDim.x; F.bid = blockIdx.x;
    unsigned* ctl = (unsigned*)(WSB() + WS_CTL);
    if (F.tid < 64) ((LAS unsigned*)(F.lds + LDSCTL_OFF))[F.tid] = 0u;
    __syncthreads();
    XcdBarrier bar; bar.bar = ctl + CW_BAR; bar.x = 0; bar.st = nullptr; bar.wave = F.wave;
    if (MK_N_LAUNCHES == 1) bar = xcd_barrier_post(ctl + CW_BAR, (volatile LAS unsigned*)(F.lds + LDSCTL_OFF));
    const int lo = args.ph_lo, hi = args.ph_hi;
#ifndef PROBE_DUP
#define PROBE_DUP -1
#endif
#define IN(k) (lo <= (k) && (k) < hi)
#define REP(k) for (int rep_ = 0; rep_ < ((k) == PROBE_DUP ? 2 : 1); ++rep_)
#define SEAM(k) do { if (IN(k) && IN((k) + 1)) xcd_barrier(bar); } while (0)
    LAS unsigned char* const ldsg = F.lds;
#define RELANE() do { const int l_ = fresh_lane(); F.lane = l_; F.tid = F.wave * 64 + l_; } while (0)

    if (IN(0)) { RELANE(); REP(0) p0_prologue(F); SEAM(0); }
    if (IN(1)) {
        { pg8::Gemm g{WSP(bf16, WS_X8), WSP(bf16, WS_W18), NTOK, N1M, D_MODEL / 2, D_MODEL / 2}; pg8::StaticOrder S; S.init(NTOK, N1M, F.G, F.bid);
          pg8::Epi1 E{WSP(bf16, WS_QA), WSP(bf16, WS_QIDX), WSP(bf16, WS_QB), WSP(bf16, WS_KB), WSP(bf16, WS_VB), WSP(bf16, WS_F), INP(I_BGATE), 0};
          pg8::gemm_phase<pg8::Epi1, pg8::StaticOrder, true, true, true>(ldsg, g, S, E, F.wave); }
        if (F.bid < 256) {
          const int ks = F.bid & 3, sp = (F.bid >> 2) & 1, spm = F.bid >> 3;
          pg8::Gemm g{WSP(bf16, WS_XB) + ks * 1024, WSP(bf16, WS_E) + (size_t)N1M * D_MODEL + ks * 1024, NTOK, 512, 1024, D_MODEL}; pg8::OneUnit S{spm, sp};
          pg8::EpiPart E{WSP(float, WS_PART) + (size_t)(ks * 2 + sp) * NTOK * 256};
          pg8::gemm_phase<pg8::EpiPart, pg8::OneUnit, true, true>(ldsg, g, S, E, F.wave); }
        { pg8::Gemm g{WSP(bf16, WS_PB), WSP(bf16, WS_WPLT), NTOK, D_MODEL, D_PLE, D_PLE}; pg8::StaticOrder S; S.init(NTOK, D_MODEL, F.G, F.bid);
          pg8::EpiBf16P E{WSP(bf16, WS_PL), D_MODEL};
          pg8::gemm_phase<pg8::EpiBf16P, pg8::StaticOrder, true, true>(ldsg, g, S, E, F.wave); }
        SEAM(1);
    }
    if (IN(2)) { RELANE(); REP(2) p2_small(F); SEAM(2); }
    if (IN(3)) { REP(3) { if (!(args.pad & 2)) p3_fox(F); __syncthreads(); if (!(args.pad & 1)) p3_dsa(F, args.pad); __syncthreads(); } SEAM(3); }
    if (IN(4)) { RELANE(); REP(4) p4_oa(F); SEAM(4); }
    if (IN(5)) {
        { pg8::Gemm g{WSP(bf16, WS_QA), WSP(bf16, WS_WBAT), NTOK, D_MODEL, 1024, 1024}; pg8::StaticOrder S; S.init(NTOK, D_MODEL, F.G, F.bid);
          pg8::Epi2a E{WSP(bf16, WS_F), WSP(bf16, WS_E), 1.0f / (Q8_O * Q8_WB)};
          pg8::gemm_phase<pg8::Epi2a, pg8::StaticOrder, true, true, true>(ldsg, g, S, E, F.wave); }
        { pg8::Gemm g{WSP(bf16, WS_OB), WSP(bf16, WS_WBBT), NTOK, D_MODEL, 1024, 1024}; pg8::StaticOrder S; S.init(NTOK, D_MODEL, F.G, F.bid);
          pg8::Epi2b E{WSP(bf16, WS_F), WSP(bf16, WS_E), WSP(bf16, WS_XB), 1.0f / (Q8_O * Q8_WB)};
          pg8::gemm_phase<pg8::Epi2b, pg8::StaticOrder, true, true, true>(ldsg, g, S, E, F.wave); }
        SEAM(5);
    }
    if (IN(6)) {
        pg8::Gemm g{WSP(bf16, WS_XB), WSP(bf16, WS_WOT), NTOK, D_MODEL, D_MODEL / 2, D_MODEL / 2}; pg8::StaticOrder S; S.init(NTOK, D_MODEL, F.G, F.bid);
        pg8::Epi3 E{INP(I_X), WSP(bf16, WS_E), ALPHA, 1.0f / (Q8_MG * Q8_WO)};
        pg8::gemm_phase<pg8::Epi3, pg8::StaticOrder, true, true, true>(ldsg, g, S, E, F.wave);
        SEAM(6);
    }
    if (IN(7)) { RELANE(); REP(7) p7_ln1(F); SEAM(7); }
    if (IN(8)) {
        { pg8::Gemm g{WSP(bf16, WS_X8), WSP(bf16, WS_W48), NTOK, N4, D_MODEL / 2, D_MODEL / 2}; pg8::StaticOrder S; S.init(NTOK, N4, F.G, F.bid);
          pg8::Epi4 E{WSP(float, WS_E), WSP(bf16, WS_PL), INP(I_BPG), 0};
          pg8::gemm_phase<pg8::Epi4, pg8::StaticOrder, true, true, true>(ldsg, g, S, E, F.wave); }
        SEAM(8);
    }
    if (IN(9)) { if (DBG_OUT) dbg_copy(F, DBG_OUT); else { RELANE(); REP(9) p9_peer(F); } }
#undef IN
#undef SEAM
}

extern "C" void kernel_launch(void* const* d_in, const int* in_sizes, int n_in, void* d_out, int out_size, void* d_ws, size_t ws_size, hipStream_t stream) {
    static int grid = 0;
    if (grid == 0) {
        if (n_in != 23 || out_size != NTOK * D_MODEL || ws_size < WS_END) { fprintf(stderr, "kernel_launch: unexpected problem (n_in %d, out %d, ws %zu); nothing launched\n", n_in, out_size, ws_size); grid = -1; return; }
        int dev = 0, cus = 0, per_cu = 0;
        if (hipGetDevice(&dev) != hipSuccess || hipDeviceGetAttribute(&cus, hipDeviceAttributeMultiprocessorCount, dev) != hipSuccess) { grid = -1; return; }
        if (hipFuncSetAttribute((const void*)mk_fwd, hipFuncAttributeMaxDynamicSharedMemorySize, LDS_BYTES) != hipSuccess) { fprintf(stderr, "kernel_launch: hipFuncSetAttribute failed\n"); grid = -1; return; }
        if (hipOccupancyMaxActiveBlocksPerMultiprocessor(&per_cu, (const void*)mk_fwd, NTHREADS, LDS_BYTES) != hipSuccess || per_cu < 1) { fprintf(stderr, "kernel_launch: occupancy query says %d\n", per_cu); (void)hipGetLastError(); grid = -1; return; }
        grid = cus;
    }
    if (grid < 0) return;
    if (hipMemsetAsync((char*)d_ws + WS_CTL, 0, CTL_ZERO_BYTES, stream) != hipSuccess) return;
    Args a{};
    for (int i = 0; i < 23; ++i) a.in[i] = (const float*)d_in[i];
    a.out = (float*)d_out; a.ws = (unsigned char*)d_ws;
    for (int li = 0; li < MK_N_LAUNCHES; ++li) {
#if DBG_OUT
        { const int lastp[10] = {9, 7, 6, 5, 4, 3, 2, 1, 1, 8}; if (MK_N_LAUNCHES > 1 && li > lastp[DBG_OUT] && li != 9) continue; }
#endif
        a.ph_lo = (MK_N_LAUNCHES == 1) ? 0 : li; a.ph_hi = (MK_N_LAUNCHES == 1) ? N_PHASES : li + 1; a.li = li; a.pad = 0;
#ifdef HOST_DUP
        if (MK_N_LAUNCHES > 1 && li == HOST_DUP) {
#ifdef HOST_DUP_PAD
            a.pad = HOST_DUP_PAD;
#endif
            hipLaunchKernelGGL(mk_fwd, dim3(grid), dim3(NTHREADS), LDS_BYTES, stream, a); a.pad = 0; }
#endif
        hipLaunchKernelGGL(mk_fwd, dim3(grid), dim3(NTHREADS), LDS_BYTES, stream, a);
    }
}
```

```cpp
#include <hip/hip_runtime.h>
#include <cstdio>
#include <cstdint>

#ifndef MK_N_LAUNCHES
#define MK_N_LAUNCHES 1
#endif

#define GAS __attribute__((address_space(1)))
#define LAS __attribute__((address_space(3)))
typedef unsigned short bf16;
typedef float f32x4 __attribute__((ext_vector_type(4)));
typedef float f32x2 __attribute__((ext_vector_type(2)));
typedef unsigned u32x4 __attribute__((ext_vector_type(4)));
typedef unsigned u32x2 __attribute__((ext_vector_type(2)));
typedef short bf16x8 __attribute__((ext_vector_type(8)));

constexpr int D_MODEL = 4096, BATCH = 4, SEQ = 2048, NTOK = BATCH * SEQ;
constexpr int A_HEADS = 16, A_HD = 128, A_LAT = 256, IDX_HEADS = 32, IDX_DIM = 64, TOPK = 256, CHUNK = 64;
constexpr int B_HEADS = 16, B_HD = 128;
constexpr int PEER_HEADS = 8, PEER_KEYS = 128, PEER_QDIM = 256, PEER_TOPK = 16, N_EXPERTS = PEER_KEYS * PEER_KEYS, PEER_M = PEER_HEADS * PEER_TOPK;
constexpr int D_PLE = 256;
constexpr int IN_WIDTH = 10608;
constexpr int N1 = 18944;
constexpr int N1M = 18432;
constexpr int N4 = 6144;
constexpr float LN_EPS = 1e-5f;
constexpr float ALPHA = 1.18920711500272f;

__device__ __forceinline__ unsigned f2bf(float f) { unsigned u = __builtin_bit_cast(unsigned, f); return (u + 0x7fffu + ((u >> 16) & 1u)) >> 16; }
typedef __bf16 bf16x2_n __attribute__((ext_vector_type(2)));
__device__ __forceinline__ unsigned pk2(float lo, float hi) { const bf16x2_n b = __builtin_convertvector((f32x2){lo, hi}, bf16x2_n); return __builtin_bit_cast(unsigned, b); }
__device__ __forceinline__ float bflo(unsigned w) { return __builtin_bit_cast(float, w << 16); }
__device__ __forceinline__ float bfhi(unsigned w) { return __builtin_bit_cast(float, w & 0xffff0000u); }
__device__ __forceinline__ float bf2f(bf16 b) { return __builtin_bit_cast(float, (unsigned)b << 16); }
__device__ __forceinline__ float sigmoidf_(float x) { return __builtin_amdgcn_rcpf(1.0f + __expf(-x)); }
__device__ __forceinline__ float wave_sum(float v) {
#pragma unroll
    for (int o = 1; o < 64; o <<= 1) v += __shfl_xor(v, o);
    return v;
}
__device__ __forceinline__ float wave_max(float v) {
#pragma unroll
    for (int o = 1; o < 64; o <<= 1) v = fmaxf(v, __shfl_xor(v, o));
    return v;
}
__device__ __forceinline__ int fresh_lane() { int l; asm volatile("v_mbcnt_lo_u32_b32 %0, -1, 0\n\tv_mbcnt_hi_u32_b32 %0, -1, %0" : "=v"(l)); return l; }
constexpr float Q8_ACT = 30.0f, Q8_W = 1920.0f;
constexpr float Q8_O = 21.0f, Q8_WB = 1368.0f;
constexpr float Q8_MG = 32.0f, Q8_WO = 3250.0f;
__device__ __forceinline__ unsigned pk_q8x4(float a, float b, float c, float d, float sc) {
    const int i0 = __float2int_rn(fminf(fmaxf(a * sc, -127.f), 127.f)), i1 = __float2int_rn(fminf(fmaxf(b * sc, -127.f), 127.f));
    const int i2 = __float2int_rn(fminf(fmaxf(c * sc, -127.f), 127.f)), i3 = __float2int_rn(fminf(fmaxf(d * sc, -127.f), 127.f));
    return (unsigned)(i0 & 255) | ((unsigned)(i1 & 255) << 8) | ((unsigned)(i2 & 255) << 16) | ((unsigned)i3 << 24); }
#define LDS_WAIT() asm volatile("s_waitcnt lgkmcnt(0)" ::: "memory")
#define VM_WAIT() asm volatile("s_waitcnt vmcnt(0)" ::: "memory")
#define CFENCE() asm volatile("" ::: "memory")
namespace pg8 {
#define PG8_LAS __attribute__((address_space(3)))
typedef unsigned short bf16_t;
typedef short bf16x8 __attribute__((ext_vector_type(8)));
typedef float f32x4 __attribute__((ext_vector_type(4)));
typedef unsigned u32x4 __attribute__((ext_vector_type(4)));
constexpr int BM = 256, BK = 64, HALF = 128, HTB = HALF * BK * 2  , STAGE_BYTES = 8 * HTB, NXCD = 8, WGM = 8;

__host__ __device__ __forceinline__ int lds_byte(int r, int c) { const int st = (r >> 4) * 2 + (c >> 5), rr = r & 15, cc = c & 31, ob = rr * 64 + cc * 2; return st * 1024 + (ob ^ (((ob >> 9) & 1) << 5)); }
__host__ __device__ __forceinline__ void stage_rc(int b, int& R, int& C) { const int st = b / 1024, sb = b % 1024, swz = sb ^ (((sb >> 9) & 1) << 5); R = (st >> 1) * 16 + swz / 64; C = (st & 1) * 32 + (swz % 64) / 2; }
__host__ __device__ __forceinline__ int perm32(int rho) { const int n = rho >> 4, i = rho & 15; return 8 * (i >> 2) + 4 * n + (i & 3); }

struct Unit { int pm, pn; };
struct Gemm { const bf16_t* A; const bf16_t* Bt; int M, N, K, ld; };

struct StaticOrder {
    int nM, nN, nwg, G, c;
    __host__ __device__ void init(int M, int N, int G_, int c_) { nM = M / BM; nN = N / BM; nwg = nM * nN; G = G_; c = c_; }
    __host__ __device__ bool next(int i, Unit& u) const {
        const long L = (long)i * G + c; if (L >= nwg) return false;
        int wgid = (int)L; { const int q = nwg / NXCD, r = nwg % NXCD, xcd = wgid % NXCD, off = wgid / NXCD; wgid = (xcd < r ? xcd * (q + 1) : r * (q + 1) + (xcd - r) * q) + off; }
        const int nig = WGM * nN, gid = wgid / nig, fm = gid * WGM, gsz = (nM - fm) < WGM ? (nM - fm) : WGM;
        u.pm = fm + ((wgid % nig) % gsz); u.pn = (wgid % nig) / gsz; return true;
    }
    __device__ __forceinline__ void a_ready(const Unit&) const {}
    __device__ __forceinline__ void done(const Unit&) const {}
};
typedef __bf16 bf16x2_nat __attribute__((ext_vector_type(2)));
__device__ __forceinline__ unsigned cvt_pk_bf16(float lo, float hi) { typedef float f2_ __attribute__((ext_vector_type(2))); const bf16x2_nat b = __builtin_convertvector((f2_){lo, hi}, bf16x2_nat); return __builtin_bit_cast(unsigned, b); }
typedef unsigned u32x2 __attribute__((ext_vector_type(2)));
__device__ __forceinline__ unsigned q8x4(float a, float b, float c, float d, float sc) {
    const int i0 = __float2int_rn(fminf(fmaxf(a * sc, -127.f), 127.f)), i1 = __float2int_rn(fminf(fmaxf(b * sc, -127.f), 127.f));
    const int i2 = __float2int_rn(fminf(fmaxf(c * sc, -127.f), 127.f)), i3 = __float2int_rn(fminf(fmaxf(d * sc, -127.f), 127.f));
    return (unsigned)(i0 & 255) | ((unsigned)(i1 & 255) << 8) | ((unsigned)(i2 & 255) << 16) | ((unsigned)i3 << 24); }
__device__ __forceinline__ float sigm(float x) { return __builtin_amdgcn_rcpf(1.0f + __expf(-x)); }
__device__ __forceinline__ float blo(unsigned w) { return __builtin_bit_cast(float, w << 16); }
__device__ __forceinline__ float bhi(unsigned w) { return __builtin_bit_cast(float, w & 0xffff0000u); }

struct Epi1 {
    static constexpr bool PERM = true, AFTER_DRAIN = false;
    bf16_t *QA, *QIDX, *QB, *KB, *VB, *G; const float* b_gate; int pn_off;
    __device__ __forceinline__ void operator()(const f32x4 (&acc)[2][2][4][2], const Unit& u, int wr, int wc, int fr, int fq) const {
        const int pn = u.pn + pn_off, row0 = u.pm * BM + wr * 64 + fr, cl = wc * 32 + 8 * fq;
        if (pn >= 40) {
            const int gc = (pn - 40) * 256 + cl;
            f32x4 bv[2][2];
#pragma unroll
            for (int bj = 0; bj < 2; ++bj)
#pragma unroll
                for (int n = 0; n < 2; ++n) bv[bj][n] = *(const f32x4*)(b_gate + gc + bj * HALF + 4 * n);
#pragma unroll
            for (int ai = 0; ai < 2; ++ai)
#pragma unroll
                for (int m = 0; m < 4; ++m) { bf16_t* rowp = G + (size_t)(row0 + ai * HALF + m * 16) * 8192 + gc;
#pragma unroll
                    for (int bj = 0; bj < 2; ++bj) { const f32x4 v0 = acc[ai][bj][m][0] * (1.0f / 57600.0f) + bv[bj][0], v1 = acc[ai][bj][m][1] * (1.0f / 57600.0f) + bv[bj][1];
                        u32x4 w; w.x = cvt_pk_bf16(sigm(v0[0]), sigm(v0[1])); w.y = cvt_pk_bf16(sigm(v0[2]), sigm(v0[3])); w.z = cvt_pk_bf16(sigm(v1[0]), sigm(v1[1])); w.w = cvt_pk_bf16(sigm(v1[2]), sigm(v1[3]));
                        *(u32x4*)(rowp + bj * HALF) = w; } }
        } else {
            bf16_t* dst; int c0;
            if (pn < 8) { dst = QA; c0 = pn; } else if (pn < 16) { dst = QIDX; c0 = pn - 8; } else if (pn < 24) { dst = QB; c0 = pn - 16; } else if (pn < 32) { dst = KB; c0 = pn - 24; } else { dst = VB; c0 = pn - 32; }
            c0 = c0 * 256 + cl;
#pragma unroll
            for (int ai = 0; ai < 2; ++ai)
#pragma unroll
                for (int m = 0; m < 4; ++m) { bf16_t* rowp = dst + (size_t)(row0 + ai * HALF + m * 16) * 2048 + c0;
#pragma unroll
                    for (int bj = 0; bj < 2; ++bj) { const f32x4 v0 = acc[ai][bj][m][0] * (1.0f / 57600.0f), v1 = acc[ai][bj][m][1] * (1.0f / 57600.0f);
                        u32x4 w; w.x = cvt_pk_bf16(v0[0], v0[1]); w.y = cvt_pk_bf16(v0[2], v0[3]); w.z = cvt_pk_bf16(v1[0], v1[1]); w.w = cvt_pk_bf16(v1[2], v1[3]);
                        *(u32x4*)(rowp + bj * HALF) = w; } }
        }
    }
};
struct OneUnit {
    int pm, pn;
    __device__ bool next(int i, Unit& u) const { if (i) return false; u.pm = pm; u.pn = pn; return true; }
    __device__ __forceinline__ void a_ready(const Unit&) const {}
    __device__ __forceinline__ void done(const Unit&) const {}
};
struct EpiPart {
    static constexpr bool PERM = true, AFTER_DRAIN = false;
    float* P;
    __device__ __forceinline__ void operator()(const f32x4 (&acc)[2][2][4][2], const Unit& u, int wr, int wc, int fr, int fq) const {
        const int row0 = u.pm * BM + wr * 64 + fr, cl = wc * 32 + 8 * fq;
#pragma unroll
        for (int ai = 0; ai < 2; ++ai)
#pragma unroll
            for (int m = 0; m < 4; ++m) { float* rowp = P + (size_t)(row0 + ai * HALF + m * 16) * 256 + cl;
#pragma unroll
                for (int bj = 0; bj < 2; ++bj) { *(f32x4*)(rowp + bj * HALF) = acc[ai][bj][m][0]; *(f32x4*)(rowp + bj * HALF + 4) = acc[ai][bj][m][1]; } }
    }
};
struct EpiBf16P {
    static constexpr bool PERM = true, AFTER_DRAIN = false;
    bf16_t* C; int ldc;
    __device__ __forceinline__ void operator()(const f32x4 (&acc)[2][2][4][2], const Unit& u, int wr, int wc, int fr, int fq) const {
        const int row0 = u.pm * BM + wr * 64 + fr, col0 = u.pn * BM + wc * 32 + 8 * fq;
#pragma unroll
        for (int ai = 0; ai < 2; ++ai)
#pragma unroll
            for (int m = 0; m < 4; ++m) { bf16_t* rowp = C + (size_t)(row0 + ai * HALF + m * 16) * ldc + col0;
#pragma unroll
                for (int bj = 0; bj < 2; ++bj) { const f32x4 v0 = acc[ai][bj][m][0], v1 = acc[ai][bj][m][1];
                    u32x4 w; w.x = cvt_pk_bf16(v0[0], v0[1]); w.y = cvt_pk_bf16(v0[2], v0[3]); w.z = cvt_pk_bf16(v1[0], v1[1]); w.w = cvt_pk_bf16(v1[2], v1[3]);
                    *(u32x4*)(rowp + bj * HALF) = w; }
                asm volatile("" ::: "memory"); }
    }
};
struct EpiF32P {
    static constexpr bool PERM = true, AFTER_DRAIN = false;
    float* C; int ldc;
    __device__ __forceinline__ void operator()(const f32x4 (&acc)[2][2][4][2], const Unit& u, int wr, int wc, int fr, int fq) const {
        const int row0 = u.pm * BM + wr * 64 + fr, col0 = u.pn * BM + wc * 32 + 8 * fq;
#pragma unroll
        for (int ai = 0; ai < 2; ++ai)
#pragma unroll
            for (int m = 0; m < 4; ++m) { float* rowp = C + (size_t)(row0 + ai * HALF + m * 16) * ldc + col0;
#pragma unroll
                for (int bj = 0; bj < 2; ++bj) { *(f32x4*)(rowp + bj * HALF) = acc[ai][bj][m][0]; *(f32x4*)(rowp + bj * HALF + 4) = acc[ai][bj][m][1]; } }
    }
};
struct Epi2a {
    static constexpr bool PERM = true, AFTER_DRAIN = false;
    const bf16_t* G; bf16_t* MGT; float sacc;
    __device__ __forceinline__ void operator()(const f32x4 (&acc)[2][2][4][2], const Unit& u, int wr, int wc, int fr, int fq) const {
        const int row0 = u.pm * BM + wr * 64 + fr, col0 = u.pn * BM + wc * 32 + 8 * fq;
#pragma unroll
        for (int ai = 0; ai < 2; ++ai)
#pragma unroll
            for (int m = 0; m < 4; ++m) { const size_t r = (size_t)(row0 + ai * HALF + m * 16);
#pragma unroll
                for (int bj = 0; bj < 2; ++bj) { const u32x4 g = *(const u32x4*)(G + r * 8192 + col0 + bj * HALF); const f32x4 v0 = acc[ai][bj][m][0] * sacc, v1 = acc[ai][bj][m][1] * sacc;
                    u32x4 w; w.x = cvt_pk_bf16(v0[0] * blo(g.x), v0[1] * bhi(g.x)); w.y = cvt_pk_bf16(v0[2] * blo(g.y), v0[3] * bhi(g.y)); w.z = cvt_pk_bf16(v1[0] * blo(g.z), v1[1] * bhi(g.z)); w.w = cvt_pk_bf16(v1[2] * blo(g.w), v1[3] * bhi(g.w));
                    *(u32x4*)(MGT + r * 4096 + col0 + bj * HALF) = w; }
                asm volatile("" ::: "memory"); }
    }
};
struct Epi2b {
    static constexpr bool PERM = true, AFTER_DRAIN = false;
    const bf16_t* G; const bf16_t* MGT; bf16_t* MG; float sacc;
    __device__ __forceinline__ void operator()(const f32x4 (&acc)[2][2][4][2], const Unit& u, int wr, int wc, int fr, int fq) const {
        const int row0 = u.pm * BM + wr * 64 + fr, col0 = u.pn * BM + wc * 32 + 8 * fq;
#pragma unroll
        for (int ai = 0; ai < 2; ++ai)
#pragma unroll
            for (int m = 0; m < 4; ++m) { const size_t r = (size_t)(row0 + ai * HALF + m * 16);
#pragma unroll
                for (int bj = 0; bj < 2; ++bj) { const u32x4 g = *(const u32x4*)(G + r * 8192 + 4096 + col0 + bj * HALF); const f32x4 v0 = acc[ai][bj][m][0] * sacc, v1 = acc[ai][bj][m][1] * sacc;
                    const u32x4 t = *(const u32x4*)(MGT + r * 4096 + col0 + bj * HALF);
                    u32x2 w; w.x = q8x4(blo(t.x) + v0[0] * blo(g.x), bhi(t.x) + v0[1] * bhi(g.x), blo(t.y) + v0[2] * blo(g.y), bhi(t.y) + v0[3] * bhi(g.y), 32.0f);
                    w.y = q8x4(blo(t.z) + v1[0] * blo(g.z), bhi(t.z) + v1[1] * bhi(g.z), blo(t.w) + v1[2] * blo(g.w), bhi(t.w) + v1[3] * bhi(g.w), 32.0f);
                    *(u32x2*)((unsigned char*)MG + r * 4096 + col0 + bj * HALF) = w; }
                asm volatile("" ::: "memory"); }
    }
};
struct Epi3 {
    static constexpr bool PERM = true, AFTER_DRAIN = false;
    const float* X; bf16_t* Y; float alpha, sacc;
    __device__ __forceinline__ void operator()(const f32x4 (&acc)[2][2][4][2], const Unit& u, int wr, int wc, int fr, int fq) const {
        const int row0 = u.pm * BM + wr * 64 + fr, col0 = u.pn * BM + wc * 32 + 8 * fq;
#pragma unroll
        for (int ai = 0; ai < 2; ++ai)
#pragma unroll
            for (int m = 0; m < 4; ++m) { const size_t off = (size_t)(row0 + ai * HALF + m * 16) * 4096 + col0;
#pragma unroll
                for (int bj = 0; bj < 2; ++bj) { const f32x4 x0 = *(const f32x4*)(X + off + bj * HALF), x1 = *(const f32x4*)(X + off + bj * HALF + 4);
                    const f32x4 y0 = x0 * alpha + acc[ai][bj][m][0] * sacc, y1 = x1 * alpha + acc[ai][bj][m][1] * sacc;
                    u32x4 w; w.x = cvt_pk_bf16(y0[0], y0[1]); w.y = cvt_pk_bf16(y0[2], y0[3]); w.z = cvt_pk_bf16(y1[0], y1[1]); w.w = cvt_pk_bf16(y1[2], y1[3]);
                    *(u32x4*)(Y + off + bj * HALF) = w; }
                asm volatile("" ::: "memory"); }
    }
};
struct Epi4 {
    static constexpr bool PERM = true, AFTER_DRAIN = false;
    float* PQ; bf16_t* PL; const float* b_pg; int pn_off;
    __device__ __forceinline__ void operator()(const f32x4 (&acc)[2][2][4][2], const Unit& u, int wr, int wc, int fr, int fq) const {
        const int row0 = u.pm * BM + wr * 64 + fr, cl = wc * 32 + 8 * fq, pn = u.pn + pn_off;
        if (pn < 8) {
#pragma unroll
            for (int ai = 0; ai < 2; ++ai)
#pragma unroll
                for (int m = 0; m < 4; ++m) { float* rowp = PQ + (size_t)(row0 + ai * HALF + m * 16) * 2048 + pn * 256 + cl;
#pragma unroll
                    for (int bj = 0; bj < 2; ++bj) { *(f32x4*)(rowp + bj * HALF) = acc[ai][bj][m][0] * (1.0f / 57600.0f); *(f32x4*)(rowp + bj * HALF + 4) = acc[ai][bj][m][1] * (1.0f / 57600.0f); } }
        } else {
            const int c0 = (pn - 8) * 256 + cl;
            f32x4 bv[2][2];
#pragma unroll
            for (int bj = 0; bj < 2; ++bj)
#pragma unroll
                for (int n = 0; n < 2; ++n) bv[bj][n] = *(const f32x4*)(b_pg + c0 + bj * HALF + 4 * n);
#pragma unroll
            for (int ai = 0; ai < 2; ++ai)
#pragma unroll
                for (int m = 0; m < 4; ++m) { bf16_t* rowp = PL + (size_t)(row0 + ai * HALF + m * 16) * 4096 + c0;
#pragma unroll
                    for (int bj = 0; bj < 2; ++bj) { const u32x4 p = *(const u32x4*)(rowp + bj * HALF);
                        const f32x4 v0 = acc[ai][bj][m][0] * (1.0f / 57600.0f) + bv[bj][0], v1 = acc[ai][bj][m][1] * (1.0f / 57600.0f) + bv[bj][1];
                        u32x4 w; w.x = cvt_pk_bf16(sigm(v0[0]) * blo(p.x), sigm(v0[1]) * bhi(p.x)); w.y = cvt_pk_bf16(sigm(v0[2]) * blo(p.y), sigm(v0[3]) * bhi(p.y));
                        w.z = cvt_pk_bf16(sigm(v1[0]) * blo(p.z), sigm(v1[1]) * bhi(p.z)); w.w = cvt_pk_bf16(sigm(v1[2]) * blo(p.w), sigm(v1[3]) * bhi(p.w));
                        *(u32x4*)(rowp + bj * HALF) = w; }
                    asm volatile("" ::: "memory"); }
        }
    }
};
typedef int pg8_i32x4 __attribute__((ext_vector_type(4)));
typedef int pg8_i32x8 __attribute__((ext_vector_type(8)));
__device__ __forceinline__ pg8_i32x8 cat8(bf16x8 lo, bf16x8 hi) { const pg8_i32x4 a = __builtin_bit_cast(pg8_i32x4, lo), b = __builtin_bit_cast(pg8_i32x4, hi); return __builtin_shufflevector(a, b, 0, 1, 2, 3, 4, 5, 6, 7); }
template <class Epi, class Sched, bool ALIGN_EPI = false, bool SP2 = false, bool F8 = false>
__device__ __forceinline__ void gemm_phase(PG8_LAS unsigned char* lds, const Gemm g, const Sched& S, const Epi& E, const int wave_id) {
    int tid_ = wave_id * 64 + fresh_lane();
    const int tid = tid_, wid = __builtin_amdgcn_readfirstlane(tid >> 6), lane = tid & 63, wr = wid >> 2, wc = wid & 3, fr = lane & 15, fq = lane >> 4;
    const int K = g.K, nt = K / BK, LD = g.ld;
    unsigned voffA, voffB;
    { int R, C; stage_rc(tid * 16, R, C); const int Rb = Epi::PERM ? ((R & ~31) + perm32(R & 31)) : R; voffA = (unsigned)(R * LD + C) * 2u; voffB = (unsigned)(Rb * LD + C) * 2u; }
    const size_t rstep = (size_t)64 * LD * 2;
    const size_t kstep = (size_t)(BK * 2);
    const size_t hstep = (size_t)HALF * LD * 2;
    const size_t tstep = 2 * hstep;
    const unsigned ldsw = (unsigned)wid * 1024u;
    const int aoff = lds_byte(wr * 64 + fr, fq * 8), boff = lds_byte(wc * 32 + fr, fq * 8);
#define PG8_SA(b, h) (((b) * 2 + (h)) * HTB)
#define PG8_SB(b, h) ((4 + (b) * 2 + (h)) * HTB)
#define PG8_STAGE(bufoff, gbase, voff) do { _Pragma("unroll") for (int _i = 0; _i < 2; ++_i) \
        __builtin_amdgcn_global_load_lds((const unsigned*)((const char*)(gbase) + _i * rstep + (voff)), (PG8_LAS unsigned*)(lds + (bufoff) + ldsw + _i * 8192), 16, 0, 0); } while (0)
#define PG8_LDA(dst, b, h) do { _Pragma("unroll") for (int m = 0; m < 4; ++m) _Pragma("unroll") for (int k = 0; k < 2; ++k) dst[m][k] = *(const PG8_LAS bf16x8*)(lds + PG8_SA(b, h) + aoff + m * 2048 + k * 1024); } while (0)
#define PG8_LDB(dst, b, h) do { _Pragma("unroll") for (int n = 0; n < 2; ++n) _Pragma("unroll") for (int k = 0; k < 2; ++k) dst[n][k] = *(const PG8_LAS bf16x8*)(lds + PG8_SB(b, h) + boff + n * 2048 + k * 1024); } while (0)
#define PG8_MMA(ai, bj, At, Bt) do { __builtin_amdgcn_s_setprio(1); _Pragma("unroll") for (int m = 0; m < 4; ++m) _Pragma("unroll") for (int n = 0; n < 2; ++n) { \
        _Pragma("unroll") for (int k = 0; k < 2; ++k) { \
            if constexpr (F8) acc[ai][bj][m][n] = __builtin_bit_cast(f32x4, __builtin_amdgcn_mfma_i32_16x16x64_i8(__builtin_bit_cast(pg8_i32x4, Bt[n][k]), __builtin_bit_cast(pg8_i32x4, At[m][k]), __builtin_bit_cast(pg8_i32x4, acc[ai][bj][m][n]), 0, 0, 0)); \
            else acc[ai][bj][m][n] = __builtin_amdgcn_mfma_f32_16x16x32_bf16(Bt[n][k], At[m][k], acc[ai][bj][m][n], 0, 0, 0); } } __builtin_amdgcn_s_setprio(0); } while (0)
#define PG8_WAIT_V(n) asm volatile("s_waitcnt vmcnt(" #n ")" ::: "memory")
#define PG8_WAIT_L(n) asm volatile("s_waitcnt lgkmcnt(" #n ")" ::: "memory")
#define PG8_BAR __builtin_amdgcn_s_barrier()
#define PG8_SCHED __builtin_amdgcn_sched_barrier(0)
    Unit cur, nxt; int ui = 0;
    if (!S.next(0, cur)) return;
    f32x4 acc[2][2][4][2];
#pragma unroll
    for (int a = 0; a < 2; ++a)
#pragma unroll
        for (int b = 0; b < 2; ++b)
#pragma unroll
            for (int m = 0; m < 4; ++m)
#pragma unroll
                for (int n = 0; n < 2; ++n) acc[a][b][m][n] = (f32x4){0.f, 0.f, 0.f, 0.f};
    bf16x8 At[4][2], B0[2][2], B1[2][2];
    const char* cA = (const char*)g.A + (size_t)cur.pm * tstep; const char* cB = (const char*)g.Bt + (size_t)cur.pn * tstep;
    S.a_ready(cur);
    if constexpr (SP2) {
        PG8_STAGE(PG8_SB(0, 0), cB, voffB); PG8_STAGE(PG8_SB(0, 1), cB + hstep, voffB); PG8_STAGE(PG8_SA(0, 0), cA, voffA); PG8_STAGE(PG8_SA(0, 1), cA + hstep, voffA);
        if (wr == 1) PG8_BAR;
        PG8_WAIT_V(2); PG8_BAR;
        PG8_STAGE(PG8_SB(1, 0), cB + kstep, voffB); PG8_STAGE(PG8_SA(1, 0), cA + kstep, voffA); PG8_STAGE(PG8_SB(1, 1), cB + hstep + kstep, voffB);
        PG8_WAIT_V(6); PG8_BAR;
    } else {
        PG8_STAGE(PG8_SB(0, 0), cB, voffB); PG8_STAGE(PG8_SA(0, 0), cA, voffA); PG8_STAGE(PG8_SB(0, 1), cB + hstep, voffB); PG8_STAGE(PG8_SA(0, 1), cA + hstep, voffA);
        if (wr == 1) PG8_BAR;
        PG8_WAIT_V(4); PG8_BAR;
        PG8_STAGE(PG8_SB(1, 0), cB + kstep, voffB); PG8_STAGE(PG8_SA(1, 0), cA + kstep, voffA); PG8_STAGE(PG8_SB(1, 1), cB + hstep + kstep, voffB);
        PG8_WAIT_V(6); PG8_BAR;
    }
    for (;;) {
        const bool has_next = S.next(ui + 1, nxt);
        const char* nA = has_next ? (const char*)g.A + (size_t)nxt.pm * tstep : cA; const char* nB = has_next ? (const char*)g.Bt + (size_t)nxt.pn * tstep : cB;
#pragma unroll 1
        for (int t = 0; t < nt; t += 2) {
            const bool last = (t == nt - 2);
            const char* a1 = cA + (size_t)(t + 1) * kstep;
            const char* a2 = last ? nA : cA + (size_t)(t + 2) * kstep; const char* b2 = last ? nB : cB + (size_t)(t + 2) * kstep;
            const char* a3 = a2 + kstep; const char* b3 = b2 + kstep;
            if (last && has_next) S.a_ready(nxt);
            if constexpr (SP2) {
            PG8_LDB(B0, 0, 0); PG8_LDB(B1, 0, 1); PG8_SCHED; PG8_LDA(At, 0, 0); PG8_STAGE(PG8_SA(1, 1), a1 + hstep, voffA);
            PG8_WAIT_V(8); PG8_WAIT_L(0); PG8_BAR; PG8_MMA(0, 0, At, B0); PG8_MMA(0, 1, At, B1); PG8_BAR; PG8_SCHED;
            PG8_LDA(At, 0, 1); PG8_STAGE(PG8_SB(0, 0), b2, voffB); PG8_STAGE(PG8_SB(0, 1), b2 + hstep, voffB); PG8_STAGE(PG8_SA(0, 0), a2, voffA);
            PG8_WAIT_V(8); PG8_WAIT_L(0); PG8_BAR; PG8_MMA(1, 0, At, B0); PG8_MMA(1, 1, At, B1); PG8_BAR; PG8_SCHED;
            PG8_LDB(B0, 1, 0); PG8_LDB(B1, 1, 1); PG8_SCHED; PG8_LDA(At, 1, 0); PG8_STAGE(PG8_SA(0, 1), a2 + hstep, voffA);
            PG8_WAIT_V(8); PG8_WAIT_L(0); PG8_BAR; PG8_MMA(0, 0, At, B0); PG8_MMA(0, 1, At, B1); PG8_BAR; PG8_SCHED;
            PG8_LDA(At, 1, 1); PG8_STAGE(PG8_SB(1, 0), b3, voffB); PG8_STAGE(PG8_SB(1, 1), b3 + hstep, voffB); PG8_STAGE(PG8_SA(1, 0), a3, voffA);
            PG8_WAIT_V(8); PG8_WAIT_L(0); PG8_BAR; PG8_MMA(1, 0, At, B0); PG8_MMA(1, 1, At, B1); PG8_BAR; PG8_SCHED;
            } else {
            PG8_LDB(B0, 0, 0); PG8_SCHED; PG8_LDA(At, 0, 0); PG8_STAGE(PG8_SA(1, 1), a1 + hstep, voffA);
            PG8_WAIT_L(8); PG8_BAR; PG8_WAIT_L(0); PG8_MMA(0, 0, At, B0); PG8_BAR; PG8_SCHED;
            PG8_LDB(B1, 0, 1); PG8_STAGE(PG8_SB(0, 0), b2, voffB);
            PG8_BAR; PG8_WAIT_L(0); PG8_MMA(0, 1, At, B1); PG8_BAR;
            PG8_LDA(At, 0, 1); PG8_STAGE(PG8_SA(0, 0), a2, voffA);
            PG8_BAR; PG8_WAIT_L(0); PG8_MMA(1, 0, At, B0); PG8_BAR; PG8_SCHED;
            PG8_STAGE(PG8_SB(0, 1), b2 + hstep, voffB);
            PG8_WAIT_V(6); PG8_BAR; PG8_MMA(1, 1, At, B1); PG8_BAR;
            PG8_LDB(B0, 1, 0); PG8_SCHED; PG8_LDA(At, 1, 0); PG8_STAGE(PG8_SA(0, 1), a2 + hstep, voffA);
            PG8_WAIT_L(8); PG8_BAR; PG8_WAIT_L(0); PG8_MMA(0, 0, At, B0); PG8_BAR; PG8_SCHED;
            PG8_LDB(B1, 1, 1); PG8_STAGE(PG8_SB(1, 0), b3, voffB);
            PG8_BAR; PG8_WAIT_L(0); PG8_MMA(0, 1, At, B1); PG8_BAR;
            PG8_LDA(At, 1, 1); PG8_STAGE(PG8_SA(1, 0), a3, voffA);
            PG8_BAR; PG8_WAIT_L(0); PG8_MMA(1, 0, At, B0); PG8_BAR; PG8_SCHED;
            PG8_STAGE(PG8_SB(1, 1), b3 + hstep, voffB);
            PG8_WAIT_V(6); PG8_BAR; PG8_MMA(1, 1, At, B1); PG8_BAR;
            }
        }
        if constexpr (ALIGN_EPI) { if (wr == 0) PG8_BAR; }
        if constexpr (F8) {
#pragma unroll
            for (int a = 0; a < 2; ++a)
#pragma unroll
                for (int b = 0; b < 2; ++b)
#pragma unroll
                    for (int m = 0; m < 4; ++m)
#pragma unroll
                        for (int n = 0; n < 2; ++n) { const pg8_i32x4 iv = __builtin_bit_cast(pg8_i32x4, acc[a][b][m][n]); acc[a][b][m][n] = (f32x4){(float)iv[0], (float)iv[1], (float)iv[2], (float)iv[3]}; } }
        if constexpr (!Epi::AFTER_DRAIN) { const int le = fresh_lane(); E(acc, cur, wr, wc, le & 15, le >> 4); S.done(cur); }
        if (!has_next) break;
#pragma unroll
        for (int a = 0; a < 2; ++a)
#pragma unroll
            for (int b = 0; b < 2; ++b)
#pragma unroll
                for (int m = 0; m < 4; ++m)
#pragma unroll
                    for (int n = 0; n < 2; ++n) acc[a][b][m][n] = (f32x4){0.f, 0.f, 0.f, 0.f};
        cur = nxt; cA = nA; cB = nB; ++ui;
        if constexpr (ALIGN_EPI) { if (wr == 1) PG8_BAR; }
    }
    PG8_WAIT_V(0);
    if constexpr (!ALIGN_EPI) { if (wr == 0) PG8_BAR; }
    PG8_BAR;
    if constexpr (Epi::AFTER_DRAIN) { E.fused(acc, cur, wr, wc, fr, fq, lds, wid, lane); S.done(cur); }
#undef PG8_SA
#undef PG8_SB
#undef PG8_STAGE
#undef PG8_LDA
#undef PG8_LDB
#undef PG8_MMA
#undef PG8_WAIT_V
#undef PG8_WAIT_L
#undef PG8_BAR
#undef PG8_SCHED
}
}

#define XB_TMO      128
#define XB_XCNT(j)  (256  + 64 * (j))
#define XB_XSUB(j)  (1280 + 64 * (j))
#define XB_XGEN(j)  (2304 + 64 * (j))
#define XB_TOP      3328
#define XB_TOPGEN   3392
#define XCD_BAR_WORDS 3456
#define XB_SPIN_CAP (1u << 18)

__device__ __forceinline__ unsigned xb_ld(unsigned* p)              { return __hip_atomic_load(p, __ATOMIC_RELAXED, __HIP_MEMORY_SCOPE_AGENT); }
__device__ __forceinline__ unsigned xb_add(unsigned* p, unsigned v) { return __hip_atomic_fetch_add(p, v, __ATOMIC_RELAXED, __HIP_MEMORY_SCOPE_AGENT); }
__device__ __forceinline__ unsigned xb_xcc_id() { return (unsigned)__builtin_amdgcn_s_getreg((3 << 11) | 20) & 0xFu; }
#define XB_SPIN(cond, bar) do { unsigned _sp = 0; while (cond) { __builtin_amdgcn_s_sleep(1); \
    if ((++_sp & 255u) == 0u) { if (xb_ld(&(bar)[XB_TMO])) break; if (_sp > XB_SPIN_CAP) { atomicAdd(&(bar)[XB_TMO], 1u); break; } } } } while (0)

struct XcdBarrier {
    unsigned* bar; unsigned x; int wave;
    volatile LAS unsigned* st;
};

__device__ __forceinline__ XcdBarrier xcd_barrier_post(unsigned* bar, volatile LAS unsigned* st) {
    XcdBarrier b; b.bar = bar; b.x = xb_xcc_id(); b.st = st; b.wave = __builtin_amdgcn_readfirstlane(threadIdx.x >> 6);
    if (threadIdx.x == 0) (void)xb_add(&bar[XB_XCNT(b.x)], 1u);
    return b;
}
__device__ __forceinline__ void xcd_barrier_complete(unsigned* bar, unsigned x, unsigned& nloc, unsigned& nx) {
    const unsigned G = gridDim.x * gridDim.y * gridDim.z;
    unsigned sum, cnt, mine, sp = 0u;
    for (;;) {
        sum = 0u; cnt = 0u; mine = 0u;
#pragma unroll
        for (unsigned j = 0; j < 16; ++j) { const unsigned c = xb_ld(&bar[XB_XCNT(j)]); sum += c; cnt += (c > 0u) ? 1u : 0u; mine = (j == x) ? c : mine; }
        if (sum == G) break;
        __builtin_amdgcn_s_sleep(1);
        if ((++sp & 255u) == 0u) { if (xb_ld(&bar[XB_TMO])) break; if (sp > XB_SPIN_CAP) { atomicAdd(&bar[XB_TMO], 1u); break; } }
    }
    nloc = mine > 0u ? mine : 1u; nx = cnt > 0u ? cnt : 1u;
}

__device__ __forceinline__ void xcd_barrier(const XcdBarrier& b) {
    asm volatile("s_waitcnt vmcnt(0)" ::: "memory");
    __syncthreads();
    if (b.wave == 0 && fresh_lane() == 0) {
        unsigned* bar = b.bar;
        __builtin_amdgcn_s_waitcnt(0);
        unsigned nloc = b.st[0], nx = b.st[1];
        if (nloc == 0u) { xcd_barrier_complete(bar, b.x, nloc, nx); b.st[0] = nloc; b.st[1] = nx; }
        const unsigned old = xb_add(&bar[XB_XSUB(b.x)], 1u);
        const unsigned gen = old / nloc;
        if (old + 1u == (gen + 1u) * nloc) {
            __builtin_amdgcn_fence(__ATOMIC_RELEASE, "agent");
            asm volatile("s_waitcnt vmcnt(0)" ::: "memory");
            const unsigned og = xb_add(&bar[XB_TOP], 1u);
            const unsigned tg = og / nx;
            if (og + 1u == (tg + 1u) * nx) xb_add(&bar[XB_TOPGEN], 1u);
            else XB_SPIN(xb_ld(&bar[XB_TOPGEN]) == tg, bar);
            __builtin_amdgcn_fence(__ATOMIC_ACQUIRE, "agent");
            xb_add(&bar[XB_XGEN(b.x)], 1u);
            asm volatile("s_waitcnt vmcnt(0)" ::: "memory");
        } else {
            XB_SPIN(xb_ld(&bar[XB_XGEN(b.x)]) == gen, bar);
            __builtin_amdgcn_fence(__ATOMIC_ACQUIRE, "agent");
            asm volatile("s_waitcnt vmcnt(0)" ::: "memory");
        }
    }
    __syncthreads();
}

constexpr size_t MiB = 1u << 20;
constexpr size_t WS_CTL = 0, CTL_ZERO_BYTES = 1 * MiB;
constexpr size_t WS_UB   = 1 * MiB;
constexpr size_t WS_VT   = WS_UB + 128 * MiB;
constexpr size_t WS_WBAT = WS_VT + 128 * MiB;
constexpr size_t WS_WBBT = WS_WBAT + 16 * MiB;
constexpr size_t WS_WOT  = WS_WBBT + 16 * MiB;
constexpr size_t WS_W4T  = WS_WOT + 32 * MiB;
constexpr size_t WS_WPLT = WS_W4T + 48 * MiB;
constexpr size_t WS_PB   = WS_WPLT + 2 * MiB;
constexpr size_t WS_XB   = WS_PB + 4 * MiB;
constexpr size_t WS_E    = WS_XB + 64 * MiB;
constexpr size_t WS_F    = WS_E + 148 * MiB;
constexpr size_t WS_QA   = WS_F + 128 * MiB;
constexpr size_t WS_QIDX = WS_QA + 32 * MiB;
constexpr size_t WS_QB   = WS_QIDX + 32 * MiB;
constexpr size_t WS_KB   = WS_QB + 32 * MiB;
constexpr size_t WS_VB   = WS_KB + 32 * MiB;
constexpr size_t WS_OB   = WS_VB + 32 * MiB;
constexpr size_t WS_CKV  = WS_OB + 32 * MiB;
constexpr size_t WS_SM   = WS_CKV + 8 * MiB;
constexpr size_t WS_CKVN = WS_SM + 8 * MiB;
constexpr size_t WS_CUM  = WS_CKVN + 4 * MiB;
constexpr size_t WS_PL   = WS_CUM + 1 * MiB;
constexpr size_t WS_WUKB = WS_PL + 128 * MiB;
constexpr size_t WS_WUVT = WS_WUKB + 1 * MiB;
constexpr size_t WS_KIDXB = WS_WUVT + 1 * MiB;
constexpr size_t WS_SCL = WS_KIDXB + 1 * MiB;
constexpr size_t WS_END  = WS_SCL + 1 * MiB;
constexpr size_t WS_PART = WS_UB + 64 * MiB;
constexpr size_t WS_X8   = WS_VT + 32 * MiB;
constexpr size_t WS_W18  = WS_E;
constexpr size_t WS_W48  = WS_VT + 64 * MiB;
constexpr size_t WS_WIDX = WS_SM;
constexpr size_t WS_QLAT = WS_E, WS_OLAT = WS_E + 64 * MiB;
static_assert(WS_END <= (size_t)1174 * MiB, "d_ws map");
constexpr int CW_BAR = 4096;

constexpr int NWAVES = 8, NTHREADS = 512;
constexpr int LDS_BYTES = 147456;
constexpr int LDSCTL_OFF = LDS_BYTES - 256;

typedef float f32x16 __attribute__((ext_vector_type(16)));
typedef short s16x4 __attribute__((ext_vector_type(4)));
template <int K>
__device__ __forceinline__ void small_gemm_tile(const bf16* A, int lda, const bf16* Bt, int ldb, bf16* C, int ldc, int lane, unsigned char* C8 = nullptr, float sc8 = 1.0f) {
    const int r = lane & 15, g = lane >> 4;
    f32x4 acc[4][4];
#pragma unroll
    for (int a = 0; a < 4; ++a)
#pragma unroll
        for (int b = 0; b < 4; ++b) acc[a][b] = (f32x4){0.f, 0.f, 0.f, 0.f};
    const bf16* ap = A + (size_t)r * lda + 8 * g; const bf16* bp = Bt + (size_t)r * ldb + 8 * g;
#pragma unroll 2
    for (int s = 0; s < K / 32; ++s) {
        bf16x8 af[4], bfr[4];
#pragma unroll
        for (int i = 0; i < 4; ++i) { af[i] = *(const bf16x8*)(ap + (size_t)(16 * i) * lda + 32 * s); bfr[i] = *(const bf16x8*)(bp + (size_t)(16 * i) * ldb + 32 * s); }
#pragma unroll
        for (int ni = 0; ni < 4; ++ni)
#pragma unroll
            for (int ti = 0; ti < 4; ++ti) acc[ni][ti] = __builtin_amdgcn_mfma_f32_16x16x32_bf16(bfr[ni], af[ti], acc[ni][ti], 0, 0, 0);
    }
#pragma unroll
    for (int ni = 0; ni < 4; ++ni)
#pragma unroll
        for (int ti = 0; ti < 4; ++ti) {
            if (C8) { *(unsigned*)(C8 + (size_t)(16 * ti + r) * ldc + 16 * ni + 4 * g) = pk_q8x4(acc[ni][ti][0], acc[ni][ti][1], acc[ni][ti][2], acc[ni][ti][3], sc8); continue; }
            u32x2 wv; wv.x = pk2(acc[ni][ti][0], acc[ni][ti][1]); wv.y = pk2(acc[ni][ti][2], acc[ni][ti][3]);
            *(u32x2*)(C + (size_t)(16 * ti + r) * ldc + 16 * ni + 4 * g) = wv; }
}
__device__ __forceinline__ bf16x8 ld8_f32_bf16(const float* p) { const f32x4 a = *(const f32x4*)p, b = *(const f32x4*)(p + 4); union { bf16x8 v; unsigned u[4]; } r; r.u[0] = pk2(a[0], a[1]); r.u[1] = pk2(a[2], a[3]); r.u[2] = pk2(b[0], b[1]); r.u[3] = pk2(b[2], b[3]); return r.v; }
template <int K>
__device__ __forceinline__ void small_gemm_tile_f32(const float* A, int lda, const float* Bt, int ldb, bf16* C, int ldc, int lane, unsigned char* C8 = nullptr) {
    const int r = lane & 15, g = lane >> 4;
    f32x4 acc[4][4];
#pragma unroll
    for (int a = 0; a < 4; ++a)
#pragma unroll
        for (int b = 0; b < 4; ++b) acc[a][b] = (f32x4){0.f, 0.f, 0.f, 0.f};
    const float* ap = A + (size_t)r * lda + 8 * g; const float* bp = Bt + (size_t)r * ldb + 8 * g;
#pragma unroll 1
    for (int s = 0; s < K / 32; ++s) {
        bf16x8 af[4], bfr[4];
#pragma unroll
        for (int i = 0; i < 4; ++i) { af[i] = ld8_f32_bf16(ap + (size_t)(16 * i) * lda + 32 * s); bfr[i] = ld8_f32_bf16(bp + (size_t)(16 * i) * ldb + 32 * s); }
#pragma unroll
        for (int ni = 0; ni < 4; ++ni)
#pragma unroll
            for (int ti = 0; ti < 4; ++ti) acc[ni][ti] = __builtin_amdgcn_mfma_f32_16x16x32_bf16(bfr[ni], af[ti], acc[ni][ti], 0, 0, 0);
    }
#pragma unroll
    for (int ni = 0; ni < 4; ++ni)
#pragma unroll
        for (int ti = 0; ti < 4; ++ti) { u32x2 wv; wv.x = pk2(acc[ni][ti][0], acc[ni][ti][1]); wv.y = pk2(acc[ni][ti][2], acc[ni][ti][3]);
            *(u32x2*)(C + (size_t)(16 * ti + r) * ldc + 16 * ni + 4 * g) = wv;
            if (C8) *(unsigned*)(C8 + (size_t)(16 * ti + r) * ldc + 16 * ni + 4 * g) = pk_q8x4(acc[ni][ti][0], acc[ni][ti][1], acc[ni][ti][2], acc[ni][ti][3], Q8_W); }
}
struct Args { const float* in[23]; float* out; unsigned char* ws; int ph_lo, ph_hi, li, pad; };
enum InIdx { I_X = 0, I_P, I_WIN, I_BFORGET, I_GLAT, I_WUK, I_WUV, I_WBA, I_WBB, I_WGATE, I_BGATE, I_WOUT, I_LN1G, I_LN1B, I_PWQ, I_PSUB, I_PU, I_PV, I_WPLE, I_WPG, I_BPG, I_LN2G, I_LN2B };

struct Frame {
    LAS unsigned char* lds;
    int tid, lane, wave, G, bid;
};
#define KARGQ ((const __attribute__((address_space(4))) unsigned long long*)__builtin_amdgcn_kernarg_segment_ptr())
#define INP(i) ((const float*)(const GAS float*)KARGQ[(i)])
#define OUTP() ((float*)(GAS float*)KARGQ[23])
#define WSB() ((unsigned char*)(GAS unsigned char*)KARGQ[24])
#define WSP(T, off) ((T*)(WSB() + (off)))

__device__ __forceinline__ void transpose_item(const float* W, int ldw, int src_col, int ncols, int k0, bf16* WT, int K, int dst_row0, LAS float* scr, int lane) {
    const int c = lane & 31;
    float tmp[32];
    const float* wp = W + (size_t)(k0 + (lane >> 5)) * ldw + src_col + c;
#pragma unroll
    for (int i = 0; i < 32; ++i) tmp[i] = (c < ncols) ? wp[(size_t)(2 * i) * ldw] : 0.f;
#pragma unroll
    for (int i = 0; i < 32; ++i) scr[(2 * i + (lane >> 5)) * 33 + c] = tmp[i];
    LDS_WAIT();
    const int c8 = lane & 7;
#pragma unroll
    for (int j = 0; j < 4; ++j) { const int n = (lane >> 3) + 8 * j; const LAS float* s = scr + (8 * c8) * 33 + n;
        u32x4 o; o.x = pk2(s[0 * 33], s[1 * 33]); o.y = pk2(s[2 * 33], s[3 * 33]); o.z = pk2(s[4 * 33], s[5 * 33]); o.w = pk2(s[6 * 33], s[7 * 33]);
        *(u32x4*)(WT + (size_t)(dst_row0 + n) * K + k0 + 8 * c8) = o; }
    LDS_WAIT();
}
__device__ __forceinline__ void transpose_item_q8(const float* W, int ldw, int src_col, int k0, unsigned char* WT8, int K, int dst_row0, float sc, LAS float* scr, int lane) {
    const int c = lane & 31;
    float tmp[32];
    const float* wp = W + (size_t)(k0 + (lane >> 5)) * ldw + src_col + c;
#pragma unroll
    for (int i = 0; i < 32; ++i) tmp[i] = wp[(size_t)(2 * i) * ldw];
#pragma unroll
    for (int i = 0; i < 32; ++i) scr[(2 * i + (lane >> 5)) * 33 + c] = tmp[i];
    LDS_WAIT();
    const int c8 = lane & 7;
#pragma unroll
    for (int j = 0; j < 4; ++j) { const int n = (lane >> 3) + 8 * j; const LAS float* s = scr + (8 * c8) * 33 + n;
        u32x2 o; o.x = pk_q8x4(s[0 * 33], s[1 * 33], s[2 * 33], s[3 * 33], sc); o.y = pk_q8x4(s[4 * 33], s[5 * 33], s[6 * 33], s[7 * 33], sc);
        *(u32x2*)(WT8 + (size_t)(dst_row0 + n) * K + k0 + 8 * c8) = o; }
    LDS_WAIT();
}
__device__ __forceinline__ void cvt_bf16_stream(const float* src, bf16* dst, size_t n8, size_t gt, size_t gstride) {
    size_t i = gt;
    for (; i + 3 * gstride < n8; i += 4 * gstride) {
        f32x4 a[4], b[4];
#pragma unroll
        for (int u = 0; u < 4; ++u) { a[u] = *(const f32x4*)(src + (i + u * gstride) * 8); b[u] = *(const f32x4*)(src + (i + u * gstride) * 8 + 4); }
#pragma unroll
        for (int u = 0; u < 4; ++u) { u32x4 o; o.x = pk2(a[u][0], a[u][1]); o.y = pk2(a[u][2], a[u][3]); o.z = pk2(b[u][0], b[u][1]); o.w = pk2(b[u][2], b[u][3]); *(u32x4*)(dst + (i + u * gstride) * 8) = o; } }
    for (; i < n8; i += gstride) { const f32x4 a = *(const f32x4*)(src + i * 8), b = *(const f32x4*)(src + i * 8 + 4);
        u32x4 o; o.x = pk2(a[0], a[1]); o.y = pk2(a[2], a[3]); o.z = pk2(b[0], b[1]); o.w = pk2(b[2], b[3]); *(u32x4*)(dst + i * 8) = o; }
}
__device__ __forceinline__ void p0_prologue(Frame& F) {
    LAS float* scr = (LAS float*)(F.lds + F.wave * 16384);
    const int gw = F.bid * NWAVES + F.wave, NGW = F.G * NWAVES;
    const float* w_in = INP(I_WIN); const float* w_gate = INP(I_WGATE);
    constexpr int NDB1 = N1 / 32, I_1 = NDB1 * 64;
    constexpr int I_BA = 128 * 32, I_BB = I_BA, I_O = 128 * 64, I_4 = 128 * 64, I_PL = 128 * 4;
    constexpr int NITEMS = I_1 + I_BA + I_BB + I_O + I_4 + I_PL;
    for (int it = gw; it < NITEMS; it += NGW) {
        int r = it;
        if (r < I_1) { const int kb = r / NDB1, db = r % NDB1; const float* W; int ldw, col, nc;
            if (db < 576) {
                if (db < 64) { W = w_in; ldw = IN_WIDTH; col = db * 32; }
                else if (db < 128) { W = w_in; ldw = IN_WIDTH; col = 2304 + (db - 64) * 32; }
                else if (db < 320) { W = w_in; ldw = IN_WIDTH; col = 4448 + (db - 128) * 32; }
                else { W = w_gate; ldw = 8192; col = (db - 320) * 32; }
                transpose_item_q8(W, ldw, col, kb * 64, WSP(unsigned char, WS_W18), 4096, db * 32, Q8_W, scr, F.lane); continue; }
            else if (db < 584) { W = w_in; ldw = IN_WIDTH; col = 2048 + (db - 576) * 32; nc = 32; }
            else { const int j = db - 584; W = w_in; ldw = IN_WIDTH; col = (j < 2) ? 4352 + 32 * j : (j == 2 ? 4416 : 10592); nc = (j < 3) ? 32 : (j == 3 ? 16 : 0); }
            transpose_item(W, ldw, col, nc, kb * 64, WSP(bf16, WS_E), 4096, db * 32, scr, F.lane); continue; }
        r -= I_1;
        if (r < I_BA) { const int kb = r / 128, db = r % 128; transpose_item_q8(INP(I_WBA), 4096, db * 32, kb * 64, WSP(unsigned char, WS_WBAT), 2048, db * 32, Q8_WB, scr, F.lane); continue; }
        r -= I_BA;
        if (r < I_BB) { const int kb = r / 128, db = r % 128; transpose_item_q8(INP(I_WBB), 4096, db * 32, kb * 64, WSP(unsigned char, WS_WBBT), 2048, db * 32, Q8_WB, scr, F.lane); continue; }
        r -= I_BB;
        if (r < I_O) { const int kb = r / 128, db = r % 128; transpose_item_q8(INP(I_WOUT), 4096, db * 32, kb * 64, WSP(unsigned char, WS_WOT), 4096, db * 32, Q8_WO, scr, F.lane); continue; }
        r -= I_O;
        if (r < I_4) { const int kb = r / 128, db = r % 128;
            transpose_item_q8(INP(I_WPG), 4096, db * 32, kb * 64, WSP(unsigned char, WS_W48), 4096, 2048 + db * 32, Q8_W, scr, F.lane); continue; }
        r -= I_4;
        { const int kb = r / 128, db = r % 128; transpose_item(INP(I_WPLE), 4096, db * 32, 32, kb * 64, WSP(bf16, WS_WPLT), 256, db * 32, scr, F.lane); }
    }
    for (int it = gw; it < 16 * 2 * 64; it += NGW) { const int dt = it & 63, nt = (it >> 6) & 1, l = it >> 7;
        small_gemm_tile_f32<128>(INP(I_PSUB) + (size_t)(l * 128 + nt * 64) * 128, 128, INP(I_PWQ) + (size_t)(dt * 64) * 2048 + (l >> 1) * 256 + (l & 1) * 128, 2048,
                                 WSP(bf16, WS_W4T) + (size_t)(l * 128 + nt * 64) * 4096 + dt * 64, 4096, F.lane, WSP(unsigned char, WS_W48) + (size_t)(l * 128 + nt * 64) * 4096 + dt * 64); }
    const size_t gt = (size_t)F.bid * NTHREADS + F.tid, gs = (size_t)F.G * NTHREADS;
    { const float* src = INP(I_X); bf16* dst = WSP(bf16, WS_XB); unsigned char* d8 = WSP(unsigned char, WS_X8); const size_t n8 = (size_t)NTOK * D_MODEL / 8;
      for (size_t i = gt; i < n8; i += 4 * gs) {
          if (i + 3 * gs >= n8) { for (size_t j = i; j < n8; j += gs) { const f32x4 a = *(const f32x4*)(src + j * 8), b = *(const f32x4*)(src + j * 8 + 4);
                  u32x4 o; o.x = pk2(a[0], a[1]); o.y = pk2(a[2], a[3]); o.z = pk2(b[0], b[1]); o.w = pk2(b[2], b[3]); *(u32x4*)(dst + j * 8) = o;
                  u32x2 q; q.x = pk_q8x4(a[0], a[1], a[2], a[3], Q8_ACT); q.y = pk_q8x4(b[0], b[1], b[2], b[3], Q8_ACT); *(u32x2*)(d8 + j * 8) = q; } break; }
          f32x4 a[4], b[4];
#pragma unroll
          for (int u = 0; u < 4; ++u) { a[u] = *(const f32x4*)(src + (i + u * gs) * 8); b[u] = *(const f32x4*)(src + (i + u * gs) * 8 + 4); }
#pragma unroll
          for (int u = 0; u < 4; ++u) { u32x4 o; o.x = pk2(a[u][0], a[u][1]); o.y = pk2(a[u][2], a[u][3]); o.z = pk2(b[u][0], b[u][1]); o.w = pk2(b[u][2], b[u][3]); *(u32x4*)(dst + (i + u * gs) * 8) = o;
              u32x2 q; q.x = pk_q8x4(a[u][0], a[u][1], a[u][2], a[u][3], Q8_ACT); q.y = pk_q8x4(b[u][0], b[u][1], b[u][2], b[u][3], Q8_ACT); *(u32x2*)(d8 + (i + u * gs) * 8) = q; } } }
    cvt_bf16_stream(INP(I_P), WSP(bf16, WS_PB), (size_t)NTOK * D_PLE / 8, gt, gs);
    { float* SCL = WSP(float, WS_SCL);
      for (int row = gw; row < 2 * N_EXPERTS; row += NGW) { const int tb = row >= N_EXPERTS ? 1 : 0, e = row - tb * N_EXPERTS;
          const float* src = (tb ? INP(I_PV) : INP(I_PU)) + (size_t)e * 4096; unsigned char* dst = (tb ? WSP(unsigned char, WS_VT) : WSP(unsigned char, WS_UB)) + (size_t)e * 2048;
          f32x4 v[16]; float ssq = 0.f;
#pragma unroll
          for (int jj = 0; jj < 2; ++jj)
#pragma unroll
              for (int q = 0; q < 8; ++q) { const f32x4 x = *(const f32x4*)(src + (jj * 64 + F.lane) * 32 + 4 * q); v[8 * jj + q] = x; ssq += (x[0] * x[0] + x[1] * x[1]) + (x[2] * x[2] + x[3] * x[3]); }
          const float sig = sqrtf(wave_sum(ssq) * (1.0f / 4096.0f)); const float inv = sig > 0.f ? 2.1f / sig : 0.f;
#pragma unroll
          for (int jj = 0; jj < 2; ++jj) { u32x4 o;
#pragma unroll
              for (int i = 0; i < 4; ++i) { const f32x4 a = v[8 * jj + 2 * i] * inv, b = v[8 * jj + 2 * i + 1] * inv; unsigned p = 0u;
                  p = __builtin_amdgcn_cvt_scalef32_pk_fp4_f32(p, a[0], a[1], 1.0f, 0); p = __builtin_amdgcn_cvt_scalef32_pk_fp4_f32(p, a[2], a[3], 1.0f, 1);
                  p = __builtin_amdgcn_cvt_scalef32_pk_fp4_f32(p, b[0], b[1], 1.0f, 2); p = __builtin_amdgcn_cvt_scalef32_pk_fp4_f32(p, b[2], b[3], 1.0f, 3); o[i] = p; }
              *(u32x4*)(dst + (jj * 64 + F.lane) * 16) = o; }
          if (F.lane == 0) SCL[row] = sig > 0.f ? sig * (1.0f / 2.1f) : 1.0f; } }
    { const float* w_uk = INP(I_WUK); const float* w_uv = INP(I_WUV); bf16* WUKB = WSP(bf16, WS_WUKB); bf16* WUVT = WSP(bf16, WS_WUVT);
      for (size_t i = gt; i < 65536; i += gs) { const int d8 = (int)(i & 15), c = (int)(i >> 4) & 255, h = (int)(i >> 12);
          const float* src = w_uk + (size_t)c * 2048 + h * 128 + d8 * 8; const f32x4 a = *(const f32x4*)src, b = *(const f32x4*)(src + 4);
          u32x4 o; o.x = pk2(a[0], a[1]); o.y = pk2(a[2], a[3]); o.z = pk2(b[0], b[1]); o.w = pk2(b[2], b[3]); *(u32x4*)(WUKB + i * 8) = o; }
      for (size_t i = gt; i < 65536; i += gs) { const int c8 = (int)(i & 31), d = (int)(i >> 5) & 127, h = (int)(i >> 12);
          const float* src = w_uv + (size_t)(c8 * 8) * 2048 + h * 128 + d;
          u32x4 o; o.x = pk2(src[0], src[2048]); o.y = pk2(src[2 * 2048], src[3 * 2048]); o.z = pk2(src[4 * 2048], src[5 * 2048]); o.w = pk2(src[6 * 2048], src[7 * 2048]); *(u32x4*)(WUVT + i * 8) = o; } }
}

__device__ __forceinline__ f32x4 part_sum4(const float* PART, int tile, size_t off) { const size_t pl = (size_t)NTOK * 256; const float* p = PART + (size_t)tile * pl + off;
    return (*(const f32x4*)p + *(const f32x4*)(p + 2 * pl)) + (*(const f32x4*)(p + 4 * pl) + *(const f32x4*)(p + 6 * pl)); }
__device__ __forceinline__ float log_sigmoid(float z) { return fminf(z, 0.f) - log1pf(__expf(-fabsf(z))); }
__device__ __forceinline__ void p2_small(Frame& F) {
    const int gw = F.bid * NWAVES + F.wave, NGW = F.G * NWAVES, lane = F.lane;
    { const float* PART = WSP(float, WS_PART); bf16* CKVN = WSP(bf16, WS_CKVN); const f32x4 g = *(const f32x4*)(INP(I_GLAT) + 4 * lane);
      for (int t = gw; t < NTOK; t += NGW) { const f32x4 v = part_sum4(PART, 0, (size_t)t * 256 + 4 * lane);
          const float ss = wave_sum(v[0] * v[0] + v[1] * v[1] + v[2] * v[2] + v[3] * v[3]); const float r = 1.0f / sqrtf(ss * (1.0f / 256.0f) + LN_EPS);
          u32x2 o; o.x = pk2(v[0] * r * g[0], v[1] * r * g[1]); o.y = pk2(v[2] * r * g[2], v[3] * r * g[3]); *(u32x2*)(CKVN + (size_t)t * 256 + 4 * lane) = o; } }
    { const float* PART = WSP(float, WS_PART); float* CUML = WSP(float, WS_CUM); float* SEGT = WSP(float, WS_CUM + 512 * 1024); const float* bfp = INP(I_BFORGET);
      for (int it = gw; it < BATCH * (SEQ / 64); it += NGW) { const int b = it / (SEQ / 64), seg = it % (SEQ / 64), pos = seg * 64 + lane;
          f32x4 f[4];
#pragma unroll
          for (int q = 0; q < 4; ++q) f[q] = part_sum4(PART, 1, (size_t)(b * SEQ + pos) * 256 + 96 + 4 * q);
#pragma unroll
          for (int h = 0; h < B_HEADS; ++h) { float v = log_sigmoid(f[h >> 2][h & 3] + bfp[h]);
#pragma unroll
              for (int o = 1; o < 64; o <<= 1) { const float t = __shfl_up(v, o); if (lane >= o) v += t; }
              CUML[(size_t)(b * B_HEADS + h) * SEQ + pos] = v; if (lane == 63) SEGT[(b * B_HEADS + h) * (SEQ / 64) + seg] = v; } } }
    { const bf16* QA = WSP(bf16, WS_QA); bf16* QLAT = WSP(bf16, WS_QLAT); const bf16* WUKB = WSP(bf16, WS_WUKB);
      for (int it = gw; it < (NTOK / 64) * A_HEADS * 4; it += NGW) { const int ct = it & 3, h = (it >> 2) & 15, tt = it >> 6;
          small_gemm_tile<128>(QA + (size_t)tt * 64 * 2048 + h * 128, 2048, WUKB + (size_t)(h * 256 + ct * 64) * 128, 128, QLAT + (size_t)tt * 64 * 4096 + h * 256 + ct * 64, 4096, lane); } }
    { const float* PART = WSP(float, WS_PART); bf16* KIDXB = WSP(bf16, WS_KIDXB); float* WIDX = WSP(float, WS_WIDX); const size_t gt = (size_t)F.bid * NTHREADS + F.tid, gs = (size_t)F.G * NTHREADS;
      for (size_t i = gt; i < (size_t)NTOK * 8; i += gs) { const size_t t = i >> 3; const int q = (int)(i & 7); *(f32x4*)(WIDX + t * 32 + 4 * q) = part_sum4(PART, 1, t * 256 + 64 + 4 * q); }
      for (size_t i = gt; i < (size_t)NTOK * 8; i += gs) { const size_t t = i >> 3; const int c8 = (int)(i & 7); const f32x4 a = part_sum4(PART, 1, t * 256 + c8 * 8), b = part_sum4(PART, 1, t * 256 + c8 * 8 + 4);
          u32x4 o; o.x = pk2(a[0], a[1]); o.y = pk2(a[2], a[3]); o.z = pk2(b[0], b[1]); o.w = pk2(b[2], b[3]);
          const size_t tl = t & (SEQ - 1); *(u32x4*)(KIDXB + (t - tl) * 64 + (tl >> 5) * 2048 + (c8 >> 1) * 512 + (tl & 31) * 16 + (c8 & 1) * 8) = o; } }
}

__device__ __forceinline__ unsigned f2key(float f) { const unsigned b = __builtin_bit_cast(unsigned, f); return (b & 0x80000000u) ? ~b : (b | 0x80000000u); }
__device__ __forceinline__ int lanes_below(unsigned long long m) { return (int)__builtin_amdgcn_mbcnt_hi((unsigned)(m >> 32), __builtin_amdgcn_mbcnt_lo((unsigned)m, 0u)); }
__device__ __forceinline__ void p4_oa(Frame& F) {
    const int gw = F.bid * NWAVES + F.wave, NGW = F.G * NWAVES, lane = F.lane;
    const bf16* OLAT = WSP(bf16, WS_OLAT); bf16* OA = WSP(bf16, WS_QA); const bf16* WUVT = WSP(bf16, WS_WUVT);
    for (int it = gw; it < (NTOK / 64) * A_HEADS * 2; it += NGW) { const int dt = it & 1, h = (it >> 1) & 15, tt = it >> 5;
        small_gemm_tile<256>(OLAT + (size_t)tt * 64 * 4096 + h * 256, 4096, WUVT + (size_t)(h * 128 + dt * 64) * 256, 256, nullptr, 2048, lane, (unsigned char*)OA + (size_t)tt * 64 * 2048 + h * 128 + dt * 64, Q8_O); }
}
__device__ __forceinline__ void p7_ln1(Frame& F) {
    const int gw = F.bid * NWAVES + F.wave, NGW = F.G * NWAVES, lane = F.lane;
    const bf16* Y1 = WSP(bf16, WS_E); bf16* H1B = WSP(bf16, WS_XB); unsigned char* H18 = WSP(unsigned char, WS_X8); const float* g = INP(I_LN1G); const float* bb = INP(I_LN1B);
    for (int t = gw; t < NTOK; t += NGW) { const bf16* yr = Y1 + (size_t)t * 4096;
        f32x4 v[16]; float s = 0.f;
#pragma unroll
        for (int j = 0; j < 8; ++j) { const u32x4 w = *(const u32x4*)(yr + (j * 64 + lane) * 8); v[2 * j] = (f32x4){bflo(w.x), bfhi(w.x), bflo(w.y), bfhi(w.y)}; v[2 * j + 1] = (f32x4){bflo(w.z), bfhi(w.z), bflo(w.w), bfhi(w.w)};
            s += (v[2 * j][0] + v[2 * j][1]) + (v[2 * j][2] + v[2 * j][3]) + (v[2 * j + 1][0] + v[2 * j + 1][1]) + (v[2 * j + 1][2] + v[2 * j + 1][3]); }
        const float mean = wave_sum(s) * (1.0f / 4096.0f); float q = 0.f;
#pragma unroll
        for (int j = 0; j < 16; ++j) { v[j] = v[j] - mean; q += (v[j][0] * v[j][0] + v[j][1] * v[j][1]) + (v[j][2] * v[j][2] + v[j][3] * v[j][3]); }
        const float rstd = 1.0f / sqrtf(wave_sum(q) * (1.0f / 4096.0f) + LN_EPS);
#pragma unroll
        for (int j = 0; j < 8; ++j) { const int off = (j * 64 + lane) * 8; const f32x4 g0 = *(const f32x4*)(g + off), g1 = *(const f32x4*)(g + off + 4), b0 = *(const f32x4*)(bb + off), b1 = *(const f32x4*)(bb + off + 4);
            const f32x4 o0 = v[2 * j] * rstd * g0 + b0, o1 = v[2 * j + 1] * rstd * g1 + b1;
            u32x4 w; w.x = pk2(o0[0], o0[1]); w.y = pk2(o0[2], o0[3]); w.z = pk2(o1[0], o1[1]); w.w = pk2(o1[2], o1[3]); *(u32x4*)(H1B + (size_t)t * 4096 + off) = w;
            u32x2 q8; q8.x = pk_q8x4(o0[0], o0[1], o0[2], o0[3], Q8_ACT); q8.y = pk_q8x4(o1[0], o1[1], o1[2], o1[3], Q8_ACT); *(u32x2*)(H18 + (size_t)t * 4096 + off) = q8; } }
}
constexpr int FOX_KP = 272, FOX_VP = 320, FOX_VOFF = 17408, FOX_COFF = 37888;
__device__ __forceinline__ void fox_unit(Frame& F, int b, int h, int qb) {
    const int tid = F.tid, lane = F.lane, w = F.wave, r = lane & 31, hh = lane >> 5;
    LAS unsigned char* Ks = F.lds; LAS unsigned char* Vs = F.lds + FOX_VOFF; LAS float* cks = (LAS float*)(F.lds + FOX_COFF);
    const bf16* QB = WSP(bf16, WS_QB); const bf16* KB = WSP(bf16, WS_KB); const bf16* VB = WSP(bf16, WS_VB); bf16* OB = WSP(bf16, WS_OB);
    const float* cum = WSP(float, WS_CUM) + (size_t)(b * B_HEADS + h) * SEQ;
    LAS float* segp = (LAS float*)(F.lds + FOX_COFF + 256);
    const int Q0 = qb * 256, q0 = Q0 + 32 * w, ntiles = (Q0 + 256) / 64, tl = (q0 + 31) / 64;
    const float SC = 0.12751741614123135f, LOG2E = 1.4426950408889634f;
    bf16x8 qf[8];
    { const bf16* qp = QB + ((size_t)b * SEQ + q0 + r) * 2048 + h * 128 + 8 * hh;
#pragma unroll
      for (int s = 0; s < 8; ++s) qf[s] = *(const bf16x8*)(qp + 16 * s); }
    f32x16 o[4];
#pragma unroll
    for (int dt = 0; dt < 4; ++dt)
#pragma unroll
        for (int i = 0; i < 16; ++i) o[dt][i] = 0.f;
    float m = -1e30f, l = 0.f;
    const int pk0 = tid >> 4, pc0 = tid & 15;
    const bf16* kg = KB + ((size_t)b * SEQ + pk0) * 2048 + h * 128 + 8 * pc0; const bf16* vg = VB + ((size_t)b * SEQ + pk0) * 2048 + h * 128 + 8 * pc0;
    u32x4 kr0, kr1, vr0, vr1; float cr = 0.f;
#define FOX_LOAD(kt) do { const size_t go = (size_t)(kt) * 64 * 2048; kr0 = *(const u32x4*)(kg + go); kr1 = *(const u32x4*)(kg + go + 32 * 2048); vr0 = *(const u32x4*)(vg + go); vr1 = *(const u32x4*)(vg + go + 32 * 2048); \
        if (tid < 64) cr = (cum[(kt) * 64 + tid] + segp[(kt)]) * LOG2E; } while (0)
    if (tid < 64) { float v = (lane < 32) ? WSP(float, WS_CUM + 512 * 1024)[(b * B_HEADS + h) * (SEQ / 64) + lane] : 0.f; const float own = v;
#pragma unroll
        for (int o = 1; o < 32; o <<= 1) { const float t = __shfl_up(v, o); if (lane >= o) v += t; }
        if (lane < 32) segp[lane] = v - own;
        CFENCE(); LDS_WAIT(); }
    FOX_LOAD(0);
    const int ka_off = r * FOX_KP + 16 * hh;
    const int vt_off = (4 * hh + ((lane & 15) >> 2)) * FOX_VP + (16 * ((lane >> 4) & 1) + 4 * (lane & 3)) * 2;
    const int ck_off = 4 * hh;
    for (int kt = 0; kt < ntiles; ++kt) {
        __syncthreads();
        *(LAS u32x4*)(Ks + pk0 * FOX_KP + pc0 * 16) = kr0; *(LAS u32x4*)(Ks + (pk0 + 32) * FOX_KP + pc0 * 16) = kr1;
        *(LAS u32x4*)(Vs + pk0 * FOX_VP + pc0 * 16) = vr0; *(LAS u32x4*)(Vs + (pk0 + 32) * FOX_VP + pc0 * 16) = vr1;
        if (tid < 64) cks[tid] = cr;
        __syncthreads();
        if (kt + 1 < ntiles) FOX_LOAD(kt + 1);
        if (kt <= tl) {
            f32x16 s0, s1;
#pragma unroll
            for (int i = 0; i < 16; ++i) { s0[i] = 0.f; s1[i] = 0.f; }
#pragma unroll
            for (int s = 0; s < 8; ++s) { const bf16x8 a0 = *(const LAS bf16x8*)(Ks + ka_off + 32 * s), a1 = *(const LAS bf16x8*)(Ks + ka_off + 32 * FOX_KP + 32 * s);
                s0 = __builtin_amdgcn_mfma_f32_32x32x16_bf16(a0, qf[s], s0, 0, 0, 0); s1 = __builtin_amdgcn_mfma_f32_32x32x16_bf16(a1, qf[s], s1, 0, 0, 0); }
            const bool diag = (64 * kt + 63 > q0); const int qme = q0 + r - 64 * kt;
            float mx = m;
#pragma unroll
            for (int g4 = 0; g4 < 4; ++g4) { const f32x4 c0 = *(const LAS f32x4*)(cks + ck_off + 8 * g4), c1 = *(const LAS f32x4*)(cks + ck_off + 32 + 8 * g4);
#pragma unroll
                for (int i = 0; i < 4; ++i) { const int kl = 8 * g4 + 4 * hh + i; float t0 = s0[4 * g4 + i] * SC - c0[i], t1 = s1[4 * g4 + i] * SC - c1[i];
                    if (diag) { if (kl > qme) t0 = -INFINITY; if (kl + 32 > qme) t1 = -INFINITY; }
                    s0[4 * g4 + i] = t0; s1[4 * g4 + i] = t1; mx = fmaxf(mx, fmaxf(t0, t1)); } }
            mx = fmaxf(mx, __shfl_xor(mx, 32));
            if (__any(mx > m + 8.0f)) {
                const float alpha = __builtin_amdgcn_exp2f(m - mx); m = mx; l *= alpha;
#pragma unroll
                for (int dt = 0; dt < 4; ++dt)
#pragma unroll
                    for (int i = 0; i < 16; ++i) o[dt][i] *= alpha; }
            float ls = 0.f;
            union { bf16x8 v; unsigned u[4]; } pf[4];
#pragma unroll
            for (int ks = 0; ks < 2; ++ks)
#pragma unroll
                for (int j = 0; j < 4; ++j) { const float a0 = __builtin_amdgcn_exp2f(s0[8 * ks + 2 * j] - m), a1 = __builtin_amdgcn_exp2f(s0[8 * ks + 2 * j + 1] - m);
                    const float b0 = __builtin_amdgcn_exp2f(s1[8 * ks + 2 * j] - m), b1 = __builtin_amdgcn_exp2f(s1[8 * ks + 2 * j + 1] - m);
                    ls += (a0 + a1) + (b0 + b1); pf[ks].u[j] = pk2(a0, a1); pf[2 + ks].u[j] = pk2(b0, b1); }
            l += ls;
#pragma unroll
            for (int f = 0; f < 4; ++f) {
                const int vb = vt_off + 16 * f * FOX_VP;
#pragma unroll
                for (int dt = 0; dt < 4; ++dt) {
                    const s16x4 x0 = __builtin_amdgcn_ds_read_tr16_b64_v4i16((LAS s16x4*)(Vs + vb + 64 * dt)), x1 = __builtin_amdgcn_ds_read_tr16_b64_v4i16((LAS s16x4*)(Vs + vb + 8 * FOX_VP + 64 * dt));
                    const bf16x8 af = {x0[0], x0[1], x0[2], x0[3], x1[0], x1[1], x1[2], x1[3]};
                    o[dt] = __builtin_amdgcn_mfma_f32_32x32x16_bf16(af, pf[f].v, o[dt], 0, 0, 0); }
                __builtin_amdgcn_sched_barrier(0);
            }
        }
    }
#undef FOX_LOAD
    l += __shfl_xor(l, 32);
    const float inv = 1.0f / l;
    unsigned char* op = (unsigned char*)OB + ((size_t)b * SEQ + q0 + r) * 2048 + h * 128 + 4 * hh;
#pragma unroll
    for (int dt = 0; dt < 4; ++dt)
#pragma unroll
        for (int g4 = 0; g4 < 4; ++g4) *(unsigned*)(op + 32 * dt + 8 * g4) = pk_q8x4(o[dt][4 * g4] * inv, o[dt][4 * g4 + 1] * inv, o[dt][4 * g4 + 2] * inv, o[dt][4 * g4 + 3] * inv, Q8_O);
}
__device__ __forceinline__ void p3_fox(Frame& F) {
    for (int pr = F.bid; pr < BATCH * B_HEADS * 4; pr += F.G) { const int bh = pr >> 2, j = pr & 3, b = bh >> 4, h = bh & 15;
        fox_unit(F, b, h, 7 - j);
        fox_unit(F, b, h, j); }
}
constexpr int DSA_WLDS = 16896;
__device__ __forceinline__ void p3_dsa(Frame& F, int flags) {
    const int gw = F.bid * NWAVES + F.wave, NGW = F.G * NWAVES;
    LAS unsigned char* wb = F.lds + F.wave * DSA_WLDS;
    LAS float* SCb2 = (LAS float*)wb; LAS unsigned short* IDX = (LAS unsigned short*)(wb + 16384);
    const bf16* QIDX = WSP(bf16, WS_QIDX); const bf16* KIDXB = WSP(bf16, WS_KIDXB); const float* WIDX = WSP(float, WS_WIDX); const bf16* CKVN = WSP(bf16, WS_CKVN); const bf16* QLAT = WSP(bf16, WS_QLAT); bf16* OLAT = WSP(bf16, WS_OLAT);
    const float idx_scale = 0.022097086912079608f, SCL = 0.12751741614123135f  ;
    for (int ip = gw; ip < NTOK / 2; ip += NGW) {
        const int b = (2 * ip) / SEQ, ttp = (2 * ip) % SEQ, tp0 = (b & 2) ? (SEQ - 2 - ttp) : ttp;
         const size_t rowp = (size_t)b * SEQ + tp0; const int chunk_end = (tp0 / CHUNK + 1) * CHUNK;
        {
        const int lane = fresh_lane(), r32 = lane & 31, hh = lane >> 5;
        if (!(flags & 4)) {
            bf16x8 qi[2][4]; f32x4 wv[2][4];
#pragma unroll
            for (int q2 = 0; q2 < 2; ++q2) {
#pragma unroll
                for (int s = 0; s < 4; ++s) qi[q2][s] = *(const bf16x8*)(QIDX + (rowp + q2) * 2048 + r32 * 64 + 16 * s + 8 * hh);
#pragma unroll
                for (int g4 = 0; g4 < 4; ++g4) wv[q2][g4] = *(const f32x4*)(WIDX + (rowp + q2) * 32 + 8 * g4 + 4 * hh); }
            const bf16* kp = KIDXB + (size_t)b * SEQ * 64 + r32 * 16 + 8 * hh;
            bf16x8 kb[8][4];
#define DSA_SCORE(kbt, tile, q2) do { f32x16 acc; _Pragma("unroll") for (int i = 0; i < 16; ++i) acc[i] = 0.f; \
                _Pragma("unroll") for (int s = 0; s < 4; ++s) acc = __builtin_amdgcn_mfma_f32_32x32x16_bf16(qi[q2][s], kbt[s], acc, 0, 0, 0); \
                float sc = 0.f; _Pragma("unroll") for (int g4 = 0; g4 < 4; ++g4) _Pragma("unroll") for (int i = 0; i < 4; ++i) sc += fmaxf(acc[4 * g4 + i], 0.f) * wv[q2][g4][i]; \
                sc += __shfl_xor(sc, 32); if (lane < 32) SCb2[(q2) * 2048 + (tile) * 32 + lane] = sc * idx_scale; } while (0)
            const int ntile8 = ((chunk_end + 255) >> 8) << 3;
            for (int t0 = 0; t0 < ntile8; t0 += 8) {
#pragma unroll
                for (int u = 0; u < 8; ++u)
#pragma unroll
                    for (int s = 0; s < 4; ++s) kb[u][s] = *(const bf16x8*)(kp + (size_t)(t0 + u) * 2048 + 512 * s);
#pragma unroll
                for (int u = 0; u < 8; ++u) { DSA_SCORE(kb[u], t0 + u, 0); DSA_SCORE(kb[u], t0 + u, 1); __builtin_amdgcn_sched_barrier(0); }
            }
#undef DSA_SCORE
        }
        }
        CFENCE(); LDS_WAIT();
#pragma unroll 1
        for (int q2 = 0; q2 < 2; ++q2) {
        const int lane = fresh_lane(), r16 = lane & 15, g = lane >> 4;
        const int t = tp0 + q2; const size_t row = rowp + q2; LAS float* SCb = SCb2 + q2 * 2048;
        const int nsel = chunk_end < TOPK ? chunk_end : TOPK;
        if (chunk_end <= TOPK || (flags & 8)) { for (int s = lane; s < nsel; s += 64) IDX[s] = (unsigned short)s; }
        else {
            unsigned key[32]; const int nreg = chunk_end >> 6;
#pragma unroll
            for (int i = 0; i < 32; ++i) key[i] = (i < nreg) ? f2key(SCb[i * 64 + lane]) : 0u;
            unsigned T = 0u;
            for (int bit = 31; bit >= 0; --bit) { const unsigned cand = T | (1u << bit); int cnt = 0;
#pragma unroll
                for (int i = 0; i < 32; ++i) cnt += __builtin_popcountll(__ballot(key[i] >= cand));
                if (cnt >= TOPK) { T = cand; if (cnt == TOPK) break; } }
            int cgt = 0;
#pragma unroll
            for (int i = 0; i < 32; ++i) cgt += __builtin_popcountll(__ballot(key[i] > T));
            int rem = TOPK - cgt, base = 0;
#pragma unroll
            for (int i = 0; i < 32; ++i) { const bool gt = key[i] > T, eq = key[i] == T; const unsigned long long meq = __ballot(eq); const bool take = gt || (eq && lanes_below(meq) < rem);
                const unsigned long long msel = __ballot(take); if (take) IDX[base + lanes_below(msel)] = (unsigned short)(i * 64 + lane);
                base += __builtin_popcountll(msel); const int ne = __builtin_popcountll(meq); rem -= (ne < rem ? ne : rem); }
        }
        CFENCE(); LDS_WAIT();
        if (!(flags & 16)) {
            int r16l = r16; asm volatile("" : "+v"(r16l));
            union { bf16x8 v; unsigned short e[8]; } sel0, sel1;
#pragma unroll
            for (int j = 0; j < 8; ++j) { sel0.e[j] = (8 * g + j == r16l) ? 0x3F80 : 0; sel1.e[j] = (8 * g + j == 16 + r16l) ? 0x3F80 : 0; }
            const float slope2 = exp2f(-0.5f * (float)(r16l + 1)) * 1.4426950408889634f;
            bf16x8 ql[8];
#pragma unroll
            for (int s = 0; s < 8; ++s) ql[s] = *(const bf16x8*)(QLAT + row * 4096 + r16 * 256 + 32 * s + 8 * g);
            f32x4 o[16];
#pragma unroll
            for (int ct = 0; ct < 16; ++ct) o[ct] = (f32x4){0.f, 0.f, 0.f, 0.f};
            float m = -1e30f, l = 0.f;
            const bf16* cbase = CKVN + (size_t)b * SEQ * 256 + 8 * g;
            const int nstep = nsel >> 5;
            for (int st = 0; st < nstep; ++st) {
                const int ia = IDX[32 * st + r16], ib = IDX[32 * st + 16 + r16];
                bf16x8 ca[8], cb[8];
#pragma unroll
                for (int s = 0; s < 8; ++s) { ca[s] = *(const bf16x8*)(cbase + (size_t)ia * 256 + 32 * s); cb[s] = *(const bf16x8*)(cbase + (size_t)ib * 256 + 32 * s); }
                f32x4 sa = (f32x4){0.f, 0.f, 0.f, 0.f}, sb = sa;
#pragma unroll
                for (int s = 0; s < 8; ++s) { sa = __builtin_amdgcn_mfma_f32_16x16x32_bf16(ca[s], ql[s], sa, 0, 0, 0); sb = __builtin_amdgcn_mfma_f32_16x16x32_bf16(cb[s], ql[s], sb, 0, 0, 0); }
                const u32x2 ja = *(const LAS u32x2*)(IDX + 32 * st + 4 * g), jb = *(const LAS u32x2*)(IDX + 32 * st + 16 + 4 * g);
                const int da0 = t - (int)(ja.x & 0xffff), da1 = t - (int)(ja.x >> 16), da2 = t - (int)(ja.y & 0xffff), da3 = t - (int)(ja.y >> 16);
                const int db0 = t - (int)(jb.x & 0xffff), db1 = t - (int)(jb.x >> 16), db2 = t - (int)(jb.y & 0xffff), db3 = t - (int)(jb.y >> 16);
                sa[0] = sa[0] * SCL - slope2 * (float)(da0 < 0 ? -da0 : da0); sa[1] = sa[1] * SCL - slope2 * (float)(da1 < 0 ? -da1 : da1);
                sa[2] = sa[2] * SCL - slope2 * (float)(da2 < 0 ? -da2 : da2); sa[3] = sa[3] * SCL - slope2 * (float)(da3 < 0 ? -da3 : da3);
                sb[0] = sb[0] * SCL - slope2 * (float)(db0 < 0 ? -db0 : db0); sb[1] = sb[1] * SCL - slope2 * (float)(db1 < 0 ? -db1 : db1);
                sb[2] = sb[2] * SCL - slope2 * (float)(db2 < 0 ? -db2 : db2); sb[3] = sb[3] * SCL - slope2 * (float)(db3 < 0 ? -db3 : db3);
                float mx = fmaxf(fmaxf(fmaxf(sa[0], sa[1]), fmaxf(sa[2], sa[3])), fmaxf(fmaxf(sb[0], sb[1]), fmaxf(sb[2], sb[3])));
                mx = fmaxf(mx, __shfl_xor(mx, 16)); mx = fmaxf(mx, __shfl_xor(mx, 32));
                float alpha = 1.0f;
                if (__any(mx > m + 8.0f)) { mx = fmaxf(mx, m); alpha = __builtin_amdgcn_exp2f(m - mx); m = mx;
#pragma unroll
                    for (int ct = 0; ct < 16; ++ct) o[ct] *= alpha; }
#pragma unroll
                for (int i = 0; i < 4; ++i) { sa[i] = __builtin_amdgcn_exp2f(sa[i] - m); sb[i] = __builtin_amdgcn_exp2f(sb[i] - m); }
                l = l * alpha + ((sa[0] + sa[1]) + (sa[2] + sa[3])) + ((sb[0] + sb[1]) + (sb[2] + sb[3]));
                union { bf16x8 v; unsigned u[4]; } pf;
                pf.u[0] = pk2(sa[0], sa[1]); pf.u[1] = pk2(sa[2], sa[3]); pf.u[2] = pk2(sb[0], sb[1]); pf.u[3] = pk2(sb[2], sb[3]);
#pragma unroll
                for (int s = 0; s < 8; ++s) {
                    const f32x4 z = (f32x4){0.f, 0.f, 0.f, 0.f};
                    const f32x4 ta0 = __builtin_amdgcn_mfma_f32_16x16x32_bf16(ca[s], sel0.v, z, 0, 0, 0), ta1 = __builtin_amdgcn_mfma_f32_16x16x32_bf16(ca[s], sel1.v, z, 0, 0, 0);
                    const f32x4 tb0 = __builtin_amdgcn_mfma_f32_16x16x32_bf16(cb[s], sel0.v, z, 0, 0, 0), tb1 = __builtin_amdgcn_mfma_f32_16x16x32_bf16(cb[s], sel1.v, z, 0, 0, 0);
                    union { bf16x8 v; unsigned u[4]; } v0, v1;
                    v0.u[0] = pk2(ta0[0], ta0[1]); v0.u[1] = pk2(ta0[2], ta0[3]); v0.u[2] = pk2(tb0[0], tb0[1]); v0.u[3] = pk2(tb0[2], tb0[3]);
                    v1.u[0] = pk2(ta1[0], ta1[1]); v1.u[1] = pk2(ta1[2], ta1[3]); v1.u[2] = pk2(tb1[0], tb1[1]); v1.u[3] = pk2(tb1[2], tb1[3]);
                    o[2 * s] = __builtin_amdgcn_mfma_f32_16x16x32_bf16(v0.v, pf.v, o[2 * s], 0, 0, 0);
                    o[2 * s + 1] = __builtin_amdgcn_mfma_f32_16x16x32_bf16(v1.v, pf.v, o[2 * s + 1], 0, 0, 0);
                }
            }
            l += __shfl_xor(l, 16); l += __shfl_xor(l, 32);
            const float inv = 1.0f / l;
            bf16* op = OLAT + row * 4096 + r16 * 256 + 4 * g;
#pragma unroll
            for (int ct = 0; ct < 16; ++ct) { u32x2 wv; wv.x = pk2(o[ct][0] * inv, o[ct][1] * inv); wv.y = pk2(o[ct][2] * inv, o[ct][3] * inv); *(u32x2*)(op + 16 * ct) = wv; }
        }
        CFENCE(); LDS_WAIT();
        }
    }
}
constexpr int PEER_WLDS = 2048 + 8192;
typedef int i32x8 __attribute__((ext_vector_type(8)));
typedef __bf16 bf16x2_d __attribute__((ext_vector_type(2)));
__device__ __forceinline__ float dot2bf(unsigned a, unsigned b, float c) { return __builtin_amdgcn_fdot2_f32_bf16(__builtin_bit_cast(bf16x2_d, a), __builtin_bit_cast(bf16x2_d, b), c, false); }
__device__ __forceinline__ f32x4 fp8x4(unsigned w) { const f32x2 lo = __builtin_amdgcn_cvt_pk_f32_fp8((int)w, false), hi = __builtin_amdgcn_cvt_pk_f32_fp8((int)w, true); return (f32x4){lo[0], lo[1], hi[0], hi[1]}; }
__device__ __forceinline__ float fp8dot4(unsigned w, f32x4 x) { const f32x4 f = fp8x4(w); return (f[0] * x[0] + f[1] * x[1]) + (f[2] * x[2] + f[3] * x[3]); }
#define DPPF(v, ctrl, rmask) __builtin_bit_cast(float, __builtin_amdgcn_update_dpp(0, __builtin_bit_cast(int, (v)), (ctrl), (rmask), 0xf, false))
__device__ __forceinline__ float wave_sum_u(float v) {
    v += DPPF(v, 0xB1, 0xf); v += DPPF(v, 0x4E, 0xf); v += DPPF(v, 0x141, 0xf); v += DPPF(v, 0x140, 0xf);
    v += DPPF(v, 0x142, 0xa); v += DPPF(v, 0x143, 0xc);
    return __builtin_bit_cast(float, __builtin_amdgcn_readlane(__builtin_bit_cast(int, v), 63));
}
template <int NV>
__device__ __forceinline__ void select16(const unsigned (&key)[NV], bool (&sel)[NV], int (&pos)[NV]) {
    unsigned T = 0u;
    for (int bit = 31; bit >= 0; --bit) { const unsigned cand = T | (1u << bit); int cnt = 0;
#pragma unroll
        for (int r = 0; r < NV; ++r) cnt += __builtin_popcountll(__ballot(key[r] >= cand));
        if (cnt >= PEER_TOPK) { T = cand; if (cnt == PEER_TOPK) break; } }
    int cgt = 0;
#pragma unroll
    for (int r = 0; r < NV; ++r) cgt += __builtin_popcountll(__ballot(key[r] > T));
    int rem = PEER_TOPK - cgt, base = 0;
#pragma unroll
    for (int r = 0; r < NV; ++r) { const bool gt = key[r] > T, eq = key[r] == T; const unsigned long long meq = __ballot(eq); const bool take = gt || (eq && lanes_below(meq) < rem);
        const unsigned long long msel = __ballot(take); sel[r] = take; pos[r] = base + lanes_below(msel);
        base += __builtin_popcountll(msel); const int ne = __builtin_popcountll(meq); rem -= (ne < rem ? ne : rem); }
}
__device__ __forceinline__ void p9_peer(Frame& F) {
    const int gw = F.bid * NWAVES + F.wave, NGW = F.G * NWAVES, lane = F.lane;
    LAS unsigned char* wb = F.lds + F.wave * PEER_WLDS;
    LAS float* tv = (LAS float*)wb; LAS int* ti = (LAS int*)(wb + 128); LAS float* cv = (LAS float*)(wb + 256); LAS int* cc = (LAS int*)(wb + 320); LAS int* eidx = (LAS int*)(wb + 512); LAS float* coef = (LAS float*)(wb + 1024); LAS float* su = (LAS float*)(wb + 1536);
    const float* S = WSP(float, WS_E); const bf16* H1B = WSP(bf16, WS_XB); const bf16* PLE = WSP(bf16, WS_PL); const unsigned char* UB = WSP(unsigned char, WS_UB); const unsigned char* VT = WSP(unsigned char, WS_VT); const float* SCL = WSP(float, WS_SCL);
    const float* g2 = INP(I_LN2G); const float* b2 = INP(I_LN2B);
    for (int tok = gw; tok < NTOK; tok += NGW) {
        const float* srow = S + (size_t)tok * 2048;
        LAS float* sl = (LAS float*)(wb + 2048);
#pragma unroll
        for (int j = 0; j < 8; ++j) *(LAS f32x4*)(sl + (j * 64 + lane) * 4) = *(const f32x4*)(srow + (j * 64 + lane) * 4);
        CFENCE(); LDS_WAIT();
#pragma unroll 1
        for (int h = 0; h < PEER_HEADS; ++h) {
#pragma unroll
            for (int side = 0; side < 2; ++side) { const float v0 = sl[(2 * h + side) * 128 + lane], v1 = sl[(2 * h + side) * 128 + 64 + lane];
                const unsigned key[2] = {f2key(v0), f2key(v1)}; bool sel[2]; int pos[2]; select16<2>(key, sel, pos);
                if (sel[0]) { tv[side * 16 + pos[0]] = v0; ti[side * 16 + pos[0]] = lane; }
                if (sel[1]) { tv[side * 16 + pos[1]] = v1; ti[side * 16 + pos[1]] = lane + 64; } }
            CFENCE(); LDS_WAIT();
            { const int i0 = lane >> 4, j = lane & 15; const float vj = tv[16 + j];
              const float c0 = tv[i0] + vj, c1 = tv[i0 + 4] + vj, c2 = tv[i0 + 8] + vj, c3 = tv[i0 + 12] + vj;
              const unsigned key[4] = {f2key(c0), f2key(c1), f2key(c2), f2key(c3)}; bool sel[4]; int pos[4]; select16<4>(key, sel, pos);
              if (sel[0]) { cv[pos[0]] = c0; cc[pos[0]] = lane; } if (sel[1]) { cv[pos[1]] = c1; cc[pos[1]] = lane + 64; }
              if (sel[2]) { cv[pos[2]] = c2; cc[pos[2]] = lane + 128; } if (sel[3]) { cv[pos[3]] = c3; cc[pos[3]] = lane + 192; } }
            CFENCE(); LDS_WAIT();
            { const float val = cv[lane & 15]; const int ci = cc[lane & 15]; float mx = val;
#pragma unroll
              for (int o = 1; o < 16; o <<= 1) mx = fmaxf(mx, __shfl_xor(mx, o));
              const float e = __expf(val - mx); float sm = e;
#pragma unroll
              for (int o = 1; o < 16; o <<= 1) sm += __shfl_xor(sm, o);
              if (lane < 16) { eidx[h * 16 + lane] = ti[ci >> 4] * 128 + ti[16 + (ci & 15)]; coef[h * 16 + lane] = e / sm; } }
            CFENCE(); LDS_WAIT();
        }
        { const int e0 = eidx[lane], e1 = eidx[lane + 64];
          const float s0 = SCL[e0], s1 = SCL[e1], t0 = SCL[N_EXPERTS + e0], t1 = SCL[N_EXPERTS + e1];
          su[lane] = s0; su[lane + 64] = s1; coef[lane] *= t0; coef[lane + 64] *= t1; }
        CFENCE(); LDS_WAIT();
        {
            u32x4 hb[2][3];
            u32x4 hx[2][4]; float mx = 0.f;
#pragma unroll
            for (int jj = 0; jj < 2; ++jj)
#pragma unroll
                for (int i = 0; i < 4; ++i) { hx[jj][i] = *(const u32x4*)(H1B + (size_t)tok * 4096 + (jj * 64 + lane) * 32 + 8 * i);
#pragma unroll
                    for (int k = 0; k < 4; ++k) mx = fmaxf(mx, fmaxf(fabsf(bflo(hx[jj][i][k])), fabsf(bfhi(hx[jj][i][k])))); }
            mx = wave_max(mx) * (1.0f / 6.0f);
            int eb = (int)((__builtin_bit_cast(unsigned, mx) + 0x007fffffu) >> 23); eb = eb < 1 ? 1 : (eb > 253 ? 253 : eb);
            const float sup = __builtin_bit_cast(float, (unsigned)(254 - eb) << 23), sdn = __builtin_bit_cast(float, (unsigned)eb << 23);
#pragma unroll
            for (int jj = 0; jj < 2; ++jj)
#pragma unroll
                for (int i = 0; i < 4; ++i) { unsigned w0 = 0u, w1 = 0u, w2 = 0u;
#define HDIG(k) { float x0 = bflo(hx[jj][i][k]) * sup, x1 = bfhi(hx[jj][i][k]) * sup; \
                      w0 = __builtin_amdgcn_cvt_scalef32_pk_fp4_f32(w0, x0, x1, 1.0f, k); f32x2 dq = __builtin_amdgcn_cvt_scalef32_pk_f32_fp4(w0, 1.0f, k); x0 = (x0 - dq[0]) * 4.0f; x1 = (x1 - dq[1]) * 4.0f; \
                      w1 = __builtin_amdgcn_cvt_scalef32_pk_fp4_f32(w1, x0, x1, 1.0f, k); dq = __builtin_amdgcn_cvt_scalef32_pk_f32_fp4(w1, 1.0f, k); x0 = (x0 - dq[0]) * 8.0f; x1 = (x1 - dq[1]) * 8.0f; \
                      w2 = __builtin_amdgcn_cvt_scalef32_pk_fp4_f32(w2, x0, x1, 1.0f, k); }
                    HDIG(0) HDIG(1) HDIG(2) HDIG(3)
#undef HDIG
                    hb[jj][0][i] = w0; hb[jj][1][i] = w1; hb[jj][2][i] = w2; }
            const int dsel = ((lane >> 4) == ((lane & 15) >> 2)) ? (lane & 3) : 4;
#define U_LOAD(R, MB) { _Pragma("unroll") for (int q = 0; q < 8; ++q) { const int e_ = __builtin_amdgcn_readfirstlane(eidx[8 * (MB) + q]); const u32x4* p = (const u32x4*)(UB + (size_t)e_ * 2048) + lane; R[q][0] = p[0]; R[q][1] = p[64]; } }
#define HB8(d) (i32x8){(int)hb[jj][d].x, (int)hb[jj][d].y, (int)hb[jj][d].z, (int)hb[jj][d].w, 0, 0, 0, 0}
#define U_COMP(R, MB) { float a[8]; const float sq = su[8 * (MB) + (lane & 7)]; \
                _Pragma("unroll") for (int q = 0; q < 8; ++q) { f32x4 c = (f32x4){0.f, 0.f, 0.f, 0.f}; \
                    _Pragma("unroll") for (int jj = 0; jj < 2; ++jj) { const i32x8 av = (i32x8){(int)R[q][jj].x, (int)R[q][jj].y, (int)R[q][jj].z, (int)R[q][jj].w, 0, 0, 0, 0}; \
                        c = __builtin_amdgcn_mfma_scale_f32_16x16x128_f8f6f4(av, HB8(0), c, 4, 4, 0, 0x7f7f7f7f, 0, 0x7f7f7f7f);     \
                        c = __builtin_amdgcn_mfma_scale_f32_16x16x128_f8f6f4(av, HB8(1), c, 4, 4, 0, 0x7f7f7f7f, 0, 0x7d7d7d7d);     \
                        c = __builtin_amdgcn_mfma_scale_f32_16x16x128_f8f6f4(av, HB8(2), c, 4, 4, 0, 0x7f7f7f7f, 0, 0x7a7a7a7a); }   \
                    float d = (dsel == 0) ? c[0] : 0.f; d = (dsel == 1) ? c[1] : d; d = (dsel == 2) ? c[2] : d; d = (dsel == 3) ? c[3] : d; \
                    a[q] = wave_sum_u(d); } \
                float z = a[0]; \
                _Pragma("unroll") for (int q = 1; q < 8; ++q) z = (lane == q) ? a[q] : z; \
                z *= sdn * sq; \
                const float act = 0.5f * z * (1.0f + erff(z * 0.70710678118654752f)); \
                if (lane < 8) coef[8 * (MB) + lane] *= act; }
            u32x4 ra[8][2], rb[8][2];
            U_LOAD(ra, 0)
#pragma unroll 1
            for (int mb = 0; mb < PEER_M / 8 - 2; mb += 2) {
                U_LOAD(rb, mb + 1)
                __builtin_amdgcn_sched_barrier(0);
                U_COMP(ra, mb)
                __builtin_amdgcn_sched_barrier(0);
                U_LOAD(ra, mb + 2)
                __builtin_amdgcn_sched_barrier(0);
                U_COMP(rb, mb + 1)
                __builtin_amdgcn_sched_barrier(0);
            }
            U_LOAD(rb, PEER_M / 8 - 1)
            __builtin_amdgcn_sched_barrier(0);
            U_COMP(ra, PEER_M / 8 - 2)
            __builtin_amdgcn_sched_barrier(0);
            U_COMP(rb, PEER_M / 8 - 1)
#undef U_LOAD
#undef U_COMP
#undef HB8
        }
        CFENCE(); LDS_WAIT();
        f32x2 y[32];
#pragma unroll
        for (int i = 0; i < 32; ++i) y[i] = (f32x2){0.f, 0.f};
#pragma unroll 1
        for (int mb = 0; mb < PEER_M / 8; ++mb) {
            u32x4 r[8][2]; float c[8];
#pragma unroll
            for (int q = 0; q < 8; ++q) { const int e = __builtin_amdgcn_readfirstlane(eidx[8 * mb + q]); c[q] = coef[8 * mb + q];
                const u32x4* p = (const u32x4*)(VT + (size_t)e * 2048) + lane; r[q][0] = p[0]; r[q][1] = p[64]; }
#pragma unroll
            for (int q = 0; q < 8; ++q)
#pragma unroll
                for (int jj = 0; jj < 2; ++jj)
#pragma unroll
                    for (int i = 0; i < 4; ++i) { const unsigned w = r[q][jj][i];
                        y[(4 * jj + i) * 4 + 0] += __builtin_amdgcn_cvt_scalef32_pk_f32_fp4(w, 1.0f, 0) * c[q]; y[(4 * jj + i) * 4 + 1] += __builtin_amdgcn_cvt_scalef32_pk_f32_fp4(w, 1.0f, 1) * c[q];
                        y[(4 * jj + i) * 4 + 2] += __builtin_amdgcn_cvt_scalef32_pk_f32_fp4(w, 1.0f, 2) * c[q]; y[(4 * jj + i) * 4 + 3] += __builtin_amdgcn_cvt_scalef32_pk_f32_fp4(w, 1.0f, 3) * c[q]; }
        }
        { const bf16* hr = H1B + (size_t)tok * 4096; const bf16* pr = PLE + (size_t)tok * 4096; float s = 0.f;
#pragma unroll
          for (int jj = 0; jj < 2; ++jj) {
#pragma unroll
              for (int i = 0; i < 4; ++i) { const int off = (jj * 64 + lane) * 32 + 8 * i; const int yb = (4 * jj + i) * 4;
                  const u32x4 hw = *(const u32x4*)(hr + off), pw = *(const u32x4*)(pr + off); const f32x4 h0 = (f32x4){bflo(hw.x), bfhi(hw.x), bflo(hw.y), bfhi(hw.y)}, h1 = (f32x4){bflo(hw.z), bfhi(hw.z), bflo(hw.w), bfhi(hw.w)}, p0 = (f32x4){bflo(pw.x), bfhi(pw.x), bflo(pw.y), bfhi(pw.y)}, p1 = (f32x4){bflo(pw.z), bfhi(pw.z), bflo(pw.w), bfhi(pw.w)};
                  y[yb][0] += h0[0] * ALPHA + p0[0]; y[yb][1] += h0[1] * ALPHA + p0[1]; y[yb + 1][0] += h0[2] * ALPHA + p0[2]; y[yb + 1][1] += h0[3] * ALPHA + p0[3];
                  y[yb + 2][0] += h1[0] * ALPHA + p1[0]; y[yb + 2][1] += h1[1] * ALPHA + p1[1]; y[yb + 3][0] += h1[2] * ALPHA + p1[2]; y[yb + 3][1] += h1[3] * ALPHA + p1[3];
                  s += (y[yb][0] + y[yb][1]) + (y[yb + 1][0] + y[yb + 1][1]) + (y[yb + 2][0] + y[yb + 2][1]) + (y[yb + 3][0] + y[yb + 3][1]); }
              CFENCE(); }
          const float mean = wave_sum(s) * (1.0f / 4096.0f); float q = 0.f;
#pragma unroll
          for (int i = 0; i < 32; ++i) { y[i] = y[i] - mean; q += y[i][0] * y[i][0] + y[i][1] * y[i][1]; }
          const float rstd = 1.0f / sqrtf(wave_sum(q) * (1.0f / 4096.0f) + LN_EPS);
          float* orow = OUTP() + (size_t)tok * 4096;
#pragma unroll
          for (int jj = 0; jj < 2; ++jj) {
#pragma unroll
              for (int i = 0; i < 4; ++i) { const int off = (jj * 64 + lane) * 32 + 8 * i; const int yb = (4 * jj + i) * 4;
                  const f32x4 g0 = *(const f32x4*)(g2 + off), g1 = *(const f32x4*)(g2 + off + 4), c0 = *(const f32x4*)(b2 + off), c1 = *(const f32x4*)(b2 + off + 4);
                  *(f32x4*)(orow + off) = (f32x4){y[yb][0] * rstd * g0[0] + c0[0], y[yb][1] * rstd * g0[1] + c0[1], y[yb + 1][0] * rstd * g0[2] + c0[2], y[yb + 1][1] * rstd * g0[3] + c0[3]};
                  *(f32x4*)(orow + off + 4) = (f32x4){y[yb + 2][0] * rstd * g1[0] + c1[0], y[yb + 2][1] * rstd * g1[1] + c1[1], y[yb + 3][0] * rstd * g1[2] + c1[2], y[yb + 3][1] * rstd * g1[3] + c1[3]}; }
              CFENCE(); } }
        CFENCE(); LDS_WAIT();
    }
}
#ifndef DBG_OUT
#define DBG_OUT 0
#endif
__device__ __forceinline__ void dbg_copy(Frame& F, int which) {
    const size_t gt = (size_t)F.bid * NTHREADS + F.tid, gs = (size_t)F.G * NTHREADS, n = (size_t)NTOK * 4096;
    for (size_t i = gt; i < n; i += gs) { const size_t t = i >> 12; const int c = (int)(i & 4095); float v = 0.f;
        if (which == 1) v = WSP(float, WS_F)[i];
        else if (which == 2) v = WSP(float, WS_E)[i];
        else if (which == 3) v = bf2f(WSP(bf16, WS_XB)[i]);
        else if (which == 4) v = (c < 2048) ? bf2f(WSP(bf16, WS_QA)[t * 2048 + c]) : bf2f(WSP(bf16, WS_OB)[t * 2048 + c - 2048]);
        else if (which == 5) v = bf2f(WSP(bf16, WS_OLAT)[i]);
        else if (which == 6) v = bf2f(WSP(bf16, WS_QLAT)[i]);
        else if (which == 7) v = (c < 2048) ? bf2f(WSP(bf16, WS_QIDX)[t * 2048 + c]) : bf2f(WSP(bf16, WS_KB)[t * 2048 + c - 2048]);
        else if (which == 8) v = bf2f(WSP(bf16, WS_F)[t * 8192 + c]);
        else if (which == 9) v = (c < 2048) ? WSP(float, WS_E)[t * 2048 + c] : bf2f(WSP(bf16, WS_PL)[t * 4096 + c]);
        OUTP()[i] = v; }
}

constexpr int N_PHASES = 10;
__global__ void __launch_bounds__(NTHREADS, 2) mk_fwd(Args args) {
    extern __shared__ __attribute__((aligned(16))) unsigned char lds_raw[];
    Frame F;
    F.lds = (LAS unsigned char*)lds_raw; F.tid = threadIdx.x; F.lane = F.tid & 63; F.wave = __builtin_amdgcn_readfirstlane(F.tid >> 6); F.G = gridDim.x; F.bid = blockIdx.x;
    unsigned* ctl = (unsigned*)(WSB() + WS_CTL);
    if (F.tid < 64) ((LAS unsigned*)(F.lds + LDSCTL_OFF))[F.tid] = 0u;
    __syncthreads();
    XcdBarrier bar; bar.bar = ctl + CW_BAR; bar.x = 0; bar.st = nullptr; bar.wave = F.wave;
    if (MK_N_LAUNCHES == 1) bar = xcd_barrier_post(ctl + CW_BAR, (volatile LAS unsigned*)(F.lds + LDSCTL_OFF));
    const int lo = args.ph_lo, hi = args.ph_hi;
#ifndef PROBE_DUP
#define PROBE_DUP -1
#endif
#define IN(k) (lo <= (k) && (k) < hi)
#define REP(k) for (int rep_ = 0; rep_ < ((k) == PROBE_DUP ? 2 : 1); ++rep_)
#define SEAM(k) do { if (IN(k) && IN((k) + 1)) xcd_barrier(bar); } while (0)
    LAS unsigned char* const ldsg = F.lds;
#define RELANE() do { const int l_ = fresh_lane(); F.lane = l_; F.tid = F.wave * 64 + l_; } while (0)

    if (IN(0)) { RELANE(); REP(0) p0_prologue(F); SEAM(0); }
    if (IN(1)) {
        { pg8::Gemm g{WSP(bf16, WS_X8), WSP(bf16, WS_W18), NTOK, N1M, D_MODEL / 2, D_MODEL / 2}; pg8::StaticOrder S; S.init(NTOK, N1M, F.G, F.bid);
          pg8::Epi1 E{WSP(bf16, WS_QA), WSP(bf16, WS_QIDX), WSP(bf16, WS_QB), WSP(bf16, WS_KB), WSP(bf16, WS_VB), WSP(bf16, WS_F), INP(I_BGATE), 0};
          pg8::gemm_phase<pg8::Epi1, pg8::StaticOrder, true, true, true>(ldsg, g, S, E, F.wave); }
        if (F.bid < 256) {
          const int ks = F.bid & 3, sp = (F.bid >> 2) & 1, spm = F.bid >> 3;
          pg8::Gemm g{WSP(bf16, WS_XB) + ks * 1024, WSP(bf16, WS_E) + (size_t)N1M * D_MODEL + ks * 1024, NTOK, 512, 1024, D_MODEL}; pg8::OneUnit S{spm, sp};
          pg8::EpiPart E{WSP(float, WS_PART) + (size_t)(ks * 2 + sp) * NTOK * 256};
          pg8::gemm_phase<pg8::EpiPart, pg8::OneUnit, true, true>(ldsg, g, S, E, F.wave); }
        { pg8::Gemm g{WSP(bf16, WS_PB), WSP(bf16, WS_WPLT), NTOK, D_MODEL, D_PLE, D_PLE}; pg8::StaticOrder S; S.init(NTOK, D_MODEL, F.G, F.bid);
          pg8::EpiBf16P E{WSP(bf16, WS_PL), D_MODEL};
          pg8::gemm_phase<pg8::EpiBf16P, pg8::StaticOrder, true, true>(ldsg, g, S, E, F.wave); }
        SEAM(1);
    }
    if (IN(2)) { RELANE(); REP(2) p2_small(F); SEAM(2); }
    if (IN(3)) { REP(3) { if (!(args.pad & 2)) p3_fox(F); __syncthreads(); if (!(args.pad & 1)) p3_dsa(F, args.pad); __syncthreads(); } SEAM(3); }
    if (IN(4)) { RELANE(); REP(4) p4_oa(F); SEAM(4); }
    if (IN(5)) {
        { pg8::Gemm g{WSP(bf16, WS_QA), WSP(bf16, WS_WBAT), NTOK, D_MODEL, 1024, 1024}; pg8::StaticOrder S; S.init(NTOK, D_MODEL, F.G, F.bid);
          pg8::Epi2a E{WSP(bf16, WS_F), WSP(bf16, WS_E), 1.0f / (Q8_O * Q8_WB)};
          pg8::gemm_phase<pg8::Epi2a, pg8::StaticOrder, true, true, true>(ldsg, g, S, E, F.wave); }
        { pg8::Gemm g{WSP(bf16, WS_OB), WSP(bf16, WS_WBBT), NTOK, D_MODEL, 1024, 1024}; pg8::StaticOrder S; S.init(NTOK, D_MODEL, F.G, F.bid);
          pg8::Epi2b E{WSP(bf16, WS_F), WSP(bf16, WS_E), WSP(bf16, WS_XB), 1.0f / (Q8_O * Q8_WB)};
          pg8::gemm_phase<pg8::Epi2b, pg8::StaticOrder, true, true, true>(ldsg, g, S, E, F.wave); }
        SEAM(5);
    }
    if (IN(6)) {
        pg8::Gemm g{WSP(bf16, WS_XB), WSP(bf16, WS_WOT), NTOK, D_MODEL, D_MODEL / 2, D_MODEL / 2}; pg8::StaticOrder S; S.init(NTOK, D_MODEL, F.G, F.bid);
        pg8::Epi3 E{INP(I_X), WSP(bf16, WS_E), ALPHA, 1.0f / (Q8_MG * Q8_WO)};
        pg8::gemm_phase<pg8::Epi3, pg8::StaticOrder, true, true, true>(ldsg, g, S, E, F.wave);
        SEAM(6);
    }
    if (IN(7)) { RELANE(); REP(7) p7_ln1(F); SEAM(7); }
    if (IN(8)) {
        { pg8::Gemm g{WSP(bf16, WS_X8), WSP(bf16, WS_W48), NTOK, N4, D_MODEL / 2, D_MODEL / 2}; pg8::StaticOrder S; S.init(NTOK, N4, F.G, F.bid);
          pg8::Epi4 E{WSP(float, WS_E), WSP(bf16, WS_PL), INP(I_BPG), 0};
          pg8::gemm_phase<pg8::Epi4, pg8::StaticOrder, true, true, true>(ldsg, g, S, E, F.wave); }
        SEAM(8);
    }
    if (IN(9)) { if (DBG_OUT) dbg_copy(F, DBG_OUT); else { RELANE(); REP(9) p9_peer(F); } }
#undef IN
#undef SEAM
}

extern "C" void kernel_launch(void* const* d_in, const int* in_sizes, int n_in, void* d_out, int out_size, void* d_ws, size_t ws_size, hipStream_t stream) {
    static int grid = 0;
    if (grid == 0) {
        if (n_in != 23 || out_size != NTOK * D_MODEL || ws_size < WS_END) { fprintf(stderr, "kernel_launch: unexpected problem (n_in %d, out %d, ws %zu); nothing launched\n", n_in, out_size, ws_size); grid = -1; return; }
        int dev = 0, cus = 0, per_cu = 0;
        if (hipGetDevice(&dev) != hipSuccess || hipDeviceGetAttribute(&cus, hipDeviceAttributeMultiprocessorCount, dev) != hipSuccess) { grid = -1; return; }
        if (hipFuncSetAttribute((const void*)mk_fwd, hipFuncAttributeMaxDynamicSharedMemorySize, LDS_BYTES) != hipSuccess) { fprintf(stderr, "kernel_launch: hipFuncSetAttribute failed\n"); grid = -1; return; }
        if (hipOccupancyMaxActiveBlocksPerMultiprocessor(&per_cu, (const void*)mk_fwd, NTHREADS, LDS_BYTES) != hipSuccess || per_cu < 1) { fprintf(stderr, "kernel_launch: occupancy query says %d\n", per_cu); (void)hipGetLastError(); grid = -1; return; }
        grid = cus;
    }
    if (grid < 0) return;
    if (hipMemsetAsync((char*)d_ws + WS_CTL, 0, CTL_ZERO_BYTES, stream) != hipSuccess) return;
    Args a{};
    for (int i = 0; i < 23; ++i) a.in[i] = (const float*)d_in[i];
    a.out = (float*)d_out; a.ws = (unsigned char*)d_ws;
    for (int li = 0; li < MK_N_LAUNCHES; ++li) {
#if DBG_OUT
        { const int lastp[10] = {9, 7, 6, 5, 4, 3, 2, 1, 1, 8}; if (MK_N_LAUNCHES > 1 && li > lastp[DBG_OUT] && li != 9) continue; }
#endif
        a.ph_lo = (MK_N_LAUNCHES == 1) ? 0 : li; a.ph_hi = (MK_N_LAUNCHES == 1) ? N_PHASES : li + 1; a.li = li; a.pad = 0;
#ifdef HOST_DUP
        if (MK_N_LAUNCHES > 1 && li == HOST_DUP) {
#ifdef HOST_DUP_PAD
            a.pad = HOST_DUP_PAD;
#endif
            hipLaunchKernelGGL(mk_fwd, dim3(grid), dim3(NTHREADS), LDS_BYTES, stream, a); a.pad = 0; }
#endif
        hipLaunchKernelGGL(mk_fwd, dim3(grid), dim3(NTHREADS), LDS_BYTES, stream, a);
    }
}
```

```cpp
#include <hip/hip_runtime.h>
#include <cstdio>
#include <cstdint>

#ifndef MK_N_LAUNCHES
#define MK_N_LAUNCHES 1
#endif

#define GAS __attribute__((address_space(1)))
#define LAS __attribute__((address_space(3)))
typedef unsigned short bf16;
typedef float f32x4 __attribute__((ext_vector_type(4)));
typedef float f32x2 __attribute__((ext_vector_type(2)));
typedef unsigned u32x4 __attribute__((ext_vector_type(4)));
typedef unsigned u32x2 __attribute__((ext_vector_type(2)));
typedef short bf16x8 __attribute__((ext_vector_type(8)));

constexpr int D_MODEL = 4096, BATCH = 4, SEQ = 2048, NTOK = BATCH * SEQ;
constexpr int A_HEADS = 16, A_HD = 128, A_LAT = 256, IDX_HEADS = 32, IDX_DIM = 64, TOPK = 256, CHUNK = 64;
constexpr int B_HEADS = 16, B_HD = 128;
constexpr int PEER_HEADS = 8, PEER_KEYS = 128, PEER_QDIM = 256, PEER_TOPK = 16, N_EXPERTS = PEER_KEYS * PEER_KEYS, PEER_M = PEER_HEADS * PEER_TOPK;
constexpr int D_PLE = 256;
constexpr int IN_WIDTH = 10608;
constexpr int N1 = 18944;
constexpr int N1M = 18432;
constexpr int N4 = 6144;
constexpr float LN_EPS = 1e-5f;
constexpr float ALPHA = 1.18920711500272f;

__device__ __forceinline__ unsigned f2bf(float f) { unsigned u = __builtin_bit_cast(unsigned, f); return (u + 0x7fffu + ((u >> 16) & 1u)) >> 16; }
typedef __bf16 bf16x2_n __attribute__((ext_vector_type(2)));
__device__ __forceinline__ unsigned pk2(float lo, float hi) { const bf16x2_n b = __builtin_convertvector((f32x2){lo, hi}, bf16x2_n); return __builtin_bit_cast(unsigned, b); }
__device__ __forceinline__ float bflo(unsigned w) { return __builtin_bit_cast(float, w << 16); }
__device__ __forceinline__ float bfhi(unsigned w) { return __builtin_bit_cast(float, w & 0xffff0000u); }
__device__ __forceinline__ float bf2f(bf16 b) { return __builtin_bit_cast(float, (unsigned)b << 16); }
__device__ __forceinline__ float sigmoidf_(float x) { return __builtin_amdgcn_rcpf(1.0f + __expf(-x)); }
__device__ __forceinline__ float wave_sum(float v) {
#pragma unroll
    for (int o = 1; o < 64; o <<= 1) v += __shfl_xor(v, o);
    return v;
}
__device__ __forceinline__ float wave_max(float v) {
#pragma unroll
    for (int o = 1; o < 64; o <<= 1) v = fmaxf(v, __shfl_xor(v, o));
    return v;
}
__device__ __forceinline__ int fresh_lane() { int l; asm volatile("v_mbcnt_lo_u32_b32 %0, -1, 0\n\tv_mbcnt_hi_u32_b32 %0, -1, %0" : "=v"(l)); return l; }
constexpr float Q8_ACT = 30.0f, Q8_W = 1920.0f;
constexpr float Q8_O = 21.0f, Q8_WB = 1368.0f;
constexpr float Q8_MG = 32.0f, Q8_WO = 3250.0f;
__device__ __forceinline__ unsigned pk_q8x4(float a, float b, float c, float d, float sc) {
    const int i0 = __float2int_rn(fminf(fmaxf(a * sc, -127.f), 127.f)), i1 = __float2int_rn(fminf(fmaxf(b * sc, -127.f), 127.f));
    const int i2 = __float2int_rn(fminf(fmaxf(c * sc, -127.f), 127.f)), i3 = __float2int_rn(fminf(fmaxf(d * sc, -127.f), 127.f));
    return (unsigned)(i0 & 255) | ((unsigned)(i1 & 255) << 8) | ((unsigned)(i2 & 255) << 16) | ((unsigned)i3 << 24); }
#define LDS_WAIT() asm volatile("s_waitcnt lgkmcnt(0)" ::: "memory")
#define VM_WAIT() asm volatile("s_waitcnt vmcnt(0)" ::: "memory")
#define CFENCE() asm volatile("" ::: "memory")
namespace pg8 {
#define PG8_LAS __attribute__((address_space(3)))
typedef unsigned short bf16_t;
typedef short bf16x8 __attribute__((ext_vector_type(8)));
typedef float f32x4 __attribute__((ext_vector_type(4)));
typedef unsigned u32x4 __attribute__((ext_vector_type(4)));
constexpr int BM = 256, BK = 64, HALF = 128, HTB = HALF * BK * 2  , STAGE_BYTES = 8 * HTB, NXCD = 8, WGM = 8;

__host__ __device__ __forceinline__ int lds_byte(int r, int c) { const int st = (r >> 4) * 2 + (c >> 5), rr = r & 15, cc = c & 31, ob = rr * 64 + cc * 2; return st * 1024 + (ob ^ (((ob >> 9) & 1) << 5)); }
__host__ __device__ __forceinline__ void stage_rc(int b, int& R, int& C) { const int st = b / 1024, sb = b % 1024, swz = sb ^ (((sb >> 9) & 1) << 5); R = (st >> 1) * 16 + swz / 64; C = (st & 1) * 32 + (swz % 64) / 2; }
__host__ __device__ __forceinline__ int perm32(int rho) { const int n = rho >> 4, i = rho & 15; return 8 * (i >> 2) + 4 * n + (i & 3); }

struct Unit { int pm, pn; };
struct Gemm { const bf16_t* A; const bf16_t* Bt; int M, N, K, ld; };

struct StaticOrder {
    int nM, nN, nwg, G, c;
    __host__ __device__ void init(int M, int N, int G_, int c_) { nM = M / BM; nN = N / BM; nwg = nM * nN; G = G_; c = c_; }
    __host__ __device__ bool next(int i, Unit& u) const {
        const long L = (long)i * G + c; if (L >= nwg) return false;
        int wgid = (int)L; { const int q = nwg / NXCD, r = nwg % NXCD, xcd = wgid % NXCD, off = wgid / NXCD; wgid = (xcd < r ? xcd * (q + 1) : r * (q + 1) + (xcd - r) * q) + off; }
        const int nig = WGM * nN, gid = wgid / nig, fm = gid * WGM, gsz = (nM - fm) < WGM ? (nM - fm) : WGM;
        u.pm = fm + ((wgid % nig) % gsz); u.pn = (wgid % nig) / gsz; return true;
    }
    __device__ __forceinline__ void a_ready(const Unit&) const {}
    __device__ __forceinline__ void done(const Unit&) const {}
};
typedef __bf16 bf16x2_nat __attribute__((ext_vector_type(2)));
__device__ __forceinline__ unsigned cvt_pk_bf16(float lo, float hi) { typedef float f2_ __attribute__((ext_vector_type(2))); const bf16x2_nat b = __builtin_convertvector((f2_){lo, hi}, bf16x2_nat); return __builtin_bit_cast(unsigned, b); }
typedef unsigned u32x2 __attribute__((ext_vector_type(2)));
__device__ __forceinline__ unsigned q8x4(float a, float b, float c, float d, float sc) {
    const int i0 = __float2int_rn(fminf(fmaxf(a * sc, -127.f), 127.f)), i1 = __float2int_rn(fminf(fmaxf(b * sc, -127.f), 127.f));
    const int i2 = __float2int_rn(fminf(fmaxf(c * sc, -127.f), 127.f)), i3 = __float2int_rn(fminf(fmaxf(d * sc, -127.f), 127.f));
    return (unsigned)(i0 & 255) | ((unsigned)(i1 & 255) << 8) | ((unsigned)(i2 & 255) << 16) | ((unsigned)i3 << 24); }
__device__ __forceinline__ float sigm(float x) { return __builtin_amdgcn_rcpf(1.0f + __expf(-x)); }
__device__ __forceinline__ float blo(unsigned w) { return __builtin_bit_cast(float, w << 16); }
__device__ __forceinline__ float bhi(unsigned w) { return __builtin_bit_cast(float, w & 0xffff0000u); }

struct Epi1 {
    static constexpr bool PERM = true, AFTER_DRAIN = false;
    bf16_t *QA, *QIDX, *QB, *KB, *VB, *G; const float* b_gate; int pn_off;
    __device__ __forceinline__ void operator()(const f32x4 (&acc)[2][2][4][2], const Unit& u, int wr, int wc, int fr, int fq) const {
        const int pn = u.pn + pn_off, row0 = u.pm * BM + wr * 64 + fr, cl = wc * 32 + 8 * fq;
        if (pn >= 40) {
            const int gc = (pn - 40) * 256 + cl;
            f32x4 bv[2][2];
#pragma unroll
            for (int bj = 0; bj < 2; ++bj)
#pragma unroll
                for (int n = 0; n < 2; ++n) bv[bj][n] = *(const f32x4*)(b_gate + gc + bj * HALF + 4 * n);
#pragma unroll
            for (int ai = 0; ai < 2; ++ai)
#pragma unroll
                for (int m = 0; m < 4; ++m) { bf16_t* rowp = G + (size_t)(row0 + ai * HALF + m * 16) * 8192 + gc;
#pragma unroll
                    for (int bj = 0; bj < 2; ++bj) { const f32x4 v0 = acc[ai][bj][m][0] * (1.0f / 57600.0f) + bv[bj][0], v1 = acc[ai][bj][m][1] * (1.0f / 57600.0f) + bv[bj][1];
                        u32x4 w; w.x = cvt_pk_bf16(sigm(v0[0]), sigm(v0[1])); w.y = cvt_pk_bf16(sigm(v0[2]), sigm(v0[3])); w.z = cvt_pk_bf16(sigm(v1[0]), sigm(v1[1])); w.w = cvt_pk_bf16(sigm(v1[2]), sigm(v1[3]));
                        *(u32x4*)(rowp + bj * HALF) = w; } }
        } else {
            bf16_t* dst; int c0;
            if (pn < 8) { dst = QA; c0 = pn; } else if (pn < 16) { dst = QIDX; c0 = pn - 8; } else if (pn < 24) { dst = QB; c0 = pn - 16; } else if (pn < 32) { dst = KB; c0 = pn - 24; } else { dst = VB; c0 = pn - 32; }
            c0 = c0 * 256 + cl;
#pragma unroll
            for (int ai = 0; ai < 2; ++ai)
#pragma unroll
                for (int m = 0; m < 4; ++m) { bf16_t* rowp = dst + (size_t)(row0 + ai * HALF + m * 16) * 2048 + c0;
#pragma unroll
                    for (int bj = 0; bj < 2; ++bj) { const f32x4 v0 = acc[ai][bj][m][0] * (1.0f / 57600.0f), v1 = acc[ai][bj][m][1] * (1.0f / 57600.0f);
                        u32x4 w; w.x = cvt_pk_bf16(v0[0], v0[1]); w.y = cvt_pk_bf16(v0[2], v0[3]); w.z = cvt_pk_bf16(v1[0], v1[1]); w.w = cvt_pk_bf16(v1[2], v1[3]);
                        *(u32x4*)(rowp + bj * HALF) = w; } }
        }
    }
};
struct OneUnit {
    int pm, pn;
    __device__ bool next(int i, Unit& u) const { if (i) return false; u.pm = pm; u.pn = pn; return true; }
    __device__ __forceinline__ void a_ready(const Unit&) const {}
    __device__ __forceinline__ void done(const Unit&) const {}
};
struct EpiPart {
    static constexpr bool PERM = true, AFTER_DRAIN = false;
    float* P;
    __device__ __forceinline__ void operator()(const f32x4 (&acc)[2][2][4][2], const Unit& u, int wr, int wc, int fr, int fq) const {
        const int row0 = u.pm * BM + wr * 64 + fr, cl = wc * 32 + 8 * fq;
#pragma unroll
        for (int ai = 0; ai < 2; ++ai)
#pragma unroll
            for (int m = 0; m < 4; ++m) { float* rowp = P + (size_t)(row0 + ai * HALF + m * 16) * 256 + cl;
#pragma unroll
                for (int bj = 0; bj < 2; ++bj) { *(f32x4*)(rowp + bj * HALF) = acc[ai][bj][m][0]; *(f32x4*)(rowp + bj * HALF + 4) = acc[ai][bj][m][1]; } }
    }
};
struct EpiBf16P {
    static constexpr bool PERM = true, AFTER_DRAIN = false;
    bf16_t* C; int ldc;
    __device__ __forceinline__ void operator()(const f32x4 (&acc)[2][2][4][2], const Unit& u, int wr, int wc, int fr, int fq) const {
        const int row0 = u.pm * BM + wr * 64 + fr, col0 = u.pn * BM + wc * 32 + 8 * fq;
#pragma unroll
        for (int ai = 0; ai < 2; ++ai)
#pragma unroll
            for (int m = 0; m < 4; ++m) { bf16_t* rowp = C + (size_t)(row0 + ai * HALF + m * 16) * ldc + col0;
#pragma unroll
                for (int bj = 0; bj < 2; ++bj) { const f32x4 v0 = acc[ai][bj][m][0], v1 = acc[ai][bj][m][1];
                    u32x4 w; w.x = cvt_pk_bf16(v0[0], v0[1]); w.y = cvt_pk_bf16(v0[2], v0[3]); w.z = cvt_pk_bf16(v1[0], v1[1]); w.w = cvt_pk_bf16(v1[2], v1[3]);
                    *(u32x4*)(rowp + bj * HALF) = w; }
                asm volatile("" ::: "memory"); }
    }
};
struct EpiF32P {
    static constexpr bool PERM = true, AFTER_DRAIN = false;
    float* C; int ldc;
    __device__ __forceinline__ void operator()(const f32x4 (&acc)[2][2][4][2], const Unit& u, int wr, int wc, int fr, int fq) const {
        const int row0 = u.pm * BM + wr * 64 + fr, col0 = u.pn * BM + wc * 32 + 8 * fq;
#pragma unroll
        for (int ai = 0; ai < 2; ++ai)
#pragma unroll
            for (int m = 0; m < 4; ++m) { float* rowp = C + (size_t)(row0 + ai * HALF + m * 16) * ldc + col0;
#pragma unroll
                for (int bj = 0; bj < 2; ++bj) { *(f32x4*)(rowp + bj * HALF) = acc[ai][bj][m][0]; *(f32x4*)(rowp + bj * HALF + 4) = acc[ai][bj][m][1]; } }
    }
};
struct Epi2a {
    static constexpr bool PERM = true, AFTER_DRAIN = false;
    const bf16_t* G; bf16_t* MGT; float sacc;
    __device__ __forceinline__ void operator()(const f32x4 (&acc)[2][2][4][2], const Unit& u, int wr, int wc, int fr, int fq) const {
        const int row0 = u.pm * BM + wr * 64 + fr, col0 = u.pn * BM + wc * 32 + 8 * fq;
#pragma unroll
        for (int ai = 0; ai < 2; ++ai)
#pragma unroll
            for (int m = 0; m < 4; ++m) { const size_t r = (size_t)(row0 + ai * HALF + m * 16);
#pragma unroll
                for (int bj = 0; bj < 2; ++bj) { const u32x4 g = *(const u32x4*)(G + r * 8192 + col0 + bj * HALF); const f32x4 v0 = acc[ai][bj][m][0] * sacc, v1 = acc[ai][bj][m][1] * sacc;
                    u32x4 w; w.x = cvt_pk_bf16(v0[0] * blo(g.x), v0[1] * bhi(g.x)); w.y = cvt_pk_bf16(v0[2] * blo(g.y), v0[3] * bhi(g.y)); w.z = cvt_pk_bf16(v1[0] * blo(g.z), v1[1] * bhi(g.z)); w.w = cvt_pk_bf16(v1[2] * blo(g.w), v1[3] * bhi(g.w));
                    *(u32x4*)(MGT + r * 4096 + col0 + bj * HALF) = w; }
                asm volatile("" ::: "memory"); }
    }
};
struct Epi2b {
    static constexpr bool PERM = true, AFTER_DRAIN = false;
    const bf16_t* G; const bf16_t* MGT; bf16_t* MG; float sacc;
    __device__ __forceinline__ void operator()(const f32x4 (&acc)[2][2][4][2], const Unit& u, int wr, int wc, int fr, int fq) const {
        const int row0 = u.pm * BM + wr * 64 + fr, col0 = u.pn * BM + wc * 32 + 8 * fq;
#pragma unroll
        for (int ai = 0; ai < 2; ++ai)
#pragma unroll
            for (int m = 0; m < 4; ++m) { const size_t r = (size_t)(row0 + ai * HALF + m * 16);
#pragma unroll
                for (int bj = 0; bj < 2; ++bj) { const u32x4 g = *(const u32x4*)(G + r * 8192 + 4096 + col0 + bj * HALF); const f32x4 v0 = acc[ai][bj][m][0] * sacc, v1 = acc[ai][bj][m][1] * sacc;
                    const u32x4 t = *(const u32x4*)(MGT + r * 4096 + col0 + bj * HALF);
                    u32x2 w; w.x = q8x4(blo(t.x) + v0[0] * blo(g.x), bhi(t.x) + v0[1] * bhi(g.x), blo(t.y) + v0[2] * blo(g.y), bhi(t.y) + v0[3] * bhi(g.y), 32.0f);
                    w.y = q8x4(blo(t.z) + v1[0] * blo(g.z), bhi(t.z) + v1[1] * bhi(g.z), blo(t.w) + v1[2] * blo(g.w), bhi(t.w) + v1[3] * bhi(g.w), 32.0f);
                    *(u32x2*)((unsigned char*)MG + r * 4096 + col0 + bj * HALF) = w; }
                asm volatile("" ::: "memory"); }
    }
};
struct Epi3 {
    static constexpr bool PERM = true, AFTER_DRAIN = false;
    const float* X; bf16_t* Y; float alpha, sacc;
    __device__ __forceinline__ void operator()(const f32x4 (&acc)[2][2][4][2], const Unit& u, int wr, int wc, int fr, int fq) const {
        const int row0 = u.pm * BM + wr * 64 + fr, col0 = u.pn * BM + wc * 32 + 8 * fq;
#pragma unroll
        for (int ai = 0; ai < 2; ++ai)
#pragma unroll
            for (int m = 0; m < 4; ++m) { const size_t off = (size_t)(row0 + ai * HALF + m * 16) * 4096 + col0;
#pragma unroll
                for (int bj = 0; bj < 2; ++bj) { const f32x4 x0 = *(const f32x4*)(X + off + bj * HALF), x1 = *(const f32x4*)(X + off + bj * HALF + 4);
                    const f32x4 y0 = x0 * alpha + acc[ai][bj][m][0] * sacc, y1 = x1 * alpha + acc[ai][bj][m][1] * sacc;
                    u32x4 w; w.x = cvt_pk_bf16(y0[0], y0[1]); w.y = cvt_pk_bf16(y0[2], y0[3]); w.z = cvt_pk_bf16(y1[0], y1[1]); w.w = cvt_pk_bf16(y1[2], y1[3]);
                    *(u32x4*)(Y + off + bj * HALF) = w; }
                asm volatile("" ::: "memory"); }
    }
};
struct Epi4 {
    static constexpr bool PERM = true, AFTER_DRAIN = false;
    float* PQ; bf16_t* PL; const float* b_pg; int pn_off;
    __device__ __forceinline__ void operator()(const f32x4 (&acc)[2][2][4][2], const Unit& u, int wr, int wc, int fr, int fq) const {
        const int row0 = u.pm * BM + wr * 64 + fr, cl = wc * 32 + 8 * fq, pn = u.pn + pn_off;
        if (pn < 8) {
#pragma unroll
            for (int ai = 0; ai < 2; ++ai)
#pragma unroll
                for (int m = 0; m < 4; ++m) { float* rowp = PQ + (size_t)(row0 + ai * HALF + m * 16) * 2048 + pn * 256 + cl;
#pragma unroll
                    for (int bj = 0; bj < 2; ++bj) { *(f32x4*)(rowp + bj * HALF) = acc[ai][bj][m][0] * (1.0f / 57600.0f); *(f32x4*)(rowp + bj * HALF + 4) = acc[ai][bj][m][1] * (1.0f / 57600.0f); } }
        } else {
            const int c0 = (pn - 8) * 256 + cl;
            f32x4 bv[2][2];
#pragma unroll
            for (int bj = 0; bj < 2; ++bj)
#pragma unroll
                for (int n = 0; n < 2; ++n) bv[bj][n] = *(const f32x4*)(b_pg + c0 + bj * HALF + 4 * n);
#pragma unroll
            for (int ai = 0; ai < 2; ++ai)
#pragma unroll
                for (int m = 0; m < 4; ++m) { bf16_t* rowp = PL + (size_t)(row0 + ai * HALF + m * 16) * 4096 + c0;
#pragma unroll
                    for (int bj = 0; bj < 2; ++bj) { const u32x4 p = *(const u32x4*)(rowp + bj * HALF);
                        const f32x4 v0 = acc[ai][bj][m][0] * (1.0f / 57600.0f) + bv[bj][0], v1 = acc[ai][bj][m][1] * (1.0f / 57600.0f) + bv[bj][1];
                        u32x4 w; w.x = cvt_pk_bf16(sigm(v0[0]) * blo(p.x), sigm(v0[1]) * bhi(p.x)); w.y = cvt_pk_bf16(sigm(v0[2]) * blo(p.y), sigm(v0[3]) * bhi(p.y));
                        w.z = cvt_pk_bf16(sigm(v1[0]) * blo(p.z), sigm(v1[1]) * bhi(p.z)); w.w = cvt_pk_bf16(sigm(v1[2]) * blo(p.w), sigm(v1[3]) * bhi(p.w));
                        *(u32x4*)(rowp + bj * HALF) = w; }
                    asm volatile("" ::: "memory"); }
        }
    }
};
typedef int pg8_i32x4 __attribute__((ext_vector_type(4)));
typedef int pg8_i32x8 __attribute__((ext_vector_type(8)));
__device__ __forceinline__ pg8_i32x8 cat8(bf16x8 lo, bf16x8 hi) { const pg8_i32x4 a = __builtin_bit_cast(pg8_i32x4, lo), b = __builtin_bit_cast(pg8_i32x4, hi); return __builtin_shufflevector(a, b, 0, 1, 2, 3, 4, 5, 6, 7); }
template <class Epi, class Sched, bool ALIGN_EPI = false, bool SP2 = false, bool F8 = false>
__device__ __forceinline__ void gemm_phase(PG8_LAS unsigned char* lds, const Gemm g, const Sched& S, const Epi& E, const int wave_id) {
    int tid_ = wave_id * 64 + fresh_lane();
    const int tid = tid_, wid = __builtin_amdgcn_readfirstlane(tid >> 6), lane = tid & 63, wr = wid >> 2, wc = wid & 3, fr = lane & 15, fq = lane >> 4;
    const int K = g.K, nt = K / BK, LD = g.ld;
    unsigned voffA, voffB;
    { int R, C; stage_rc(tid * 16, R, C); const int Rb = Epi::PERM ? ((R & ~31) + perm32(R & 31)) : R; voffA = (unsigned)(R * LD + C) * 2u; voffB = (unsigned)(Rb * LD + C) * 2u; }
    const size_t rstep = (size_t)64 * LD * 2;
    const size_t kstep = (size_t)(BK * 2);
    const size_t hstep = (size_t)HALF * LD * 2;
    const size_t tstep = 2 * hstep;
    const unsigned ldsw = (unsigned)wid * 1024u;
    const int aoff = lds_byte(wr * 64 + fr, fq * 8), boff = lds_byte(wc * 32 + fr, fq * 8);
#define PG8_SA(b, h) (((b) * 2 + (h)) * HTB)
#define PG8_SB(b, h) ((4 + (b) * 2 + (h)) * HTB)
#define PG8_STAGE(bufoff, gbase, voff) do { _Pragma("unroll") for (int _i = 0; _i < 2; ++_i) \
        __builtin_amdgcn_global_load_lds((const unsigned*)((const char*)(gbase) + _i * rstep + (voff)), (PG8_LAS unsigned*)(lds + (bufoff) + ldsw + _i * 8192), 16, 0, 0); } while (0)
#define PG8_LDA(dst, b, h) do { _Pragma("unroll") for (int m = 0; m < 4; ++m) _Pragma("unroll") for (int k = 0; k < 2; ++k) dst[m][k] = *(const PG8_LAS bf16x8*)(lds + PG8_SA(b, h) + aoff + m * 2048 + k * 1024); } while (0)
#define PG8_LDB(dst, b, h) do { _Pragma("unroll") for (int n = 0; n < 2; ++n) _Pragma("unroll") for (int k = 0; k < 2; ++k) dst[n][k] = *(const PG8_LAS bf16x8*)(lds + PG8_SB(b, h) + boff + n * 2048 + k * 1024); } while (0)
#define PG8_MMA(ai, bj, At, Bt) do { __builtin_amdgcn_s_setprio(1); _Pragma("unroll") for (int m = 0; m < 4; ++m) _Pragma("unroll") for (int n = 0; n < 2; ++n) { \
        _Pragma("unroll") for (int k = 0; k < 2; ++k) { \
            if constexpr (F8) acc[ai][bj][m][n] = __builtin_bit_cast(f32x4, __builtin_amdgcn_mfma_i32_16x16x64_i8(__builtin_bit_cast(pg8_i32x4, Bt[n][k]), __builtin_bit_cast(pg8_i32x4, At[m][k]), __builtin_bit_cast(pg8_i32x4, acc[ai][bj][m][n]), 0, 0, 0)); \
            else acc[ai][bj][m][n] = __builtin_amdgcn_mfma_f32_16x16x32_bf16(Bt[n][k], At[m][k], acc[ai][bj][m][n], 0, 0, 0); } } __builtin_amdgcn_s_setprio(0); } while (0)
#define PG8_WAIT_V(n) asm volatile("s_waitcnt vmcnt(" #n ")" ::: "memory")
#define PG8_WAIT_L(n) asm volatile("s_waitcnt lgkmcnt(" #n ")" ::: "memory")
#define PG8_BAR __builtin_amdgcn_s_barrier()
#define PG8_SCHED __builtin_amdgcn_sched_barrier(0)
    Unit cur, nxt; int ui = 0;
    if (!S.next(0, cur)) return;
    f32x4 acc[2][2][4][2];
#pragma unroll
    for (int a = 0; a < 2; ++a)
#pragma unroll
        for (int b = 0; b < 2; ++b)
#pragma unroll
            for (int m = 0; m < 4; ++m)
#pragma unroll
                for (int n = 0; n < 2; ++n) acc[a][b][m][n] = (f32x4){0.f, 0.f, 0.f, 0.f};
    bf16x8 At[4][2], B0[2][2], B1[2][2];
    const char* cA = (const char*)g.A + (size_t)cur.pm * tstep; const char* cB = (const char*)g.Bt + (size_t)cur.pn * tstep;
    S.a_ready(cur);
    if constexpr (SP2) {
        PG8_STAGE(PG8_SB(0, 0), cB, voffB); PG8_STAGE(PG8_SB(0, 1), cB + hstep, voffB); PG8_STAGE(PG8_SA(0, 0), cA, voffA); PG8_STAGE(PG8_SA(0, 1), cA + hstep, voffA);
        if (wr == 1) PG8_BAR;
        PG8_WAIT_V(2); PG8_BAR;
        PG8_STAGE(PG8_SB(1, 0), cB + kstep, voffB); PG8_STAGE(PG8_SA(1, 0), cA + kstep, voffA); PG8_STAGE(PG8_SB(1, 1), cB + hstep + kstep, voffB);
        PG8_WAIT_V(6); PG8_BAR;
    } else {
        PG8_STAGE(PG8_SB(0, 0), cB, voffB); PG8_STAGE(PG8_SA(0, 0), cA, voffA); PG8_STAGE(PG8_SB(0, 1), cB + hstep, voffB); PG8_STAGE(PG8_SA(0, 1), cA + hstep, voffA);
        if (wr == 1) PG8_BAR;
        PG8_WAIT_V(4); PG8_BAR;
        PG8_STAGE(PG8_SB(1, 0), cB + kstep, voffB); PG8_STAGE(PG8_SA(1, 0), cA + kstep, voffA); PG8_STAGE(PG8_SB(1, 1), cB + hstep + kstep, voffB);
        PG8_WAIT_V(6); PG8_BAR;
    }
    for (;;) {
        const bool has_next = S.next(ui + 1, nxt);
        const char* nA = has_next ? (const char*)g.A + (size_t)nxt.pm * tstep : cA; const char* nB = has_next ? (const char*)g.Bt + (size_t)nxt.pn * tstep : cB;
#pragma unroll 1
        for (int t = 0; t < nt; t += 2) {
            const bool last = (t == nt - 2);
            const char* a1 = cA + (size_t)(t + 1) * kstep;
            const char* a2 = last ? nA : cA + (size_t)(t + 2) * kstep; const char* b2 = last ? nB : cB + (size_t)(t + 2) * kstep;
            const char* a3 = a2 + kstep; const char* b3 = b2 + kstep;
            if (last && has_next) S.a_ready(nxt);
            if constexpr (SP2) {
            PG8_LDB(B0, 0, 0); PG8_LDB(B1, 0, 1); PG8_SCHED; PG8_LDA(At, 0, 0); PG8_STAGE(PG8_SA(1, 1), a1 + hstep, voffA);
            PG8_WAIT_V(8); PG8_WAIT_L(0); PG8_BAR; PG8_MMA(0, 0, At, B0); PG8_MMA(0, 1, At, B1); PG8_BAR; PG8_SCHED;
            PG8_LDA(At, 0, 1); PG8_STAGE(PG8_SB(0, 0), b2, voffB); PG8_STAGE(PG8_SB(0, 1), b2 + hstep, voffB); PG8_STAGE(PG8_SA(0, 0), a2, voffA);
            PG8_WAIT_V(8); PG8_WAIT_L(0); PG8_BAR; PG8_MMA(1, 0, At, B0); PG8_MMA(1, 1, At, B1); PG8_BAR; PG8_SCHED;
            PG8_LDB(B0, 1, 0); PG8_LDB(B1, 1, 1); PG8_SCHED; PG8_LDA(At, 1, 0); PG8_STAGE(PG8_SA(0, 1), a2 + hstep, voffA);
            PG8_WAIT_V(8); PG8_WAIT_L(0); PG8_BAR; PG8_MMA(0, 0, At, B0); PG8_MMA(0, 1, At, B1); PG8_BAR; PG8_SCHED;
            PG8_LDA(At, 1, 1); PG8_STAGE(PG8_SB(1, 0), b3, voffB); PG8_STAGE(PG8_SB(1, 1), b3 + hstep, voffB); PG8_STAGE(PG8_SA(1, 0), a3, voffA);
            PG8_WAIT_V(8); PG8_WAIT_L(0); PG8_BAR; PG8_MMA(1, 0, At, B0); PG8_MMA(1, 1, At, B1); PG8_BAR; PG8_SCHED;
            } else {
            PG8_LDB(B0, 0, 0); PG8_SCHED; PG8_LDA(At, 0, 0); PG8_STAGE(PG8_SA(1, 1), a1 + hstep, voffA);
            PG8_WAIT_L(8); PG8_BAR; PG8_WAIT_L(0); PG8_MMA(0, 0, At, B0); PG8_BAR; PG8_SCHED;
            PG8_LDB(B1, 0, 1); PG8_STAGE(PG8_SB(0, 0), b2, voffB);
            PG8_BAR; PG8_WAIT_L(0); PG8_MMA(0, 1, At, B1); PG8_BAR;
            PG8_LDA(At, 0, 1); PG8_STAGE(PG8_SA(0, 0), a2, voffA);
            PG8_BAR; PG8_WAIT_L(0); PG8_MMA(1, 0, At, B0); PG8_BAR; PG8_SCHED;
            PG8_STAGE(PG8_SB(0, 1), b2 + hstep, voffB);
            PG8_WAIT_V(6); PG8_BAR; PG8_MMA(1, 1, At, B1); PG8_BAR;
            PG8_LDB(B0, 1, 0); PG8_SCHED; PG8_LDA(At, 1, 0); PG8_STAGE(PG8_SA(0, 1), a2 + hstep, voffA);
            PG8_WAIT_L(8); PG8_BAR; PG8_WAIT_L(0); PG8_MMA(0, 0, At, B0); PG8_BAR; PG8_SCHED;
            PG8_LDB(B1, 1, 1); PG8_STAGE(PG8_SB(1, 0), b3, voffB);
            PG8_BAR; PG8_WAIT_L(0); PG8_MMA(0, 1, At, B1); PG8_BAR;
            PG8_LDA(At, 1, 1); PG8_STAGE(PG8_SA(1, 0), a3, voffA);
            PG8_BAR; PG8_WAIT_L(0); PG8_MMA(1, 0, At, B0); PG8_BAR; PG8_SCHED;
            PG8_STAGE(PG8_SB(1, 1), b3 + hstep, voffB);
            PG8_WAIT_V(6); PG8_BAR; PG8_MMA(1, 1, At, B1); PG8_BAR;
            }
        }
        if constexpr (ALIGN_EPI) { if (wr == 0) PG8_BAR; }
        if constexpr (F8) {
#pragma unroll
            for (int a = 0; a < 2; ++a)
#pragma unroll
                for (int b = 0; b < 2; ++b)
#pragma unroll
                    for (int m = 0; m < 4; ++m)
#pragma unroll
                        for (int n = 0; n < 2; ++n) { const pg8_i32x4 iv = __builtin_bit_cast(pg8_i32x4, acc[a][b][m][n]); acc[a][b][m][n] = (f32x4){(float)iv[0], (float)iv[1], (float)iv[2], (float)iv[3]}; } }
        if constexpr (!Epi::AFTER_DRAIN) { const int le = fresh_lane(); E(acc, cur, wr, wc, le & 15, le >> 4); S.done(cur); }
        if (!has_next) break;
#pragma unroll
        for (int a = 0; a < 2; ++a)
#pragma unroll
            for (int b = 0; b < 2; ++b)
#pragma unroll
                for (int m = 0; m < 4; ++m)
#pragma unroll
                    for (int n = 0; n < 2; ++n) acc[a][b][m][n] = (f32x4){0.f, 0.f, 0.f, 0.f};
        cur = nxt; cA = nA; cB = nB; ++ui;
        if constexpr (ALIGN_EPI) { if (wr == 1) PG8_BAR; }
    }
    PG8_WAIT_V(0);
    if constexpr (!ALIGN_EPI) { if (wr == 0) PG8_BAR; }
    PG8_BAR;
    if constexpr (Epi::AFTER_DRAIN) { E.fused(acc, cur, wr, wc, fr, fq, lds, wid, lane); S.done(cur); }
#undef PG8_SA
#undef PG8_SB
#undef PG8_STAGE
#undef PG8_LDA
#undef PG8_LDB
#undef PG8_MMA
#undef PG8_WAIT_V
#undef PG8_WAIT_L
#undef PG8_BAR
#undef PG8_SCHED
}
}

#define XB_TMO      128
#define XB_XCNT(j)  (256  + 64 * (j))
#define XB_XSUB(j)  (1280 + 64 * (j))
#define XB_XGEN(j)  (2304 + 64 * (j))
#define XB_TOP      3328
#define XB_TOPGEN   3392
#define XCD_BAR_WORDS 3456
#define XB_SPIN_CAP (1u << 18)

__device__ __forceinline__ unsigned xb_ld(unsigned* p)              { return __hip_atomic_load(p, __ATOMIC_RELAXED, __HIP_MEMORY_SCOPE_AGENT); }
__device__ __forceinline__ unsigned xb_add(unsigned* p, unsigned v) { return __hip_atomic_fetch_add(p, v, __ATOMIC_RELAXED, __HIP_MEMORY_SCOPE_AGENT); }
__device__ __forceinline__ unsigned xb_xcc_id() { return (unsigned)__builtin_amdgcn_s_getreg((3 << 11) | 20) & 0xFu; }
#define XB_SPIN(cond, bar) do { unsigned _sp = 0; while (cond) { __builtin_amdgcn_s_sleep(1); \
    if ((++_sp & 255u) == 0u) { if (xb_ld(&(bar)[XB_TMO])) break; if (_sp > XB_SPIN_CAP) { atomicAdd(&(bar)[XB_TMO], 1u); break; } } } } while (0)

struct XcdBarrier {
    unsigned* bar; unsigned x; int wave;
    volatile LAS unsigned* st;
};

__device__ __forceinline__ XcdBarrier xcd_barrier_post(unsigned* bar, volatile LAS unsigned* st) {
    XcdBarrier b; b.bar = bar; b.x = xb_xcc_id(); b.st = st; b.wave = __builtin_amdgcn_readfirstlane(threadIdx.x >> 6);
    if (threadIdx.x == 0) (void)xb_add(&bar[XB_XCNT(b.x)], 1u);
    return b;
}
__device__ __forceinline__ void xcd_barrier_complete(unsigned* bar, unsigned x, unsigned& nloc, unsigned& nx) {
    const unsigned G = gridDim.x * gridDim.y * gridDim.z;
    unsigned sum, cnt, mine, sp = 0u;
    for (;;) {
        sum = 0u; cnt = 0u; mine = 0u;
#pragma unroll
        for (unsigned j = 0; j < 16; ++j) { const unsigned c = xb_ld(&bar[XB_XCNT(j)]); sum += c; cnt += (c > 0u) ? 1u : 0u; mine = (j == x) ? c : mine; }
        if (sum == G) break;
        __builtin_amdgcn_s_sleep(1);
        if ((++sp & 255u) == 0u) { if (xb_ld(&bar[XB_TMO])) break; if (sp > XB_SPIN_CAP) { atomicAdd(&bar[XB_TMO], 1u); break; } }
    }
    nloc = mine > 0u ? mine : 1u; nx = cnt > 0u ? cnt : 1u;
}

__device__ __forceinline__ void xcd_barrier(const XcdBarrier& b) {
    asm volatile("s_waitcnt vmcnt(0)" ::: "memory");
    __syncthreads();
    if (b.wave == 0 && fresh_lane() == 0) {
        unsigned* bar = b.bar;
        __builtin_amdgcn_s_waitcnt(0);
        unsigned nloc = b.st[0], nx = b.st[1];
        if (nloc == 0u) { xcd_barrier_complete(bar, b.x, nloc, nx); b.st[0] = nloc; b.st[1] = nx; }
        const unsigned old = xb_add(&bar[XB_XSUB(b.x)], 1u);
        const unsigned gen = old / nloc;
        if (old + 1u == (gen + 1u) * nloc) {
            __builtin_amdgcn_fence(__ATOMIC_RELEASE, "agent");
            asm volatile("s_waitcnt vmcnt(0)" ::: "memory");
            const unsigned og = xb_add(&bar[XB_TOP], 1u);
            const unsigned tg = og / nx;
            if (og + 1u == (tg + 1u) * nx) xb_add(&bar[XB_TOPGEN], 1u);
            else XB_SPIN(xb_ld(&bar[XB_TOPGEN]) == tg, bar);
            __builtin_amdgcn_fence(__ATOMIC_ACQUIRE, "agent");
            xb_add(&bar[XB_XGEN(b.x)], 1u);
            asm volatile("s_waitcnt vmcnt(0)" ::: "memory");
        } else {
            XB_SPIN(xb_ld(&bar[XB_XGEN(b.x)]) == gen, bar);
            __builtin_amdgcn_fence(__ATOMIC_ACQUIRE, "agent");
            asm volatile("s_waitcnt vmcnt(0)" ::: "memory");
        }
    }
    __syncthreads();
}

constexpr size_t MiB = 1u << 20;
constexpr size_t WS_CTL = 0, CTL_ZERO_BYTES = 1 * MiB;
constexpr size_t WS_UB   = 1 * MiB;
constexpr size_t WS_VT   = WS_UB + 128 * MiB;
constexpr size_t WS_WBAT = WS_VT + 128 * MiB;
constexpr size_t WS_WBBT = WS_WBAT + 16 * MiB;
constexpr size_t WS_WOT  = WS_WBBT + 16 * MiB;
constexpr size_t WS_W4T  = WS_WOT + 32 * MiB;
constexpr size_t WS_WPLT = WS_W4T + 48 * MiB;
constexpr size_t WS_PB   = WS_WPLT + 2 * MiB;
constexpr size_t WS_XB   = WS_PB + 4 * MiB;
constexpr size_t WS_E    = WS_XB + 64 * MiB;
constexpr size_t WS_F    = WS_E + 148 * MiB;
constexpr size_t WS_QA   = WS_F + 128 * MiB;
constexpr size_t WS_QIDX = WS_QA + 32 * MiB;
constexpr size_t WS_QB   = WS_QIDX + 32 * MiB;
constexpr size_t WS_KB   = WS_QB + 32 * MiB;
constexpr size_t WS_VB   = WS_KB + 32 * MiB;
constexpr size_t WS_OB   = WS_VB + 32 * MiB;
constexpr size_t WS_CKV  = WS_OB + 32 * MiB;
constexpr size_t WS_SM   = WS_CKV + 8 * MiB;
constexpr size_t WS_CKVN = WS_SM + 8 * MiB;
constexpr size_t WS_CUM  = WS_CKVN + 4 * MiB;
constexpr size_t WS_PL   = WS_CUM + 1 * MiB;
constexpr size_t WS_WUKB = WS_PL + 128 * MiB;
constexpr size_t WS_WUVT = WS_WUKB + 1 * MiB;
constexpr size_t WS_KIDXB = WS_WUVT + 1 * MiB;
constexpr size_t WS_SCL = WS_KIDXB + 1 * MiB;
constexpr size_t WS_END  = WS_SCL + 1 * MiB;
constexpr size_t WS_PART = WS_UB + 64 * MiB;
constexpr size_t WS_X8   = WS_VT + 32 * MiB;
constexpr size_t WS_W18  = WS_E;
constexpr size_t WS_W48  = WS_VT + 64 * MiB;
constexpr size_t WS_WIDX = WS_SM;
constexpr size_t WS_QLAT = WS_E, WS_OLAT = WS_E + 64 * MiB;
static_assert(WS_END <= (size_t)1174 * MiB, "d_ws map");
constexpr int CW_BAR = 4096;

constexpr int NWAVES = 8, NTHREADS = 512;
constexpr int LDS_BYTES = 147456;
constexpr int LDSCTL_OFF = LDS_BYTES - 256;

typedef float f32x16 __attribute__((ext_vector_type(16)));
typedef short s16x4 __attribute__((ext_vector_type(4)));
template <int K>
__device__ __forceinline__ void small_gemm_tile(const bf16* A, int lda, const bf16* Bt, int ldb, bf16* C, int ldc, int lane, unsigned char* C8 = nullptr, float sc8 = 1.0f) {
    const int r = lane & 15, g = lane >> 4;
    f32x4 acc[4][4];
#pragma unroll
    for (int a = 0; a < 4; ++a)
#pragma unroll
        for (int b = 0; b < 4; ++b) acc[a][b] = (f32x4){0.f, 0.f, 0.f, 0.f};
    const bf16* ap = A + (size_t)r * lda + 8 * g; const bf16* bp = Bt + (size_t)r * ldb + 8 * g;
#pragma unroll 2
    for (int s = 0; s < K / 32; ++s) {
        bf16x8 af[4], bfr[4];
#pragma unroll
        for (int i = 0; i < 4; ++i) { af[i] = *(const bf16x8*)(ap + (size_t)(16 * i) * lda + 32 * s); bfr[i] = *(const bf16x8*)(bp + (size_t)(16 * i) * ldb + 32 * s); }
#pragma unroll
        for (int ni = 0; ni < 4; ++ni)
#pragma unroll
            for (int ti = 0; ti < 4; ++ti) acc[ni][ti] = __builtin_amdgcn_mfma_f32_16x16x32_bf16(bfr[ni], af[ti], acc[ni][ti], 0, 0, 0);
    }
#pragma unroll
    for (int ni = 0; ni < 4; ++ni)
#pragma unroll
        for (int ti = 0; ti < 4; ++ti) {
            if (C8) { *(unsigned*)(C8 + (size_t)(16 * ti + r) * ldc + 16 * ni + 4 * g) = pk_q8x4(acc[ni][ti][0], acc[ni][ti][1], acc[ni][ti][2], acc[ni][ti][3], sc8); continue; }
            u32x2 wv; wv.x = pk2(acc[ni][ti][0], acc[ni][ti][1]); wv.y = pk2(acc[ni][ti][2], acc[ni][ti][3]);
            *(u32x2*)(C + (size_t)(16 * ti + r) * ldc + 16 * ni + 4 * g) = wv; }
}
__device__ __forceinline__ bf16x8 ld8_f32_bf16(const float* p) { const f32x4 a = *(const f32x4*)p, b = *(const f32x4*)(p + 4); union { bf16x8 v; unsigned u[4]; } r; r.u[0] = pk2(a[0], a[1]); r.u[1] = pk2(a[2], a[3]); r.u[2] = pk2(b[0], b[1]); r.u[3] = pk2(b[2], b[3]); return r.v; }
template <int K>
__device__ __forceinline__ void small_gemm_tile_f32(const float* A, int lda, const float* Bt, int ldb, bf16* C, int ldc, int lane, unsigned char* C8 = nullptr) {
    const int r = lane & 15, g = lane >> 4;
    f32x4 acc[4][4];
#pragma unroll
    for (int a = 0; a < 4; ++a)
#pragma unroll
        for (int b = 0; b < 4; ++b) acc[a][b] = (f32x4){0.f, 0.f, 0.f, 0.f};
    const float* ap = A + (size_t)r * lda + 8 * g; const float* bp = Bt + (size_t)r * ldb + 8 * g;
#pragma unroll 1
    for (int s = 0; s < K / 32; ++s) {
        bf16x8 af[4], bfr[4];
#pragma unroll
        for (int i = 0; i < 4; ++i) { af[i] = ld8_f32_bf16(ap + (size_t)(16 * i) * lda + 32 * s); bfr[i] = ld8_f32_bf16(bp + (size_t)(16 * i) * ldb + 32 * s); }
#pragma unroll
        for (int ni = 0; ni < 4; ++ni)
#pragma unroll
            for (int ti = 0; ti < 4; ++ti) acc[ni][ti] = __builtin_amdgcn_mfma_f32_16x16x32_bf16(bfr[ni], af[ti], acc[ni][ti], 0, 0, 0);
    }
#pragma unroll
    for (int ni = 0; ni < 4; ++ni)
#pragma unroll
        for (int ti = 0; ti < 4; ++ti) { u32x2 wv; wv.x = pk2(acc[ni][ti][0], acc[ni][ti][1]); wv.y = pk2(acc[ni][ti][2], acc[ni][ti][3]);
            *(u32x2*)(C + (size_t)(16 * ti + r) * ldc + 16 * ni + 4 * g) = wv;
            if (C8) *(unsigned*)(C8 + (size_t)(16 * ti + r) * ldc + 16 * ni + 4 * g) = pk_q8x4(acc[ni][ti][0], acc[ni][ti][1], acc[ni][ti][2], acc[ni][ti][3], Q8_W); }
}
struct Args { const float* in[23]; float* out; unsigned char* ws; int ph_lo, ph_hi, li, pad; };
enum InIdx { I_X = 0, I_P, I_WIN, I_BFORGET, I_GLAT, I_WUK, I_WUV, I_WBA, I_WBB, I_WGATE, I_BGATE, I_WOUT, I_LN1G, I_LN1B, I_PWQ, I_PSUB, I_PU, I_PV, I_WPLE, I_WPG, I_BPG, I_LN2G, I_LN2B };

struct Frame {
    LAS unsigned char* lds;
    int tid, lane, wave, G, bid;
};
#define KARGQ ((const __attribute__((address_space(4))) unsigned long long*)__builtin_amdgcn_kernarg_segment_ptr())
#define INP(i) ((const float*)(const GAS float*)KARGQ[(i)])
#define OUTP() ((float*)(GAS float*)KARGQ[23])
#define WSB() ((unsigned char*)(GAS unsigned char*)KARGQ[24])
#define WSP(T, off) ((T*)(WSB() + (off)))

__device__ __forceinline__ void transpose_item(const float* W, int ldw, int src_col, int ncols, int k0, bf16* WT, int K, int dst_row0, LAS float* scr, int lane) {
    const int c = lane & 31;
    float tmp[32];
    const float* wp = W + (size_t)(k0 + (lane >> 5)) * ldw + src_col + c;
#pragma unroll
    for (int i = 0; i < 32; ++i) tmp[i] = (c < ncols) ? wp[(size_t)(2 * i) * ldw] : 0.f;
#pragma unroll
    for (int i = 0; i < 32; ++i) scr[(2 * i + (lane >> 5)) * 33 + c] = tmp[i];
    LDS_WAIT();
    const int c8 = lane & 7;
#pragma unroll
    for (int j = 0; j < 4; ++j) { const int n = (lane >> 3) + 8 * j; const LAS float* s = scr + (8 * c8) * 33 + n;
        u32x4 o; o.x = pk2(s[0 * 33], s[1 * 33]); o.y = pk2(s[2 * 33], s[3 * 33]); o.z = pk2(s[4 * 33], s[5 * 33]); o.w = pk2(s[6 * 33], s[7 * 33]);
        *(u32x4*)(WT + (size_t)(dst_row0 + n) * K + k0 + 8 * c8) = o; }
    LDS_WAIT();
}
__device__ __forceinline__ void transpose_item_q8(const float* W, int ldw, int src_col, int k0, unsigned char* WT8, int K, int dst_row0, float sc, LAS float* scr, int lane) {
    const int c = lane & 31;
    float tmp[32];
    const float* wp = W + (size_t)(k0 + (lane >> 5)) * ldw + src_col + c;
#pragma unroll
    for (int i = 0; i < 32; ++i) tmp[i] = wp[(size_t)(2 * i) * ldw];
#pragma unroll
    for (int i = 0; i < 32; ++i) scr[(2 * i + (lane >> 5)) * 33 + c] = tmp[i];
    LDS_WAIT();
    const int c8 = lane & 7;
#pragma unroll
    for (int j = 0; j < 4; ++j) { const int n = (lane >> 3) + 8 * j; const LAS float* s = scr + (8 * c8) * 33 + n;
        u32x2 o; o.x = pk_q8x4(s[0 * 33], s[1 * 33], s[2 * 33], s[3 * 33], sc); o.y = pk_q8x4(s[4 * 33], s[5 * 33], s[6 * 33], s[7 * 33], sc);
        *(u32x2*)(WT8 + (size_t)(dst_row0 + n) * K + k0 + 8 * c8) = o; }
    LDS_WAIT();
}
__device__ __forceinline__ void cvt_bf16_stream(const float* src, bf16* dst, size_t n8, size_t gt, size_t gstride) {
    size_t i = gt;
    for (; i + 3 * gstride < n8; i += 4 * gstride) {
        f32x4 a[4], b[4];
#pragma unroll
        for (int u = 0; u < 4; ++u) { a[u] = *(const f32x4*)(src + (i + u * gstride) * 8); b[u] = *(const f32x4*)(src + (i + u * gstride) * 8 + 4); }
#pragma unroll
        for (int u = 0; u < 4; ++u) { u32x4 o; o.x = pk2(a[u][0], a[u][1]); o.y = pk2(a[u][2], a[u][3]); o.z = pk2(b[u][0], b[u][1]); o.w = pk2(b[u][2], b[u][3]); *(u32x4*)(dst + (i + u * gstride) * 8) = o; } }
    for (; i < n8; i += gstride) { const f32x4 a = *(const f32x4*)(src + i * 8), b = *(const f32x4*)(src + i * 8 + 4);
        u32x4 o; o.x = pk2(a[0], a[1]); o.y = pk2(a[2], a[3]); o.z = pk2(b[0], b[1]); o.w = pk2(b[2], b[3]); *(u32x4*)(dst + i * 8) = o; }
}
__device__ __forceinline__ void p0_prologue(Frame& F) {
    LAS float* scr = (LAS float*)(F.lds + F.wave * 16384);
    const int gw = F.bid * NWAVES + F.wave, NGW = F.G * NWAVES;
    const float* w_in = INP(I_WIN); const float* w_gate = INP(I_WGATE);
    constexpr int NDB1 = N1 / 32, I_1 = NDB1 * 64;
    constexpr int I_BA = 128 * 32, I_BB = I_BA, I_O = 128 * 64, I_4 = 128 * 64, I_PL = 128 * 4;
    constexpr int NITEMS = I_1 + I_BA + I_BB + I_O + I_4 + I_PL;
    for (int it = gw; it < NITEMS; it += NGW) {
        int r = it;
        if (r < I_1) { const int kb = r / NDB1, db = r % NDB1; const float* W; int ldw, col, nc;
            if (db < 576) {
                if (db < 64) { W = w_in; ldw = IN_WIDTH; col = db * 32; }
                else if (db < 128) { W = w_in; ldw = IN_WIDTH; col = 2304 + (db - 64) * 32; }
                else if (db < 320) { W = w_in; ldw = IN_WIDTH; col = 4448 + (db - 128) * 32; }
                else { W = w_gate; ldw = 8192; col = (db - 320) * 32; }
                transpose_item_q8(W, ldw, col, kb * 64, WSP(unsigned char, WS_W18), 4096, db * 32, Q8_W, scr, F.lane); continue; }
            else if (db < 584) { W = w_in; ldw = IN_WIDTH; col = 2048 + (db - 576) * 32; nc = 32; }
            else { const int j = db - 584; W = w_in; ldw = IN_WIDTH; col = (j < 2) ? 4352 + 32 * j : (j == 2 ? 4416 : 10592); nc = (j < 3) ? 32 : (j == 3 ? 16 : 0); }
            transpose_item(W, ldw, col, nc, kb * 64, WSP(bf16, WS_E), 4096, db * 32, scr, F.lane); continue; }
        r -= I_1;
        if (r < I_BA) { const int kb = r / 128, db = r % 128; transpose_item_q8(INP(I_WBA), 4096, db * 32, kb * 64, WSP(unsigned char, WS_WBAT), 2048, db * 32, Q8_WB, scr, F.lane); continue; }
        r -= I_BA;
        if (r < I_BB) { const int kb = r / 128, db = r % 128; transpose_item_q8(INP(I_WBB), 4096, db * 32, kb * 64, WSP(unsigned char, WS_WBBT), 2048, db * 32, Q8_WB, scr, F.lane); continue; }
        r -= I_BB;
        if (r < I_O) { const int kb = r / 128, db = r % 128; transpose_item_q8(INP(I_WOUT), 4096, db * 32, kb * 64, WSP(unsigned char, WS_WOT), 4096, db * 32, Q8_WO, scr, F.lane); continue; }
        r -= I_O;
        if (r < I_4) { const int kb = r / 128, db = r % 128;
            transpose_item_q8(INP(I_WPG), 4096, db * 32, kb * 64, WSP(unsigned char, WS_W48), 4096, 2048 + db * 32, Q8_W, scr, F.lane); continue; }
        r -= I_4;
        { const int kb = r / 128, db = r % 128; transpose_item(INP(I_WPLE), 4096, db * 32, 32, kb * 64, WSP(bf16, WS_WPLT), 256, db * 32, scr, F.lane); }
    }
    for (int it = gw; it < 16 * 2 * 64; it += NGW) { const int dt = it & 63, nt = (it >> 6) & 1, l = it >> 7;
        small_gemm_tile_f32<128>(INP(I_PSUB) + (size_t)(l * 128 + nt * 64) * 128, 128, INP(I_PWQ) + (size_t)(dt * 64) * 2048 + (l >> 1) * 256 + (l & 1) * 128, 2048,
                                 WSP(bf16, WS_W4T) + (size_t)(l * 128 + nt * 64) * 4096 + dt * 64, 4096, F.lane, WSP(unsigned char, WS_W48) + (size_t)(l * 128 + nt * 64) * 4096 + dt * 64); }
    const size_t gt = (size_t)F.bid * NTHREADS + F.tid, gs = (size_t)F.G * NTHREADS;
    { const float* src = INP(I_X); bf16* dst = WSP(bf16, WS_XB); unsigned char* d8 = WSP(unsigned char, WS_X8); const size_t n8 = (size_t)NTOK * D_MODEL / 8;
      for (size_t i = gt; i < n8; i += 4 * gs) {
          if (i + 3 * gs >= n8) { for (size_t j = i; j < n8; j += gs) { const f32x4 a = *(const f32x4*)(src + j * 8), b = *(const f32x4*)(src + j * 8 + 4);
                  u32x4 o; o.x = pk2(a[0], a[1]); o.y = pk2(a[2], a[3]); o.z = pk2(b[0], b[1]); o.w = pk2(b[2], b[3]); *(u32x4*)(dst + j * 8) = o;
                  u32x2 q; q.x = pk_q8x4(a[0], a[1], a[2], a[3], Q8_ACT); q.y = pk_q8x4(b[0], b[1], b[2], b[3], Q8_ACT); *(u32x2*)(d8 + j * 8) = q; } break; }
          f32x4 a[4], b[4];
#pragma unroll
          for (int u = 0; u < 4; ++u) { a[u] = *(const f32x4*)(src + (i + u * gs) * 8); b[u] = *(const f32x4*)(src + (i + u * gs) * 8 + 4); }
#pragma unroll
          for (int u = 0; u < 4; ++u) { u32x4 o; o.x = pk2(a[u][0], a[u][1]); o.y = pk2(a[u][2], a[u][3]); o.z = pk2(b[u][0], b[u][1]); o.w = pk2(b[u][2], b[u][3]); *(u32x4*)(dst + (i + u * gs) * 8) = o;
              u32x2 q; q.x = pk_q8x4(a[u][0], a[u][1], a[u][2], a[u][3], Q8_ACT); q.y = pk_q8x4(b[u][0], b[u][1], b[u][2], b[u][3], Q8_ACT); *(u32x2*)(d8 + (i + u * gs) * 8) = q; } } }
    cvt_bf16_stream(INP(I_P), WSP(bf16, WS_PB), (size_t)NTOK * D_PLE / 8, gt, gs);
    { float* SCL = WSP(float, WS_SCL);
      for (int row = gw; row < 2 * N_EXPERTS; row += NGW) { const int tb = row >= N_EXPERTS ? 1 : 0, e = row - tb * N_EXPERTS;
          const float* src = (tb ? INP(I_PV) : INP(I_PU)) + (size_t)e * 4096; unsigned char* dst = (tb ? WSP(unsigned char, WS_VT) : WSP(unsigned char, WS_UB)) + (size_t)e * 2048;
          f32x4 v[16]; float ssq = 0.f;
#pragma unroll
          for (int jj = 0; jj < 2; ++jj)
#pragma unroll
              for (int q = 0; q < 8; ++q) { const f32x4 x = *(const f32x4*)(src + (jj * 64 + F.lane) * 32 + 4 * q); v[8 * jj + q] = x; ssq += (x[0] * x[0] + x[1] * x[1]) + (x[2] * x[2] + x[3] * x[3]); }
          const float sig = sqrtf(wave_sum(ssq) * (1.0f / 4096.0f)); const float inv = sig > 0.f ? 2.1f / sig : 0.f;
#pragma unroll
          for (int jj = 0; jj < 2; ++jj) { u32x4 o;
#pragma unroll
              for (int i = 0; i < 4; ++i) { const f32x4 a = v[8 * jj + 2 * i] * inv, b = v[8 * jj + 2 * i + 1] * inv; unsigned p = 0u;
                  p = __builtin_amdgcn_cvt_scalef32_pk_fp4_f32(p, a[0], a[1], 1.0f, 0); p = __builtin_amdgcn_cvt_scalef32_pk_fp4_f32(p, a[2], a[3], 1.0f, 1);
                  p = __builtin_amdgcn_cvt_scalef32_pk_fp4_f32(p, b[0], b[1], 1.0f, 2); p = __builtin_amdgcn_cvt_scalef32_pk_fp4_f32(p, b[2], b[3], 1.0f, 3); o[i] = p; }
              *(u32x4*)(dst + (jj * 64 + F.lane) * 16) = o; }
          if (F.lane == 0) SCL[row] = sig > 0.f ? sig * (1.0f / 2.1f) : 1.0f; } }
    { const float* w_uk = INP(I_WUK); const float* w_uv = INP(I_WUV); bf16* WUKB = WSP(bf16, WS_WUKB); bf16* WUVT = WSP(bf16, WS_WUVT);
      for (size_t i = gt; i < 65536; i += gs) { const int d8 = (int)(i & 15), c = (int)(i >> 4) & 255, h = (int)(i >> 12);
          const float* src = w_uk + (size_t)c * 2048 + h * 128 + d8 * 8; const f32x4 a = *(const f32x4*)src, b = *(const f32x4*)(src + 4);
          u32x4 o; o.x = pk2(a[0], a[1]); o.y = pk2(a[2], a[3]); o.z = pk2(b[0], b[1]); o.w = pk2(b[2], b[3]); *(u32x4*)(WUKB + i * 8) = o; }
      for (size_t i = gt; i < 65536; i += gs) { const int c8 = (int)(i & 31), d = (int)(i >> 5) & 127, h = (int)(i >> 12);
          const float* src = w_uv + (size_t)(c8 * 8) * 2048 + h * 128 + d;
          u32x4 o; o.x = pk2(src[0], src[2048]); o.y = pk2(src[2 * 2048], src[3 * 2048]); o.z = pk2(src[4 * 2048], src[5 * 2048]); o.w = pk2(src[6 * 2048], src[7 * 2048]); *(u32x4*)(WUVT + i * 8) = o; } }
}

__device__ __forceinline__ f32x4 part_sum4(const float* PART, int tile, size_t off) { const size_t pl = (size_t)NTOK * 256; const float* p = PART + (size_t)tile * pl + off;
    return (*(const f32x4*)p + *(const f32x4*)(p + 2 * pl)) + (*(const f32x4*)(p + 4 * pl) + *(const f32x4*)(p + 6 * pl)); }
__device__ __forceinline__ float log_sigmoid(float z) { return fminf(z, 0.f) - log1pf(__expf(-fabsf(z))); }
__device__ __forceinline__ void p2_small(Frame& F) {
    const int gw = F.bid * NWAVES + F.wave, NGW = F.G * NWAVES, lane = F.lane;
    { const float* PART = WSP(float, WS_PART); bf16* CKVN = WSP(bf16, WS_CKVN); const f32x4 g = *(const f32x4*)(INP(I_GLAT) + 4 * lane);
      for (int t = gw; t < NTOK; t += NGW) { const f32x4 v = part_sum4(PART, 0, (size_t)t * 256 + 4 * lane);
          const float ss = wave_sum(v[0] * v[0] + v[1] * v[1] + v[2] * v[2] + v[3] * v[3]); const float r = 1.0f / sqrtf(ss * (1.0f / 256.0f) + LN_EPS);
          u32x2 o; o.x = pk2(v[0] * r * g[0], v[1] * r * g[1]); o.y = pk2(v[2] * r * g[2], v[3] * r * g[3]); *(u32x2*)(CKVN + (size_t)t * 256 + 4 * lane) = o; } }
    { const float* PART = WSP(float, WS_PART); float* CUML = WSP(float, WS_CUM); float* SEGT = WSP(float, WS_CUM + 512 * 1024); const float* bfp = INP(I_BFORGET);
      for (int it = gw; it < BATCH * (SEQ / 64); it += NGW) { const int b = it / (SEQ / 64), seg = it % (SEQ / 64), pos = seg * 64 + lane;
          f32x4 f[4];
#pragma unroll
          for (int q = 0; q < 4; ++q) f[q] = part_sum4(PART, 1, (size_t)(b * SEQ + pos) * 256 + 96 + 4 * q);
#pragma unroll
          for (int h = 0; h < B_HEADS; ++h) { float v = log_sigmoid(f[h >> 2][h & 3] + bfp[h]);
#pragma unroll
              for (int o = 1; o < 64; o <<= 1) { const float t = __shfl_up(v, o); if (lane >= o) v += t; }
              CUML[(size_t)(b * B_HEADS + h) * SEQ + pos] = v; if (lane == 63) SEGT[(b * B_HEADS + h) * (SEQ / 64) + seg] = v; } } }
    { const bf16* QA = WSP(bf16, WS_QA); bf16* QLAT = WSP(bf16, WS_QLAT); const bf16* WUKB = WSP(bf16, WS_WUKB);
      for (int it = gw; it < (NTOK / 64) * A_HEADS * 4; it += NGW) { const int ct = it & 3, h = (it >> 2) & 15, tt = it >> 6;
          small_gemm_tile<128>(QA + (size_t)tt * 64 * 2048 + h * 128, 2048, WUKB + (size_t)(h * 256 + ct * 64) * 128, 128, QLAT + (size_t)tt * 64 * 4096 + h * 256 + ct * 64, 4096, lane); } }
    { const float* PART = WSP(float, WS_PART); bf16* KIDXB = WSP(bf16, WS_KIDXB); float* WIDX = WSP(float, WS_WIDX); const size_t gt = (size_t)F.bid * NTHREADS + F.tid, gs = (size_t)F.G * NTHREADS;
      for (size_t i = gt; i < (size_t)NTOK * 8; i += gs) { const size_t t = i >> 3; const int q = (int)(i & 7); *(f32x4*)(WIDX + t * 32 + 4 * q) = part_sum4(PART, 1, t * 256 + 64 + 4 * q); }
      for (size_t i = gt; i < (size_t)NTOK * 8; i += gs) { const size_t t = i >> 3; const int c8 = (int)(i & 7); const f32x4 a = part_sum4(PART, 1, t * 256 + c8 * 8), b = part_sum4(PART, 1, t * 256 + c8 * 8 + 4);
          u32x4 o; o.x = pk2(a[0], a[1]); o.y = pk2(a[2], a[3]); o.z = pk2(b[0], b[1]); o.w = pk2(b[2], b[3]);
          const size_t tl = t & (SEQ - 1); *(u32x4*)(KIDXB + (t - tl) * 64 + (tl >> 5) * 2048 + (c8 >> 1) * 512 + (tl & 31) * 16 + (c8 & 1) * 8) = o; } }
}

__device__ __forceinline__ unsigned f2key(float f) { const unsigned b = __builtin_bit_cast(unsigned, f); return (b & 0x80000000u) ? ~b : (b | 0x80000000u); }
__device__ __forceinline__ int lanes_below(unsigned long long m) { return (int)__builtin_amdgcn_mbcnt_hi((unsigned)(m >> 32), __builtin_amdgcn_mbcnt_lo((unsigned)m, 0u)); }
__device__ __forceinline__ void p4_oa(Frame& F) {
    const int gw = F.bid * NWAVES + F.wave, NGW = F.G * NWAVES, lane = F.lane;
    const bf16* OLAT = WSP(bf16, WS_OLAT); bf16* OA = WSP(bf16, WS_QA); const bf16* WUVT = WSP(bf16, WS_WUVT);
    for (int it = gw; it < (NTOK / 64) * A_HEADS * 2; it += NGW) { const int dt = it & 1, h = (it >> 1) & 15, tt = it >> 5;
        small_gemm_tile<256>(OLAT + (size_t)tt * 64 * 4096 + h * 256, 4096, WUVT + (size_t)(h * 128 + dt * 64) * 256, 256, nullptr, 2048, lane, (unsigned char*)OA + (size_t)tt * 64 * 2048 + h * 128 + dt * 64, Q8_O); }
}
__device__ __forceinline__ void p7_ln1(Frame& F) {
    const int gw = F.bid * NWAVES + F.wave, NGW = F.G * NWAVES, lane = F.lane;
    const bf16* Y1 = WSP(bf16, WS_E); bf16* H1B = WSP(bf16, WS_XB); unsigned char* H18 = WSP(unsigned char, WS_X8); const float* g = INP(I_LN1G); const float* bb = INP(I_LN1B);
    for (int t = gw; t < NTOK; t += NGW) { const bf16* yr = Y1 + (size_t)t * 4096;
        f32x4 v[16]; float s = 0.f;
#pragma unroll
        for (int j = 0; j < 8; ++j) { const u32x4 w = *(const u32x4*)(yr + (j * 64 + lane) * 8); v[2 * j] = (f32x4){bflo(w.x), bfhi(w.x), bflo(w.y), bfhi(w.y)}; v[2 * j + 1] = (f32x4){bflo(w.z), bfhi(w.z), bflo(w.w), bfhi(w.w)};
            s += (v[2 * j][0] + v[2 * j][1]) + (v[2 * j][2] + v[2 * j][3]) + (v[2 * j + 1][0] + v[2 * j + 1][1]) + (v[2 * j + 1][2] + v[2 * j + 1][3]); }
        const float mean = wave_sum(s) * (1.0f / 4096.0f); float q = 0.f;
#pragma unroll
        for (int j = 0; j < 16; ++j) { v[j] = v[j] - mean; q += (v[j][0] * v[j][0] + v[j][1] * v[j][1]) + (v[j][2] * v[j][2] + v[j][3] * v[j][3]); }
        const float rstd = 1.0f / sqrtf(wave_sum(q) * (1.0f / 4096.0f) + LN_EPS);
#pragma unroll
        for (int j = 0; j < 8; ++j) { const int off = (j * 64 + lane) * 8; const f32x4 g0 = *(const f32x4*)(g + off), g1 = *(const f32x4*)(g + off + 4), b0 = *(const f32x4*)(bb + off), b1 = *(const f32x4*)(bb + off + 4);
            const f32x4 o0 = v[2 * j] * rstd * g0 + b0, o1 = v[2 * j + 1] * rstd * g1 + b1;
            u32x4 w; w.x = pk2(o0[0], o0[1]); w.y = pk2(o0[2], o0[3]); w.z = pk2(o1[0], o1[1]); w.w = pk2(o1[2], o1[3]); *(u32x4*)(H1B + (size_t)t * 4096 + off) = w;
            u32x2 q8; q8.x = pk_q8x4(o0[0], o0[1], o0[2], o0[3], Q8_ACT); q8.y = pk_q8x4(o1[0], o1[1], o1[2], o1[3], Q8_ACT); *(u32x2*)(H18 + (size_t)t * 4096 + off) = q8; } }
}
constexpr int FOX_KP = 272, FOX_VP = 320, FOX_VOFF = 17408, FOX_COFF = 37888;
__device__ __forceinline__ void fox_unit(Frame& F, int b, int h, int qb) {
    const int tid = F.tid, lane = F.lane, w = F.wave, r = lane & 31, hh = lane >> 5;
    LAS unsigned char* Ks = F.lds; LAS unsigned char* Vs = F.lds + FOX_VOFF; LAS float* cks = (LAS float*)(F.lds + FOX_COFF);
    const bf16* QB = WSP(bf16, WS_QB); const bf16* KB = WSP(bf16, WS_KB); const bf16* VB = WSP(bf16, WS_VB); bf16* OB = WSP(bf16, WS_OB);
    const float* cum = WSP(float, WS_CUM) + (size_t)(b * B_HEADS + h) * SEQ;
    LAS float* segp = (LAS float*)(F.lds + FOX_COFF + 256);
    const int Q0 = qb * 256, q0 = Q0 + 32 * w, ntiles = (Q0 + 256) / 64, tl = (q0 + 31) / 64;
    const float SC = 0.12751741614123135f, LOG2E = 1.4426950408889634f;
    bf16x8 qf[8];
    { const bf16* qp = QB + ((size_t)b * SEQ + q0 + r) * 2048 + h * 128 + 8 * hh;
#pragma unroll
      for (int s = 0; s < 8; ++s) qf[s] = *(const bf16x8*)(qp + 16 * s); }
    f32x16 o[4];
#pragma unroll
    for (int dt = 0; dt < 4; ++dt)
#pragma unroll
        for (int i = 0; i < 16; ++i) o[dt][i] = 0.f;
    float m = -1e30f, l = 0.f;
    const int pk0 = tid >> 4, pc0 = tid & 15;
    const bf16* kg = KB + ((size_t)b * SEQ + pk0) * 2048 + h * 128 + 8 * pc0; const bf16* vg = VB + ((size_t)b * SEQ + pk0) * 2048 + h * 128 + 8 * pc0;
    u32x4 kr0, kr1, vr0, vr1; float cr = 0.f;
#define FOX_LOAD(kt) do { const size_t go = (size_t)(kt) * 64 * 2048; kr0 = *(const u32x4*)(kg + go); kr1 = *(const u32x4*)(kg + go + 32 * 2048); vr0 = *(const u32x4*)(vg + go); vr1 = *(const u32x4*)(vg + go + 32 * 2048); \
        if (tid < 64) cr = (cum[(kt) * 64 + tid] + segp[(kt)]) * LOG2E; } while (0)
    if (tid < 64) { float v = (lane < 32) ? WSP(float, WS_CUM + 512 * 1024)[(b * B_HEADS + h) * (SEQ / 64) + lane] : 0.f; const float own = v;
#pragma unroll
        for (int o = 1; o < 32; o <<= 1) { const float t = __shfl_up(v, o); if (lane >= o) v += t; }
        if (lane < 32) segp[lane] = v - own;
        CFENCE(); LDS_WAIT(); }
    FOX_LOAD(0);
    const int ka_off = r * FOX_KP + 16 * hh;
    const int vt_off = (4 * hh + ((lane & 15) >> 2)) * FOX_VP + (16 * ((lane >> 4) & 1) + 4 * (lane & 3)) * 2;
    const int ck_off = 4 * hh;
    for (int kt = 0; kt < ntiles; ++kt) {
        __syncthreads();
        *(LAS u32x4*)(Ks + pk0 * FOX_KP + pc0 * 16) = kr0; *(LAS u32x4*)(Ks + (pk0 + 32) * FOX_KP + pc0 * 16) = kr1;
        *(LAS u32x4*)(Vs + pk0 * FOX_VP + pc0 * 16) = vr0; *(LAS u32x4*)(Vs + (pk0 + 32) * FOX_VP + pc0 * 16) = vr1;
        if (tid < 64) cks[tid] = cr;
        __syncthreads();
        if (kt + 1 < ntiles) FOX_LOAD(kt + 1);
        if (kt <= tl) {
            f32x16 s0, s1;
#pragma unroll
            for (int i = 0; i < 16; ++i) { s0[i] = 0.f; s1[i] = 0.f; }
#pragma unroll
            for (int s = 0; s < 8; ++s) { const bf16x8 a0 = *(const LAS bf16x8*)(Ks + ka_off + 32 * s), a1 = *(const LAS bf16x8*)(Ks + ka_off + 32 * FOX_KP + 32 * s);
                s0 = __builtin_amdgcn_mfma_f32_32x32x16_bf16(a0, qf[s], s0, 0, 0, 0); s1 = __builtin_amdgcn_mfma_f32_32x32x16_bf16(a1, qf[s], s1, 0, 0, 0); }
            const bool diag = (64 * kt + 63 > q0); const int qme = q0 + r - 64 * kt;
            float mx = m;
#pragma unroll
            for (int g4 = 0; g4 < 4; ++g4) { const f32x4 c0 = *(const LAS f32x4*)(cks + ck_off + 8 * g4), c1 = *(const LAS f32x4*)(cks + ck_off + 32 + 8 * g4);
#pragma unroll
                for (int i = 0; i < 4; ++i) { const int kl = 8 * g4 + 4 * hh + i; float t0 = s0[4 * g4 + i] * SC - c0[i], t1 = s1[4 * g4 + i] * SC - c1[i];
                    if (diag) { if (kl > qme) t0 = -INFINITY; if (kl + 32 > qme) t1 = -INFINITY; }
                    s0[4 * g4 + i] = t0; s1[4 * g4 + i] = t1; mx = fmaxf(mx, fmaxf(t0, t1)); } }
            mx = fmaxf(mx, __shfl_xor(mx, 32));
            if (__any(mx > m + 8.0f)) {
                const float alpha = __builtin_amdgcn_exp2f(m - mx); m = mx; l *= alpha;
#pragma unroll
                for (int dt = 0; dt < 4; ++dt)
#pragma unroll
                    for (int i = 0; i < 16; ++i) o[dt][i] *= alpha; }
            float ls = 0.f;
            union { bf16x8 v; unsigned u[4]; } pf[4];
#pragma unroll
            for (int ks = 0; ks < 2; ++ks)
#pragma unroll
                for (int j = 0; j < 4; ++j) { const float a0 = __builtin_amdgcn_exp2f(s0[8 * ks + 2 * j] - m), a1 = __builtin_amdgcn_exp2f(s0[8 * ks + 2 * j + 1] - m);
                    const float b0 = __builtin_amdgcn_exp2f(s1[8 * ks + 2 * j] - m), b1 = __builtin_amdgcn_exp2f(s1[8 * ks + 2 * j + 1] - m);
                    ls += (a0 + a1) + (b0 + b1); pf[ks].u[j] = pk2(a0, a1); pf[2 + ks].u[j] = pk2(b0, b1); }
            l += ls;
#pragma unroll
            for (int f = 0; f < 4; ++f) {
                const int vb = vt_off + 16 * f * FOX_VP;
#pragma unroll
                for (int dt = 0; dt < 4; ++dt) {
                    const s16x4 x0 = __builtin_amdgcn_ds_read_tr16_b64_v4i16((LAS s16x4*)(Vs + vb + 64 * dt)), x1 = __builtin_amdgcn_ds_read_tr16_b64_v4i16((LAS s16x4*)(Vs + vb + 8 * FOX_VP + 64 * dt));
                    const bf16x8 af = {x0[0], x0[1], x0[2], x0[3], x1[0], x1[1], x1[2], x1[3]};
                    o[dt] = __builtin_amdgcn_mfma_f32_32x32x16_bf16(af, pf[f].v, o[dt], 0, 0, 0); }
                __builtin_amdgcn_sched_barrier(0);
            }
        }
    }
#undef FOX_LOAD
    l += __shfl_xor(l, 32);
    const float inv = 1.0f / l;
    unsigned char* op = (unsigned char*)OB + ((size_t)b * SEQ + q0 + r) * 2048 + h * 128 + 4 * hh;
#pragma unroll
    for (int dt = 0; dt < 4; ++dt)
#pragma unroll
        for (int g4 = 0; g4 < 4; ++g4) *(unsigned*)(op + 32 * dt + 8 * g4) = pk_q8x4(o[dt][4 * g4] * inv, o[dt][4 * g4 + 1] * inv, o[dt][4 * g4 + 2] * inv, o[dt][4 * g4 + 3] * inv, Q8_O);
}
__device__ __forceinline__ void p3_fox(Frame& F) {
    for (int pr = F.bid; pr < BATCH * B_HEADS * 4; pr += F.G) { const int bh = pr >> 2, j = pr & 3, b = bh >> 4, h = bh & 15;
        fox_unit(F, b, h, 7 - j);
        fox_unit(F, b, h, j); }
}
constexpr int DSA_WLDS = 16896;
__device__ __forceinline__ void p3_dsa(Frame& F, int flags) {
    const int gw = F.bid * NWAVES + F.wave, NGW = F.G * NWAVES;
    LAS unsigned char* wb = F.lds + F.wave * DSA_WLDS;
    LAS float* SCb2 = (LAS float*)wb; LAS unsigned short* IDX = (LAS unsigned short*)(wb + 16384);
    const bf16* QIDX = WSP(bf16, WS_QIDX); const bf16* KIDXB = WSP(bf16, WS_KIDXB); const float* WIDX = WSP(float, WS_WIDX); const bf16* CKVN = WSP(bf16, WS_CKVN); const bf16* QLAT = WSP(bf16, WS_QLAT); bf16* OLAT = WSP(bf16, WS_OLAT);
    const float idx_scale = 0.022097086912079608f, SCL = 0.12751741614123135f  ;
    for (int ip = gw; ip < NTOK / 2; ip += NGW) {
        const int b = (2 * ip) / SEQ, ttp = (2 * ip) % SEQ, tp0 = (b & 2) ? (SEQ - 2 - ttp) : ttp;
         const size_t rowp = (size_t)b * SEQ + tp0; const int chunk_end = (tp0 / CHUNK + 1) * CHUNK;
        {
        const int lane = fresh_lane(), r32 = lane & 31, hh = lane >> 5;
        if (!(flags & 4)) {
            bf16x8 qi[2][4]; f32x4 wv[2][4];
#pragma unroll
            for (int q2 = 0; q2 < 2; ++q2) {
#pragma unroll
                for (int s = 0; s < 4; ++s) qi[q2][s] = *(const bf16x8*)(QIDX + (rowp + q2) * 2048 + r32 * 64 + 16 * s + 8 * hh);
#pragma unroll
                for (int g4 = 0; g4 < 4; ++g4) wv[q2][g4] = *(const f32x4*)(WIDX + (rowp + q2) * 32 + 8 * g4 + 4 * hh); }
            const bf16* kp = KIDXB + (size_t)b * SEQ * 64 + r32 * 16 + 8 * hh;
            bf16x8 kb[8][4];
#define DSA_SCORE(kbt, tile, q2) do { f32x16 acc; _Pragma("unroll") for (int i = 0; i < 16; ++i) acc[i] = 0.f; \
                _Pragma("unroll") for (int s = 0; s < 4; ++s) acc = __builtin_amdgcn_mfma_f32_32x32x16_bf16(qi[q2][s], kbt[s], acc, 0, 0, 0); \
                float sc = 0.f; _Pragma("unroll") for (int g4 = 0; g4 < 4; ++g4) _Pragma("unroll") for (int i = 0; i < 4; ++i) sc += fmaxf(acc[4 * g4 + i], 0.f) * wv[q2][g4][i]; \
                sc += __shfl_xor(sc, 32); if (lane < 32) SCb2[(q2) * 2048 + (tile) * 32 + lane] = sc * idx_scale; } while (0)
            const int ntile8 = ((chunk_end + 255) >> 8) << 3;
            for (int t0 = 0; t0 < ntile8; t0 += 8) {
#pragma unroll
                for (int u = 0; u < 8; ++u)
#pragma unroll
                    for (int s = 0; s < 4; ++s) kb[u][s] = *(const bf16x8*)(kp + (size_t)(t0 + u) * 2048 + 512 * s);
#pragma unroll
                for (int u = 0; u < 8; ++u) { DSA_SCORE(kb[u], t0 + u, 0); DSA_SCORE(kb[u], t0 + u, 1); __builtin_amdgcn_sched_barrier(0); }
            }
#undef DSA_SCORE
        }
        }
        CFENCE(); LDS_WAIT();
#pragma unroll 1
        for (int q2 = 0; q2 < 2; ++q2) {
        const int lane = fresh_lane(), r16 = lane & 15, g = lane >> 4;
        const int t = tp0 + q2; const size_t row = rowp + q2; LAS float* SCb = SCb2 + q2 * 2048;
        const int nsel = chunk_end < TOPK ? chunk_end : TOPK;
        if (chunk_end <= TOPK || (flags & 8)) { for (int s = lane; s < nsel; s += 64) IDX[s] = (unsigned short)s; }
        else {
            unsigned key[32]; const int nreg = chunk_end >> 6;
#pragma unroll
            for (int i = 0; i < 32; ++i) key[i] = (i < nreg) ? f2key(SCb[i * 64 + lane]) : 0u;
            unsigned T = 0u;
            for (int bit = 31; bit >= 0; --bit) { const unsigned cand = T | (1u << bit); int cnt = 0;
#pragma unroll
                for (int i = 0; i < 32; ++i) cnt += __builtin_popcountll(__ballot(key[i] >= cand));
                if (cnt >= TOPK) { T = cand; if (cnt == TOPK) break; } }
            int cgt = 0;
#pragma unroll
            for (int i = 0; i < 32; ++i) cgt += __builtin_popcountll(__ballot(key[i] > T));
            int rem = TOPK - cgt, base = 0;
#pragma unroll
            for (int i = 0; i < 32; ++i) { const bool gt = key[i] > T, eq = key[i] == T; const unsigned long long meq = __ballot(eq); const bool take = gt || (eq && lanes_below(meq) < rem);
                const unsigned long long msel = __ballot(take); if (take) IDX[base + lanes_below(msel)] = (unsigned short)(i * 64 + lane);
                base += __builtin_popcountll(msel); const int ne = __builtin_popcountll(meq); rem -= (ne < rem ? ne : rem); }
        }
        CFENCE(); LDS_WAIT();
        if (!(flags & 16)) {
            int r16l = r16; asm volatile("" : "+v"(r16l));
            union { bf16x8 v; unsigned short e[8]; } sel0, sel1;
#pragma unroll
            for (int j = 0; j < 8; ++j) { sel0.e[j] = (8 * g + j == r16l) ? 0x3F80 : 0; sel1.e[j] = (8 * g + j == 16 + r16l) ? 0x3F80 : 0; }
            const float slope2 = exp2f(-0.5f * (float)(r16l + 1)) * 1.4426950408889634f;
            bf16x8 ql[8];
#pragma unroll
            for (int s = 0; s < 8; ++s) ql[s] = *(const bf16x8*)(QLAT + row * 4096 + r16 * 256 + 32 * s + 8 * g);
            f32x4 o[16];
#pragma unroll
            for (int ct = 0; ct < 16; ++ct) o[ct] = (f32x4){0.f, 0.f, 0.f, 0.f};
            float m = -1e30f, l = 0.f;
            const bf16* cbase = CKVN + (size_t)b * SEQ * 256 + 8 * g;
            const int nstep = nsel >> 5;
            for (int st = 0; st < nstep; ++st) {
                const int ia = IDX[32 * st + r16], ib = IDX[32 * st + 16 + r16];
                bf16x8 ca[8], cb[8];
#pragma unroll
                for (int s = 0; s < 8; ++s) { ca[s] = *(const bf16x8*)(cbase + (size_t)ia * 256 + 32 * s); cb[s] = *(const bf16x8*)(cbase + (size_t)ib * 256 + 32 * s); }
                f32x4 sa = (f32x4){0.f, 0.f, 0.f, 0.f}, sb = sa;
#pragma unroll
                for (int s = 0; s < 8; ++s) { sa = __builtin_amdgcn_mfma_f32_16x16x32_bf16(ca[s], ql[s], sa, 0, 0, 0); sb = __builtin_amdgcn_mfma_f32_16x16x32_bf16(cb[s], ql[s], sb, 0, 0, 0); }
                const u32x2 ja = *(const LAS u32x2*)(IDX + 32 * st + 4 * g), jb = *(const LAS u32x2*)(IDX + 32 * st + 16 + 4 * g);
                const int da0 = t - (int)(ja.x & 0xffff), da1 = t - (int)(ja.x >> 16), da2 = t - (int)(ja.y & 0xffff), da3 = t - (int)(ja.y >> 16);
                const int db0 = t - (int)(jb.x & 0xffff), db1 = t - (int)(jb.x >> 16), db2 = t - (int)(jb.y & 0xffff), db3 = t - (int)(jb.y >> 16);
                sa[0] = sa[0] * SCL - slope2 * (float)(da0 < 0 ? -da0 : da0); sa[1] = sa[1] * SCL - slope2 * (float)(da1 < 0 ? -da1 : da1);
                sa[2] = sa[2] * SCL - slope2 * (float)(da2 < 0 ? -da2 : da2); sa[3] = sa[3] * SCL - slope2 * (float)(da3 < 0 ? -da3 : da3);
                sb[0] = sb[0] * SCL - slope2 * (float)(db0 < 0 ? -db0 : db0); sb[1] = sb[1] * SCL - slope2 * (float)(db1 < 0 ? -db1 : db1);
                sb[2] = sb[2] * SCL - slope2 * (float)(db2 < 0 ? -db2 : db2); sb[3] = sb[3] * SCL - slope2 * (float)(db3 < 0 ? -db3 : db3);
                float mx = fmaxf(fmaxf(fmaxf(sa[0], sa[1]), fmaxf(sa[2], sa[3])), fmaxf(fmaxf(sb[0], sb[1]), fmaxf(sb[2], sb[3])));
                mx = fmaxf(mx, __shfl_xor(mx, 16)); mx = fmaxf(mx, __shfl_xor(mx, 32));
                float alpha = 1.0f;
                if (__any(mx > m + 8.0f)) { mx = fmaxf(mx, m); alpha = __builtin_amdgcn_exp2f(m - mx); m = mx;
#pragma unroll
                    for (int ct = 0; ct < 16; ++ct) o[ct] *= alpha; }
#pragma unroll
                for (int i = 0; i < 4; ++i) { sa[i] = __builtin_amdgcn_exp2f(sa[i] - m); sb[i] = __builtin_amdgcn_exp2f(sb[i] - m); }
                l = l * alpha + ((sa[0] + sa[1]) + (sa[2] + sa[3])) + ((sb[0] + sb[1]) + (sb[2] + sb[3]));
                union { bf16x8 v; unsigned u[4]; } pf;
                pf.u[0] = pk2(sa[0], sa[1]); pf.u[1] = pk2(sa[2], sa[3]); pf.u[2] = pk2(sb[0], sb[1]); pf.u[3] = pk2(sb[2], sb[3]);
#pragma unroll
                for (int s = 0; s < 8; ++s) {
                    const f32x4 z = (f32x4){0.f, 0.f, 0.f, 0.f};
                    const f32x4 ta0 = __builtin_amdgcn_mfma_f32_16x16x32_bf16(ca[s], sel0.v, z, 0, 0, 0), ta1 = __builtin_amdgcn_mfma_f32_16x16x32_bf16(ca[s], sel1.v, z, 0, 0, 0);
                    const f32x4 tb0 = __builtin_amdgcn_mfma_f32_16x16x32_bf16(cb[s], sel0.v, z, 0, 0, 0), tb1 = __builtin_amdgcn_mfma_f32_16x16x32_bf16(cb[s], sel1.v, z, 0, 0, 0);
                    union { bf16x8 v; unsigned u[4]; } v0, v1;
                    v0.u[0] = pk2(ta0[0], ta0[1]); v0.u[1] = pk2(ta0[2], ta0[3]); v0.u[2] = pk2(tb0[0], tb0[1]); v0.u[3] = pk2(tb0[2], tb0[3]);
                    v1.u[0] = pk2(ta1[0], ta1[1]); v1.u[1] = pk2(ta1[2], ta1[3]); v1.u[2] = pk2(tb1[0], tb1[1]); v1.u[3] = pk2(tb1[2], tb1[3]);
                    o[2 * s] = __builtin_amdgcn_mfma_f32_16x16x32_bf16(v0.v, pf.v, o[2 * s], 0, 0, 0);
                    o[2 * s + 1] = __builtin_amdgcn_mfma_f32_16x16x32_bf16(v1.v, pf.v, o[2 * s + 1], 0, 0, 0);
                }
            }
            l += __shfl_xor(l, 16); l += __shfl_xor(l, 32);
            const float inv = 1.0f / l;
            bf16* op = OLAT + row * 4096 + r16 * 256 + 4 * g;
#pragma unroll
            for (int ct = 0; ct < 16; ++ct) { u32x2 wv; wv.x = pk2(o[ct][0] * inv, o[ct][1] * inv); wv.y = pk2(o[ct][2] * inv, o[ct][3] * inv); *(u32x2*)(op + 16 * ct) = wv; }
        }
        CFENCE(); LDS_WAIT();
        }
    }
}
constexpr int PEER_WLDS = 2048 + 8192;
typedef int i32x8 __attribute__((ext_vector_type(8)));
typedef __bf16 bf16x2_d __attribute__((ext_vector_type(2)));
__device__ __forceinline__ float dot2bf(unsigned a, unsigned b, float c) { return __builtin_amdgcn_fdot2_f32_bf16(__builtin_bit_cast(bf16x2_d, a), __builtin_bit_cast(bf16x2_d, b), c, false); }
__device__ __forceinline__ f32x4 fp8x4(unsigned w) { const f32x2 lo = __builtin_amdgcn_cvt_pk_f32_fp8((int)w, false), hi = __builtin_amdgcn_cvt_pk_f32_fp8((int)w, true); return (f32x4){lo[0], lo[1], hi[0], hi[1]}; }
__device__ __forceinline__ float fp8dot4(unsigned w, f32x4 x) { const f32x4 f = fp8x4(w); return (f[0] * x[0] + f[1] * x[1]) + (f[2] * x[2] + f[3] * x[3]); }
#define DPPF(v, ctrl, rmask) __builtin_bit_cast(float, __builtin_amdgcn_update_dpp(0, __builtin_bit_cast(int, (v)), (ctrl), (rmask), 0xf, false))
__device__ __forceinline__ float wave_sum_u(float v) {
    v += DPPF(v, 0xB1, 0xf); v += DPPF(v, 0x4E, 0xf); v += DPPF(v, 0x141, 0xf); v += DPPF(v, 0x140, 0xf);
    v += DPPF(v, 0x142, 0xa); v += DPPF(v, 0x143, 0xc);
    return __builtin_bit_cast(float, __builtin_amdgcn_readlane(__builtin_bit_cast(int, v), 63));
}
template <int NV>
__device__ __forceinline__ void select16(const unsigned (&key)[NV], bool (&sel)[NV], int (&pos)[NV]) {
    unsigned T = 0u;
    for (int bit = 31; bit >= 0; --bit) { const unsigned cand = T | (1u << bit); int cnt = 0;
#pragma unroll
        for (int r = 0; r < NV; ++r) cnt += __builtin_popcountll(__ballot(key[r] >= cand));
        if (cnt >= PEER_TOPK) { T = cand; if (cnt == PEER_TOPK) break; } }
    int cgt = 0;
#pragma unroll
    for (int r = 0; r < NV; ++r) cgt += __builtin_popcountll(__ballot(key[r] > T));
    int rem = PEER_TOPK - cgt, base = 0;
#pragma unroll
    for (int r = 0; r < NV; ++r) { const bool gt = key[r] > T, eq = key[r] == T; const unsigned long long meq = __ballot(eq); const bool take = gt || (eq && lanes_below(meq) < rem);
        const unsigned long long msel = __ballot(take); sel[r] = take; pos[r] = base + lanes_below(msel);
        base += __builtin_popcountll(msel); const int ne = __builtin_popcountll(meq); rem -= (ne < rem ? ne : rem); }
}
__device__ __forceinline__ void p9_peer(Frame& F) {
    const int gw = F.bid * NWAVES + F.wave, NGW = F.G * NWAVES, lane = F.lane;
    LAS unsigned char* wb = F.lds + F.wave * PEER_WLDS;
    LAS float* tv = (LAS float*)wb; LAS int* ti = (LAS int*)(wb + 128); LAS float* cv = (LAS float*)(wb + 256); LAS int* cc = (LAS int*)(wb + 320); LAS int* eidx = (LAS int*)(wb + 512); LAS float* coef = (LAS float*)(wb + 1024); LAS float* su = (LAS float*)(wb + 1536);
    const float* S = WSP(float, WS_E); const bf16* H1B = WSP(bf16, WS_XB); const bf16* PLE = WSP(bf16, WS_PL); const unsigned char* UB = WSP(unsigned char, WS_UB); const unsigned char* VT = WSP(unsigned char, WS_VT); const float* SCL = WSP(float, WS_SCL);
    const float* g2 = INP(I_LN2G); const float* b2 = INP(I_LN2B);
    for (int tok = gw; tok < NTOK; tok += NGW) {
        const float* srow = S + (size_t)tok * 2048;
        LAS float* sl = (LAS float*)(wb + 2048);
#pragma unroll
        for (int j = 0; j < 8; ++j) *(LAS f32x4*)(sl + (j * 64 + lane) * 4) = *(const f32x4*)(srow + (j * 64 + lane) * 4);
        CFENCE(); LDS_WAIT();
        {
            u32x4 hb[2][3];
            u32x4 hx[2][4]; float mx = 0.f;
#pragma unroll
            for (int jj = 0; jj < 2; ++jj)
#pragma unroll
                for (int i = 0; i < 4; ++i) { hx[jj][i] = *(const u32x4*)(H1B + (size_t)tok * 4096 + (jj * 64 + lane) * 32 + 8 * i);
#pragma unroll
                    for (int k = 0; k < 4; ++k) mx = fmaxf(mx, fmaxf(fabsf(bflo(hx[jj][i][k])), fabsf(bfhi(hx[jj][i][k])))); }
            mx = wave_max(mx) * (1.0f / 6.0f);
            int eb = (int)((__builtin_bit_cast(unsigned, mx) + 0x007fffffu) >> 23); eb = eb < 1 ? 1 : (eb > 253 ? 253 : eb);
            const float sup = __builtin_bit_cast(float, (unsigned)(254 - eb) << 23), sdn = __builtin_bit_cast(float, (unsigned)eb << 23);
#pragma unroll
            for (int jj = 0; jj < 2; ++jj)
#pragma unroll
                for (int i = 0; i < 4; ++i) { unsigned w0 = 0u, w1 = 0u, w2 = 0u;
#define HDIG(k) { float x0 = bflo(hx[jj][i][k]) * sup, x1 = bfhi(hx[jj][i][k]) * sup; \
                      w0 = __builtin_amdgcn_cvt_scalef32_pk_fp4_f32(w0, x0, x1, 1.0f, k); f32x2 dq = __builtin_amdgcn_cvt_scalef32_pk_f32_fp4(w0, 1.0f, k); x0 = (x0 - dq[0]) * 4.0f; x1 = (x1 - dq[1]) * 4.0f; \
                      w1 = __builtin_amdgcn_cvt_scalef32_pk_fp4_f32(w1, x0, x1, 1.0f, k); dq = __builtin_amdgcn_cvt_scalef32_pk_f32_fp4(w1, 1.0f, k); x0 = (x0 - dq[0]) * 8.0f; x1 = (x1 - dq[1]) * 8.0f; \
                      w2 = __builtin_amdgcn_cvt_scalef32_pk_fp4_f32(w2, x0, x1, 1.0f, k); }
                    HDIG(0) HDIG(1) HDIG(2) HDIG(3)
#undef HDIG
                    hb[jj][0][i] = w0; hb[jj][1][i] = w1; hb[jj][2][i] = w2; }
            const int dsel = ((lane >> 4) == ((lane & 15) >> 2)) ? (lane & 3) : 4;
#define U_LOAD(R, SU, SV, MB) { _Pragma("unroll") for (int q = 0; q < 8; ++q) { const int e_ = __builtin_amdgcn_readfirstlane(eidx[8 * (MB) + q]); const u32x4* p = (const u32x4*)(UB + (size_t)e_ * 2048) + lane; R[q][0] = p[0]; R[q][1] = p[64]; } \
                { const int el_ = eidx[8 * (MB) + (lane & 7)]; SU = SCL[el_]; SV = SCL[N_EXPERTS + el_]; } }
#define HB8(d) (i32x8){(int)hb[jj][d].x, (int)hb[jj][d].y, (int)hb[jj][d].z, (int)hb[jj][d].w, 0, 0, 0, 0}
#define U_COMP(R, SU, SV, MB) { float a[8]; \
                _Pragma("unroll") for (int q = 0; q < 8; ++q) { f32x4 c = (f32x4){0.f, 0.f, 0.f, 0.f}; \
                    _Pragma("unroll") for (int jj = 0; jj < 2; ++jj) { const i32x8 av = (i32x8){(int)R[q][jj].x, (int)R[q][jj].y, (int)R[q][jj].z, (int)R[q][jj].w, 0, 0, 0, 0}; \
                        c = __builtin_amdgcn_mfma_scale_f32_16x16x128_f8f6f4(av, HB8(0), c, 4, 4, 0, 0x7f7f7f7f, 0, 0x7f7f7f7f);     \
                        c = __builtin_amdgcn_mfma_scale_f32_16x16x128_f8f6f4(av, HB8(1), c, 4, 4, 0, 0x7f7f7f7f, 0, 0x7d7d7d7d);     \
                        c = __builtin_amdgcn_mfma_scale_f32_16x16x128_f8f6f4(av, HB8(2), c, 4, 4, 0, 0x7f7f7f7f, 0, 0x7a7a7a7a); }   \
                    float d = (dsel == 0) ? c[0] : 0.f; d = (dsel == 1) ? c[1] : d; d = (dsel == 2) ? c[2] : d; d = (dsel == 3) ? c[3] : d; \
                    a[q] = wave_sum_u(d); } \
                float z = a[0]; \
                _Pragma("unroll") for (int q = 1; q < 8; ++q) z = (lane == q) ? a[q] : z; \
                z *= sdn * SU; \
                const float act = 0.5f * z * (1.0f + erff(z * 0.70710678118654752f)); \
                if (lane < 8) coef[8 * (MB) + lane] *= act * SV; }
            u32x4 ra[8][2], rb[8][2]; float sua, sva, sub, svb;
#define ROUTE_HEAD(h) { \
            _Pragma("unroll") \
            for (int side = 0; side < 2; ++side) { const float v0 = sl[(2 * h + side) * 128 + lane], v1 = sl[(2 * h + side) * 128 + 64 + lane]; \
                const unsigned key[2] = {f2key(v0), f2key(v1)}; bool sel[2]; int pos[2]; select16<2>(key, sel, pos); \
                if (sel[0]) { tv[side * 16 + pos[0]] = v0; ti[side * 16 + pos[0]] = lane; } \
                if (sel[1]) { tv[side * 16 + pos[1]] = v1; ti[side * 16 + pos[1]] = lane + 64; } } \
            CFENCE(); LDS_WAIT(); \
            { const int i0 = lane >> 4, j = lane & 15; const float vj = tv[16 + j]; \
              const float c0 = tv[i0] + vj, c1 = tv[i0 + 4] + vj, c2 = tv[i0 + 8] + vj, c3 = tv[i0 + 12] + vj; \
              const unsigned key[4] = {f2key(c0), f2key(c1), f2key(c2), f2key(c3)}; bool sel[4]; int pos[4]; select16<4>(key, sel, pos); \
              if (sel[0]) { cv[pos[0]] = c0; cc[pos[0]] = lane; } if (sel[1]) { cv[pos[1]] = c1; cc[pos[1]] = lane + 64; } \
              if (sel[2]) { cv[pos[2]] = c2; cc[pos[2]] = lane + 128; } if (sel[3]) { cv[pos[3]] = c3; cc[pos[3]] = lane + 192; } } \
            CFENCE(); LDS_WAIT(); \
            { const float val = cv[lane & 15]; const int ci = cc[lane & 15]; float mx = val; \
            _Pragma("unroll") \
              for (int o = 1; o < 16; o <<= 1) mx = fmaxf(mx, __shfl_xor(mx, o)); \
              const float e = __expf(val - mx); float sm = e; \
            _Pragma("unroll") \
              for (int o = 1; o < 16; o <<= 1) sm += __shfl_xor(sm, o); \
              if (lane < 16) { eidx[h * 16 + lane] = ti[ci >> 4] * 128 + ti[16 + (ci & 15)]; coef[h * 16 + lane] = e / sm; } } \
            CFENCE(); LDS_WAIT(); }
            ROUTE_HEAD(0)
            __builtin_amdgcn_sched_barrier(0);
            U_LOAD(ra, sua, sva, 0)
            U_LOAD(rb, sub, svb, 1)
#pragma unroll 1
            for (int h = 1; h < PEER_HEADS; ++h) {
                __builtin_amdgcn_sched_barrier(0);
                ROUTE_HEAD(h)
                __builtin_amdgcn_sched_barrier(0);
                U_COMP(ra, sua, sva, 2 * h - 2)
                __builtin_amdgcn_sched_barrier(0);
                U_LOAD(ra, sua, sva, 2 * h)
                __builtin_amdgcn_sched_barrier(0);
                U_COMP(rb, sub, svb, 2 * h - 1)
                __builtin_amdgcn_sched_barrier(0);
                U_LOAD(rb, sub, svb, 2 * h + 1)
            }
            __builtin_amdgcn_sched_barrier(0);
            U_COMP(ra, sua, sva, PEER_M / 8 - 2)
            __builtin_amdgcn_sched_barrier(0);
            U_COMP(rb, sub, svb, PEER_M / 8 - 1)
#undef ROUTE_HEAD
#undef U_LOAD
#undef U_COMP
#undef HB8
        }
        CFENCE(); LDS_WAIT();
        f32x2 y[32];
#pragma unroll
        for (int i = 0; i < 32; ++i) y[i] = (f32x2){0.f, 0.f};
#pragma unroll 1
        for (int mb = 0; mb < PEER_M / 8; ++mb) {
            u32x4 r[8][2]; float c[8];
#pragma unroll
            for (int q = 0; q < 8; ++q) { const int e = __builtin_amdgcn_readfirstlane(eidx[8 * mb + q]); c[q] = coef[8 * mb + q];
                const u32x4* p = (const u32x4*)(VT + (size_t)e * 2048) + lane; r[q][0] = p[0]; r[q][1] = p[64]; }
#pragma unroll
            for (int q = 0; q < 8; ++q)
#pragma unroll
                for (int jj = 0; jj < 2; ++jj)
#pragma unroll
                    for (int i = 0; i < 4; ++i) { const unsigned w = r[q][jj][i];
                        y[(4 * jj + i) * 4 + 0] += __builtin_amdgcn_cvt_scalef32_pk_f32_fp4(w, 1.0f, 0) * c[q]; y[(4 * jj + i) * 4 + 1] += __builtin_amdgcn_cvt_scalef32_pk_f32_fp4(w, 1.0f, 1) * c[q];
                        y[(4 * jj + i) * 4 + 2] += __builtin_amdgcn_cvt_scalef32_pk_f32_fp4(w, 1.0f, 2) * c[q]; y[(4 * jj + i) * 4 + 3] += __builtin_amdgcn_cvt_scalef32_pk_f32_fp4(w, 1.0f, 3) * c[q]; }
        }
        { const bf16* hr = H1B + (size_t)tok * 4096; const bf16* pr = PLE + (size_t)tok * 4096; float s = 0.f;
#pragma unroll
          for (int jj = 0; jj < 2; ++jj) {
#pragma unroll
              for (int i = 0; i < 4; ++i) { const int off = (jj * 64 + lane) * 32 + 8 * i; const int yb = (4 * jj + i) * 4;
                  const u32x4 hw = *(const u32x4*)(hr + off), pw = *(const u32x4*)(pr + off); const f32x4 h0 = (f32x4){bflo(hw.x), bfhi(hw.x), bflo(hw.y), bfhi(hw.y)}, h1 = (f32x4){bflo(hw.z), bfhi(hw.z), bflo(hw.w), bfhi(hw.w)}, p0 = (f32x4){bflo(pw.x), bfhi(pw.x), bflo(pw.y), bfhi(pw.y)}, p1 = (f32x4){bflo(pw.z), bfhi(pw.z), bflo(pw.w), bfhi(pw.w)};
                  y[yb][0] += h0[0] * ALPHA + p0[0]; y[yb][1] += h0[1] * ALPHA + p0[1]; y[yb + 1][0] += h0[2] * ALPHA + p0[2]; y[yb + 1][1] += h0[3] * ALPHA + p0[3];
                  y[yb + 2][0] += h1[0] * ALPHA + p1[0]; y[yb + 2][1] += h1[1] * ALPHA + p1[1]; y[yb + 3][0] += h1[2] * ALPHA + p1[2]; y[yb + 3][1] += h1[3] * ALPHA + p1[3];
                  s += (y[yb][0] + y[yb][1]) + (y[yb + 1][0] + y[yb + 1][1]) + (y[yb + 2][0] + y[yb + 2][1]) + (y[yb + 3][0] + y[yb + 3][1]); }
              CFENCE(); }
          const float mean = wave_sum(s) * (1.0f / 4096.0f); float q = 0.f;
#pragma unroll
          for (int i = 0; i < 32; ++i) { y[i] = y[i] - mean; q += y[i][0] * y[i][0] + y[i][1] * y[i][1]; }
          const float rstd = 1.0f / sqrtf(wave_sum(q) * (1.0f / 4096.0f) + LN_EPS);
          float* orow = OUTP() + (size_t)tok * 4096;
#pragma unroll
          for (int jj = 0; jj < 2; ++jj) {
#pragma unroll
              for (int i = 0; i < 4; ++i) { const int off = (jj * 64 + lane) * 32 + 8 * i; const int yb = (4 * jj + i) * 4;
                  const f32x4 g0 = *(const f32x4*)(g2 + off), g1 = *(const f32x4*)(g2 + off + 4), c0 = *(const f32x4*)(b2 + off), c1 = *(const f32x4*)(b2 + off + 4);
                  *(f32x4*)(orow + off) = (f32x4){y[yb][0] * rstd * g0[0] + c0[0], y[yb][1] * rstd * g0[1] + c0[1], y[yb + 1][0] * rstd * g0[2] + c0[2], y[yb + 1][1] * rstd * g0[3] + c0[3]};
                  *(f32x4*)(orow + off + 4) = (f32x4){y[yb + 2][0] * rstd * g1[0] + c1[0], y[yb + 2][1] * rstd * g1[1] + c1[1], y[yb + 3][0] * rstd * g1[2] + c1[2], y[yb + 3][1] * rstd * g1[3] + c1[3]}; }
              CFENCE(); } }
        CFENCE(); LDS_WAIT();
    }
}
#ifndef DBG_OUT
#define DBG_OUT 0
#endif
__device__ __forceinline__ void dbg_copy(Frame& F, int which) {
    const size_t gt = (size_t)F.bid * NTHREADS + F.tid, gs = (size_t)F.G * NTHREADS, n = (size_t)NTOK * 4096;
    for (size_t i = gt; i < n; i += gs) { const size_t t = i >> 12; const int c = (int)(i & 4095); float v = 0.f;
        if (which == 1) v = WSP(float, WS_F)[i];
        else if (which == 2) v = WSP(float, WS_E)[i];
        else if (which == 3) v = bf2f(WSP(bf16, WS_XB)[i]);
        else if (which == 4) v = (c < 2048) ? bf2f(WSP(bf16, WS_QA)[t * 2048 + c]) : bf2f(WSP(bf16, WS_OB)[t * 2048 + c - 2048]);
        else if (which == 5) v = bf2f(WSP(bf16, WS_OLAT)[i]);
        else if (which == 6) v = bf2f(WSP(bf16, WS_QLAT)[i]);
        else if (which == 7) v = (c < 2048) ? bf2f(WSP(bf16, WS_QIDX)[t * 2048 + c]) : bf2f(WSP(bf16, WS_KB)[t * 2048 + c - 2048]);
        else if (which == 8) v = bf2f(WSP(bf16, WS_F)[t * 8192 + c]);
        else if (which == 9) v = (c < 2048) ? WSP(float, WS_E)[t * 2048 + c] : bf2f(WSP(bf16, WS_PL)[t * 4096 + c]);
        OUTP()[i] = v; }
}

constexpr int N_PHASES = 10;
__global__ void __launch_bounds__(NTHREADS, 2) mk_fwd(Args args) {
    extern __shared__ __attribute__((aligned(16))) unsigned char lds_raw[];
    Frame F;
    F.lds = (LAS unsigned char*)lds_raw; F.tid = threadIdx.x; F.lane = F.tid & 63; F.wave = __builtin_amdgcn_readfirstlane(F.tid >> 6); F.G = gridDim.x; F.bid = blockIdx.x;
    unsigned* ctl = (unsigned*)(WSB() + WS_CTL);
    if (F.tid < 64) ((LAS unsigned*)(F.lds + LDSCTL_OFF))[F.tid] = 0u;
    __syncthreads();
    XcdBarrier bar; bar.bar = ctl + CW_BAR; bar.x = 0; bar.st = nullptr; bar.wave = F.wave;
    if (MK_N_LAUNCHES == 1) bar = xcd_barrier_post(ctl + CW_BAR, (volatile LAS unsigned*)(F.lds + LDSCTL_OFF));
    const int lo = args.ph_lo, hi = args.ph_hi;
#ifndef PROBE_DUP
#define PROBE_DUP -1
#endif
#define IN(k) (lo <= (k) && (k) < hi)
#define REP(k) for (int rep_ = 0; rep_ < ((k) == PROBE_DUP ? 2 : 1); ++rep_)
#define SEAM(k) do { if (IN(k) && IN((k) + 1)) xcd_barrier(bar); } while (0)
    LAS unsigned char* const ldsg = F.lds;
#define RELANE() do { const int l_ = fresh_lane(); F.lane = l_; F.tid = F.wave * 64 + l_; } while (0)

    if (IN(0)) { RELANE(); REP(0) p0_prologue(F); SEAM(0); }
    if (IN(1)) {
        { pg8::Gemm g{WSP(bf16, WS_X8), WSP(bf16, WS_W18), NTOK, N1M, D_MODEL / 2, D_MODEL / 2}; pg8::StaticOrder S; S.init(NTOK, N1M, F.G, F.bid);
          pg8::Epi1 E{WSP(bf16, WS_QA), WSP(bf16, WS_QIDX), WSP(bf16, WS_QB), WSP(bf16, WS_KB), WSP(bf16, WS_VB), WSP(bf16, WS_F), INP(I_BGATE), 0};
          pg8::gemm_phase<pg8::Epi1, pg8::StaticOrder, true, true, true>(ldsg, g, S, E, F.wave); }
        if (F.bid < 256) {
          const int ks = F.bid & 3, sp = (F.bid >> 2) & 1, spm = F.bid >> 3;
          pg8::Gemm g{WSP(bf16, WS_XB) + ks * 1024, WSP(bf16, WS_E) + (size_t)N1M * D_MODEL + ks * 1024, NTOK, 512, 1024, D_MODEL}; pg8::OneUnit S{spm, sp};
          pg8::EpiPart E{WSP(float, WS_PART) + (size_t)(ks * 2 + sp) * NTOK * 256};
          pg8::gemm_phase<pg8::EpiPart, pg8::OneUnit, true, true>(ldsg, g, S, E, F.wave); }
        { pg8::Gemm g{WSP(bf16, WS_PB), WSP(bf16, WS_WPLT), NTOK, D_MODEL, D_PLE, D_PLE}; pg8::StaticOrder S; S.init(NTOK, D_MODEL, F.G, F.bid);
          pg8::EpiBf16P E{WSP(bf16, WS_PL), D_MODEL};
          pg8::gemm_phase<pg8::EpiBf16P, pg8::StaticOrder, true, true>(ldsg, g, S, E, F.wave); }
        SEAM(1);
    }
    if (IN(2)) { RELANE(); REP(2) p2_small(F); SEAM(2); }
    if (IN(3)) { REP(3) { if (!(args.pad & 2)) p3_fox(F); __syncthreads(); if (!(args.pad & 1)) p3_dsa(F, args.pad); __syncthreads(); } SEAM(3); }
    if (IN(4)) { RELANE(); REP(4) p4_oa(F); SEAM(4); }
    if (IN(5)) {
        { pg8::Gemm g{WSP(bf16, WS_QA), WSP(bf16, WS_WBAT), NTOK, D_MODEL, 1024, 1024}; pg8::StaticOrder S; S.init(NTOK, D_MODEL, F.G, F.bid);
          pg8::Epi2a E{WSP(bf16, WS_F), WSP(bf16, WS_E), 1.0f / (Q8_O * Q8_WB)};
          pg8::gemm_phase<pg8::Epi2a, pg8::StaticOrder, true, true, true>(ldsg, g, S, E, F.wave); }
        { pg8::Gemm g{WSP(bf16, WS_OB), WSP(bf16, WS_WBBT), NTOK, D_MODEL, 1024, 1024}; pg8::StaticOrder S; S.init(NTOK, D_MODEL, F.G, F.bid);
          pg8::Epi2b E{WSP(bf16, WS_F), WSP(bf16, WS_E), WSP(bf16, WS_XB), 1.0f / (Q8_O * Q8_WB)};
          pg8::gemm_phase<pg8::Epi2b, pg8::StaticOrder, true, true, true>(ldsg, g, S, E, F.wave); }
        SEAM(5);
    }
    if (IN(6)) {
        pg8::Gemm g{WSP(bf16, WS_XB), WSP(bf16, WS_WOT), NTOK, D_MODEL, D_MODEL / 2, D_MODEL / 2}; pg8::StaticOrder S; S.init(NTOK, D_MODEL, F.G, F.bid);
        pg8::Epi3 E{INP(I_X), WSP(bf16, WS_E), ALPHA, 1.0f / (Q8_MG * Q8_WO)};
        pg8::gemm_phase<pg8::Epi3, pg8::StaticOrder, true, true, true>(ldsg, g, S, E, F.wave);
        SEAM(6);
    }
    if (IN(7)) { RELANE(); REP(7) p7_ln1(F); SEAM(7); }
    if (IN(8)) {
        { pg8::Gemm g{WSP(bf16, WS_X8), WSP(bf16, WS_W48), NTOK, N4, D_MODEL / 2, D_MODEL / 2}; pg8::StaticOrder S; S.init(NTOK, N4, F.G, F.bid);
          pg8::Epi4 E{WSP(float, WS_E), WSP(bf16, WS_PL), INP(I_BPG), 0};
          pg8::gemm_phase<pg8::Epi4, pg8::StaticOrder, true, true, true>(ldsg, g, S, E, F.wave); }
        SEAM(8);
    }
    if (IN(9)) { if (DBG_OUT) dbg_copy(F, DBG_OUT); else { RELANE(); REP(9) p9_peer(F); } }
#undef IN
#undef SEAM
}

extern "C" void kernel_launch(void* const* d_in, const int* in_sizes, int n_in, void* d_out, int out_size, void* d_ws, size_t ws_size, hipStream_t stream) {
    static int grid = 0;
    if (grid == 0) {
        if (n_in != 23 || out_size != NTOK * D_MODEL || ws_size < WS_END) { fprintf(stderr, "kernel_launch: unexpected problem (n_in %d, out %d, ws %zu); nothing launched\n", n_in, out_size, ws_size); grid = -1; return; }
        int dev = 0, cus = 0, per_cu = 0;
        if (hipGetDevice(&dev) != hipSuccess || hipDeviceGetAttribute(&cus, hipDeviceAttributeMultiprocessorCount, dev) != hipSuccess) { grid = -1; return; }
        if (hipFuncSetAttribute((const void*)mk_fwd, hipFuncAttributeMaxDynamicSharedMemorySize, LDS_BYTES) != hipSuccess) { fprintf(stderr, "kernel_launch: hipFuncSetAttribute failed\n"); grid = -1; return; }
        if (hipOccupancyMaxActiveBlocksPerMultiprocessor(&per_cu, (const void*)mk_fwd, NTHREADS, LDS_BYTES) != hipSuccess || per_cu < 1) { fprintf(stderr, "kernel_launch: occupancy query says %d\n", per_cu); (void)hipGetLastError(); grid = -1; return; }
        grid = cus;
    }
    if (grid < 0) return;
    if (hipMemsetAsync((char*)d_ws + WS_CTL, 0, CTL_ZERO_BYTES, stream) != hipSuccess) return;
    Args a{};
    for (int i = 0; i < 23; ++i) a.in[i] = (const float*)d_in[i];
    a.out = (float*)d_out; a.ws = (unsigned char*)d_ws;
    for (int li = 0; li < MK_N_LAUNCHES; ++li) {
#if DBG_OUT
        { const int lastp[10] = {9, 7, 6, 5, 4, 3, 2, 1, 1, 8}; if (MK_N_LAUNCHES > 1 && li > lastp[DBG_OUT] && li != 9) continue; }
#endif
        a.ph_lo = (MK_N_LAUNCHES == 1) ? 0 : li; a.ph_hi = (MK_N_LAUNCHES == 1) ? N_PHASES : li + 1; a.li = li; a.pad = 0;
#ifdef HOST_DUP
        if (MK_N_LAUNCHES > 1 && li == HOST_DUP) {
#ifdef HOST_DUP_PAD
            a.pad = HOST_DUP_PAD;
#endif
            hipLaunchKernelGGL(mk_fwd, dim3(grid), dim3(NTHREADS), LDS_BYTES, stream, a); a.pad = 0; }
#endif
        hipLaunchKernelGGL(mk_fwd, dim3(grid), dim3(NTHREADS), LDS_BYTES, stream, a);
    }
}
```

```cpp
#include <hip/hip_runtime.h>
#include <cstdio>
#include <cstdint>

#ifndef MK_N_LAUNCHES
#define MK_N_LAUNCHES 1
#endif

#define GAS __attribute__((address_space(1)))
#define LAS __attribute__((address_space(3)))
typedef unsigned short bf16;
typedef float f32x4 __attribute__((ext_vector_type(4)));
typedef float f32x2 __attribute__((ext_vector_type(2)));
typedef unsigned u32x4 __attribute__((ext_vector_type(4)));
typedef unsigned u32x2 __attribute__((ext_vector_type(2)));
typedef short bf16x8 __attribute__((ext_vector_type(8)));

constexpr int D_MODEL = 4096, BATCH = 4, SEQ = 2048, NTOK = BATCH * SEQ;
constexpr int A_HEADS = 16, A_HD = 128, A_LAT = 256, IDX_HEADS = 32, IDX_DIM = 64, TOPK = 256, CHUNK = 64;
constexpr int B_HEADS = 16, B_HD = 128;
constexpr int PEER_HEADS = 8, PEER_KEYS = 128, PEER_QDIM = 256, PEER_TOPK = 16, N_EXPERTS = PEER_KEYS * PEER_KEYS, PEER_M = PEER_HEADS * PEER_TOPK;
constexpr int D_PLE = 256;
constexpr int IN_WIDTH = 10608;
constexpr int N1 = 18944;
constexpr int N1M = 18432;
constexpr int N4 = 6144;
constexpr float LN_EPS = 1e-5f;
constexpr float ALPHA = 1.18920711500272f;

__device__ __forceinline__ unsigned f2bf(float f) { unsigned u = __builtin_bit_cast(unsigned, f); return (u + 0x7fffu + ((u >> 16) & 1u)) >> 16; }
typedef __bf16 bf16x2_n __attribute__((ext_vector_type(2)));
__device__ __forceinline__ unsigned pk2(float lo, float hi) { const bf16x2_n b = __builtin_convertvector((f32x2){lo, hi}, bf16x2_n); return __builtin_bit_cast(unsigned, b); }
__device__ __forceinline__ float bflo(unsigned w) { return __builtin_bit_cast(float, w << 16); }
__device__ __forceinline__ float bfhi(unsigned w) { return __builtin_bit_cast(float, w & 0xffff0000u); }
__device__ __forceinline__ float bf2f(bf16 b) { return __builtin_bit_cast(float, (unsigned)b << 16); }
__device__ __forceinline__ float sigmoidf_(float x) { return __builtin_amdgcn_rcpf(1.0f + __expf(-x)); }
__device__ __forceinline__ float wave_sum(float v) {
#pragma unroll
    for (int o = 1; o < 64; o <<= 1) v += __shfl_xor(v, o);
    return v;
}
__device__ __forceinline__ float wave_max(float v) {
#pragma unroll
    for (int o = 1; o < 64; o <<= 1) v = fmaxf(v, __shfl_xor(v, o));
    return v;
}
__device__ __forceinline__ int fresh_lane() { int l; asm volatile("v_mbcnt_lo_u32_b32 %0, -1, 0\n\tv_mbcnt_hi_u32_b32 %0, -1, %0" : "=v"(l)); return l; }
constexpr float Q8_ACT = 30.0f, Q8_W = 1920.0f;
constexpr float Q8_O = 21.0f, Q8_WB = 1368.0f;
constexpr float Q8_MG = 32.0f, Q8_WO = 3250.0f;
__device__ __forceinline__ unsigned pk_q8x4(float a, float b, float c, float d, float sc) {
    const int i0 = __float2int_rn(fminf(fmaxf(a * sc, -127.f), 127.f)), i1 = __float2int_rn(fminf(fmaxf(b * sc, -127.f), 127.f));
    const int i2 = __float2int_rn(fminf(fmaxf(c * sc, -127.f), 127.f)), i3 = __float2int_rn(fminf(fmaxf(d * sc, -127.f), 127.f));
    return (unsigned)(i0 & 255) | ((unsigned)(i1 & 255) << 8) | ((unsigned)(i2 & 255) << 16) | ((unsigned)i3 << 24); }
#define LDS_WAIT() asm volatile("s_waitcnt lgkmcnt(0)" ::: "memory")
#define VM_WAIT() asm volatile("s_waitcnt vmcnt(0)" ::: "memory")
#define CFENCE() asm volatile("" ::: "memory")
namespace pg8 {
#define PG8_LAS __attribute__((address_space(3)))
typedef unsigned short bf16_t;
typedef short bf16x8 __attribute__((ext_vector_type(8)));
typedef float f32x4 __attribute__((ext_vector_type(4)));
typedef unsigned u32x4 __attribute__((ext_vector_type(4)));
constexpr int BM = 256, BK = 64, HALF = 128, HTB = HALF * BK * 2  , STAGE_BYTES = 8 * HTB, NXCD = 8, WGM = 8;

__host__ __device__ __forceinline__ int lds_byte(int r, int c) { const int st = (r >> 4) * 2 + (c >> 5), rr = r & 15, cc = c & 31, ob = rr * 64 + cc * 2; return st * 1024 + (ob ^ (((ob >> 9) & 1) << 5)); }
__host__ __device__ __forceinline__ void stage_rc(int b, int& R, int& C) { const int st = b / 1024, sb = b % 1024, swz = sb ^ (((sb >> 9) & 1) << 5); R = (st >> 1) * 16 + swz / 64; C = (st & 1) * 32 + (swz % 64) / 2; }
__host__ __device__ __forceinline__ int perm32(int rho) { const int n = rho >> 4, i = rho & 15; return 8 * (i >> 2) + 4 * n + (i & 3); }

struct Unit { int pm, pn; };
struct Gemm { const bf16_t* A; const bf16_t* Bt; int M, N, K, ld; };

struct StaticOrder {
    int nM, nN, nwg, G, c;
    __host__ __device__ void init(int M, int N, int G_, int c_) { nM = M / BM; nN = N / BM; nwg = nM * nN; G = G_; c = c_; }
    __host__ __device__ bool next(int i, Unit& u) const {
        const long L = (long)i * G + c; if (L >= nwg) return false;
        int wgid = (int)L; { const int q = nwg / NXCD, r = nwg % NXCD, xcd = wgid % NXCD, off = wgid / NXCD; wgid = (xcd < r ? xcd * (q + 1) : r * (q + 1) + (xcd - r) * q) + off; }
        const int nig = WGM * nN, gid = wgid / nig, fm = gid * WGM, gsz = (nM - fm) < WGM ? (nM - fm) : WGM;
        u.pm = fm + ((wgid % nig) % gsz); u.pn = (wgid % nig) / gsz; return true;
    }
    __device__ __forceinline__ void a_ready(const Unit&) const {}
    __device__ __forceinline__ void done(const Unit&) const {}
};
typedef __bf16 bf16x2_nat __attribute__((ext_vector_type(2)));
__device__ __forceinline__ unsigned cvt_pk_bf16(float lo, float hi) { typedef float f2_ __attribute__((ext_vector_type(2))); const bf16x2_nat b = __builtin_convertvector((f2_){lo, hi}, bf16x2_nat); return __builtin_bit_cast(unsigned, b); }
typedef unsigned u32x2 __attribute__((ext_vector_type(2)));
__device__ __forceinline__ unsigned q8x4(float a, float b, float c, float d, float sc) {
    const int i0 = __float2int_rn(fminf(fmaxf(a * sc, -127.f), 127.f)), i1 = __float2int_rn(fminf(fmaxf(b * sc, -127.f), 127.f));
    const int i2 = __float2int_rn(fminf(fmaxf(c * sc, -127.f), 127.f)), i3 = __float2int_rn(fminf(fmaxf(d * sc, -127.f), 127.f));
    return (unsigned)(i0 & 255) | ((unsigned)(i1 & 255) << 8) | ((unsigned)(i2 & 255) << 16) | ((unsigned)i3 << 24); }
__device__ __forceinline__ float sigm(float x) { return __builtin_amdgcn_rcpf(1.0f + __expf(-x)); }
__device__ __forceinline__ float blo(unsigned w) { return __builtin_bit_cast(float, w << 16); }
__device__ __forceinline__ float bhi(unsigned w) { return __builtin_bit_cast(float, w & 0xffff0000u); }

struct Epi1 {
    static constexpr bool PERM = true, AFTER_DRAIN = false;
    bf16_t *QA, *QIDX, *QB, *KB, *VB, *G; const float* b_gate; int pn_off;
    __device__ __forceinline__ void operator()(const f32x4 (&acc)[2][2][4][2], const Unit& u, int wr, int wc, int fr, int fq) const {
        const int pn = u.pn + pn_off, row0 = u.pm * BM + wr * 64 + fr, cl = wc * 32 + 8 * fq;
        if (pn >= 40) {
            const int gc = (pn - 40) * 256 + cl;
            f32x4 bv[2][2];
#pragma unroll
            for (int bj = 0; bj < 2; ++bj)
#pragma unroll
                for (int n = 0; n < 2; ++n) bv[bj][n] = *(const f32x4*)(b_gate + gc + bj * HALF + 4 * n);
#pragma unroll
            for (int ai = 0; ai < 2; ++ai)
#pragma unroll
                for (int m = 0; m < 4; ++m) { bf16_t* rowp = G + (size_t)(row0 + ai * HALF + m * 16) * 8192 + gc;
#pragma unroll
                    for (int bj = 0; bj < 2; ++bj) { const f32x4 v0 = acc[ai][bj][m][0] * (1.0f / 57600.0f) + bv[bj][0], v1 = acc[ai][bj][m][1] * (1.0f / 57600.0f) + bv[bj][1];
                        u32x4 w; w.x = cvt_pk_bf16(sigm(v0[0]), sigm(v0[1])); w.y = cvt_pk_bf16(sigm(v0[2]), sigm(v0[3])); w.z = cvt_pk_bf16(sigm(v1[0]), sigm(v1[1])); w.w = cvt_pk_bf16(sigm(v1[2]), sigm(v1[3]));
                        *(u32x4*)(rowp + bj * HALF) = w; } }
        } else {
            bf16_t* dst; int c0;
            if (pn < 8) { dst = QA; c0 = pn; } else if (pn < 16) { dst = QIDX; c0 = pn - 8; } else if (pn < 24) { dst = QB; c0 = pn - 16; } else if (pn < 32) { dst = KB; c0 = pn - 24; } else { dst = VB; c0 = pn - 32; }
            c0 = c0 * 256 + cl;
#pragma unroll
            for (int ai = 0; ai < 2; ++ai)
#pragma unroll
                for (int m = 0; m < 4; ++m) { bf16_t* rowp = dst + (size_t)(row0 + ai * HALF + m * 16) * 2048 + c0;
#pragma unroll
                    for (int bj = 0; bj < 2; ++bj) { const f32x4 v0 = acc[ai][bj][m][0] * (1.0f / 57600.0f), v1 = acc[ai][bj][m][1] * (1.0f / 57600.0f);
                        u32x4 w; w.x = cvt_pk_bf16(v0[0], v0[1]); w.y = cvt_pk_bf16(v0[2], v0[3]); w.z = cvt_pk_bf16(v1[0], v1[1]); w.w = cvt_pk_bf16(v1[2], v1[3]);
                        *(u32x4*)(rowp + bj * HALF) = w; } }
        }
    }
};
struct OneUnit {
    int pm, pn;
    __device__ bool next(int i, Unit& u) const { if (i) return false; u.pm = pm; u.pn = pn; return true; }
    __device__ __forceinline__ void a_ready(const Unit&) const {}
    __device__ __forceinline__ void done(const Unit&) const {}
};
struct EpiPart {
    static constexpr bool PERM = true, AFTER_DRAIN = false;
    float* P; float sc;
    __device__ __forceinline__ void operator()(const f32x4 (&acc)[2][2][4][2], const Unit& u, int wr, int wc, int fr, int fq) const {
        const int row0 = u.pm * BM + wr * 64 + fr, cl = wc * 32 + 8 * fq;
#pragma unroll
        for (int ai = 0; ai < 2; ++ai)
#pragma unroll
            for (int m = 0; m < 4; ++m) { float* rowp = P + (size_t)(row0 + ai * HALF + m * 16) * 256 + cl;
#pragma unroll
                for (int bj = 0; bj < 2; ++bj) { *(f32x4*)(rowp + bj * HALF) = acc[ai][bj][m][0] * sc; *(f32x4*)(rowp + bj * HALF + 4) = acc[ai][bj][m][1] * sc; } }
    }
};
struct EpiBf16P {
    static constexpr bool PERM = true, AFTER_DRAIN = false;
    bf16_t* C; int ldc;
    __device__ __forceinline__ void operator()(const f32x4 (&acc)[2][2][4][2], const Unit& u, int wr, int wc, int fr, int fq) const {
        const int row0 = u.pm * BM + wr * 64 + fr, col0 = u.pn * BM + wc * 32 + 8 * fq;
#pragma unroll
        for (int ai = 0; ai < 2; ++ai)
#pragma unroll
            for (int m = 0; m < 4; ++m) { bf16_t* rowp = C + (size_t)(row0 + ai * HALF + m * 16) * ldc + col0;
#pragma unroll
                for (int bj = 0; bj < 2; ++bj) { const f32x4 v0 = acc[ai][bj][m][0], v1 = acc[ai][bj][m][1];
                    u32x4 w; w.x = cvt_pk_bf16(v0[0], v0[1]); w.y = cvt_pk_bf16(v0[2], v0[3]); w.z = cvt_pk_bf16(v1[0], v1[1]); w.w = cvt_pk_bf16(v1[2], v1[3]);
                    *(u32x4*)(rowp + bj * HALF) = w; }
                asm volatile("" ::: "memory"); }
    }
};
struct EpiF32P {
    static constexpr bool PERM = true, AFTER_DRAIN = false;
    float* C; int ldc;
    __device__ __forceinline__ void operator()(const f32x4 (&acc)[2][2][4][2], const Unit& u, int wr, int wc, int fr, int fq) const {
        const int row0 = u.pm * BM + wr * 64 + fr, col0 = u.pn * BM + wc * 32 + 8 * fq;
#pragma unroll
        for (int ai = 0; ai < 2; ++ai)
#pragma unroll
            for (int m = 0; m < 4; ++m) { float* rowp = C + (size_t)(row0 + ai * HALF + m * 16) * ldc + col0;
#pragma unroll
                for (int bj = 0; bj < 2; ++bj) { *(f32x4*)(rowp + bj * HALF) = acc[ai][bj][m][0]; *(f32x4*)(rowp + bj * HALF + 4) = acc[ai][bj][m][1]; } }
    }
};
struct Epi2a {
    static constexpr bool PERM = true, AFTER_DRAIN = false;
    const bf16_t* G; bf16_t* MGT; float sacc;
    __device__ __forceinline__ void operator()(const f32x4 (&acc)[2][2][4][2], const Unit& u, int wr, int wc, int fr, int fq) const {
        const int row0 = u.pm * BM + wr * 64 + fr, col0 = u.pn * BM + wc * 32 + 8 * fq;
#pragma unroll
        for (int ai = 0; ai < 2; ++ai)
#pragma unroll
            for (int m = 0; m < 4; ++m) { const size_t r = (size_t)(row0 + ai * HALF + m * 16);
#pragma unroll
                for (int bj = 0; bj < 2; ++bj) { const u32x4 g = *(const u32x4*)(G + r * 8192 + col0 + bj * HALF); const f32x4 v0 = acc[ai][bj][m][0] * sacc, v1 = acc[ai][bj][m][1] * sacc;
                    u32x4 w; w.x = cvt_pk_bf16(v0[0] * blo(g.x), v0[1] * bhi(g.x)); w.y = cvt_pk_bf16(v0[2] * blo(g.y), v0[3] * bhi(g.y)); w.z = cvt_pk_bf16(v1[0] * blo(g.z), v1[1] * bhi(g.z)); w.w = cvt_pk_bf16(v1[2] * blo(g.w), v1[3] * bhi(g.w));
                    *(u32x4*)(MGT + r * 4096 + col0 + bj * HALF) = w; }
                asm volatile("" ::: "memory"); }
    }
};
struct Epi2b {
    static constexpr bool PERM = true, AFTER_DRAIN = false;
    const bf16_t* G; const bf16_t* MGT; bf16_t* MG; float sacc;
    __device__ __forceinline__ void operator()(const f32x4 (&acc)[2][2][4][2], const Unit& u, int wr, int wc, int fr, int fq) const {
        const int row0 = u.pm * BM + wr * 64 + fr, col0 = u.pn * BM + wc * 32 + 8 * fq;
#pragma unroll
        for (int ai = 0; ai < 2; ++ai)
#pragma unroll
            for (int m = 0; m < 4; ++m) { const size_t r = (size_t)(row0 + ai * HALF + m * 16);
#pragma unroll
                for (int bj = 0; bj < 2; ++bj) { const u32x4 g = *(const u32x4*)(G + r * 8192 + 4096 + col0 + bj * HALF); const f32x4 v0 = acc[ai][bj][m][0] * sacc, v1 = acc[ai][bj][m][1] * sacc;
                    const u32x4 t = *(const u32x4*)(MGT + r * 4096 + col0 + bj * HALF);
                    u32x2 w; w.x = q8x4(blo(t.x) + v0[0] * blo(g.x), bhi(t.x) + v0[1] * bhi(g.x), blo(t.y) + v0[2] * blo(g.y), bhi(t.y) + v0[3] * bhi(g.y), 32.0f);
                    w.y = q8x4(blo(t.z) + v1[0] * blo(g.z), bhi(t.z) + v1[1] * bhi(g.z), blo(t.w) + v1[2] * blo(g.w), bhi(t.w) + v1[3] * bhi(g.w), 32.0f);
                    *(u32x2*)((unsigned char*)MG + r * 4096 + col0 + bj * HALF) = w; }
                asm volatile("" ::: "memory"); }
    }
};
struct Epi3 {
    static constexpr bool PERM = true, AFTER_DRAIN = false;
    const float* X; bf16_t* Y; float alpha, sacc;
    __device__ __forceinline__ void operator()(const f32x4 (&acc)[2][2][4][2], const Unit& u, int wr, int wc, int fr, int fq) const {
        const int row0 = u.pm * BM + wr * 64 + fr, col0 = u.pn * BM + wc * 32 + 8 * fq;
#pragma unroll
        for (int ai = 0; ai < 2; ++ai)
#pragma unroll
            for (int m = 0; m < 4; ++m) { const size_t off = (size_t)(row0 + ai * HALF + m * 16) * 4096 + col0;
#pragma unroll
                for (int bj = 0; bj < 2; ++bj) { const f32x4 x0 = *(const f32x4*)(X + off + bj * HALF), x1 = *(const f32x4*)(X + off + bj * HALF + 4);
                    const f32x4 y0 = x0 * alpha + acc[ai][bj][m][0] * sacc, y1 = x1 * alpha + acc[ai][bj][m][1] * sacc;
                    u32x4 w; w.x = cvt_pk_bf16(y0[0], y0[1]); w.y = cvt_pk_bf16(y0[2], y0[3]); w.z = cvt_pk_bf16(y1[0], y1[1]); w.w = cvt_pk_bf16(y1[2], y1[3]);
                    *(u32x4*)(Y + off + bj * HALF) = w; }
                asm volatile("" ::: "memory"); }
    }
};
struct Epi4 {
    static constexpr bool PERM = true, AFTER_DRAIN = false;
    float* PQ; bf16_t* PL; const float* b_pg; int pn_off;
    __device__ __forceinline__ void operator()(const f32x4 (&acc)[2][2][4][2], const Unit& u, int wr, int wc, int fr, int fq) const {
        const int row0 = u.pm * BM + wr * 64 + fr, cl = wc * 32 + 8 * fq, pn = u.pn + pn_off;
        if (pn < 8) {
#pragma unroll
            for (int ai = 0; ai < 2; ++ai)
#pragma unroll
                for (int m = 0; m < 4; ++m) { float* rowp = PQ + (size_t)(row0 + ai * HALF + m * 16) * 2048 + pn * 256 + cl;
#pragma unroll
                    for (int bj = 0; bj < 2; ++bj) { *(f32x4*)(rowp + bj * HALF) = acc[ai][bj][m][0] * (1.0f / 57600.0f); *(f32x4*)(rowp + bj * HALF + 4) = acc[ai][bj][m][1] * (1.0f / 57600.0f); } }
        } else {
            const int c0 = (pn - 8) * 256 + cl;
            f32x4 bv[2][2];
#pragma unroll
            for (int bj = 0; bj < 2; ++bj)
#pragma unroll
                for (int n = 0; n < 2; ++n) bv[bj][n] = *(const f32x4*)(b_pg + c0 + bj * HALF + 4 * n);
#pragma unroll
            for (int ai = 0; ai < 2; ++ai)
#pragma unroll
                for (int m = 0; m < 4; ++m) { bf16_t* rowp = PL + (size_t)(row0 + ai * HALF + m * 16) * 4096 + c0;
#pragma unroll
                    for (int bj = 0; bj < 2; ++bj) { const u32x4 p = *(const u32x4*)(rowp + bj * HALF);
                        const f32x4 v0 = acc[ai][bj][m][0] * (1.0f / 57600.0f) + bv[bj][0], v1 = acc[ai][bj][m][1] * (1.0f / 57600.0f) + bv[bj][1];
                        u32x4 w; w.x = cvt_pk_bf16(sigm(v0[0]) * blo(p.x), sigm(v0[1]) * bhi(p.x)); w.y = cvt_pk_bf16(sigm(v0[2]) * blo(p.y), sigm(v0[3]) * bhi(p.y));
                        w.z = cvt_pk_bf16(sigm(v1[0]) * blo(p.z), sigm(v1[1]) * bhi(p.z)); w.w = cvt_pk_bf16(sigm(v1[2]) * blo(p.w), sigm(v1[3]) * bhi(p.w));
                        *(u32x4*)(rowp + bj * HALF) = w; }
                    asm volatile("" ::: "memory"); }
        }
    }
};
typedef int pg8_i32x4 __attribute__((ext_vector_type(4)));
typedef int pg8_i32x8 __attribute__((ext_vector_type(8)));
__device__ __forceinline__ pg8_i32x8 cat8(bf16x8 lo, bf16x8 hi) { const pg8_i32x4 a = __builtin_bit_cast(pg8_i32x4, lo), b = __builtin_bit_cast(pg8_i32x4, hi); return __builtin_shufflevector(a, b, 0, 1, 2, 3, 4, 5, 6, 7); }
template <class Epi, class Sched, bool ALIGN_EPI = false, bool SP2 = false, bool F8 = false>
__device__ __forceinline__ void gemm_phase(PG8_LAS unsigned char* lds, const Gemm g, const Sched& S, const Epi& E, const int wave_id) {
    int tid_ = wave_id * 64 + fresh_lane();
    const int tid = tid_, wid = __builtin_amdgcn_readfirstlane(tid >> 6), lane = tid & 63, wr = wid >> 2, wc = wid & 3, fr = lane & 15, fq = lane >> 4;
    const int K = g.K, nt = K / BK, LD = g.ld;
    unsigned voffA, voffB;
    { int R, C; stage_rc(tid * 16, R, C); const int Rb = Epi::PERM ? ((R & ~31) + perm32(R & 31)) : R; voffA = (unsigned)(R * LD + C) * 2u; voffB = (unsigned)(Rb * LD + C) * 2u; }
    const size_t rstep = (size_t)64 * LD * 2;
    const size_t kstep = (size_t)(BK * 2);
    const size_t hstep = (size_t)HALF * LD * 2;
    const size_t tstep = 2 * hstep;
    const unsigned ldsw = (unsigned)wid * 1024u;
    const int aoff = lds_byte(wr * 64 + fr, fq * 8), boff = lds_byte(wc * 32 + fr, fq * 8);
#define PG8_SA(b, h) (((b) * 2 + (h)) * HTB)
#define PG8_SB(b, h) ((4 + (b) * 2 + (h)) * HTB)
#define PG8_STAGE(bufoff, gbase, voff) do { _Pragma("unroll") for (int _i = 0; _i < 2; ++_i) \
        __builtin_amdgcn_global_load_lds((const unsigned*)((const char*)(gbase) + _i * rstep + (voff)), (PG8_LAS unsigned*)(lds + (bufoff) + ldsw + _i * 8192), 16, 0, 0); } while (0)
#define PG8_LDA(dst, b, h) do { _Pragma("unroll") for (int m = 0; m < 4; ++m) _Pragma("unroll") for (int k = 0; k < 2; ++k) dst[m][k] = *(const PG8_LAS bf16x8*)(lds + PG8_SA(b, h) + aoff + m * 2048 + k * 1024); } while (0)
#define PG8_LDB(dst, b, h) do { _Pragma("unroll") for (int n = 0; n < 2; ++n) _Pragma("unroll") for (int k = 0; k < 2; ++k) dst[n][k] = *(const PG8_LAS bf16x8*)(lds + PG8_SB(b, h) + boff + n * 2048 + k * 1024); } while (0)
#define PG8_MMA(ai, bj, At, Bt) do { __builtin_amdgcn_s_setprio(1); _Pragma("unroll") for (int m = 0; m < 4; ++m) _Pragma("unroll") for (int n = 0; n < 2; ++n) { \
        _Pragma("unroll") for (int k = 0; k < 2; ++k) { \
            if constexpr (F8) acc[ai][bj][m][n] = __builtin_bit_cast(f32x4, __builtin_amdgcn_mfma_i32_16x16x64_i8(__builtin_bit_cast(pg8_i32x4, Bt[n][k]), __builtin_bit_cast(pg8_i32x4, At[m][k]), __builtin_bit_cast(pg8_i32x4, acc[ai][bj][m][n]), 0, 0, 0)); \
            else acc[ai][bj][m][n] = __builtin_amdgcn_mfma_f32_16x16x32_bf16(Bt[n][k], At[m][k], acc[ai][bj][m][n], 0, 0, 0); } } __builtin_amdgcn_s_setprio(0); } while (0)
#define PG8_WAIT_V(n) asm volatile("s_waitcnt vmcnt(" #n ")" ::: "memory")
#define PG8_WAIT_L(n) asm volatile("s_waitcnt lgkmcnt(" #n ")" ::: "memory")
#define PG8_BAR __builtin_amdgcn_s_barrier()
#define PG8_SCHED __builtin_amdgcn_sched_barrier(0)
    Unit cur, nxt; int ui = 0;
    if (!S.next(0, cur)) return;
    f32x4 acc[2][2][4][2];
#pragma unroll
    for (int a = 0; a < 2; ++a)
#pragma unroll
        for (int b = 0; b < 2; ++b)
#pragma unroll
            for (int m = 0; m < 4; ++m)
#pragma unroll
                for (int n = 0; n < 2; ++n) acc[a][b][m][n] = (f32x4){0.f, 0.f, 0.f, 0.f};
    bf16x8 At[4][2], B0[2][2], B1[2][2];
    const char* cA = (const char*)g.A + (size_t)cur.pm * tstep; const char* cB = (const char*)g.Bt + (size_t)cur.pn * tstep;
    S.a_ready(cur);
    if constexpr (SP2) {
        PG8_STAGE(PG8_SB(0, 0), cB, voffB); PG8_STAGE(PG8_SB(0, 1), cB + hstep, voffB); PG8_STAGE(PG8_SA(0, 0), cA, voffA); PG8_STAGE(PG8_SA(0, 1), cA + hstep, voffA);
        if (wr == 1) PG8_BAR;
        PG8_WAIT_V(2); PG8_BAR;
        PG8_STAGE(PG8_SB(1, 0), cB + kstep, voffB); PG8_STAGE(PG8_SA(1, 0), cA + kstep, voffA); PG8_STAGE(PG8_SB(1, 1), cB + hstep + kstep, voffB);
        PG8_WAIT_V(6); PG8_BAR;
    } else {
        PG8_STAGE(PG8_SB(0, 0), cB, voffB); PG8_STAGE(PG8_SA(0, 0), cA, voffA); PG8_STAGE(PG8_SB(0, 1), cB + hstep, voffB); PG8_STAGE(PG8_SA(0, 1), cA + hstep, voffA);
        if (wr == 1) PG8_BAR;
        PG8_WAIT_V(4); PG8_BAR;
        PG8_STAGE(PG8_SB(1, 0), cB + kstep, voffB); PG8_STAGE(PG8_SA(1, 0), cA + kstep, voffA); PG8_STAGE(PG8_SB(1, 1), cB + hstep + kstep, voffB);
        PG8_WAIT_V(6); PG8_BAR;
    }
    for (;;) {
        const bool has_next = S.next(ui + 1, nxt);
        const char* nA = has_next ? (const char*)g.A + (size_t)nxt.pm * tstep : cA; const char* nB = has_next ? (const char*)g.Bt + (size_t)nxt.pn * tstep : cB;
#pragma unroll 1
        for (int t = 0; t < nt; t += 2) {
            const bool last = (t == nt - 2);
            const char* a1 = cA + (size_t)(t + 1) * kstep;
            const char* a2 = last ? nA : cA + (size_t)(t + 2) * kstep; const char* b2 = last ? nB : cB + (size_t)(t + 2) * kstep;
            const char* a3 = a2 + kstep; const char* b3 = b2 + kstep;
            if (last && has_next) S.a_ready(nxt);
            if constexpr (SP2) {
            PG8_LDB(B0, 0, 0); PG8_LDB(B1, 0, 1); PG8_SCHED; PG8_LDA(At, 0, 0); PG8_STAGE(PG8_SA(1, 1), a1 + hstep, voffA);
            PG8_WAIT_V(8); PG8_WAIT_L(0); PG8_BAR; PG8_MMA(0, 0, At, B0); PG8_MMA(0, 1, At, B1); PG8_BAR; PG8_SCHED;
            PG8_LDA(At, 0, 1); PG8_STAGE(PG8_SB(0, 0), b2, voffB); PG8_STAGE(PG8_SB(0, 1), b2 + hstep, voffB); PG8_STAGE(PG8_SA(0, 0), a2, voffA);
            PG8_WAIT_V(8); PG8_WAIT_L(0); PG8_BAR; PG8_MMA(1, 0, At, B0); PG8_MMA(1, 1, At, B1); PG8_BAR; PG8_SCHED;
            PG8_LDB(B0, 1, 0); PG8_LDB(B1, 1, 1); PG8_SCHED; PG8_LDA(At, 1, 0); PG8_STAGE(PG8_SA(0, 1), a2 + hstep, voffA);
            PG8_WAIT_V(8); PG8_WAIT_L(0); PG8_BAR; PG8_MMA(0, 0, At, B0); PG8_MMA(0, 1, At, B1); PG8_BAR; PG8_SCHED;
            PG8_LDA(At, 1, 1); PG8_STAGE(PG8_SB(1, 0), b3, voffB); PG8_STAGE(PG8_SB(1, 1), b3 + hstep, voffB); PG8_STAGE(PG8_SA(1, 0), a3, voffA);
            PG8_WAIT_V(8); PG8_WAIT_L(0); PG8_BAR; PG8_MMA(1, 0, At, B0); PG8_MMA(1, 1, At, B1); PG8_BAR; PG8_SCHED;
            } else {
            PG8_LDB(B0, 0, 0); PG8_SCHED; PG8_LDA(At, 0, 0); PG8_STAGE(PG8_SA(1, 1), a1 + hstep, voffA);
            PG8_WAIT_L(8); PG8_BAR; PG8_WAIT_L(0); PG8_MMA(0, 0, At, B0); PG8_BAR; PG8_SCHED;
            PG8_LDB(B1, 0, 1); PG8_STAGE(PG8_SB(0, 0), b2, voffB);
            PG8_BAR; PG8_WAIT_L(0); PG8_MMA(0, 1, At, B1); PG8_BAR;
            PG8_LDA(At, 0, 1); PG8_STAGE(PG8_SA(0, 0), a2, voffA);
            PG8_BAR; PG8_WAIT_L(0); PG8_MMA(1, 0, At, B0); PG8_BAR; PG8_SCHED;
            PG8_STAGE(PG8_SB(0, 1), b2 + hstep, voffB);
            PG8_WAIT_V(6); PG8_BAR; PG8_MMA(1, 1, At, B1); PG8_BAR;
            PG8_LDB(B0, 1, 0); PG8_SCHED; PG8_LDA(At, 1, 0); PG8_STAGE(PG8_SA(0, 1), a2 + hstep, voffA);
            PG8_WAIT_L(8); PG8_BAR; PG8_WAIT_L(0); PG8_MMA(0, 0, At, B0); PG8_BAR; PG8_SCHED;
            PG8_LDB(B1, 1, 1); PG8_STAGE(PG8_SB(1, 0), b3, voffB);
            PG8_BAR; PG8_WAIT_L(0); PG8_MMA(0, 1, At, B1); PG8_BAR;
            PG8_LDA(At, 1, 1); PG8_STAGE(PG8_SA(1, 0), a3, voffA);
            PG8_BAR; PG8_WAIT_L(0); PG8_MMA(1, 0, At, B0); PG8_BAR; PG8_SCHED;
            PG8_STAGE(PG8_SB(1, 1), b3 + hstep, voffB);
            PG8_WAIT_V(6); PG8_BAR; PG8_MMA(1, 1, At, B1); PG8_BAR;
            }
        }
        if constexpr (ALIGN_EPI) { if (wr == 0) PG8_BAR; }
        if constexpr (F8) {
#pragma unroll
            for (int a = 0; a < 2; ++a)
#pragma unroll
                for (int b = 0; b < 2; ++b)
#pragma unroll
                    for (int m = 0; m < 4; ++m)
#pragma unroll
                        for (int n = 0; n < 2; ++n) { const pg8_i32x4 iv = __builtin_bit_cast(pg8_i32x4, acc[a][b][m][n]); acc[a][b][m][n] = (f32x4){(float)iv[0], (float)iv[1], (float)iv[2], (float)iv[3]}; } }
        if constexpr (!Epi::AFTER_DRAIN) { const int le = fresh_lane(); E(acc, cur, wr, wc, le & 15, le >> 4); S.done(cur); }
        if (!has_next) break;
#pragma unroll
        for (int a = 0; a < 2; ++a)
#pragma unroll
            for (int b = 0; b < 2; ++b)
#pragma unroll
                for (int m = 0; m < 4; ++m)
#pragma unroll
                    for (int n = 0; n < 2; ++n) acc[a][b][m][n] = (f32x4){0.f, 0.f, 0.f, 0.f};
        cur = nxt; cA = nA; cB = nB; ++ui;
        if constexpr (ALIGN_EPI) { if (wr == 1) PG8_BAR; }
    }
    PG8_WAIT_V(0);
    if constexpr (!ALIGN_EPI) { if (wr == 0) PG8_BAR; }
    PG8_BAR;
    if constexpr (Epi::AFTER_DRAIN) { E.fused(acc, cur, wr, wc, fr, fq, lds, wid, lane); S.done(cur); }
#undef PG8_SA
#undef PG8_SB
#undef PG8_STAGE
#undef PG8_LDA
#undef PG8_LDB
#undef PG8_MMA
#undef PG8_WAIT_V
#undef PG8_WAIT_L
#undef PG8_BAR
#undef PG8_SCHED
}
}

#define XB_TMO      128
#define XB_XCNT(j)  (256  + 64 * (j))
#define XB_XSUB(j)  (1280 + 64 * (j))
#define XB_XGEN(j)  (2304 + 64 * (j))
#define XB_TOP      3328
#define XB_TOPGEN   3392
#define XCD_BAR_WORDS 3456
#define XB_SPIN_CAP (1u << 18)

__device__ __forceinline__ unsigned xb_ld(unsigned* p)              { return __hip_atomic_load(p, __ATOMIC_RELAXED, __HIP_MEMORY_SCOPE_AGENT); }
__device__ __forceinline__ unsigned xb_add(unsigned* p, unsigned v) { return __hip_atomic_fetch_add(p, v, __ATOMIC_RELAXED, __HIP_MEMORY_SCOPE_AGENT); }
__device__ __forceinline__ unsigned xb_xcc_id() { return (unsigned)__builtin_amdgcn_s_getreg((3 << 11) | 20) & 0xFu; }
#define XB_SPIN(cond, bar) do { unsigned _sp = 0; while (cond) { __builtin_amdgcn_s_sleep(1); \
    if ((++_sp & 255u) == 0u) { if (xb_ld(&(bar)[XB_TMO])) break; if (_sp > XB_SPIN_CAP) { atomicAdd(&(bar)[XB_TMO], 1u); break; } } } } while (0)

struct XcdBarrier {
    unsigned* bar; unsigned x; int wave;
    volatile LAS unsigned* st;
};

__device__ __forceinline__ XcdBarrier xcd_barrier_post(unsigned* bar, volatile LAS unsigned* st) {
    XcdBarrier b; b.bar = bar; b.x = xb_xcc_id(); b.st = st; b.wave = __builtin_amdgcn_readfirstlane(threadIdx.x >> 6);
    if (threadIdx.x == 0) (void)xb_add(&bar[XB_XCNT(b.x)], 1u);
    return b;
}
__device__ __forceinline__ void xcd_barrier_complete(unsigned* bar, unsigned x, unsigned& nloc, unsigned& nx) {
    const unsigned G = gridDim.x * gridDim.y * gridDim.z;
    unsigned sum, cnt, mine, sp = 0u;
    for (;;) {
        sum = 0u; cnt = 0u; mine = 0u;
#pragma unroll
        for (unsigned j = 0; j < 16; ++j) { const unsigned c = xb_ld(&bar[XB_XCNT(j)]); sum += c; cnt += (c > 0u) ? 1u : 0u; mine = (j == x) ? c : mine; }
        if (sum == G) break;
        __builtin_amdgcn_s_sleep(1);
        if ((++sp & 255u) == 0u) { if (xb_ld(&bar[XB_TMO])) break; if (sp > XB_SPIN_CAP) { atomicAdd(&bar[XB_TMO], 1u); break; } }
    }
    nloc = mine > 0u ? mine : 1u; nx = cnt > 0u ? cnt : 1u;
}

__device__ __forceinline__ void xcd_barrier(const XcdBarrier& b) {
    asm volatile("s_waitcnt vmcnt(0)" ::: "memory");
    __syncthreads();
    if (b.wave == 0 && fresh_lane() == 0) {
        unsigned* bar = b.bar;
        __builtin_amdgcn_s_waitcnt(0);
        unsigned nloc = b.st[0], nx = b.st[1];
        if (nloc == 0u) { xcd_barrier_complete(bar, b.x, nloc, nx); b.st[0] = nloc; b.st[1] = nx; }
        const unsigned old = xb_add(&bar[XB_XSUB(b.x)], 1u);
        const unsigned gen = old / nloc;
        if (old + 1u == (gen + 1u) * nloc) {
            __builtin_amdgcn_fence(__ATOMIC_RELEASE, "agent");
            asm volatile("s_waitcnt vmcnt(0)" ::: "memory");
            const unsigned og = xb_add(&bar[XB_TOP], 1u);
            const unsigned tg = og / nx;
            if (og + 1u == (tg + 1u) * nx) xb_add(&bar[XB_TOPGEN], 1u);
            else XB_SPIN(xb_ld(&bar[XB_TOPGEN]) == tg, bar);
            __builtin_amdgcn_fence(__ATOMIC_ACQUIRE, "agent");
            xb_add(&bar[XB_XGEN(b.x)], 1u);
            asm volatile("s_waitcnt vmcnt(0)" ::: "memory");
        } else {
            XB_SPIN(xb_ld(&bar[XB_XGEN(b.x)]) == gen, bar);
            __builtin_amdgcn_fence(__ATOMIC_ACQUIRE, "agent");
            asm volatile("s_waitcnt vmcnt(0)" ::: "memory");
        }
    }
    __syncthreads();
}

constexpr size_t MiB = 1u << 20;
constexpr size_t WS_CTL = 0, CTL_ZERO_BYTES = 1 * MiB;
constexpr size_t WS_UB   = 1 * MiB;
constexpr size_t WS_VT   = WS_UB + 128 * MiB;
constexpr size_t WS_WBAT = WS_VT + 128 * MiB;
constexpr size_t WS_WBBT = WS_WBAT + 16 * MiB;
constexpr size_t WS_WOT  = WS_WBBT + 16 * MiB;
constexpr size_t WS_W4T  = WS_WOT + 32 * MiB;
constexpr size_t WS_WPLT = WS_W4T + 48 * MiB;
constexpr size_t WS_PB   = WS_WPLT + 2 * MiB;
constexpr size_t WS_XB   = WS_PB + 4 * MiB;
constexpr size_t WS_E    = WS_XB + 64 * MiB;
constexpr size_t WS_F    = WS_E + 148 * MiB;
constexpr size_t WS_QA   = WS_F + 128 * MiB;
constexpr size_t WS_QIDX = WS_QA + 32 * MiB;
constexpr size_t WS_QB   = WS_QIDX + 32 * MiB;
constexpr size_t WS_KB   = WS_QB + 32 * MiB;
constexpr size_t WS_VB   = WS_KB + 32 * MiB;
constexpr size_t WS_OB   = WS_VB + 32 * MiB;
constexpr size_t WS_CKV  = WS_OB + 32 * MiB;
constexpr size_t WS_SM   = WS_CKV + 8 * MiB;
constexpr size_t WS_CKVN = WS_SM + 8 * MiB;
constexpr size_t WS_CUM  = WS_CKVN + 4 * MiB;
constexpr size_t WS_PL   = WS_CUM + 1 * MiB;
constexpr size_t WS_WUKB = WS_PL + 128 * MiB;
constexpr size_t WS_WUVT = WS_WUKB + 1 * MiB;
constexpr size_t WS_KIDXB = WS_WUVT + 1 * MiB;
constexpr size_t WS_SCL = WS_KIDXB + 1 * MiB;
constexpr size_t WS_END  = WS_SCL + 1 * MiB;
constexpr size_t WS_PART = WS_UB + 64 * MiB;
constexpr size_t WS_X8   = WS_VT + 32 * MiB;
constexpr size_t WS_W18  = WS_E;
constexpr size_t WS_W48  = WS_VT + 64 * MiB;
constexpr size_t WS_WIDX = WS_SM;
constexpr size_t WS_QLAT = WS_E, WS_OLAT = WS_E + 64 * MiB;
static_assert(WS_END <= (size_t)1174 * MiB, "d_ws map");
constexpr int CW_BAR = 4096;

constexpr int NWAVES = 8, NTHREADS = 512;
constexpr int LDS_BYTES = 147456;
constexpr int LDSCTL_OFF = LDS_BYTES - 256;

typedef float f32x16 __attribute__((ext_vector_type(16)));
typedef short s16x4 __attribute__((ext_vector_type(4)));
template <int K>
__device__ __forceinline__ void small_gemm_tile(const bf16* A, int lda, const bf16* Bt, int ldb, bf16* C, int ldc, int lane, unsigned char* C8 = nullptr, float sc8 = 1.0f) {
    const int r = lane & 15, g = lane >> 4;
    f32x4 acc[4][4];
#pragma unroll
    for (int a = 0; a < 4; ++a)
#pragma unroll
        for (int b = 0; b < 4; ++b) acc[a][b] = (f32x4){0.f, 0.f, 0.f, 0.f};
    const bf16* ap = A + (size_t)r * lda + 8 * g; const bf16* bp = Bt + (size_t)r * ldb + 8 * g;
#pragma unroll 2
    for (int s = 0; s < K / 32; ++s) {
        bf16x8 af[4], bfr[4];
#pragma unroll
        for (int i = 0; i < 4; ++i) { af[i] = *(const bf16x8*)(ap + (size_t)(16 * i) * lda + 32 * s); bfr[i] = *(const bf16x8*)(bp + (size_t)(16 * i) * ldb + 32 * s); }
#pragma unroll
        for (int ni = 0; ni < 4; ++ni)
#pragma unroll
            for (int ti = 0; ti < 4; ++ti) acc[ni][ti] = __builtin_amdgcn_mfma_f32_16x16x32_bf16(bfr[ni], af[ti], acc[ni][ti], 0, 0, 0);
    }
#pragma unroll
    for (int ni = 0; ni < 4; ++ni)
#pragma unroll
        for (int ti = 0; ti < 4; ++ti) {
            if (C8) { *(unsigned*)(C8 + (size_t)(16 * ti + r) * ldc + 16 * ni + 4 * g) = pk_q8x4(acc[ni][ti][0], acc[ni][ti][1], acc[ni][ti][2], acc[ni][ti][3], sc8); continue; }
            u32x2 wv; wv.x = pk2(acc[ni][ti][0], acc[ni][ti][1]); wv.y = pk2(acc[ni][ti][2], acc[ni][ti][3]);
            *(u32x2*)(C + (size_t)(16 * ti + r) * ldc + 16 * ni + 4 * g) = wv; }
}
__device__ __forceinline__ bf16x8 ld8_f32_bf16(const float* p) { const f32x4 a = *(const f32x4*)p, b = *(const f32x4*)(p + 4); union { bf16x8 v; unsigned u[4]; } r; r.u[0] = pk2(a[0], a[1]); r.u[1] = pk2(a[2], a[3]); r.u[2] = pk2(b[0], b[1]); r.u[3] = pk2(b[2], b[3]); return r.v; }
template <int K>
__device__ __forceinline__ void small_gemm_tile_f32(const float* A, int lda, const float* Bt, int ldb, bf16* C, int ldc, int lane, unsigned char* C8 = nullptr) {
    const int r = lane & 15, g = lane >> 4;
    f32x4 acc[4][4];
#pragma unroll
    for (int a = 0; a < 4; ++a)
#pragma unroll
        for (int b = 0; b < 4; ++b) acc[a][b] = (f32x4){0.f, 0.f, 0.f, 0.f};
    const float* ap = A + (size_t)r * lda + 8 * g; const float* bp = Bt + (size_t)r * ldb + 8 * g;
#pragma unroll 1
    for (int s = 0; s < K / 32; ++s) {
        bf16x8 af[4], bfr[4];
#pragma unroll
        for (int i = 0; i < 4; ++i) { af[i] = ld8_f32_bf16(ap + (size_t)(16 * i) * lda + 32 * s); bfr[i] = ld8_f32_bf16(bp + (size_t)(16 * i) * ldb + 32 * s); }
#pragma unroll
        for (int ni = 0; ni < 4; ++ni)
#pragma unroll
            for (int ti = 0; ti < 4; ++ti) acc[ni][ti] = __builtin_amdgcn_mfma_f32_16x16x32_bf16(bfr[ni], af[ti], acc[ni][ti], 0, 0, 0);
    }
#pragma unroll
    for (int ni = 0; ni < 4; ++ni)
#pragma unroll
        for (int ti = 0; ti < 4; ++ti) { u32x2 wv; wv.x = pk2(acc[ni][ti][0], acc[ni][ti][1]); wv.y = pk2(acc[ni][ti][2], acc[ni][ti][3]);
            *(u32x2*)(C + (size_t)(16 * ti + r) * ldc + 16 * ni + 4 * g) = wv;
            if (C8) *(unsigned*)(C8 + (size_t)(16 * ti + r) * ldc + 16 * ni + 4 * g) = pk_q8x4(acc[ni][ti][0], acc[ni][ti][1], acc[ni][ti][2], acc[ni][ti][3], Q8_W); }
}
struct Args { const float* in[23]; float* out; unsigned char* ws; int ph_lo, ph_hi, li, pad; };
enum InIdx { I_X = 0, I_P, I_WIN, I_BFORGET, I_GLAT, I_WUK, I_WUV, I_WBA, I_WBB, I_WGATE, I_BGATE, I_WOUT, I_LN1G, I_LN1B, I_PWQ, I_PSUB, I_PU, I_PV, I_WPLE, I_WPG, I_BPG, I_LN2G, I_LN2B };

struct Frame {
    LAS unsigned char* lds;
    int tid, lane, wave, G, bid;
};
#define KARGQ ((const __attribute__((address_space(4))) unsigned long long*)__builtin_amdgcn_kernarg_segment_ptr())
#define INP(i) ((const float*)(const GAS float*)KARGQ[(i)])
#define OUTP() ((float*)(GAS float*)KARGQ[23])
#define WSB() ((unsigned char*)(GAS unsigned char*)KARGQ[24])
#define WSP(T, off) ((T*)(WSB() + (off)))

__device__ __forceinline__ void transpose_item(const float* W, int ldw, int src_col, int ncols, int k0, bf16* WT, int K, int dst_row0, LAS float* scr, int lane) {
    const int c = lane & 31;
    float tmp[32];
    const float* wp = W + (size_t)(k0 + (lane >> 5)) * ldw + src_col + c;
#pragma unroll
    for (int i = 0; i < 32; ++i) tmp[i] = (c < ncols) ? wp[(size_t)(2 * i) * ldw] : 0.f;
#pragma unroll
    for (int i = 0; i < 32; ++i) scr[(2 * i + (lane >> 5)) * 33 + c] = tmp[i];
    LDS_WAIT();
    const int c8 = lane & 7;
#pragma unroll
    for (int j = 0; j < 4; ++j) { const int n = (lane >> 3) + 8 * j; const LAS float* s = scr + (8 * c8) * 33 + n;
        u32x4 o; o.x = pk2(s[0 * 33], s[1 * 33]); o.y = pk2(s[2 * 33], s[3 * 33]); o.z = pk2(s[4 * 33], s[5 * 33]); o.w = pk2(s[6 * 33], s[7 * 33]);
        *(u32x4*)(WT + (size_t)(dst_row0 + n) * K + k0 + 8 * c8) = o; }
    LDS_WAIT();
}
__device__ __forceinline__ void transpose_item_q8(const float* W, int ldw, int src_col, int k0, unsigned char* WT8, int K, int dst_row0, float sc, LAS float* scr, int lane, int ncols = 32) {
    const int c = lane & 31;
    float tmp[32];
    const float* wp = W + (size_t)(k0 + (lane >> 5)) * ldw + src_col + c;
#pragma unroll
    for (int i = 0; i < 32; ++i) tmp[i] = (c < ncols) ? wp[(size_t)(2 * i) * ldw] : 0.f;
#pragma unroll
    for (int i = 0; i < 32; ++i) scr[(2 * i + (lane >> 5)) * 33 + c] = tmp[i];
    LDS_WAIT();
    const int c8 = lane & 7;
#pragma unroll
    for (int j = 0; j < 4; ++j) { const int n = (lane >> 3) + 8 * j; const LAS float* s = scr + (8 * c8) * 33 + n;
        u32x2 o; o.x = pk_q8x4(s[0 * 33], s[1 * 33], s[2 * 33], s[3 * 33], sc); o.y = pk_q8x4(s[4 * 33], s[5 * 33], s[6 * 33], s[7 * 33], sc);
        *(u32x2*)(WT8 + (size_t)(dst_row0 + n) * K + k0 + 8 * c8) = o; }
    LDS_WAIT();
}
__device__ __forceinline__ void cvt_bf16_stream(const float* src, bf16* dst, size_t n8, size_t gt, size_t gstride) {
    size_t i = gt;
    for (; i + 3 * gstride < n8; i += 4 * gstride) {
        f32x4 a[4], b[4];
#pragma unroll
        for (int u = 0; u < 4; ++u) { a[u] = *(const f32x4*)(src + (i + u * gstride) * 8); b[u] = *(const f32x4*)(src + (i + u * gstride) * 8 + 4); }
#pragma unroll
        for (int u = 0; u < 4; ++u) { u32x4 o; o.x = pk2(a[u][0], a[u][1]); o.y = pk2(a[u][2], a[u][3]); o.z = pk2(b[u][0], b[u][1]); o.w = pk2(b[u][2], b[u][3]); *(u32x4*)(dst + (i + u * gstride) * 8) = o; } }
    for (; i < n8; i += gstride) { const f32x4 a = *(const f32x4*)(src + i * 8), b = *(const f32x4*)(src + i * 8 + 4);
        u32x4 o; o.x = pk2(a[0], a[1]); o.y = pk2(a[2], a[3]); o.z = pk2(b[0], b[1]); o.w = pk2(b[2], b[3]); *(u32x4*)(dst + i * 8) = o; }
}
__device__ __forceinline__ void p0_prologue(Frame& F) {
    LAS float* scr = (LAS float*)(F.lds + F.wave * 16384);
    const int gw = F.bid * NWAVES + F.wave, NGW = F.G * NWAVES;
    const float* w_in = INP(I_WIN); const float* w_gate = INP(I_WGATE);
    constexpr int NDB1 = N1 / 32, I_1 = NDB1 * 64;
    constexpr int I_BA = 128 * 32, I_BB = I_BA, I_O = 128 * 64, I_4 = 128 * 64, I_PL = 128 * 4;
    constexpr int NITEMS = I_1 + I_BA + I_BB + I_O + I_4 + I_PL;
    for (int it = gw; it < NITEMS; it += NGW) {
        int r = it;
        if (r < I_1) { const int kb = r / NDB1, db = r % NDB1; const float* W = w_in; int ldw = IN_WIDTH, col, nc = 32;
            if (db < 64) col = db * 32;
            else if (db < 128) col = 2304 + (db - 64) * 32;
            else if (db < 320) col = 4448 + (db - 128) * 32;
            else if (db < 576) { W = w_gate; ldw = 8192; col = (db - 320) * 32; }
            else if (db < 584) col = 2048 + (db - 576) * 32;
            else { const int j = db - 584; col = (j < 2) ? 4352 + 32 * j : (j == 2 ? 4416 : 10592); nc = (j < 3) ? 32 : (j == 3 ? 16 : 0); }
            transpose_item_q8(W, ldw, col, kb * 64, WSP(unsigned char, WS_W18), 4096, db * 32, Q8_W, scr, F.lane, nc); continue; }
        r -= I_1;
        if (r < I_BA) { const int kb = r / 128, db = r % 128; transpose_item_q8(INP(I_WBA), 4096, db * 32, kb * 64, WSP(unsigned char, WS_WBAT), 2048, db * 32, Q8_WB, scr, F.lane); continue; }
        r -= I_BA;
        if (r < I_BB) { const int kb = r / 128, db = r % 128; transpose_item_q8(INP(I_WBB), 4096, db * 32, kb * 64, WSP(unsigned char, WS_WBBT), 2048, db * 32, Q8_WB, scr, F.lane); continue; }
        r -= I_BB;
        if (r < I_O) { const int kb = r / 128, db = r % 128; transpose_item_q8(INP(I_WOUT), 4096, db * 32, kb * 64, WSP(unsigned char, WS_WOT), 4096, db * 32, Q8_WO, scr, F.lane); continue; }
        r -= I_O;
        if (r < I_4) { const int kb = r / 128, db = r % 128;
            transpose_item_q8(INP(I_WPG), 4096, db * 32, kb * 64, WSP(unsigned char, WS_W48), 4096, 2048 + db * 32, Q8_W, scr, F.lane); continue; }
        r -= I_4;
        { const int kb = r / 128, db = r % 128; transpose_item(INP(I_WPLE), 4096, db * 32, 32, kb * 64, WSP(bf16, WS_WPLT), 256, db * 32, scr, F.lane); }
    }
    for (int it = gw; it < 16 * 2 * 64; it += NGW) { const int dt = it & 63, nt = (it >> 6) & 1, l = it >> 7;
        small_gemm_tile_f32<128>(INP(I_PSUB) + (size_t)(l * 128 + nt * 64) * 128, 128, INP(I_PWQ) + (size_t)(dt * 64) * 2048 + (l >> 1) * 256 + (l & 1) * 128, 2048,
                                 WSP(bf16, WS_W4T) + (size_t)(l * 128 + nt * 64) * 4096 + dt * 64, 4096, F.lane, WSP(unsigned char, WS_W48) + (size_t)(l * 128 + nt * 64) * 4096 + dt * 64); }
    const size_t gt = (size_t)F.bid * NTHREADS + F.tid, gs = (size_t)F.G * NTHREADS;
    { const float* src = INP(I_X); unsigned char* d8 = WSP(unsigned char, WS_X8); const size_t n8 = (size_t)NTOK * D_MODEL / 8;
      size_t i = gt;
      for (; i + 3 * gs < n8; i += 4 * gs) {
          f32x4 a[4], b[4];
#pragma unroll
          for (int u = 0; u < 4; ++u) { a[u] = *(const f32x4*)(src + (i + u * gs) * 8); b[u] = *(const f32x4*)(src + (i + u * gs) * 8 + 4); }
#pragma unroll
          for (int u = 0; u < 4; ++u) { u32x2 q; q.x = pk_q8x4(a[u][0], a[u][1], a[u][2], a[u][3], Q8_ACT); q.y = pk_q8x4(b[u][0], b[u][1], b[u][2], b[u][3], Q8_ACT); *(u32x2*)(d8 + (i + u * gs) * 8) = q; } }
      for (; i < n8; i += gs) { const f32x4 a = *(const f32x4*)(src + i * 8), b = *(const f32x4*)(src + i * 8 + 4);
          u32x2 q; q.x = pk_q8x4(a[0], a[1], a[2], a[3], Q8_ACT); q.y = pk_q8x4(b[0], b[1], b[2], b[3], Q8_ACT); *(u32x2*)(d8 + i * 8) = q; } }
    cvt_bf16_stream(INP(I_P), WSP(bf16, WS_PB), (size_t)NTOK * D_PLE / 8, gt, gs);
    { float* SCL = WSP(float, WS_SCL);
      for (int row = gw; row < 2 * N_EXPERTS; row += NGW) { const int tb = row >= N_EXPERTS ? 1 : 0, e = row - tb * N_EXPERTS;
          const float* src = (tb ? INP(I_PV) : INP(I_PU)) + (size_t)e * 4096; unsigned char* dst = (tb ? WSP(unsigned char, WS_VT) : WSP(unsigned char, WS_UB)) + (size_t)e * 2048;
          f32x4 v[16]; float ssq = 0.f;
#pragma unroll
          for (int jj = 0; jj < 2; ++jj)
#pragma unroll
              for (int q = 0; q < 8; ++q) { const f32x4 x = *(const f32x4*)(src + (jj * 64 + F.lane) * 32 + 4 * q); v[8 * jj + q] = x; ssq += (x[0] * x[0] + x[1] * x[1]) + (x[2] * x[2] + x[3] * x[3]); }
          const float sig = sqrtf(wave_sum(ssq) * (1.0f / 4096.0f)); const float inv = sig > 0.f ? 2.1f / sig : 0.f;
#pragma unroll
          for (int jj = 0; jj < 2; ++jj) { u32x4 o;
#pragma unroll
              for (int i = 0; i < 4; ++i) { const f32x4 a = v[8 * jj + 2 * i] * inv, b = v[8 * jj + 2 * i + 1] * inv; unsigned p = 0u;
                  p = __builtin_amdgcn_cvt_scalef32_pk_fp4_f32(p, a[0], a[1], 1.0f, 0); p = __builtin_amdgcn_cvt_scalef32_pk_fp4_f32(p, a[2], a[3], 1.0f, 1);
                  p = __builtin_amdgcn_cvt_scalef32_pk_fp4_f32(p, b[0], b[1], 1.0f, 2); p = __builtin_amdgcn_cvt_scalef32_pk_fp4_f32(p, b[2], b[3], 1.0f, 3); o[i] = p; }
              *(u32x4*)(dst + (jj * 64 + F.lane) * 16) = o; }
          if (F.lane == 0) SCL[row] = sig > 0.f ? sig * (1.0f / 2.1f) : 1.0f; } }
    { const float* w_uk = INP(I_WUK); const float* w_uv = INP(I_WUV); bf16* WUKB = WSP(bf16, WS_WUKB); bf16* WUVT = WSP(bf16, WS_WUVT);
      for (size_t i = gt; i < 65536; i += gs) { const int d8 = (int)(i & 15), c = (int)(i >> 4) & 255, h = (int)(i >> 12);
          const float* src = w_uk + (size_t)c * 2048 + h * 128 + d8 * 8; const f32x4 a = *(const f32x4*)src, b = *(const f32x4*)(src + 4);
          u32x4 o; o.x = pk2(a[0], a[1]); o.y = pk2(a[2], a[3]); o.z = pk2(b[0], b[1]); o.w = pk2(b[2], b[3]); *(u32x4*)(WUKB + i * 8) = o; }
      for (size_t i = gt; i < 65536; i += gs) { const int c8 = (int)(i & 31), d = (int)(i >> 5) & 127, h = (int)(i >> 12);
          const float* src = w_uv + (size_t)(c8 * 8) * 2048 + h * 128 + d;
          u32x4 o; o.x = pk2(src[0], src[2048]); o.y = pk2(src[2 * 2048], src[3 * 2048]); o.z = pk2(src[4 * 2048], src[5 * 2048]); o.w = pk2(src[6 * 2048], src[7 * 2048]); *(u32x4*)(WUVT + i * 8) = o; } }
}

__device__ __forceinline__ f32x4 part_sum4(const float* PART, int tile, size_t off) { const size_t pl = (size_t)NTOK * 256; const float* p = PART + (size_t)tile * pl + off;
    return (*(const f32x4*)p + *(const f32x4*)(p + 2 * pl)) + (*(const f32x4*)(p + 4 * pl) + *(const f32x4*)(p + 6 * pl)); }
__device__ __forceinline__ float log_sigmoid(float z) { return fminf(z, 0.f) - log1pf(__expf(-fabsf(z))); }
__device__ __forceinline__ void p2_small(Frame& F) {
    const int gw = F.bid * NWAVES + F.wave, NGW = F.G * NWAVES, lane = F.lane;
    { const float* PART = WSP(float, WS_PART); bf16* CKVN = WSP(bf16, WS_CKVN); const f32x4 g = *(const f32x4*)(INP(I_GLAT) + 4 * lane);
      for (int t = gw; t < NTOK; t += NGW) { const f32x4 v = part_sum4(PART, 0, (size_t)t * 256 + 4 * lane);
          const float ss = wave_sum(v[0] * v[0] + v[1] * v[1] + v[2] * v[2] + v[3] * v[3]); const float r = 1.0f / sqrtf(ss * (1.0f / 256.0f) + LN_EPS);
          u32x2 o; o.x = pk2(v[0] * r * g[0], v[1] * r * g[1]); o.y = pk2(v[2] * r * g[2], v[3] * r * g[3]); *(u32x2*)(CKVN + (size_t)t * 256 + 4 * lane) = o; } }
    { const float* PART = WSP(float, WS_PART); float* CUML = WSP(float, WS_CUM); float* SEGT = WSP(float, WS_CUM + 512 * 1024); const float* bfp = INP(I_BFORGET);
      for (int it = gw; it < BATCH * (SEQ / 64); it += NGW) { const int b = it / (SEQ / 64), seg = it % (SEQ / 64), pos = seg * 64 + lane;
          f32x4 f[4];
#pragma unroll
          for (int q = 0; q < 4; ++q) f[q] = part_sum4(PART, 1, (size_t)(b * SEQ + pos) * 256 + 96 + 4 * q);
#pragma unroll
          for (int h = 0; h < B_HEADS; ++h) { float v = log_sigmoid(f[h >> 2][h & 3] + bfp[h]);
#pragma unroll
              for (int o = 1; o < 64; o <<= 1) { const float t = __shfl_up(v, o); if (lane >= o) v += t; }
              CUML[(size_t)(b * B_HEADS + h) * SEQ + pos] = v; if (lane == 63) SEGT[(b * B_HEADS + h) * (SEQ / 64) + seg] = v; } } }
    { const bf16* QA = WSP(bf16, WS_QA); bf16* QLAT = WSP(bf16, WS_QLAT); const bf16* WUKB = WSP(bf16, WS_WUKB);
      for (int it = gw; it < (NTOK / 64) * A_HEADS * 4; it += NGW) { const int ct = it & 3, h = (it >> 2) & 15, tt = it >> 6;
          small_gemm_tile<128>(QA + (size_t)tt * 64 * 2048 + h * 128, 2048, WUKB + (size_t)(h * 256 + ct * 64) * 128, 128, QLAT + (size_t)tt * 64 * 4096 + h * 256 + ct * 64, 4096, lane); } }
    { const float* PART = WSP(float, WS_PART); bf16* KIDXB = WSP(bf16, WS_KIDXB); float* WIDX = WSP(float, WS_WIDX); const size_t gt = (size_t)F.bid * NTHREADS + F.tid, gs = (size_t)F.G * NTHREADS;
      for (size_t i = gt; i < (size_t)NTOK * 8; i += gs) { const size_t t = i >> 3; const int q = (int)(i & 7); *(f32x4*)(WIDX + t * 32 + 4 * q) = part_sum4(PART, 1, t * 256 + 64 + 4 * q); }
      for (size_t i = gt; i < (size_t)NTOK * 8; i += gs) { const size_t t = i >> 3; const int c8 = (int)(i & 7); const f32x4 a = part_sum4(PART, 1, t * 256 + c8 * 8), b = part_sum4(PART, 1, t * 256 + c8 * 8 + 4);
          u32x4 o; o.x = pk2(a[0], a[1]); o.y = pk2(a[2], a[3]); o.z = pk2(b[0], b[1]); o.w = pk2(b[2], b[3]);
          const size_t tl = t & (SEQ - 1); *(u32x4*)(KIDXB + (t - tl) * 64 + (tl >> 5) * 2048 + (c8 >> 1) * 512 + (tl & 31) * 16 + (c8 & 1) * 8) = o; } }
}

__device__ __forceinline__ unsigned f2key(float f) { const unsigned b = __builtin_bit_cast(unsigned, f); return (b & 0x80000000u) ? ~b : (b | 0x80000000u); }
__device__ __forceinline__ int lanes_below(unsigned long long m) { return (int)__builtin_amdgcn_mbcnt_hi((unsigned)(m >> 32), __builtin_amdgcn_mbcnt_lo((unsigned)m, 0u)); }
__device__ __forceinline__ void p4_oa(Frame& F) {
    const int gw = F.bid * NWAVES + F.wave, NGW = F.G * NWAVES, lane = F.lane;
    const bf16* OLAT = WSP(bf16, WS_OLAT); bf16* OA = WSP(bf16, WS_QA); const bf16* WUVT = WSP(bf16, WS_WUVT);
    for (int it = gw; it < (NTOK / 64) * A_HEADS * 2; it += NGW) { const int dt = it & 1, h = (it >> 1) & 15, tt = it >> 5;
        small_gemm_tile<256>(OLAT + (size_t)tt * 64 * 4096 + h * 256, 4096, WUVT + (size_t)(h * 128 + dt * 64) * 256, 256, nullptr, 2048, lane, (unsigned char*)OA + (size_t)tt * 64 * 2048 + h * 128 + dt * 64, Q8_O); }
}
__device__ __forceinline__ void p7_ln1(Frame& F) {
    const int gw = F.bid * NWAVES + F.wave, NGW = F.G * NWAVES, lane = F.lane;
    const bf16* Y1 = WSP(bf16, WS_E); bf16* H1B = WSP(bf16, WS_XB); unsigned char* H18 = WSP(unsigned char, WS_X8); const float* g = INP(I_LN1G); const float* bb = INP(I_LN1B);
    for (int t = gw; t < NTOK; t += NGW) { const bf16* yr = Y1 + (size_t)t * 4096;
        f32x4 v[16]; float s = 0.f;
#pragma unroll
        for (int j = 0; j < 8; ++j) { const u32x4 w = *(const u32x4*)(yr + (j * 64 + lane) * 8); v[2 * j] = (f32x4){bflo(w.x), bfhi(w.x), bflo(w.y), bfhi(w.y)}; v[2 * j + 1] = (f32x4){bflo(w.z), bfhi(w.z), bflo(w.w), bfhi(w.w)};
            s += (v[2 * j][0] + v[2 * j][1]) + (v[2 * j][2] + v[2 * j][3]) + (v[2 * j + 1][0] + v[2 * j + 1][1]) + (v[2 * j + 1][2] + v[2 * j + 1][3]); }
        const float mean = wave_sum(s) * (1.0f / 4096.0f); float q = 0.f;
#pragma unroll
        for (int j = 0; j < 16; ++j) { v[j] = v[j] - mean; q += (v[j][0] * v[j][0] + v[j][1] * v[j][1]) + (v[j][2] * v[j][2] + v[j][3] * v[j][3]); }
        const float rstd = 1.0f / sqrtf(wave_sum(q) * (1.0f / 4096.0f) + LN_EPS);
#pragma unroll
        for (int j = 0; j < 8; ++j) { const int off = (j * 64 + lane) * 8; const f32x4 g0 = *(const f32x4*)(g + off), g1 = *(const f32x4*)(g + off + 4), b0 = *(const f32x4*)(bb + off), b1 = *(const f32x4*)(bb + off + 4);
            const f32x4 o0 = v[2 * j] * rstd * g0 + b0, o1 = v[2 * j + 1] * rstd * g1 + b1;
            u32x4 w; w.x = pk2(o0[0], o0[1]); w.y = pk2(o0[2], o0[3]); w.z = pk2(o1[0], o1[1]); w.w = pk2(o1[2], o1[3]); *(u32x4*)(H1B + (size_t)t * 4096 + off) = w;
            u32x2 q8; q8.x = pk_q8x4(o0[0], o0[1], o0[2], o0[3], Q8_ACT); q8.y = pk_q8x4(o1[0], o1[1], o1[2], o1[3], Q8_ACT); *(u32x2*)(H18 + (size_t)t * 4096 + off) = q8; } }
}
constexpr int FOX_KP = 272, FOX_VP = 320, FOX_VOFF = 17408, FOX_COFF = 37888;
__device__ __forceinline__ void fox_unit(Frame& F, int b, int h, int qb) {
    const int tid = F.tid, lane = F.lane, w = F.wave, r = lane & 31, hh = lane >> 5;
    LAS unsigned char* Ks = F.lds; LAS unsigned char* Vs = F.lds + FOX_VOFF; LAS float* cks = (LAS float*)(F.lds + FOX_COFF);
    const bf16* QB = WSP(bf16, WS_QB); const bf16* KB = WSP(bf16, WS_KB); const bf16* VB = WSP(bf16, WS_VB); bf16* OB = WSP(bf16, WS_OB);
    const float* cum = WSP(float, WS_CUM) + (size_t)(b * B_HEADS + h) * SEQ;
    LAS float* segp = (LAS float*)(F.lds + FOX_COFF + 256);
    const int Q0 = qb * 256, q0 = Q0 + 32 * w, ntiles = (Q0 + 256) / 64, tl = (q0 + 31) / 64;
    const float SC = 0.12751741614123135f, LOG2E = 1.4426950408889634f;
    bf16x8 qf[8];
    { const bf16* qp = QB + ((size_t)b * SEQ + q0 + r) * 2048 + h * 128 + 8 * hh;
#pragma unroll
      for (int s = 0; s < 8; ++s) qf[s] = *(const bf16x8*)(qp + 16 * s); }
    f32x16 o[4];
#pragma unroll
    for (int dt = 0; dt < 4; ++dt)
#pragma unroll
        for (int i = 0; i < 16; ++i) o[dt][i] = 0.f;
    float m = -1e30f, l = 0.f;
    const int pk0 = tid >> 4, pc0 = tid & 15;
    const bf16* kg = KB + ((size_t)b * SEQ + pk0) * 2048 + h * 128 + 8 * pc0; const bf16* vg = VB + ((size_t)b * SEQ + pk0) * 2048 + h * 128 + 8 * pc0;
    u32x4 kr0, kr1, vr0, vr1; float cr = 0.f;
#define FOX_LOAD(kt) do { const size_t go = (size_t)(kt) * 64 * 2048; kr0 = *(const u32x4*)(kg + go); kr1 = *(const u32x4*)(kg + go + 32 * 2048); vr0 = *(const u32x4*)(vg + go); vr1 = *(const u32x4*)(vg + go + 32 * 2048); \
        if (tid < 64) cr = (cum[(kt) * 64 + tid] + segp[(kt)]) * LOG2E; } while (0)
    if (tid < 64) { float v = (lane < 32) ? WSP(float, WS_CUM + 512 * 1024)[(b * B_HEADS + h) * (SEQ / 64) + lane] : 0.f; const float own = v;
#pragma unroll
        for (int o = 1; o < 32; o <<= 1) { const float t = __shfl_up(v, o); if (lane >= o) v += t; }
        if (lane < 32) segp[lane] = v - own;
        CFENCE(); LDS_WAIT(); }
    FOX_LOAD(0);
    const int ka_off = r * FOX_KP + 16 * hh;
    const int vt_off = (4 * hh + ((lane & 15) >> 2)) * FOX_VP + (16 * ((lane >> 4) & 1) + 4 * (lane & 3)) * 2;
    const int ck_off = 4 * hh;
    for (int kt = 0; kt < ntiles; ++kt) {
        __syncthreads();
        *(LAS u32x4*)(Ks + pk0 * FOX_KP + pc0 * 16) = kr0; *(LAS u32x4*)(Ks + (pk0 + 32) * FOX_KP + pc0 * 16) = kr1;
        *(LAS u32x4*)(Vs + pk0 * FOX_VP + pc0 * 16) = vr0; *(LAS u32x4*)(Vs + (pk0 + 32) * FOX_VP + pc0 * 16) = vr1;
        if (tid < 64) cks[tid] = cr;
        __syncthreads();
        if (kt + 1 < ntiles) FOX_LOAD(kt + 1);
        if (kt <= tl) {
            f32x16 s0, s1;
#pragma unroll
            for (int i = 0; i < 16; ++i) { s0[i] = 0.f; s1[i] = 0.f; }
#pragma unroll
            for (int s = 0; s < 8; ++s) { const bf16x8 a0 = *(const LAS bf16x8*)(Ks + ka_off + 32 * s), a1 = *(const LAS bf16x8*)(Ks + ka_off + 32 * FOX_KP + 32 * s);
                s0 = __builtin_amdgcn_mfma_f32_32x32x16_bf16(a0, qf[s], s0, 0, 0, 0); s1 = __builtin_amdgcn_mfma_f32_32x32x16_bf16(a1, qf[s], s1, 0, 0, 0); }
            const bool diag = (64 * kt + 63 > q0); const int qme = q0 + r - 64 * kt;
            float mx = m;
#pragma unroll
            for (int g4 = 0; g4 < 4; ++g4) { const f32x4 c0 = *(const LAS f32x4*)(cks + ck_off + 8 * g4), c1 = *(const LAS f32x4*)(cks + ck_off + 32 + 8 * g4);
#pragma unroll
                for (int i = 0; i < 4; ++i) { const int kl = 8 * g4 + 4 * hh + i; float t0 = s0[4 * g4 + i] * SC - c0[i], t1 = s1[4 * g4 + i] * SC - c1[i];
                    if (diag) { if (kl > qme) t0 = -INFINITY; if (kl + 32 > qme) t1 = -INFINITY; }
                    s0[4 * g4 + i] = t0; s1[4 * g4 + i] = t1; mx = fmaxf(mx, fmaxf(t0, t1)); } }
            mx = fmaxf(mx, __shfl_xor(mx, 32));
            if (__any(mx > m + 8.0f)) {
                const float alpha = __builtin_amdgcn_exp2f(m - mx); m = mx; l *= alpha;
#pragma unroll
                for (int dt = 0; dt < 4; ++dt)
#pragma unroll
                    for (int i = 0; i < 16; ++i) o[dt][i] *= alpha; }
            float ls = 0.f;
            union { bf16x8 v; unsigned u[4]; } pf[4];
#pragma unroll
            for (int ks = 0; ks < 2; ++ks)
#pragma unroll
                for (int j = 0; j < 4; ++j) { const float a0 = __builtin_amdgcn_exp2f(s0[8 * ks + 2 * j] - m), a1 = __builtin_amdgcn_exp2f(s0[8 * ks + 2 * j + 1] - m);
                    const float b0 = __builtin_amdgcn_exp2f(s1[8 * ks + 2 * j] - m), b1 = __builtin_amdgcn_exp2f(s1[8 * ks + 2 * j + 1] - m);
                    ls += (a0 + a1) + (b0 + b1); pf[ks].u[j] = pk2(a0, a1); pf[2 + ks].u[j] = pk2(b0, b1); }
            l += ls;
#pragma unroll
            for (int f = 0; f < 4; ++f) {
                const int vb = vt_off + 16 * f * FOX_VP;
#pragma unroll
                for (int dt = 0; dt < 4; ++dt) {
                    const s16x4 x0 = __builtin_amdgcn_ds_read_tr16_b64_v4i16((LAS s16x4*)(Vs + vb + 64 * dt)), x1 = __builtin_amdgcn_ds_read_tr16_b64_v4i16((LAS s16x4*)(Vs + vb + 8 * FOX_VP + 64 * dt));
                    const bf16x8 af = {x0[0], x0[1], x0[2], x0[3], x1[0], x1[1], x1[2], x1[3]};
                    o[dt] = __builtin_amdgcn_mfma_f32_32x32x16_bf16(af, pf[f].v, o[dt], 0, 0, 0); }
                __builtin_amdgcn_sched_barrier(0);
            }
        }
    }
#undef FOX_LOAD
    l += __shfl_xor(l, 32);
    const float inv = 1.0f / l;
    unsigned char* op = (unsigned char*)OB + ((size_t)b * SEQ + q0 + r) * 2048 + h * 128 + 4 * hh;
#pragma unroll
    for (int dt = 0; dt < 4; ++dt)
#pragma unroll
        for (int g4 = 0; g4 < 4; ++g4) *(unsigned*)(op + 32 * dt + 8 * g4) = pk_q8x4(o[dt][4 * g4] * inv, o[dt][4 * g4 + 1] * inv, o[dt][4 * g4 + 2] * inv, o[dt][4 * g4 + 3] * inv, Q8_O);
}
__device__ __forceinline__ void p3_fox(Frame& F) {
    for (int pr = F.bid; pr < BATCH * B_HEADS * 4; pr += F.G) { const int bh = pr >> 2, j = pr & 3, b = bh >> 4, h = bh & 15;
        fox_unit(F, b, h, 7 - j);
        fox_unit(F, b, h, j); }
}
constexpr int DSA_WLDS = 16896;
__device__ __forceinline__ void p3_dsa(Frame& F, int flags) {
    const int gw = F.bid * NWAVES + F.wave, NGW = F.G * NWAVES;
    LAS unsigned char* wb = F.lds + F.wave * DSA_WLDS;
    LAS float* SCb2 = (LAS float*)wb; LAS unsigned short* IDX = (LAS unsigned short*)(wb + 16384);
    const bf16* QIDX = WSP(bf16, WS_QIDX); const bf16* KIDXB = WSP(bf16, WS_KIDXB); const float* WIDX = WSP(float, WS_WIDX); const bf16* CKVN = WSP(bf16, WS_CKVN); const bf16* QLAT = WSP(bf16, WS_QLAT); bf16* OLAT = WSP(bf16, WS_OLAT);
    const float idx_scale = 0.022097086912079608f, SCL = 0.12751741614123135f  ;
    for (int ip = gw; ip < NTOK / 2; ip += NGW) {
        const int b = (2 * ip) / SEQ, ttp = (2 * ip) % SEQ, tp0 = (b & 2) ? (SEQ - 2 - ttp) : ttp;
         const size_t rowp = (size_t)b * SEQ + tp0; const int chunk_end = (tp0 / CHUNK + 1) * CHUNK;
        {
        const int lane = fresh_lane(), r32 = lane & 31, hh = lane >> 5;
        if (!(flags & 4)) {
            bf16x8 qi[2][4]; f32x4 wv[2][4];
#pragma unroll
            for (int q2 = 0; q2 < 2; ++q2) {
#pragma unroll
                for (int s = 0; s < 4; ++s) qi[q2][s] = *(const bf16x8*)(QIDX + (rowp + q2) * 2048 + r32 * 64 + 16 * s + 8 * hh);
#pragma unroll
                for (int g4 = 0; g4 < 4; ++g4) wv[q2][g4] = *(const f32x4*)(WIDX + (rowp + q2) * 32 + 8 * g4 + 4 * hh); }
            const bf16* kp = KIDXB + (size_t)b * SEQ * 64 + r32 * 16 + 8 * hh;
            bf16x8 kb[8][4];
#define DSA_SCORE(kbt, tile, q2) do { f32x16 acc; _Pragma("unroll") for (int i = 0; i < 16; ++i) acc[i] = 0.f; \
                _Pragma("unroll") for (int s = 0; s < 4; ++s) acc = __builtin_amdgcn_mfma_f32_32x32x16_bf16(qi[q2][s], kbt[s], acc, 0, 0, 0); \
                float sc = 0.f; _Pragma("unroll") for (int g4 = 0; g4 < 4; ++g4) _Pragma("unroll") for (int i = 0; i < 4; ++i) sc += fmaxf(acc[4 * g4 + i], 0.f) * wv[q2][g4][i]; \
                sc += __shfl_xor(sc, 32); if (lane < 32) SCb2[(q2) * 2048 + (tile) * 32 + lane] = sc * idx_scale; } while (0)
            const int ntile8 = ((chunk_end + 255) >> 8) << 3;
            for (int t0 = 0; t0 < ntile8; t0 += 8) {
#pragma unroll
                for (int u = 0; u < 8; ++u)
#pragma unroll
                    for (int s = 0; s < 4; ++s) kb[u][s] = *(const bf16x8*)(kp + (size_t)(t0 + u) * 2048 + 512 * s);
#pragma unroll
                for (int u = 0; u < 8; ++u) { DSA_SCORE(kb[u], t0 + u, 0); DSA_SCORE(kb[u], t0 + u, 1); __builtin_amdgcn_sched_barrier(0); }
            }
#undef DSA_SCORE
        }
        }
        CFENCE(); LDS_WAIT();
#pragma unroll 1
        for (int q2 = 0; q2 < 2; ++q2) {
        const int lane = fresh_lane(), r16 = lane & 15, g = lane >> 4;
        const int t = tp0 + q2; const size_t row = rowp + q2; LAS float* SCb = SCb2 + q2 * 2048;
        const int nsel = chunk_end < TOPK ? chunk_end : TOPK;
        if (chunk_end <= TOPK || (flags & 8)) { for (int s = lane; s < nsel; s += 64) IDX[s] = (unsigned short)s; }
        else {
            unsigned key[32]; const int nreg = chunk_end >> 6;
#pragma unroll
            for (int i = 0; i < 32; ++i) key[i] = (i < nreg) ? f2key(SCb[i * 64 + lane]) : 0u;
            unsigned T = 0u;
            for (int bit = 31; bit >= 0; --bit) { const unsigned cand = T | (1u << bit); int cnt = 0;
#pragma unroll
                for (int i = 0; i < 32; ++i) cnt += __builtin_popcountll(__ballot(key[i] >= cand));
                if (cnt >= TOPK) { T = cand; if (cnt == TOPK) break; } }
            int cgt = 0;
#pragma unroll
            for (int i = 0; i < 32; ++i) cgt += __builtin_popcountll(__ballot(key[i] > T));
            int rem = TOPK - cgt, base = 0;
#pragma unroll
            for (int i = 0; i < 32; ++i) { const bool gt = key[i] > T, eq = key[i] == T; const unsigned long long meq = __ballot(eq); const bool take = gt || (eq && lanes_below(meq) < rem);
                const unsigned long long msel = __ballot(take); if (take) IDX[base + lanes_below(msel)] = (unsigned short)(i * 64 + lane);
                base += __builtin_popcountll(msel); const int ne = __builtin_popcountll(meq); rem -= (ne < rem ? ne : rem); }
        }
        CFENCE(); LDS_WAIT();
        if (!(flags & 16)) {
            int r16l = r16; asm volatile("" : "+v"(r16l));
            union { bf16x8 v; unsigned short e[8]; } sel0, sel1;
#pragma unroll
            for (int j = 0; j < 8; ++j) { sel0.e[j] = (8 * g + j == r16l) ? 0x3F80 : 0; sel1.e[j] = (8 * g + j == 16 + r16l) ? 0x3F80 : 0; }
            const float slope2 = exp2f(-0.5f * (float)(r16l + 1)) * 1.4426950408889634f;
            bf16x8 ql[8];
#pragma unroll
            for (int s = 0; s < 8; ++s) ql[s] = *(const bf16x8*)(QLAT + row * 4096 + r16 * 256 + 32 * s + 8 * g);
            f32x4 o[16];
#pragma unroll
            for (int ct = 0; ct < 16; ++ct) o[ct] = (f32x4){0.f, 0.f, 0.f, 0.f};
            float m = -1e30f, l = 0.f;
            const bf16* cbase = CKVN + (size_t)b * SEQ * 256 + 8 * g;
            const int nstep = nsel >> 5;
            for (int st = 0; st < nstep; ++st) {
                const int ia = IDX[32 * st + r16], ib = IDX[32 * st + 16 + r16];
                bf16x8 ca[8], cb[8];
#pragma unroll
                for (int s = 0; s < 8; ++s) { ca[s] = *(const bf16x8*)(cbase + (size_t)ia * 256 + 32 * s); cb[s] = *(const bf16x8*)(cbase + (size_t)ib * 256 + 32 * s); }
                f32x4 sa = (f32x4){0.f, 0.f, 0.f, 0.f}, sb = sa;
#pragma unroll
                for (int s = 0; s < 8; ++s) { sa = __builtin_amdgcn_mfma_f32_16x16x32_bf16(ca[s], ql[s], sa, 0, 0, 0); sb = __builtin_amdgcn_mfma_f32_16x16x32_bf16(cb[s], ql[s], sb, 0, 0, 0); }
                const u32x2 ja = *(const LAS u32x2*)(IDX + 32 * st + 4 * g), jb = *(const LAS u32x2*)(IDX + 32 * st + 16 + 4 * g);
                const int da0 = t - (int)(ja.x & 0xffff), da1 = t - (int)(ja.x >> 16), da2 = t - (int)(ja.y & 0xffff), da3 = t - (int)(ja.y >> 16);
                const int db0 = t - (int)(jb.x & 0xffff), db1 = t - (int)(jb.x >> 16), db2 = t - (int)(jb.y & 0xffff), db3 = t - (int)(jb.y >> 16);
                sa[0] = sa[0] * SCL - slope2 * (float)(da0 < 0 ? -da0 : da0); sa[1] = sa[1] * SCL - slope2 * (float)(da1 < 0 ? -da1 : da1);
                sa[2] = sa[2] * SCL - slope2 * (float)(da2 < 0 ? -da2 : da2); sa[3] = sa[3] * SCL - slope2 * (float)(da3 < 0 ? -da3 : da3);
                sb[0] = sb[0] * SCL - slope2 * (float)(db0 < 0 ? -db0 : db0); sb[1] = sb[1] * SCL - slope2 * (float)(db1 < 0 ? -db1 : db1);
                sb[2] = sb[2] * SCL - slope2 * (float)(db2 < 0 ? -db2 : db2); sb[3] = sb[3] * SCL - slope2 * (float)(db3 < 0 ? -db3 : db3);
                float mx = fmaxf(fmaxf(fmaxf(sa[0], sa[1]), fmaxf(sa[2], sa[3])), fmaxf(fmaxf(sb[0], sb[1]), fmaxf(sb[2], sb[3])));
                mx = fmaxf(mx, __shfl_xor(mx, 16)); mx = fmaxf(mx, __shfl_xor(mx, 32));
                float alpha = 1.0f;
                if (__any(mx > m + 8.0f)) { mx = fmaxf(mx, m); alpha = __builtin_amdgcn_exp2f(m - mx); m = mx;
#pragma unroll
                    for (int ct = 0; ct < 16; ++ct) o[ct] *= alpha; }
#pragma unroll
                for (int i = 0; i < 4; ++i) { sa[i] = __builtin_amdgcn_exp2f(sa[i] - m); sb[i] = __builtin_amdgcn_exp2f(sb[i] - m); }
                l = l * alpha + ((sa[0] + sa[1]) + (sa[2] + sa[3])) + ((sb[0] + sb[1]) + (sb[2] + sb[3]));
                union { bf16x8 v; unsigned u[4]; } pf;
                pf.u[0] = pk2(sa[0], sa[1]); pf.u[1] = pk2(sa[2], sa[3]); pf.u[2] = pk2(sb[0], sb[1]); pf.u[3] = pk2(sb[2], sb[3]);
#pragma unroll
                for (int s = 0; s < 8; ++s) {
                    const f32x4 z = (f32x4){0.f, 0.f, 0.f, 0.f};
                    const f32x4 ta0 = __builtin_amdgcn_mfma_f32_16x16x32_bf16(ca[s], sel0.v, z, 0, 0, 0), ta1 = __builtin_amdgcn_mfma_f32_16x16x32_bf16(ca[s], sel1.v, z, 0, 0, 0);
                    const f32x4 tb0 = __builtin_amdgcn_mfma_f32_16x16x32_bf16(cb[s], sel0.v, z, 0, 0, 0), tb1 = __builtin_amdgcn_mfma_f32_16x16x32_bf16(cb[s], sel1.v, z, 0, 0, 0);
                    union { bf16x8 v; unsigned u[4]; } v0, v1;
                    v0.u[0] = pk2(ta0[0], ta0[1]); v0.u[1] = pk2(ta0[2], ta0[3]); v0.u[2] = pk2(tb0[0], tb0[1]); v0.u[3] = pk2(tb0[2], tb0[3]);
                    v1.u[0] = pk2(ta1[0], ta1[1]); v1.u[1] = pk2(ta1[2], ta1[3]); v1.u[2] = pk2(tb1[0], tb1[1]); v1.u[3] = pk2(tb1[2], tb1[3]);
                    o[2 * s] = __builtin_amdgcn_mfma_f32_16x16x32_bf16(v0.v, pf.v, o[2 * s], 0, 0, 0);
                    o[2 * s + 1] = __builtin_amdgcn_mfma_f32_16x16x32_bf16(v1.v, pf.v, o[2 * s + 1], 0, 0, 0);
                }
            }
            l += __shfl_xor(l, 16); l += __shfl_xor(l, 32);
            const float inv = 1.0f / l;
            bf16* op = OLAT + row * 4096 + r16 * 256 + 4 * g;
#pragma unroll
            for (int ct = 0; ct < 16; ++ct) { u32x2 wv; wv.x = pk2(o[ct][0] * inv, o[ct][1] * inv); wv.y = pk2(o[ct][2] * inv, o[ct][3] * inv); *(u32x2*)(op + 16 * ct) = wv; }
        }
        CFENCE(); LDS_WAIT();
        }
    }
}
constexpr int PEER_WLDS = 2048 + 8192;
typedef int i32x8 __attribute__((ext_vector_type(8)));
typedef __bf16 bf16x2_d __attribute__((ext_vector_type(2)));
__device__ __forceinline__ float dot2bf(unsigned a, unsigned b, float c) { return __builtin_amdgcn_fdot2_f32_bf16(__builtin_bit_cast(bf16x2_d, a), __builtin_bit_cast(bf16x2_d, b), c, false); }
__device__ __forceinline__ f32x4 fp8x4(unsigned w) { const f32x2 lo = __builtin_amdgcn_cvt_pk_f32_fp8((int)w, false), hi = __builtin_amdgcn_cvt_pk_f32_fp8((int)w, true); return (f32x4){lo[0], lo[1], hi[0], hi[1]}; }
__device__ __forceinline__ float fp8dot4(unsigned w, f32x4 x) { const f32x4 f = fp8x4(w); return (f[0] * x[0] + f[1] * x[1]) + (f[2] * x[2] + f[3] * x[3]); }
#define DPPF(v, ctrl, rmask) __builtin_bit_cast(float, __builtin_amdgcn_update_dpp(0, __builtin_bit_cast(int, (v)), (ctrl), (rmask), 0xf, false))
__device__ __forceinline__ float wave_sum_u(float v) {
    v += DPPF(v, 0xB1, 0xf); v += DPPF(v, 0x4E, 0xf); v += DPPF(v, 0x141, 0xf); v += DPPF(v, 0x140, 0xf);
    v += DPPF(v, 0x142, 0xa); v += DPPF(v, 0x143, 0xc);
    return __builtin_bit_cast(float, __builtin_amdgcn_readlane(__builtin_bit_cast(int, v), 63));
}
template <int NV>
__device__ __forceinline__ void select16(const unsigned (&key)[NV], bool (&sel)[NV], int (&pos)[NV]) {
    unsigned T = 0u;
    for (int bit = 31; bit >= 0; --bit) { const unsigned cand = T | (1u << bit); int cnt = 0;
#pragma unroll
        for (int r = 0; r < NV; ++r) cnt += __builtin_popcountll(__ballot(key[r] >= cand));
        if (cnt >= PEER_TOPK) { T = cand; if (cnt == PEER_TOPK) break; } }
    int cgt = 0;
#pragma unroll
    for (int r = 0; r < NV; ++r) cgt += __builtin_popcountll(__ballot(key[r] > T));
    int rem = PEER_TOPK - cgt, base = 0;
#pragma unroll
    for (int r = 0; r < NV; ++r) { const bool gt = key[r] > T, eq = key[r] == T; const unsigned long long meq = __ballot(eq); const bool take = gt || (eq && lanes_below(meq) < rem);
        const unsigned long long msel = __ballot(take); sel[r] = take; pos[r] = base + lanes_below(msel);
        base += __builtin_popcountll(msel); const int ne = __builtin_popcountll(meq); rem -= (ne < rem ? ne : rem); }
}
__device__ __forceinline__ void p9_peer(Frame& F) {
    const int gw = F.bid * NWAVES + F.wave, NGW = F.G * NWAVES, lane = F.lane;
    LAS unsigned char* wb = F.lds + F.wave * PEER_WLDS;
    LAS float* tv = (LAS float*)wb; LAS int* ti = (LAS int*)(wb + 128); LAS float* cv = (LAS float*)(wb + 256); LAS int* cc = (LAS int*)(wb + 320); LAS int* eidx = (LAS int*)(wb + 512); LAS float* coef = (LAS float*)(wb + 1024); LAS float* su = (LAS float*)(wb + 1536);
    const float* S = WSP(float, WS_E); const bf16* H1B = WSP(bf16, WS_XB); const bf16* PLE = WSP(bf16, WS_PL); const unsigned char* UB = WSP(unsigned char, WS_UB); const unsigned char* VT = WSP(unsigned char, WS_VT); const float* SCL = WSP(float, WS_SCL);
    const float* g2 = INP(I_LN2G); const float* b2 = INP(I_LN2B);
    for (int tok = gw; tok < NTOK; tok += NGW) {
        const float* srow = S + (size_t)tok * 2048;
        LAS float* sl = (LAS float*)(wb + 2048);
#pragma unroll
        for (int j = 0; j < 8; ++j) *(LAS f32x4*)(sl + (j * 64 + lane) * 4) = *(const f32x4*)(srow + (j * 64 + lane) * 4);
        CFENCE(); LDS_WAIT();
        {
            u32x4 hb[2][3];
            u32x4 hx[2][4]; float mx = 0.f;
#pragma unroll
            for (int jj = 0; jj < 2; ++jj)
#pragma unroll
                for (int i = 0; i < 4; ++i) { hx[jj][i] = *(const u32x4*)(H1B + (size_t)tok * 4096 + (jj * 64 + lane) * 32 + 8 * i);
#pragma unroll
                    for (int k = 0; k < 4; ++k) mx = fmaxf(mx, fmaxf(fabsf(bflo(hx[jj][i][k])), fabsf(bfhi(hx[jj][i][k])))); }
            mx = wave_max(mx) * (1.0f / 6.0f);
            int eb = (int)((__builtin_bit_cast(unsigned, mx) + 0x007fffffu) >> 23); eb = eb < 1 ? 1 : (eb > 253 ? 253 : eb);
            const float sup = __builtin_bit_cast(float, (unsigned)(254 - eb) << 23), sdn = __builtin_bit_cast(float, (unsigned)eb << 23);
#pragma unroll
            for (int jj = 0; jj < 2; ++jj)
#pragma unroll
                for (int i = 0; i < 4; ++i) { unsigned w0 = 0u, w1 = 0u, w2 = 0u;
#define HDIG(k) { float x0 = bflo(hx[jj][i][k]) * sup, x1 = bfhi(hx[jj][i][k]) * sup; \
                      w0 = __builtin_amdgcn_cvt_scalef32_pk_fp4_f32(w0, x0, x1, 1.0f, k); f32x2 dq = __builtin_amdgcn_cvt_scalef32_pk_f32_fp4(w0, 1.0f, k); x0 = (x0 - dq[0]) * 4.0f; x1 = (x1 - dq[1]) * 4.0f; \
                      w1 = __builtin_amdgcn_cvt_scalef32_pk_fp4_f32(w1, x0, x1, 1.0f, k); dq = __builtin_amdgcn_cvt_scalef32_pk_f32_fp4(w1, 1.0f, k); x0 = (x0 - dq[0]) * 8.0f; x1 = (x1 - dq[1]) * 8.0f; \
                      w2 = __builtin_amdgcn_cvt_scalef32_pk_fp4_f32(w2, x0, x1, 1.0f, k); }
                    HDIG(0) HDIG(1) HDIG(2) HDIG(3)
#undef HDIG
                    hb[jj][0][i] = w0; hb[jj][1][i] = w1; hb[jj][2][i] = w2; }
            const int dsel = ((lane >> 4) == ((lane & 15) >> 2)) ? (lane & 3) : 4;
#define U_LOAD(R, SU, SV, MB) { _Pragma("unroll") for (int q = 0; q < 8; ++q) { const int e_ = __builtin_amdgcn_readfirstlane(eidx[8 * (MB) + q]); const u32x4* p = (const u32x4*)(UB + (size_t)e_ * 2048) + lane; R[q][0] = p[0]; R[q][1] = p[64]; } \
                { const int el_ = eidx[8 * (MB) + (lane & 7)]; SU = SCL[el_]; SV = SCL[N_EXPERTS + el_]; } }
#define HB8(d) (i32x8){(int)hb[jj][d].x, (int)hb[jj][d].y, (int)hb[jj][d].z, (int)hb[jj][d].w, 0, 0, 0, 0}
#define U_COMP(R, SU, SV, MB) { float a[8]; \
                _Pragma("unroll") for (int q = 0; q < 8; ++q) { f32x4 c = (f32x4){0.f, 0.f, 0.f, 0.f}; \
                    _Pragma("unroll") for (int jj = 0; jj < 2; ++jj) { const i32x8 av = (i32x8){(int)R[q][jj].x, (int)R[q][jj].y, (int)R[q][jj].z, (int)R[q][jj].w, 0, 0, 0, 0}; \
                        c = __builtin_amdgcn_mfma_scale_f32_16x16x128_f8f6f4(av, HB8(0), c, 4, 4, 0, 0x7f7f7f7f, 0, 0x7f7f7f7f);     \
                        c = __builtin_amdgcn_mfma_scale_f32_16x16x128_f8f6f4(av, HB8(1), c, 4, 4, 0, 0x7f7f7f7f, 0, 0x7d7d7d7d);     \
                        c = __builtin_amdgcn_mfma_scale_f32_16x16x128_f8f6f4(av, HB8(2), c, 4, 4, 0, 0x7f7f7f7f, 0, 0x7a7a7a7a); }   \
                    float d = (dsel == 0) ? c[0] : 0.f; d = (dsel == 1) ? c[1] : d; d = (dsel == 2) ? c[2] : d; d = (dsel == 3) ? c[3] : d; \
                    a[q] = wave_sum_u(d); } \
                float z = a[0]; \
                _Pragma("unroll") for (int q = 1; q < 8; ++q) z = (lane == q) ? a[q] : z; \
                z *= sdn * SU; \
                const float act = 0.5f * z * (1.0f + erff(z * 0.70710678118654752f)); \
                if (lane < 8) coef[8 * (MB) + lane] *= act * SV; }
            u32x4 ra[8][2], rb[8][2]; float sua, sva, sub, svb;
#define ROUTE_HEAD(h) { \
            _Pragma("unroll") \
            for (int side = 0; side < 2; ++side) { const float v0 = sl[(2 * h + side) * 128 + lane], v1 = sl[(2 * h + side) * 128 + 64 + lane]; \
                const unsigned key[2] = {f2key(v0), f2key(v1)}; bool sel[2]; int pos[2]; select16<2>(key, sel, pos); \
                if (sel[0]) { tv[side * 16 + pos[0]] = v0; ti[side * 16 + pos[0]] = lane; } \
                if (sel[1]) { tv[side * 16 + pos[1]] = v1; ti[side * 16 + pos[1]] = lane + 64; } } \
            CFENCE(); LDS_WAIT(); \
            { const int i0 = lane >> 4, j = lane & 15; const float vj = tv[16 + j]; \
              const float c0 = tv[i0] + vj, c1 = tv[i0 + 4] + vj, c2 = tv[i0 + 8] + vj, c3 = tv[i0 + 12] + vj; \
              const unsigned key[4] = {f2key(c0), f2key(c1), f2key(c2), f2key(c3)}; bool sel[4]; int pos[4]; select16<4>(key, sel, pos); \
              if (sel[0]) { cv[pos[0]] = c0; cc[pos[0]] = lane; } if (sel[1]) { cv[pos[1]] = c1; cc[pos[1]] = lane + 64; } \
              if (sel[2]) { cv[pos[2]] = c2; cc[pos[2]] = lane + 128; } if (sel[3]) { cv[pos[3]] = c3; cc[pos[3]] = lane + 192; } } \
            CFENCE(); LDS_WAIT(); \
            { const float val = cv[lane & 15]; const int ci = cc[lane & 15]; float mx = val; \
            _Pragma("unroll") \
              for (int o = 1; o < 16; o <<= 1) mx = fmaxf(mx, __shfl_xor(mx, o)); \
              const float e = __expf(val - mx); float sm = e; \
            _Pragma("unroll") \
              for (int o = 1; o < 16; o <<= 1) sm += __shfl_xor(sm, o); \
              if (lane < 16) { eidx[h * 16 + lane] = ti[ci >> 4] * 128 + ti[16 + (ci & 15)]; coef[h * 16 + lane] = e / sm; } } \
            CFENCE(); LDS_WAIT(); }
            ROUTE_HEAD(0)
            __builtin_amdgcn_sched_barrier(0);
            U_LOAD(ra, sua, sva, 0)
            U_LOAD(rb, sub, svb, 1)
#pragma unroll 1
            for (int h = 1; h < PEER_HEADS; ++h) {
                __builtin_amdgcn_sched_barrier(0);
                ROUTE_HEAD(h)
                __builtin_amdgcn_sched_barrier(0);
                U_COMP(ra, sua, sva, 2 * h - 2)
                __builtin_amdgcn_sched_barrier(0);
                U_LOAD(ra, sua, sva, 2 * h)
                __builtin_amdgcn_sched_barrier(0);
                U_COMP(rb, sub, svb, 2 * h - 1)
                __builtin_amdgcn_sched_barrier(0);
                U_LOAD(rb, sub, svb, 2 * h + 1)
            }
            __builtin_amdgcn_sched_barrier(0);
            U_COMP(ra, sua, sva, PEER_M / 8 - 2)
            __builtin_amdgcn_sched_barrier(0);
            U_COMP(rb, sub, svb, PEER_M / 8 - 1)
#undef ROUTE_HEAD
#undef U_LOAD
#undef U_COMP
#undef HB8
        }
        CFENCE(); LDS_WAIT();
        f32x2 y[32];
#pragma unroll
        for (int i = 0; i < 32; ++i) y[i] = (f32x2){0.f, 0.f};
#pragma unroll 1
        for (int mb = 0; mb < PEER_M / 8; ++mb) {
            u32x4 r[8][2]; float c[8];
#pragma unroll
            for (int q = 0; q < 8; ++q) { const int e = __builtin_amdgcn_readfirstlane(eidx[8 * mb + q]); c[q] = coef[8 * mb + q];
                const u32x4* p = (const u32x4*)(VT + (size_t)e * 2048) + lane; r[q][0] = p[0]; r[q][1] = p[64]; }
#pragma unroll
            for (int q = 0; q < 8; ++q)
#pragma unroll
                for (int jj = 0; jj < 2; ++jj)
#pragma unroll
                    for (int i = 0; i < 4; ++i) { const unsigned w = r[q][jj][i];
                        y[(4 * jj + i) * 4 + 0] += __builtin_amdgcn_cvt_scalef32_pk_f32_fp4(w, 1.0f, 0) * c[q]; y[(4 * jj + i) * 4 + 1] += __builtin_amdgcn_cvt_scalef32_pk_f32_fp4(w, 1.0f, 1) * c[q];
                        y[(4 * jj + i) * 4 + 2] += __builtin_amdgcn_cvt_scalef32_pk_f32_fp4(w, 1.0f, 2) * c[q]; y[(4 * jj + i) * 4 + 3] += __builtin_amdgcn_cvt_scalef32_pk_f32_fp4(w, 1.0f, 3) * c[q]; }
        }
        { const bf16* hr = H1B + (size_t)tok * 4096; const bf16* pr = PLE + (size_t)tok * 4096; float s = 0.f;
#pragma unroll
          for (int jj = 0; jj < 2; ++jj) {
#pragma unroll
              for (int i = 0; i < 4; ++i) { const int off = (jj * 64 + lane) * 32 + 8 * i; const int yb = (4 * jj + i) * 4;
                  const u32x4 hw = *(const u32x4*)(hr + off), pw = *(const u32x4*)(pr + off); const f32x4 h0 = (f32x4){bflo(hw.x), bfhi(hw.x), bflo(hw.y), bfhi(hw.y)}, h1 = (f32x4){bflo(hw.z), bfhi(hw.z), bflo(hw.w), bfhi(hw.w)}, p0 = (f32x4){bflo(pw.x), bfhi(pw.x), bflo(pw.y), bfhi(pw.y)}, p1 = (f32x4){bflo(pw.z), bfhi(pw.z), bflo(pw.w), bfhi(pw.w)};
                  y[yb][0] += h0[0] * ALPHA + p0[0]; y[yb][1] += h0[1] * ALPHA + p0[1]; y[yb + 1][0] += h0[2] * ALPHA + p0[2]; y[yb + 1][1] += h0[3] * ALPHA + p0[3];
                  y[yb + 2][0] += h1[0] * ALPHA + p1[0]; y[yb + 2][1] += h1[1] * ALPHA + p1[1]; y[yb + 3][0] += h1[2] * ALPHA + p1[2]; y[yb + 3][1] += h1[3] * ALPHA + p1[3];
                  s += (y[yb][0] + y[yb][1]) + (y[yb + 1][0] + y[yb + 1][1]) + (y[yb + 2][0] + y[yb + 2][1]) + (y[yb + 3][0] + y[yb + 3][1]); }
              CFENCE(); }
          const float mean = wave_sum(s) * (1.0f / 4096.0f); float q = 0.f;
#pragma unroll
          for (int i = 0; i < 32; ++i) { y[i] = y[i] - mean; q += y[i][0] * y[i][0] + y[i][1] * y[i][1]; }
          const float rstd = 1.0f / sqrtf(wave_sum(q) * (1.0f / 4096.0f) + LN_EPS);
          float* orow = OUTP() + (size_t)tok * 4096;
#pragma unroll
          for (int jj = 0; jj < 2; ++jj) {
#pragma unroll
              for (int i = 0; i < 4; ++i) { const int off = (jj * 64 + lane) * 32 + 8 * i; const int yb = (4 * jj + i) * 4;
                  const f32x4 g0 = *(const f32x4*)(g2 + off), g1 = *(const f32x4*)(g2 + off + 4), c0 = *(const f32x4*)(b2 + off), c1 = *(const f32x4*)(b2 + off + 4);
                  *(f32x4*)(orow + off) = (f32x4){y[yb][0] * rstd * g0[0] + c0[0], y[yb][1] * rstd * g0[1] + c0[1], y[yb + 1][0] * rstd * g0[2] + c0[2], y[yb + 1][1] * rstd * g0[3] + c0[3]};
                  *(f32x4*)(orow + off + 4) = (f32x4){y[yb + 2][0] * rstd * g1[0] + c1[0], y[yb + 2][1] * rstd * g1[1] + c1[1], y[yb + 3][0] * rstd * g1[2] + c1[2], y[yb + 3][1] * rstd * g1[3] + c1[3]}; }
              CFENCE(); } }
        CFENCE(); LDS_WAIT();
    }
}
#ifndef DBG_OUT
#define DBG_OUT 0
#endif
__device__ __forceinline__ void dbg_copy(Frame& F, int which) {
    const size_t gt = (size_t)F.bid * NTHREADS + F.tid, gs = (size_t)F.G * NTHREADS, n = (size_t)NTOK * 4096;
    for (size_t i = gt; i < n; i += gs) { const size_t t = i >> 12; const int c = (int)(i & 4095); float v = 0.f;
        if (which == 1) v = WSP(float, WS_F)[i];
        else if (which == 2) v = WSP(float, WS_E)[i];
        else if (which == 3) v = bf2f(WSP(bf16, WS_XB)[i]);
        else if (which == 4) v = (c < 2048) ? bf2f(WSP(bf16, WS_QA)[t * 2048 + c]) : bf2f(WSP(bf16, WS_OB)[t * 2048 + c - 2048]);
        else if (which == 5) v = bf2f(WSP(bf16, WS_OLAT)[i]);
        else if (which == 6) v = bf2f(WSP(bf16, WS_QLAT)[i]);
        else if (which == 7) v = (c < 2048) ? bf2f(WSP(bf16, WS_QIDX)[t * 2048 + c]) : bf2f(WSP(bf16, WS_KB)[t * 2048 + c - 2048]);
        else if (which == 8) v = bf2f(WSP(bf16, WS_F)[t * 8192 + c]);
        else if (which == 9) v = (c < 2048) ? WSP(float, WS_E)[t * 2048 + c] : bf2f(WSP(bf16, WS_PL)[t * 4096 + c]);
        OUTP()[i] = v; }
}

constexpr int N_PHASES = 10;
__global__ void __launch_bounds__(NTHREADS, 2) mk_fwd(Args args) {
    extern __shared__ __attribute__((aligned(16))) unsigned char lds_raw[];
    Frame F;
    F.lds = (LAS unsigned char*)lds_raw; F.tid = threadIdx.x; F.lane = F.tid & 63; F.wave = __builtin_amdgcn_readfirstlane(F.tid >> 6); F.G = gridDim.x; F.bid = blockIdx.x;
    unsigned* ctl = (unsigned*)(WSB() + WS_CTL);
    if (F.tid < 64) ((LAS unsigned*)(F.lds + LDSCTL_OFF))[F.tid] = 0u;
    __syncthreads();
    XcdBarrier bar; bar.bar = ctl + CW_BAR; bar.x = 0; bar.st = nullptr; bar.wave = F.wave;
    if (MK_N_LAUNCHES == 1) bar = xcd_barrier_post(ctl + CW_BAR, (volatile LAS unsigned*)(F.lds + LDSCTL_OFF));
    const int lo = args.ph_lo, hi = args.ph_hi;
#ifndef PROBE_DUP
#define PROBE_DUP -1
#endif
#define IN(k) (lo <= (k) && (k) < hi)
#define REP(k) for (int rep_ = 0; rep_ < ((k) == PROBE_DUP ? 2 : 1); ++rep_)
#define SEAM(k) do { if (IN(k) && IN((k) + 1)) xcd_barrier(bar); } while (0)
    LAS unsigned char* const ldsg = F.lds;
#define RELANE() do { const int l_ = fresh_lane(); F.lane = l_; F.tid = F.wave * 64 + l_; } while (0)

    if (IN(0)) { RELANE(); REP(0) p0_prologue(F); SEAM(0); }
    if (IN(1)) {
        { pg8::Gemm g{WSP(bf16, WS_X8), WSP(bf16, WS_W18), NTOK, N1M, D_MODEL / 2, D_MODEL / 2}; pg8::StaticOrder S; S.init(NTOK, N1M, F.G, F.bid);
          pg8::Epi1 E{WSP(bf16, WS_QA), WSP(bf16, WS_QIDX), WSP(bf16, WS_QB), WSP(bf16, WS_KB), WSP(bf16, WS_VB), WSP(bf16, WS_F), INP(I_BGATE), 0};
          pg8::gemm_phase<pg8::Epi1, pg8::StaticOrder, true, true, true>(ldsg, g, S, E, F.wave); }
        if (F.bid < 256) {
          const int ks = F.bid & 3, sp = (F.bid >> 2) & 1, spm = F.bid >> 3;
          pg8::Gemm g{WSP(bf16, WS_X8) + ks * 512, WSP(bf16, WS_W18) + (size_t)N1M * (D_MODEL / 2) + ks * 512, NTOK, 512, 512, D_MODEL / 2}; pg8::OneUnit S{spm, sp};
          pg8::EpiPart E{WSP(float, WS_PART) + (size_t)(ks * 2 + sp) * NTOK * 256, 1.0f / (Q8_ACT * Q8_W)};
          pg8::gemm_phase<pg8::EpiPart, pg8::OneUnit, true, true, true>(ldsg, g, S, E, F.wave); }
        { pg8::Gemm g{WSP(bf16, WS_PB), WSP(bf16, WS_WPLT), NTOK, D_MODEL, D_PLE, D_PLE}; pg8::StaticOrder S; S.init(NTOK, D_MODEL, F.G, F.bid);
          pg8::EpiBf16P E{WSP(bf16, WS_PL), D_MODEL};
          pg8::gemm_phase<pg8::EpiBf16P, pg8::StaticOrder, true, true>(ldsg, g, S, E, F.wave); }
        SEAM(1);
    }
    if (IN(2)) { RELANE(); REP(2) p2_small(F); SEAM(2); }
    if (IN(3)) { REP(3) { if (!(args.pad & 2)) p3_fox(F); __syncthreads(); if (!(args.pad & 1)) p3_dsa(F, args.pad); __syncthreads(); } SEAM(3); }
    if (IN(4)) { RELANE(); REP(4) p4_oa(F); SEAM(4); }
    if (IN(5)) {
        { pg8::Gemm g{WSP(bf16, WS_QA), WSP(bf16, WS_WBAT), NTOK, D_MODEL, 1024, 1024}; pg8::StaticOrder S; S.init(NTOK, D_MODEL, F.G, F.bid);
          pg8::Epi2a E{WSP(bf16, WS_F), WSP(bf16, WS_E), 1.0f / (Q8_O * Q8_WB)};
          pg8::gemm_phase<pg8::Epi2a, pg8::StaticOrder, true, true, true>(ldsg, g, S, E, F.wave); }
        { pg8::Gemm g{WSP(bf16, WS_OB), WSP(bf16, WS_WBBT), NTOK, D_MODEL, 1024, 1024}; pg8::StaticOrder S; S.init(NTOK, D_MODEL, F.G, F.bid);
          pg8::Epi2b E{WSP(bf16, WS_F), WSP(bf16, WS_E), WSP(bf16, WS_XB), 1.0f / (Q8_O * Q8_WB)};
          pg8::gemm_phase<pg8::Epi2b, pg8::StaticOrder, true, true, true>(ldsg, g, S, E, F.wave); }
        SEAM(5);
    }
    if (IN(6)) {
        pg8::Gemm g{WSP(bf16, WS_XB), WSP(bf16, WS_WOT), NTOK, D_MODEL, D_MODEL / 2, D_MODEL / 2}; pg8::StaticOrder S; S.init(NTOK, D_MODEL, F.G, F.bid);
        pg8::Epi3 E{INP(I_X), WSP(bf16, WS_E), ALPHA, 1.0f / (Q8_MG * Q8_WO)};
        pg8::gemm_phase<pg8::Epi3, pg8::StaticOrder, true, true, true>(ldsg, g, S, E, F.wave);
        SEAM(6);
    }
    if (IN(7)) { RELANE(); REP(7) p7_ln1(F); SEAM(7); }
    if (IN(8)) {
        { pg8::Gemm g{WSP(bf16, WS_X8), WSP(bf16, WS_W48), NTOK, N4, D_MODEL / 2, D_MODEL / 2}; pg8::StaticOrder S; S.init(NTOK, N4, F.G, F.bid);
          pg8::Epi4 E{WSP(float, WS_E), WSP(bf16, WS_PL), INP(I_BPG), 0};
          pg8::gemm_phase<pg8::Epi4, pg8::StaticOrder, true, true, true>(ldsg, g, S, E, F.wave); }
        SEAM(8);
    }
    if (IN(9)) { if (DBG_OUT) dbg_copy(F, DBG_OUT); else { RELANE(); REP(9) p9_peer(F); } }
#undef IN
#undef SEAM
}

extern "C" void kernel_launch(void* const* d_in, const int* in_sizes, int n_in, void* d_out, int out_size, void* d_ws, size_t ws_size, hipStream_t stream) {
    static int grid = 0;
    if (grid == 0) {
        if (n_in != 23 || out_size != NTOK * D_MODEL || ws_size < WS_END) { fprintf(stderr, "kernel_launch: unexpected problem (n_in %d, out %d, ws %zu); nothing launched\n", n_in, out_size, ws_size); grid = -1; return; }
        int dev = 0, cus = 0, per_cu = 0;
        if (hipGetDevice(&dev) != hipSuccess || hipDeviceGetAttribute(&cus, hipDeviceAttributeMultiprocessorCount, dev) != hipSuccess) { grid = -1; return; }
        if (hipFuncSetAttribute((const void*)mk_fwd, hipFuncAttributeMaxDynamicSharedMemorySize, LDS_BYTES) != hipSuccess) { fprintf(stderr, "kernel_launch: hipFuncSetAttribute failed\n"); grid = -1; return; }
        if (hipOccupancyMaxActiveBlocksPerMultiprocessor(&per_cu, (const void*)mk_fwd, NTHREADS, LDS_BYTES) != hipSuccess || per_cu < 1) { fprintf(stderr, "kernel_launch: occupancy query says %d\n", per_cu); (void)hipGetLastError(); grid = -1; return; }
        grid = cus;
    }
    if (grid < 0) return;
    if (hipMemsetAsync((char*)d_ws + WS_CTL, 0, CTL_ZERO_BYTES, stream) != hipSuccess) return;
    Args a{};
    for (int i = 0; i < 23; ++i) a.in[i] = (const float*)d_in[i];
    a.out = (float*)d_out; a.ws = (unsigned char*)d_ws;
    for (int li = 0; li < MK_N_LAUNCHES; ++li) {
#if DBG_OUT
        { const int lastp[10] = {9, 7, 6, 5, 4, 3, 2, 1, 1, 8}; if (MK_N_LAUNCHES > 1 && li > lastp[DBG_OUT] && li != 9) continue; }
#endif
        a.ph_lo = (MK_N_LAUNCHES == 1) ? 0 : li; a.ph_hi = (MK_N_LAUNCHES == 1) ? N_PHASES : li + 1; a.li = li; a.pad = 0;
#ifdef HOST_DUP
        if (MK_N_LAUNCHES > 1 && li == HOST_DUP) {
#ifdef HOST_DUP_PAD
            a.pad = HOST_DUP_PAD;
#endif
            hipLaunchKernelGGL(mk_fwd, dim3(grid), dim3(NTHREADS), LDS_BYTES, stream, a); a.pad = 0; }
#endif
        hipLaunchKernelGGL(mk_fwd, dim3(grid), dim3(NTHREADS), LDS_BYTES, stream, a);
    }
}
```

```cpp
#include <hip/hip_runtime.h>
#include <cstdio>
#include <cstdint>

#ifndef MK_N_LAUNCHES
#define MK_N_LAUNCHES 1
#endif

#define GAS __attribute__((address_space(1)))
#define LAS __attribute__((address_space(3)))
typedef unsigned short bf16;
typedef float f32x4 __attribute__((ext_vector_type(4)));
typedef float f32x2 __attribute__((ext_vector_type(2)));
typedef unsigned u32x4 __attribute__((ext_vector_type(4)));
typedef unsigned u32x2 __attribute__((ext_vector_type(2)));
typedef short bf16x8 __attribute__((ext_vector_type(8)));

constexpr int D_MODEL = 4096, BATCH = 4, SEQ = 2048, NTOK = BATCH * SEQ;
constexpr int A_HEADS = 16, A_HD = 128, A_LAT = 256, IDX_HEADS = 32, IDX_DIM = 64, TOPK = 256, CHUNK = 64;
constexpr int B_HEADS = 16, B_HD = 128;
constexpr int PEER_HEADS = 8, PEER_KEYS = 128, PEER_QDIM = 256, PEER_TOPK = 16, N_EXPERTS = PEER_KEYS * PEER_KEYS, PEER_M = PEER_HEADS * PEER_TOPK;
constexpr int D_PLE = 256;
constexpr int IN_WIDTH = 10608;
constexpr int N1 = 18944;
constexpr int N1M = 18432;
constexpr int N4 = 6144;
constexpr float LN_EPS = 1e-5f;
constexpr float ALPHA = 1.18920711500272f;

__device__ __forceinline__ unsigned f2bf(float f) { unsigned u = __builtin_bit_cast(unsigned, f); return (u + 0x7fffu + ((u >> 16) & 1u)) >> 16; }
typedef __bf16 bf16x2_n __attribute__((ext_vector_type(2)));
__device__ __forceinline__ unsigned pk2(float lo, float hi) { const bf16x2_n b = __builtin_convertvector((f32x2){lo, hi}, bf16x2_n); return __builtin_bit_cast(unsigned, b); }
__device__ __forceinline__ float bflo(unsigned w) { return __builtin_bit_cast(float, w << 16); }
__device__ __forceinline__ float bfhi(unsigned w) { return __builtin_bit_cast(float, w & 0xffff0000u); }
__device__ __forceinline__ float bf2f(bf16 b) { return __builtin_bit_cast(float, (unsigned)b << 16); }
__device__ __forceinline__ float sigmoidf_(float x) { return __builtin_amdgcn_rcpf(1.0f + __expf(-x)); }
#define DPPF_(v, ctrl, rmask) __builtin_bit_cast(float, __builtin_amdgcn_update_dpp(0, __builtin_bit_cast(int, (v)), (ctrl), (rmask), 0xf, false))
#define DPPFK_(v, ctrl, rmask) __builtin_bit_cast(float, __builtin_amdgcn_update_dpp(__builtin_bit_cast(int, (v)), __builtin_bit_cast(int, (v)), (ctrl), (rmask), 0xf, false))
__device__ __forceinline__ float wave_sum(float v) {
    v += DPPF_(v, 0xB1, 0xf); v += DPPF_(v, 0x4E, 0xf); v += DPPF_(v, 0x141, 0xf); v += DPPF_(v, 0x140, 0xf);
    v += DPPF_(v, 0x142, 0xa); v += DPPF_(v, 0x143, 0xc);
    return __builtin_bit_cast(float, __builtin_amdgcn_readlane(__builtin_bit_cast(int, v), 63));
}
__device__ __forceinline__ float wave_max(float v) {
    v = fmaxf(v, DPPFK_(v, 0xB1, 0xf)); v = fmaxf(v, DPPFK_(v, 0x4E, 0xf)); v = fmaxf(v, DPPFK_(v, 0x141, 0xf)); v = fmaxf(v, DPPFK_(v, 0x140, 0xf));
    v = fmaxf(v, DPPFK_(v, 0x142, 0xa)); v = fmaxf(v, DPPFK_(v, 0x143, 0xc));
    return __builtin_bit_cast(float, __builtin_amdgcn_readlane(__builtin_bit_cast(int, v), 63));
}
__device__ __forceinline__ int wave_sum_iu(int v) {
    v += __builtin_amdgcn_update_dpp(0, v, 0xB1, 0xf, 0xf, false); v += __builtin_amdgcn_update_dpp(0, v, 0x4E, 0xf, 0xf, false);
    v += __builtin_amdgcn_update_dpp(0, v, 0x141, 0xf, 0xf, false); v += __builtin_amdgcn_update_dpp(0, v, 0x140, 0xf, 0xf, false);
    v += __builtin_amdgcn_update_dpp(0, v, 0x142, 0xa, 0xf, false); v += __builtin_amdgcn_update_dpp(0, v, 0x143, 0xc, 0xf, false);
    return __builtin_amdgcn_readlane(v, 63);
}
__device__ __forceinline__ int fresh_lane() { int l; asm volatile("v_mbcnt_lo_u32_b32 %0, -1, 0\n\tv_mbcnt_hi_u32_b32 %0, -1, %0" : "=v"(l)); return l; }
constexpr float Q8_ACT = 30.0f, Q8_W = 1920.0f;
constexpr float Q8_O = 21.0f, Q8_WB = 1368.0f;
constexpr float Q8_MG = 32.0f, Q8_WO = 3250.0f;
__device__ __forceinline__ unsigned pk_q8x4(float a, float b, float c, float d, float sc) {
    const int i0 = __float2int_rn(fminf(fmaxf(a * sc, -127.f), 127.f)), i1 = __float2int_rn(fminf(fmaxf(b * sc, -127.f), 127.f));
    const int i2 = __float2int_rn(fminf(fmaxf(c * sc, -127.f), 127.f)), i3 = __float2int_rn(fminf(fmaxf(d * sc, -127.f), 127.f));
    return (unsigned)(i0 & 255) | ((unsigned)(i1 & 255) << 8) | ((unsigned)(i2 & 255) << 16) | ((unsigned)i3 << 24); }
#define LDS_WAIT() asm volatile("s_waitcnt lgkmcnt(0)" ::: "memory")
#define VM_WAIT() asm volatile("s_waitcnt vmcnt(0)" ::: "memory")
#define CFENCE() asm volatile("" ::: "memory")
namespace pg8 {
#define PG8_LAS __attribute__((address_space(3)))
typedef unsigned short bf16_t;
typedef short bf16x8 __attribute__((ext_vector_type(8)));
typedef float f32x4 __attribute__((ext_vector_type(4)));
typedef unsigned u32x4 __attribute__((ext_vector_type(4)));
constexpr int BM = 256, BK = 64, HALF = 128, HTB = HALF * BK * 2  , STAGE_BYTES = 8 * HTB, NXCD = 8, WGM = 8;

__host__ __device__ __forceinline__ int lds_byte(int r, int c) { const int st = (r >> 4) * 2 + (c >> 5), rr = r & 15, cc = c & 31, ob = rr * 64 + cc * 2; return st * 1024 + (ob ^ (((ob >> 9) & 1) << 5)); }
__host__ __device__ __forceinline__ void stage_rc(int b, int& R, int& C) { const int st = b / 1024, sb = b % 1024, swz = sb ^ (((sb >> 9) & 1) << 5); R = (st >> 1) * 16 + swz / 64; C = (st & 1) * 32 + (swz % 64) / 2; }
__host__ __device__ __forceinline__ int perm32(int rho) { const int n = rho >> 4, i = rho & 15; return 8 * (i >> 2) + 4 * n + (i & 3); }

struct Unit { int pm, pn; };
struct Gemm { const bf16_t* A; const bf16_t* Bt; int M, N, K, ld; };

struct StaticOrder {
    int nM, nN, nwg, G, c;
    __host__ __device__ void init(int M, int N, int G_, int c_) { nM = M / BM; nN = N / BM; nwg = nM * nN; G = G_; c = c_; }
    __host__ __device__ bool next(int i, Unit& u) const {
        const long L = (long)i * G + c; if (L >= nwg) return false;
        int wgid = (int)L; { const int q = nwg / NXCD, r = nwg % NXCD, xcd = wgid % NXCD, off = wgid / NXCD; wgid = (xcd < r ? xcd * (q + 1) : r * (q + 1) + (xcd - r) * q) + off; }
        const int nig = WGM * nN, gid = wgid / nig, fm = gid * WGM, gsz = (nM - fm) < WGM ? (nM - fm) : WGM;
        u.pm = fm + ((wgid % nig) % gsz); u.pn = (wgid % nig) / gsz; return true;
    }
    __device__ __forceinline__ void a_ready(const Unit&) const {}
    __device__ __forceinline__ void done(const Unit&) const {}
};
typedef __bf16 bf16x2_nat __attribute__((ext_vector_type(2)));
__device__ __forceinline__ unsigned cvt_pk_bf16(float lo, float hi) { typedef float f2_ __attribute__((ext_vector_type(2))); const bf16x2_nat b = __builtin_convertvector((f2_){lo, hi}, bf16x2_nat); return __builtin_bit_cast(unsigned, b); }
typedef unsigned u32x2 __attribute__((ext_vector_type(2)));
__device__ __forceinline__ unsigned q8x4(float a, float b, float c, float d, float sc) {
    const int i0 = __float2int_rn(fminf(fmaxf(a * sc, -127.f), 127.f)), i1 = __float2int_rn(fminf(fmaxf(b * sc, -127.f), 127.f));
    const int i2 = __float2int_rn(fminf(fmaxf(c * sc, -127.f), 127.f)), i3 = __float2int_rn(fminf(fmaxf(d * sc, -127.f), 127.f));
    return (unsigned)(i0 & 255) | ((unsigned)(i1 & 255) << 8) | ((unsigned)(i2 & 255) << 16) | ((unsigned)i3 << 24); }
__device__ __forceinline__ float sigm(float x) { return __builtin_amdgcn_rcpf(1.0f + __expf(-x)); }
__device__ __forceinline__ float blo(unsigned w) { return __builtin_bit_cast(float, w << 16); }
__device__ __forceinline__ float bhi(unsigned w) { return __builtin_bit_cast(float, w & 0xffff0000u); }

struct Epi1 {
    static constexpr bool PERM = true, AFTER_DRAIN = false;
    bf16_t *QA, *QIDX, *QB, *KB, *VB, *G; const float* b_gate; int pn_off;
    __device__ __forceinline__ void operator()(const f32x4 (&acc)[2][2][4][2], const Unit& u, int wr, int wc, int fr, int fq) const {
        const int pn = u.pn + pn_off, row0 = u.pm * BM + wr * 64 + fr, cl = wc * 32 + 8 * fq;
        if (pn >= 40) {
            const int gc = (pn - 40) * 256 + cl;
            f32x4 bv[2][2];
#pragma unroll
            for (int bj = 0; bj < 2; ++bj)
#pragma unroll
                for (int n = 0; n < 2; ++n) bv[bj][n] = *(const f32x4*)(b_gate + gc + bj * HALF + 4 * n);
#pragma unroll
            for (int ai = 0; ai < 2; ++ai)
#pragma unroll
                for (int m = 0; m < 4; ++m) { bf16_t* rowp = G + (size_t)(row0 + ai * HALF + m * 16) * 8192 + gc;
#pragma unroll
                    for (int bj = 0; bj < 2; ++bj) { const f32x4 v0 = acc[ai][bj][m][0] * (1.0f / 57600.0f) + bv[bj][0], v1 = acc[ai][bj][m][1] * (1.0f / 57600.0f) + bv[bj][1];
                        u32x4 w; w.x = cvt_pk_bf16(sigm(v0[0]), sigm(v0[1])); w.y = cvt_pk_bf16(sigm(v0[2]), sigm(v0[3])); w.z = cvt_pk_bf16(sigm(v1[0]), sigm(v1[1])); w.w = cvt_pk_bf16(sigm(v1[2]), sigm(v1[3]));
                        *(u32x4*)(rowp + bj * HALF) = w; } }
        } else {
            bf16_t* dst; int c0;
            if (pn < 8) { dst = QA; c0 = pn; } else if (pn < 16) { dst = QIDX; c0 = pn - 8; } else if (pn < 24) { dst = QB; c0 = pn - 16; } else if (pn < 32) { dst = KB; c0 = pn - 24; } else { dst = VB; c0 = pn - 32; }
            c0 = c0 * 256 + cl;
#pragma unroll
            for (int ai = 0; ai < 2; ++ai)
#pragma unroll
                for (int m = 0; m < 4; ++m) { bf16_t* rowp = dst + (size_t)(row0 + ai * HALF + m * 16) * 2048 + c0;
#pragma unroll
                    for (int bj = 0; bj < 2; ++bj) { const f32x4 v0 = acc[ai][bj][m][0] * (1.0f / 57600.0f), v1 = acc[ai][bj][m][1] * (1.0f / 57600.0f);
                        u32x4 w; w.x = cvt_pk_bf16(v0[0], v0[1]); w.y = cvt_pk_bf16(v0[2], v0[3]); w.z = cvt_pk_bf16(v1[0], v1[1]); w.w = cvt_pk_bf16(v1[2], v1[3]);
                        *(u32x4*)(rowp + bj * HALF) = w; } }
        }
    }
};
struct OneUnit {
    int pm, pn;
    __device__ bool next(int i, Unit& u) const { if (i) return false; u.pm = pm; u.pn = pn; return true; }
    __device__ __forceinline__ void a_ready(const Unit&) const {}
    __device__ __forceinline__ void done(const Unit&) const {}
};
struct EpiPart {
    static constexpr bool PERM = true, AFTER_DRAIN = false;
    float* P; float sc;
    __device__ __forceinline__ void operator()(const f32x4 (&acc)[2][2][4][2], const Unit& u, int wr, int wc, int fr, int fq) const {
        const int row0 = u.pm * BM + wr * 64 + fr, cl = wc * 32 + 8 * fq;
#pragma unroll
        for (int ai = 0; ai < 2; ++ai)
#pragma unroll
            for (int m = 0; m < 4; ++m) { float* rowp = P + (size_t)(row0 + ai * HALF + m * 16) * 256 + cl;
#pragma unroll
                for (int bj = 0; bj < 2; ++bj) { *(f32x4*)(rowp + bj * HALF) = acc[ai][bj][m][0] * sc; *(f32x4*)(rowp + bj * HALF + 4) = acc[ai][bj][m][1] * sc; } }
    }
};
struct EpiBf16P {
    static constexpr bool PERM = true, AFTER_DRAIN = false;
    bf16_t* C; int ldc;
    __device__ __forceinline__ void operator()(const f32x4 (&acc)[2][2][4][2], const Unit& u, int wr, int wc, int fr, int fq) const {
        const int row0 = u.pm * BM + wr * 64 + fr, col0 = u.pn * BM + wc * 32 + 8 * fq;
#pragma unroll
        for (int ai = 0; ai < 2; ++ai)
#pragma unroll
            for (int m = 0; m < 4; ++m) { bf16_t* rowp = C + (size_t)(row0 + ai * HALF + m * 16) * ldc + col0;
#pragma unroll
                for (int bj = 0; bj < 2; ++bj) { const f32x4 v0 = acc[ai][bj][m][0], v1 = acc[ai][bj][m][1];
                    u32x4 w; w.x = cvt_pk_bf16(v0[0], v0[1]); w.y = cvt_pk_bf16(v0[2], v0[3]); w.z = cvt_pk_bf16(v1[0], v1[1]); w.w = cvt_pk_bf16(v1[2], v1[3]);
                    *(u32x4*)(rowp + bj * HALF) = w; }
                asm volatile("" ::: "memory"); }
    }
};
struct EpiF32P {
    static constexpr bool PERM = true, AFTER_DRAIN = false;
    float* C; int ldc;
    __device__ __forceinline__ void operator()(const f32x4 (&acc)[2][2][4][2], const Unit& u, int wr, int wc, int fr, int fq) const {
        const int row0 = u.pm * BM + wr * 64 + fr, col0 = u.pn * BM + wc * 32 + 8 * fq;
#pragma unroll
        for (int ai = 0; ai < 2; ++ai)
#pragma unroll
            for (int m = 0; m < 4; ++m) { float* rowp = C + (size_t)(row0 + ai * HALF + m * 16) * ldc + col0;
#pragma unroll
                for (int bj = 0; bj < 2; ++bj) { *(f32x4*)(rowp + bj * HALF) = acc[ai][bj][m][0]; *(f32x4*)(rowp + bj * HALF + 4) = acc[ai][bj][m][1]; } }
    }
};
struct Epi2a {
    static constexpr bool PERM = true, AFTER_DRAIN = false;
    const bf16_t* G; bf16_t* MGT; float sacc;
    __device__ __forceinline__ void operator()(const f32x4 (&acc)[2][2][4][2], const Unit& u, int wr, int wc, int fr, int fq) const {
        const int row0 = u.pm * BM + wr * 64 + fr, col0 = u.pn * BM + wc * 32 + 8 * fq;
#pragma unroll
        for (int ai = 0; ai < 2; ++ai)
#pragma unroll
            for (int m = 0; m < 4; ++m) { const size_t r = (size_t)(row0 + ai * HALF + m * 16);
#pragma unroll
                for (int bj = 0; bj < 2; ++bj) { const u32x4 g = *(const u32x4*)(G + r * 8192 + col0 + bj * HALF); const f32x4 v0 = acc[ai][bj][m][0] * sacc, v1 = acc[ai][bj][m][1] * sacc;
                    u32x4 w; w.x = cvt_pk_bf16(v0[0] * blo(g.x), v0[1] * bhi(g.x)); w.y = cvt_pk_bf16(v0[2] * blo(g.y), v0[3] * bhi(g.y)); w.z = cvt_pk_bf16(v1[0] * blo(g.z), v1[1] * bhi(g.z)); w.w = cvt_pk_bf16(v1[2] * blo(g.w), v1[3] * bhi(g.w));
                    *(u32x4*)(MGT + r * 4096 + col0 + bj * HALF) = w; }
                asm volatile("" ::: "memory"); }
    }
};
struct Epi2b {
    static constexpr bool PERM = true, AFTER_DRAIN = false;
    const bf16_t* G; const bf16_t* MGT; bf16_t* MG; float sacc;
    __device__ __forceinline__ void operator()(const f32x4 (&acc)[2][2][4][2], const Unit& u, int wr, int wc, int fr, int fq) const {
        const int row0 = u.pm * BM + wr * 64 + fr, col0 = u.pn * BM + wc * 32 + 8 * fq;
#pragma unroll
        for (int ai = 0; ai < 2; ++ai)
#pragma unroll
            for (int m = 0; m < 4; ++m) { const size_t r = (size_t)(row0 + ai * HALF + m * 16);
#pragma unroll
                for (int bj = 0; bj < 2; ++bj) { const u32x4 g = *(const u32x4*)(G + r * 8192 + 4096 + col0 + bj * HALF); const f32x4 v0 = acc[ai][bj][m][0] * sacc, v1 = acc[ai][bj][m][1] * sacc;
                    const u32x4 t = *(const u32x4*)(MGT + r * 4096 + col0 + bj * HALF);
                    u32x2 w; w.x = q8x4(blo(t.x) + v0[0] * blo(g.x), bhi(t.x) + v0[1] * bhi(g.x), blo(t.y) + v0[2] * blo(g.y), bhi(t.y) + v0[3] * bhi(g.y), 32.0f);
                    w.y = q8x4(blo(t.z) + v1[0] * blo(g.z), bhi(t.z) + v1[1] * bhi(g.z), blo(t.w) + v1[2] * blo(g.w), bhi(t.w) + v1[3] * bhi(g.w), 32.0f);
                    *(u32x2*)((unsigned char*)MG + r * 4096 + col0 + bj * HALF) = w; }
                asm volatile("" ::: "memory"); }
    }
};
struct Epi3 {
    static constexpr bool PERM = true, AFTER_DRAIN = false;
    const float* X; bf16_t* Y; float alpha, sacc;
    __device__ __forceinline__ void operator()(const f32x4 (&acc)[2][2][4][2], const Unit& u, int wr, int wc, int fr, int fq) const {
        const int row0 = u.pm * BM + wr * 64 + fr, col0 = u.pn * BM + wc * 32 + 8 * fq;
#pragma unroll
        for (int ai = 0; ai < 2; ++ai)
#pragma unroll
            for (int m = 0; m < 4; ++m) { const size_t off = (size_t)(row0 + ai * HALF + m * 16) * 4096 + col0;
#pragma unroll
                for (int bj = 0; bj < 2; ++bj) { const f32x4 x0 = *(const f32x4*)(X + off + bj * HALF), x1 = *(const f32x4*)(X + off + bj * HALF + 4);
                    const f32x4 y0 = x0 * alpha + acc[ai][bj][m][0] * sacc, y1 = x1 * alpha + acc[ai][bj][m][1] * sacc;
                    u32x4 w; w.x = cvt_pk_bf16(y0[0], y0[1]); w.y = cvt_pk_bf16(y0[2], y0[3]); w.z = cvt_pk_bf16(y1[0], y1[1]); w.w = cvt_pk_bf16(y1[2], y1[3]);
                    *(u32x4*)(Y + off + bj * HALF) = w; }
                asm volatile("" ::: "memory"); }
    }
};
struct Epi4 {
    static constexpr bool PERM = true, AFTER_DRAIN = false;
    float* PQ; bf16_t* PL; const float* b_pg; int pn_off;
    __device__ __forceinline__ void operator()(const f32x4 (&acc)[2][2][4][2], const Unit& u, int wr, int wc, int fr, int fq) const {
        const int row0 = u.pm * BM + wr * 64 + fr, cl = wc * 32 + 8 * fq, pn = u.pn + pn_off;
        if (pn < 8) {
#pragma unroll
            for (int ai = 0; ai < 2; ++ai)
#pragma unroll
                for (int m = 0; m < 4; ++m) { float* rowp = PQ + (size_t)(row0 + ai * HALF + m * 16) * 2048 + pn * 256 + cl;
#pragma unroll
                    for (int bj = 0; bj < 2; ++bj) { *(f32x4*)(rowp + bj * HALF) = acc[ai][bj][m][0] * (1.0f / 57600.0f); *(f32x4*)(rowp + bj * HALF + 4) = acc[ai][bj][m][1] * (1.0f / 57600.0f); } }
        } else {
            const int c0 = (pn - 8) * 256 + cl;
            f32x4 bv[2][2];
#pragma unroll
            for (int bj = 0; bj < 2; ++bj)
#pragma unroll
                for (int n = 0; n < 2; ++n) bv[bj][n] = *(const f32x4*)(b_pg + c0 + bj * HALF + 4 * n);
#pragma unroll
            for (int ai = 0; ai < 2; ++ai)
#pragma unroll
                for (int m = 0; m < 4; ++m) { bf16_t* rowp = PL + (size_t)(row0 + ai * HALF + m * 16) * 4096 + c0;
#pragma unroll
                    for (int bj = 0; bj < 2; ++bj) { const u32x4 p = *(const u32x4*)(rowp + bj * HALF);
                        const f32x4 v0 = acc[ai][bj][m][0] * (1.0f / 57600.0f) + bv[bj][0], v1 = acc[ai][bj][m][1] * (1.0f / 57600.0f) + bv[bj][1];
                        u32x4 w; w.x = cvt_pk_bf16(sigm(v0[0]) * blo(p.x), sigm(v0[1]) * bhi(p.x)); w.y = cvt_pk_bf16(sigm(v0[2]) * blo(p.y), sigm(v0[3]) * bhi(p.y));
                        w.z = cvt_pk_bf16(sigm(v1[0]) * blo(p.z), sigm(v1[1]) * bhi(p.z)); w.w = cvt_pk_bf16(sigm(v1[2]) * blo(p.w), sigm(v1[3]) * bhi(p.w));
                        *(u32x4*)(rowp + bj * HALF) = w; }
                    asm volatile("" ::: "memory"); }
        }
    }
};
typedef int pg8_i32x4 __attribute__((ext_vector_type(4)));
typedef int pg8_i32x8 __attribute__((ext_vector_type(8)));
__device__ __forceinline__ pg8_i32x8 cat8(bf16x8 lo, bf16x8 hi) { const pg8_i32x4 a = __builtin_bit_cast(pg8_i32x4, lo), b = __builtin_bit_cast(pg8_i32x4, hi); return __builtin_shufflevector(a, b, 0, 1, 2, 3, 4, 5, 6, 7); }
template <class Epi, class Sched, bool ALIGN_EPI = false, bool SP2 = false, bool F8 = false>
__device__ __forceinline__ void gemm_phase(PG8_LAS unsigned char* lds, const Gemm g, const Sched& S, const Epi& E, const int wave_id) {
    int tid_ = wave_id * 64 + fresh_lane();
    const int tid = tid_, wid = __builtin_amdgcn_readfirstlane(tid >> 6), lane = tid & 63, wr = wid >> 2, wc = wid & 3, fr = lane & 15, fq = lane >> 4;
    const int K = g.K, nt = K / BK, LD = g.ld;
    unsigned voffA, voffB;
    { int R, C; stage_rc(tid * 16, R, C); const int Rb = Epi::PERM ? ((R & ~31) + perm32(R & 31)) : R; voffA = (unsigned)(R * LD + C) * 2u; voffB = (unsigned)(Rb * LD + C) * 2u; }
    const size_t rstep = (size_t)64 * LD * 2;
    const size_t kstep = (size_t)(BK * 2);
    const size_t hstep = (size_t)HALF * LD * 2;
    const size_t tstep = 2 * hstep;
    const unsigned ldsw = (unsigned)wid * 1024u;
    const int aoff = lds_byte(wr * 64 + fr, fq * 8), boff = lds_byte(wc * 32 + fr, fq * 8);
#define PG8_SA(b, h) (((b) * 2 + (h)) * HTB)
#define PG8_SB(b, h) ((4 + (b) * 2 + (h)) * HTB)
#define PG8_STAGE(bufoff, gbase, voff) do { _Pragma("unroll") for (int _i = 0; _i < 2; ++_i) \
        __builtin_amdgcn_global_load_lds((const unsigned*)((const char*)(gbase) + _i * rstep + (voff)), (PG8_LAS unsigned*)(lds + (bufoff) + ldsw + _i * 8192), 16, 0, 0); } while (0)
#define PG8_LDA(dst, b, h) do { _Pragma("unroll") for (int m = 0; m < 4; ++m) _Pragma("unroll") for (int k = 0; k < 2; ++k) dst[m][k] = *(const PG8_LAS bf16x8*)(lds + PG8_SA(b, h) + aoff + m * 2048 + k * 1024); } while (0)
#define PG8_LDB(dst, b, h) do { _Pragma("unroll") for (int n = 0; n < 2; ++n) _Pragma("unroll") for (int k = 0; k < 2; ++k) dst[n][k] = *(const PG8_LAS bf16x8*)(lds + PG8_SB(b, h) + boff + n * 2048 + k * 1024); } while (0)
#define PG8_MMA(ai, bj, At, Bt) do { __builtin_amdgcn_s_setprio(1); _Pragma("unroll") for (int m = 0; m < 4; ++m) _Pragma("unroll") for (int n = 0; n < 2; ++n) { \
        _Pragma("unroll") for (int k = 0; k < 2; ++k) { \
            if constexpr (F8) acc[ai][bj][m][n] = __builtin_bit_cast(f32x4, __builtin_amdgcn_mfma_i32_16x16x64_i8(__builtin_bit_cast(pg8_i32x4, Bt[n][k]), __builtin_bit_cast(pg8_i32x4, At[m][k]), __builtin_bit_cast(pg8_i32x4, acc[ai][bj][m][n]), 0, 0, 0)); \
            else acc[ai][bj][m][n] = __builtin_amdgcn_mfma_f32_16x16x32_bf16(Bt[n][k], At[m][k], acc[ai][bj][m][n], 0, 0, 0); } } __builtin_amdgcn_s_setprio(0); } while (0)
#define PG8_WAIT_V(n) asm volatile("s_waitcnt vmcnt(" #n ")" ::: "memory")
#define PG8_WAIT_L(n) asm volatile("s_waitcnt lgkmcnt(" #n ")" ::: "memory")
#define PG8_BAR __builtin_amdgcn_s_barrier()
#define PG8_SCHED __builtin_amdgcn_sched_barrier(0)
    Unit cur, nxt; int ui = 0;
    if (!S.next(0, cur)) return;
    f32x4 acc[2][2][4][2];
#pragma unroll
    for (int a = 0; a < 2; ++a)
#pragma unroll
        for (int b = 0; b < 2; ++b)
#pragma unroll
            for (int m = 0; m < 4; ++m)
#pragma unroll
                for (int n = 0; n < 2; ++n) acc[a][b][m][n] = (f32x4){0.f, 0.f, 0.f, 0.f};
    bf16x8 At[4][2], B0[2][2], B1[2][2];
    const char* cA = (const char*)g.A + (size_t)cur.pm * tstep; const char* cB = (const char*)g.Bt + (size_t)cur.pn * tstep;
    S.a_ready(cur);
    if constexpr (SP2) {
        PG8_STAGE(PG8_SB(0, 0), cB, voffB); PG8_STAGE(PG8_SB(0, 1), cB + hstep, voffB); PG8_STAGE(PG8_SA(0, 0), cA, voffA); PG8_STAGE(PG8_SA(0, 1), cA + hstep, voffA);
        if (wr == 1) PG8_BAR;
        PG8_WAIT_V(2); PG8_BAR;
        PG8_STAGE(PG8_SB(1, 0), cB + kstep, voffB); PG8_STAGE(PG8_SA(1, 0), cA + kstep, voffA); PG8_STAGE(PG8_SB(1, 1), cB + hstep + kstep, voffB);
        PG8_WAIT_V(6); PG8_BAR;
    } else {
        PG8_STAGE(PG8_SB(0, 0), cB, voffB); PG8_STAGE(PG8_SA(0, 0), cA, voffA); PG8_STAGE(PG8_SB(0, 1), cB + hstep, voffB); PG8_STAGE(PG8_SA(0, 1), cA + hstep, voffA);
        if (wr == 1) PG8_BAR;
        PG8_WAIT_V(4); PG8_BAR;
        PG8_STAGE(PG8_SB(1, 0), cB + kstep, voffB); PG8_STAGE(PG8_SA(1, 0), cA + kstep, voffA); PG8_STAGE(PG8_SB(1, 1), cB + hstep + kstep, voffB);
        PG8_WAIT_V(6); PG8_BAR;
    }
    for (;;) {
        const bool has_next = S.next(ui + 1, nxt);
        const char* nA = has_next ? (const char*)g.A + (size_t)nxt.pm * tstep : cA; const char* nB = has_next ? (const char*)g.Bt + (size_t)nxt.pn * tstep : cB;
#pragma unroll 1
        for (int t = 0; t < nt; t += 2) {
            const bool last = (t == nt - 2);
            const char* a1 = cA + (size_t)(t + 1) * kstep;
            const char* a2 = last ? nA : cA + (size_t)(t + 2) * kstep; const char* b2 = last ? nB : cB + (size_t)(t + 2) * kstep;
            const char* a3 = a2 + kstep; const char* b3 = b2 + kstep;
            if (last && has_next) S.a_ready(nxt);
            if constexpr (SP2) {
            PG8_LDB(B0, 0, 0); PG8_LDB(B1, 0, 1); PG8_SCHED; PG8_LDA(At, 0, 0); PG8_STAGE(PG8_SA(1, 1), a1 + hstep, voffA);
            PG8_WAIT_V(8); PG8_WAIT_L(0); PG8_BAR; PG8_MMA(0, 0, At, B0); PG8_MMA(0, 1, At, B1); PG8_BAR; PG8_SCHED;
            PG8_LDA(At, 0, 1); PG8_STAGE(PG8_SB(0, 0), b2, voffB); PG8_STAGE(PG8_SB(0, 1), b2 + hstep, voffB); PG8_STAGE(PG8_SA(0, 0), a2, voffA);
            PG8_WAIT_V(8); PG8_WAIT_L(0); PG8_BAR; PG8_MMA(1, 0, At, B0); PG8_MMA(1, 1, At, B1); PG8_BAR; PG8_SCHED;
            PG8_LDB(B0, 1, 0); PG8_LDB(B1, 1, 1); PG8_SCHED; PG8_LDA(At, 1, 0); PG8_STAGE(PG8_SA(0, 1), a2 + hstep, voffA);
            PG8_WAIT_V(8); PG8_WAIT_L(0); PG8_BAR; PG8_MMA(0, 0, At, B0); PG8_MMA(0, 1, At, B1); PG8_BAR; PG8_SCHED;
            PG8_LDA(At, 1, 1); PG8_STAGE(PG8_SB(1, 0), b3, voffB); PG8_STAGE(PG8_SB(1, 1), b3 + hstep, voffB); PG8_STAGE(PG8_SA(1, 0), a3, voffA);
            PG8_WAIT_V(8); PG8_WAIT_L(0); PG8_BAR; PG8_MMA(1, 0, At, B0); PG8_MMA(1, 1, At, B1); PG8_BAR; PG8_SCHED;
            } else {
            PG8_LDB(B0, 0, 0); PG8_SCHED; PG8_LDA(At, 0, 0); PG8_STAGE(PG8_SA(1, 1), a1 + hstep, voffA);
            PG8_WAIT_L(8); PG8_BAR; PG8_WAIT_L(0); PG8_MMA(0, 0, At, B0); PG8_BAR; PG8_SCHED;
            PG8_LDB(B1, 0, 1); PG8_STAGE(PG8_SB(0, 0), b2, voffB);
            PG8_BAR; PG8_WAIT_L(0); PG8_MMA(0, 1, At, B1); PG8_BAR;
            PG8_LDA(At, 0, 1); PG8_STAGE(PG8_SA(0, 0), a2, voffA);
            PG8_BAR; PG8_WAIT_L(0); PG8_MMA(1, 0, At, B0); PG8_BAR; PG8_SCHED;
            PG8_STAGE(PG8_SB(0, 1), b2 + hstep, voffB);
            PG8_WAIT_V(6); PG8_BAR; PG8_MMA(1, 1, At, B1); PG8_BAR;
            PG8_LDB(B0, 1, 0); PG8_SCHED; PG8_LDA(At, 1, 0); PG8_STAGE(PG8_SA(0, 1), a2 + hstep, voffA);
            PG8_WAIT_L(8); PG8_BAR; PG8_WAIT_L(0); PG8_MMA(0, 0, At, B0); PG8_BAR; PG8_SCHED;
            PG8_LDB(B1, 1, 1); PG8_STAGE(PG8_SB(1, 0), b3, voffB);
            PG8_BAR; PG8_WAIT_L(0); PG8_MMA(0, 1, At, B1); PG8_BAR;
            PG8_LDA(At, 1, 1); PG8_STAGE(PG8_SA(1, 0), a3, voffA);
            PG8_BAR; PG8_WAIT_L(0); PG8_MMA(1, 0, At, B0); PG8_BAR; PG8_SCHED;
            PG8_STAGE(PG8_SB(1, 1), b3 + hstep, voffB);
            PG8_WAIT_V(6); PG8_BAR; PG8_MMA(1, 1, At, B1); PG8_BAR;
            }
        }
        if constexpr (ALIGN_EPI) { if (wr == 0) PG8_BAR; }
        if constexpr (F8) {
#pragma unroll
            for (int a = 0; a < 2; ++a)
#pragma unroll
                for (int b = 0; b < 2; ++b)
#pragma unroll
                    for (int m = 0; m < 4; ++m)
#pragma unroll
                        for (int n = 0; n < 2; ++n) { const pg8_i32x4 iv = __builtin_bit_cast(pg8_i32x4, acc[a][b][m][n]); acc[a][b][m][n] = (f32x4){(float)iv[0], (float)iv[1], (float)iv[2], (float)iv[3]}; } }
        if constexpr (!Epi::AFTER_DRAIN) { const int le = fresh_lane(); E(acc, cur, wr, wc, le & 15, le >> 4); S.done(cur); }
        if (!has_next) break;
#pragma unroll
        for (int a = 0; a < 2; ++a)
#pragma unroll
            for (int b = 0; b < 2; ++b)
#pragma unroll
                for (int m = 0; m < 4; ++m)
#pragma unroll
                    for (int n = 0; n < 2; ++n) acc[a][b][m][n] = (f32x4){0.f, 0.f, 0.f, 0.f};
        cur = nxt; cA = nA; cB = nB; ++ui;
        if constexpr (ALIGN_EPI) { if (wr == 1) PG8_BAR; }
    }
    PG8_WAIT_V(0);
    if constexpr (!ALIGN_EPI) { if (wr == 0) PG8_BAR; }
    PG8_BAR;
    if constexpr (Epi::AFTER_DRAIN) { E.fused(acc, cur, wr, wc, fr, fq, lds, wid, lane); S.done(cur); }
#undef PG8_SA
#undef PG8_SB
#undef PG8_STAGE
#undef PG8_LDA
#undef PG8_LDB
#undef PG8_MMA
#undef PG8_WAIT_V
#undef PG8_WAIT_L
#undef PG8_BAR
#undef PG8_SCHED
}
}

#define XB_TMO      128
#define XB_XCNT(j)  (256  + 64 * (j))
#define XB_XSUB(j)  (1280 + 64 * (j))
#define XB_XGEN(j)  (2304 + 64 * (j))
#define XB_TOP      3328
#define XB_TOPGEN   3392
#define XCD_BAR_WORDS 3456
#define XB_SPIN_CAP (1u << 18)

__device__ __forceinline__ unsigned xb_ld(unsigned* p)              { return __hip_atomic_load(p, __ATOMIC_RELAXED, __HIP_MEMORY_SCOPE_AGENT); }
__device__ __forceinline__ unsigned xb_add(unsigned* p, unsigned v) { return __hip_atomic_fetch_add(p, v, __ATOMIC_RELAXED, __HIP_MEMORY_SCOPE_AGENT); }
__device__ __forceinline__ unsigned xb_xcc_id() { return (unsigned)__builtin_amdgcn_s_getreg((3 << 11) | 20) & 0xFu; }
#define XB_SPIN(cond, bar) do { unsigned _sp = 0; while (cond) { __builtin_amdgcn_s_sleep(1); \
    if ((++_sp & 255u) == 0u) { if (xb_ld(&(bar)[XB_TMO])) break; if (_sp > XB_SPIN_CAP) { atomicAdd(&(bar)[XB_TMO], 1u); break; } } } } while (0)

struct XcdBarrier {
    unsigned* bar; unsigned x; int wave;
    volatile LAS unsigned* st;
};

__device__ __forceinline__ XcdBarrier xcd_barrier_post(unsigned* bar, volatile LAS unsigned* st) {
    XcdBarrier b; b.bar = bar; b.x = xb_xcc_id(); b.st = st; b.wave = __builtin_amdgcn_readfirstlane(threadIdx.x >> 6);
    if (threadIdx.x == 0) (void)xb_add(&bar[XB_XCNT(b.x)], 1u);
    return b;
}
__device__ __forceinline__ void xcd_barrier_complete(unsigned* bar, unsigned x, unsigned& nloc, unsigned& nx) {
    const unsigned G = gridDim.x * gridDim.y * gridDim.z;
    unsigned sum, cnt, mine, sp = 0u;
    for (;;) {
        sum = 0u; cnt = 0u; mine = 0u;
#pragma unroll
        for (unsigned j = 0; j < 16; ++j) { const unsigned c = xb_ld(&bar[XB_XCNT(j)]); sum += c; cnt += (c > 0u) ? 1u : 0u; mine = (j == x) ? c : mine; }
        if (sum == G) break;
        __builtin_amdgcn_s_sleep(1);
        if ((++sp & 255u) == 0u) { if (xb_ld(&bar[XB_TMO])) break; if (sp > XB_SPIN_CAP) { atomicAdd(&bar[XB_TMO], 1u); break; } }
    }
    nloc = mine > 0u ? mine : 1u; nx = cnt > 0u ? cnt : 1u;
}

__device__ __forceinline__ void xcd_barrier(const XcdBarrier& b) {
    asm volatile("s_waitcnt vmcnt(0)" ::: "memory");
    __syncthreads();
    if (b.wave == 0 && fresh_lane() == 0) {
        unsigned* bar = b.bar;
        __builtin_amdgcn_s_waitcnt(0);
        unsigned nloc = b.st[0], nx = b.st[1];
        if (nloc == 0u) { xcd_barrier_complete(bar, b.x, nloc, nx); b.st[0] = nloc; b.st[1] = nx; }
        const unsigned old = xb_add(&bar[XB_XSUB(b.x)], 1u);
        const unsigned gen = old / nloc;
        if (old + 1u == (gen + 1u) * nloc) {
            __builtin_amdgcn_fence(__ATOMIC_RELEASE, "agent");
            asm volatile("s_waitcnt vmcnt(0)" ::: "memory");
            const unsigned og = xb_add(&bar[XB_TOP], 1u);
            const unsigned tg = og / nx;
            if (og + 1u == (tg + 1u) * nx) xb_add(&bar[XB_TOPGEN], 1u);
            else XB_SPIN(xb_ld(&bar[XB_TOPGEN]) == tg, bar);
            __builtin_amdgcn_fence(__ATOMIC_ACQUIRE, "agent");
            xb_add(&bar[XB_XGEN(b.x)], 1u);
            asm volatile("s_waitcnt vmcnt(0)" ::: "memory");
        } else {
            XB_SPIN(xb_ld(&bar[XB_XGEN(b.x)]) == gen, bar);
            __builtin_amdgcn_fence(__ATOMIC_ACQUIRE, "agent");
            asm volatile("s_waitcnt vmcnt(0)" ::: "memory");
        }
    }
    __syncthreads();
}

constexpr size_t MiB = 1u << 20;
constexpr size_t WS_CTL = 0, CTL_ZERO_BYTES = 1 * MiB;
constexpr size_t WS_UB   = 1 * MiB;
constexpr size_t WS_VT   = WS_UB + 128 * MiB;
constexpr size_t WS_WBAT = WS_VT + 128 * MiB;
constexpr size_t WS_WBBT = WS_WBAT + 16 * MiB;
constexpr size_t WS_WOT  = WS_WBBT + 16 * MiB;
constexpr size_t WS_W4T  = WS_WOT + 32 * MiB;
constexpr size_t WS_WPLT = WS_W4T + 48 * MiB;
constexpr size_t WS_PB   = WS_WPLT + 2 * MiB;
constexpr size_t WS_XB   = WS_PB + 4 * MiB;
constexpr size_t WS_E    = WS_XB + 64 * MiB;
constexpr size_t WS_F    = WS_E + 148 * MiB;
constexpr size_t WS_QA   = WS_F + 128 * MiB;
constexpr size_t WS_QIDX = WS_QA + 32 * MiB;
constexpr size_t WS_QB   = WS_QIDX + 32 * MiB;
constexpr size_t WS_KB   = WS_QB + 32 * MiB;
constexpr size_t WS_VB   = WS_KB + 32 * MiB;
constexpr size_t WS_OB   = WS_VB + 32 * MiB;
constexpr size_t WS_CKV  = WS_OB + 32 * MiB;
constexpr size_t WS_SM   = WS_CKV + 8 * MiB;
constexpr size_t WS_CKVN = WS_SM + 8 * MiB;
constexpr size_t WS_CUM  = WS_CKVN + 4 * MiB;
constexpr size_t WS_PL   = WS_CUM + 1 * MiB;
constexpr size_t WS_WUKB = WS_PL + 128 * MiB;
constexpr size_t WS_WUVT = WS_WUKB + 1 * MiB;
constexpr size_t WS_KIDXB = WS_WUVT + 1 * MiB;
constexpr size_t WS_SCL = WS_KIDXB + 1 * MiB;
constexpr size_t WS_END  = WS_SCL + 1 * MiB;
constexpr size_t WS_PART = WS_UB + 64 * MiB;
constexpr size_t WS_X8   = WS_VT + 32 * MiB;
constexpr size_t WS_W18  = WS_E;
constexpr size_t WS_W48  = WS_VT + 64 * MiB;
constexpr size_t WS_WIDX = WS_SM;
constexpr size_t WS_QLAT = WS_E, WS_OLAT = WS_E + 64 * MiB;
static_assert(WS_END <= (size_t)1174 * MiB, "d_ws map");
constexpr int CW_BAR = 4096;

constexpr int NWAVES = 8, NTHREADS = 512;
constexpr int LDS_BYTES = 147456;
constexpr int LDSCTL_OFF = LDS_BYTES - 256;

typedef float f32x16 __attribute__((ext_vector_type(16)));
typedef short s16x4 __attribute__((ext_vector_type(4)));
template <int K>
__device__ __forceinline__ void small_gemm_tile(const bf16* A, int lda, const bf16* Bt, int ldb, bf16* C, int ldc, int lane, unsigned char* C8 = nullptr, float sc8 = 1.0f, LAS unsigned char* stg = nullptr) {
    const int r = lane & 15, g = lane >> 4;
    f32x4 acc[4][4];
#pragma unroll
    for (int a = 0; a < 4; ++a)
#pragma unroll
        for (int b = 0; b < 4; ++b) acc[a][b] = (f32x4){0.f, 0.f, 0.f, 0.f};
    const bf16* ap = A + (size_t)r * lda + 8 * g; const bf16* bp = Bt + (size_t)r * ldb + 8 * g;
#pragma unroll 2
    for (int s = 0; s < K / 32; ++s) {
        bf16x8 af[4], bfr[4];
#pragma unroll
        for (int i = 0; i < 4; ++i) { af[i] = *(const bf16x8*)(ap + (size_t)(16 * i) * lda + 32 * s); bfr[i] = *(const bf16x8*)(bp + (size_t)(16 * i) * ldb + 32 * s); }
#pragma unroll
        for (int ni = 0; ni < 4; ++ni)
#pragma unroll
            for (int ti = 0; ti < 4; ++ti) acc[ni][ti] = __builtin_amdgcn_mfma_f32_16x16x32_bf16(bfr[ni], af[ti], acc[ni][ti], 0, 0, 0);
    }
#pragma unroll
    for (int ni = 0; ni < 4; ++ni)
#pragma unroll
        for (int ti = 0; ti < 4; ++ti) { const int row = 16 * ti + r;
            if (stg) {
                if (C8) *(LAS unsigned*)(stg + row * 64 + ((ni ^ (row & 3)) << 4) + 4 * g) = pk_q8x4(acc[ni][ti][0], acc[ni][ti][1], acc[ni][ti][2], acc[ni][ti][3], sc8);
                else { u32x2 wv; wv.x = pk2(acc[ni][ti][0], acc[ni][ti][1]); wv.y = pk2(acc[ni][ti][2], acc[ni][ti][3]); *(LAS u32x2*)(stg + row * 128 + (((2 * ni + (g >> 1)) ^ (row & 7)) << 4) + 8 * (g & 1)) = wv; }
                continue; }
            if (C8) { *(unsigned*)(C8 + (size_t)row * ldc + 16 * ni + 4 * g) = pk_q8x4(acc[ni][ti][0], acc[ni][ti][1], acc[ni][ti][2], acc[ni][ti][3], sc8); continue; }
            u32x2 wv; wv.x = pk2(acc[ni][ti][0], acc[ni][ti][1]); wv.y = pk2(acc[ni][ti][2], acc[ni][ti][3]);
            *(u32x2*)(C + (size_t)row * ldc + 16 * ni + 4 * g) = wv; }
    if (stg) { LDS_WAIT();
        if (C8) {
#pragma unroll
            for (int k = 0; k < 4; ++k) { const int n = k * 64 + lane, row = n >> 2, u = n & 3; *(u32x4*)(C8 + (size_t)row * ldc + u * 16) = *(const LAS u32x4*)(stg + row * 64 + ((u ^ (row & 3)) << 4)); }
        } else {
#pragma unroll
            for (int k = 0; k < 8; ++k) { const int n = k * 64 + lane, row = n >> 3, u = n & 7; *(u32x4*)(C + (size_t)row * ldc + u * 8) = *(const LAS u32x4*)(stg + row * 128 + ((u ^ (row & 7)) << 4)); }
        }
        LDS_WAIT(); }
}
__device__ __forceinline__ bf16x8 ld8_f32_bf16(const float* p) { const f32x4 a = *(const f32x4*)p, b = *(const f32x4*)(p + 4); union { bf16x8 v; unsigned u[4]; } r; r.u[0] = pk2(a[0], a[1]); r.u[1] = pk2(a[2], a[3]); r.u[2] = pk2(b[0], b[1]); r.u[3] = pk2(b[2], b[3]); return r.v; }
template <int K>
__device__ __forceinline__ void small_gemm_tile_f32(const float* A, int lda, const float* Bt, int ldb, bf16* C, int ldc, int lane, unsigned char* C8 = nullptr) {
    const int r = lane & 15, g = lane >> 4;
    f32x4 acc[4][4];
#pragma unroll
    for (int a = 0; a < 4; ++a)
#pragma unroll
        for (int b = 0; b < 4; ++b) acc[a][b] = (f32x4){0.f, 0.f, 0.f, 0.f};
    const float* ap = A + (size_t)r * lda + 8 * g; const float* bp = Bt + (size_t)r * ldb + 8 * g;
#pragma unroll 1
    for (int s = 0; s < K / 32; ++s) {
        bf16x8 af[4], bfr[4];
#pragma unroll
        for (int i = 0; i < 4; ++i) { af[i] = ld8_f32_bf16(ap + (size_t)(16 * i) * lda + 32 * s); bfr[i] = ld8_f32_bf16(bp + (size_t)(16 * i) * ldb + 32 * s); }
#pragma unroll
        for (int ni = 0; ni < 4; ++ni)
#pragma unroll
            for (int ti = 0; ti < 4; ++ti) acc[ni][ti] = __builtin_amdgcn_mfma_f32_16x16x32_bf16(bfr[ni], af[ti], acc[ni][ti], 0, 0, 0);
    }
#pragma unroll
    for (int ni = 0; ni < 4; ++ni)
#pragma unroll
        for (int ti = 0; ti < 4; ++ti) { u32x2 wv; wv.x = pk2(acc[ni][ti][0], acc[ni][ti][1]); wv.y = pk2(acc[ni][ti][2], acc[ni][ti][3]);
            *(u32x2*)(C + (size_t)(16 * ti + r) * ldc + 16 * ni + 4 * g) = wv;
            if (C8) *(unsigned*)(C8 + (size_t)(16 * ti + r) * ldc + 16 * ni + 4 * g) = pk_q8x4(acc[ni][ti][0], acc[ni][ti][1], acc[ni][ti][2], acc[ni][ti][3], Q8_W); }
}
struct Args { const float* in[23]; float* out; unsigned char* ws; int ph_lo, ph_hi, li, pad; };
enum InIdx { I_X = 0, I_P, I_WIN, I_BFORGET, I_GLAT, I_WUK, I_WUV, I_WBA, I_WBB, I_WGATE, I_BGATE, I_WOUT, I_LN1G, I_LN1B, I_PWQ, I_PSUB, I_PU, I_PV, I_WPLE, I_WPG, I_BPG, I_LN2G, I_LN2B };

struct Frame {
    LAS unsigned char* lds;
    int tid, lane, wave, G, bid;
};
#define KARGQ ((const __attribute__((address_space(4))) unsigned long long*)__builtin_amdgcn_kernarg_segment_ptr())
#define INP(i) ((const float*)(const GAS float*)KARGQ[(i)])
#define OUTP() ((float*)(GAS float*)KARGQ[23])
#define WSB() ((unsigned char*)(GAS unsigned char*)KARGQ[24])
#define WSP(T, off) ((T*)(WSB() + (off)))

__device__ __forceinline__ void transpose_item(const float* W, int ldw, int src_col, int ncols, int k0, bf16* WT, int K, int dst_row0, LAS float* scr, int lane) {
    const int c = lane & 31;
    float tmp[32];
    const float* wp = W + (size_t)(k0 + (lane >> 5)) * ldw + src_col + c;
#pragma unroll
    for (int i = 0; i < 32; ++i) tmp[i] = (c < ncols) ? wp[(size_t)(2 * i) * ldw] : 0.f;
#pragma unroll
    for (int i = 0; i < 32; ++i) scr[(2 * i + (lane >> 5)) * 33 + c] = tmp[i];
    LDS_WAIT();
    const int c8 = lane & 7;
#pragma unroll
    for (int j = 0; j < 4; ++j) { const int n = (lane >> 3) + 8 * j; const LAS float* s = scr + (8 * c8) * 33 + n;
        u32x4 o; o.x = pk2(s[0 * 33], s[1 * 33]); o.y = pk2(s[2 * 33], s[3 * 33]); o.z = pk2(s[4 * 33], s[5 * 33]); o.w = pk2(s[6 * 33], s[7 * 33]);
        *(u32x4*)(WT + (size_t)(dst_row0 + n) * K + k0 + 8 * c8) = o; }
    LDS_WAIT();
}
__device__ __forceinline__ void transpose_item_q8(const float* W, int ldw, int src_col, int k0, unsigned char* WT8, int K, int dst_row0, float sc, LAS float* scr, int lane, int ncols = 32) {
    const int c = lane & 31;
    float tmp[32];
    const float* wp = W + (size_t)(k0 + (lane >> 5)) * ldw + src_col + c;
#pragma unroll
    for (int i = 0; i < 32; ++i) tmp[i] = (c < ncols) ? wp[(size_t)(2 * i) * ldw] : 0.f;
#pragma unroll
    for (int i = 0; i < 32; ++i) scr[(2 * i + (lane >> 5)) * 33 + c] = tmp[i];
    LDS_WAIT();
    const int c8 = lane & 7;
#pragma unroll
    for (int j = 0; j < 4; ++j) { const int n = (lane >> 3) + 8 * j; const LAS float* s = scr + (8 * c8) * 33 + n;
        u32x2 o; o.x = pk_q8x4(s[0 * 33], s[1 * 33], s[2 * 33], s[3 * 33], sc); o.y = pk_q8x4(s[4 * 33], s[5 * 33], s[6 * 33], s[7 * 33], sc);
        *(u32x2*)(WT8 + (size_t)(dst_row0 + n) * K + k0 + 8 * c8) = o; }
    LDS_WAIT();
}
__device__ __forceinline__ void cvt_bf16_stream(const float* src, bf16* dst, size_t n8, size_t gt, size_t gstride) {
    size_t i = gt;
    for (; i + 3 * gstride < n8; i += 4 * gstride) {
        f32x4 a[4], b[4];
#pragma unroll
        for (int u = 0; u < 4; ++u) { a[u] = *(const f32x4*)(src + (i + u * gstride) * 8); b[u] = *(const f32x4*)(src + (i + u * gstride) * 8 + 4); }
#pragma unroll
        for (int u = 0; u < 4; ++u) { u32x4 o; o.x = pk2(a[u][0], a[u][1]); o.y = pk2(a[u][2], a[u][3]); o.z = pk2(b[u][0], b[u][1]); o.w = pk2(b[u][2], b[u][3]); *(u32x4*)(dst + (i + u * gstride) * 8) = o; } }
    for (; i < n8; i += gstride) { const f32x4 a = *(const f32x4*)(src + i * 8), b = *(const f32x4*)(src + i * 8 + 4);
        u32x4 o; o.x = pk2(a[0], a[1]); o.y = pk2(a[2], a[3]); o.z = pk2(b[0], b[1]); o.w = pk2(b[2], b[3]); *(u32x4*)(dst + i * 8) = o; }
}
__device__ __forceinline__ void p0_prologue(Frame& F) {
    LAS float* scr = (LAS float*)(F.lds + F.wave * 16384);
    const int gw = F.bid * NWAVES + F.wave, NGW = F.G * NWAVES;
    const float* w_in = INP(I_WIN); const float* w_gate = INP(I_WGATE);
    constexpr int NDB1 = N1 / 32, I_1 = NDB1 * 64;
    constexpr int I_BA = 128 * 32, I_BB = I_BA, I_O = 128 * 64, I_4 = 128 * 64, I_PL = 128 * 4;
    constexpr int NITEMS = I_1 + I_BA + I_BB + I_O + I_4 + I_PL;
    for (int it = gw; it < NITEMS; it += NGW) {
        int r = it;
        if (r < I_1) { const int kb = r / NDB1, db = r % NDB1; const float* W = w_in; int ldw = IN_WIDTH, col, nc = 32;
            if (db < 64) col = db * 32;
            else if (db < 128) col = 2304 + (db - 64) * 32;
            else if (db < 320) col = 4448 + (db - 128) * 32;
            else if (db < 576) { W = w_gate; ldw = 8192; col = (db - 320) * 32; }
            else if (db < 584) col = 2048 + (db - 576) * 32;
            else { const int j = db - 584; col = (j < 2) ? 4352 + 32 * j : (j == 2 ? 4416 : 10592); nc = (j < 3) ? 32 : (j == 3 ? 16 : 0); }
            transpose_item_q8(W, ldw, col, kb * 64, WSP(unsigned char, WS_W18), 4096, db * 32, Q8_W, scr, F.lane, nc); continue; }
        r -= I_1;
        if (r < I_BA) { const int kb = r / 128, db = r % 128; transpose_item_q8(INP(I_WBA), 4096, db * 32, kb * 64, WSP(unsigned char, WS_WBAT), 2048, db * 32, Q8_WB, scr, F.lane); continue; }
        r -= I_BA;
        if (r < I_BB) { const int kb = r / 128, db = r % 128; transpose_item_q8(INP(I_WBB), 4096, db * 32, kb * 64, WSP(unsigned char, WS_WBBT), 2048, db * 32, Q8_WB, scr, F.lane); continue; }
        r -= I_BB;
        if (r < I_O) { const int kb = r / 128, db = r % 128; transpose_item_q8(INP(I_WOUT), 4096, db * 32, kb * 64, WSP(unsigned char, WS_WOT), 4096, db * 32, Q8_WO, scr, F.lane); continue; }
        r -= I_O;
        if (r < I_4) { const int kb = r / 128, db = r % 128;
            transpose_item_q8(INP(I_WPG), 4096, db * 32, kb * 64, WSP(unsigned char, WS_W48), 4096, 2048 + db * 32, Q8_W, scr, F.lane); continue; }
        r -= I_4;
        { const int kb = r / 128, db = r % 128; transpose_item(INP(I_WPLE), 4096, db * 32, 32, kb * 64, WSP(bf16, WS_WPLT), 256, db * 32, scr, F.lane); }
    }
    for (int it = gw; it < 16 * 2 * 64; it += NGW) { const int dt = it & 63, nt = (it >> 6) & 1, l = it >> 7;
        small_gemm_tile_f32<128>(INP(I_PSUB) + (size_t)(l * 128 + nt * 64) * 128, 128, INP(I_PWQ) + (size_t)(dt * 64) * 2048 + (l >> 1) * 256 + (l & 1) * 128, 2048,
                                 WSP(bf16, WS_W4T) + (size_t)(l * 128 + nt * 64) * 4096 + dt * 64, 4096, F.lane, WSP(unsigned char, WS_W48) + (size_t)(l * 128 + nt * 64) * 4096 + dt * 64); }
    const size_t gt = (size_t)F.bid * NTHREADS + F.tid, gs = (size_t)F.G * NTHREADS;
    { const float* src = INP(I_X); unsigned char* d8 = WSP(unsigned char, WS_X8); const size_t n8 = (size_t)NTOK * D_MODEL / 8;
      size_t i = gt;
      for (; i + 3 * gs < n8; i += 4 * gs) {
          f32x4 a[4], b[4];
#pragma unroll
          for (int u = 0; u < 4; ++u) { a[u] = *(const f32x4*)(src + (i + u * gs) * 8); b[u] = *(const f32x4*)(src + (i + u * gs) * 8 + 4); }
#pragma unroll
          for (int u = 0; u < 4; ++u) { u32x2 q; q.x = pk_q8x4(a[u][0], a[u][1], a[u][2], a[u][3], Q8_ACT); q.y = pk_q8x4(b[u][0], b[u][1], b[u][2], b[u][3], Q8_ACT); *(u32x2*)(d8 + (i + u * gs) * 8) = q; } }
      for (; i < n8; i += gs) { const f32x4 a = *(const f32x4*)(src + i * 8), b = *(const f32x4*)(src + i * 8 + 4);
          u32x2 q; q.x = pk_q8x4(a[0], a[1], a[2], a[3], Q8_ACT); q.y = pk_q8x4(b[0], b[1], b[2], b[3], Q8_ACT); *(u32x2*)(d8 + i * 8) = q; } }
    cvt_bf16_stream(INP(I_P), WSP(bf16, WS_PB), (size_t)NTOK * D_PLE / 8, gt, gs);
    { float* SCL = WSP(float, WS_SCL);
      for (int row = gw; row < 2 * N_EXPERTS; row += NGW) { const int tb = row >= N_EXPERTS ? 1 : 0, e = row - tb * N_EXPERTS;
          const float* src = (tb ? INP(I_PV) : INP(I_PU)) + (size_t)e * 4096; unsigned char* dst = (tb ? WSP(unsigned char, WS_VT) : WSP(unsigned char, WS_UB)) + (size_t)e * 2048;
          f32x4 v[16]; float ssq = 0.f;
#pragma unroll
          for (int jj = 0; jj < 2; ++jj)
#pragma unroll
              for (int q = 0; q < 8; ++q) { const f32x4 x = *(const f32x4*)(src + (jj * 64 + F.lane) * 32 + 4 * q); v[8 * jj + q] = x; ssq += (x[0] * x[0] + x[1] * x[1]) + (x[2] * x[2] + x[3] * x[3]); }
          const float sig = sqrtf(wave_sum(ssq) * (1.0f / 4096.0f)); const float inv = sig > 0.f ? 2.1f / sig : 0.f;
#pragma unroll
          for (int jj = 0; jj < 2; ++jj) { u32x4 o;
#pragma unroll
              for (int i = 0; i < 4; ++i) { const f32x4 a = v[8 * jj + 2 * i] * inv, b = v[8 * jj + 2 * i + 1] * inv; unsigned p = 0u;
                  p = __builtin_amdgcn_cvt_scalef32_pk_fp4_f32(p, a[0], a[1], 1.0f, 0); p = __builtin_amdgcn_cvt_scalef32_pk_fp4_f32(p, a[2], a[3], 1.0f, 1);
                  p = __builtin_amdgcn_cvt_scalef32_pk_fp4_f32(p, b[0], b[1], 1.0f, 2); p = __builtin_amdgcn_cvt_scalef32_pk_fp4_f32(p, b[2], b[3], 1.0f, 3); o[i] = p; }
              *(u32x4*)(dst + (jj * 64 + F.lane) * 16) = o; }
          if (F.lane == 0) SCL[row] = sig > 0.f ? sig * (1.0f / 2.1f) : 1.0f; } }
    { const float* w_uk = INP(I_WUK); const float* w_uv = INP(I_WUV); bf16* WUKB = WSP(bf16, WS_WUKB); bf16* WUVT = WSP(bf16, WS_WUVT);
      for (size_t i = gt; i < 65536; i += gs) { const int d8 = (int)(i & 15), c = (int)(i >> 4) & 255, h = (int)(i >> 12);
          const float* src = w_uk + (size_t)c * 2048 + h * 128 + d8 * 8; const f32x4 a = *(const f32x4*)src, b = *(const f32x4*)(src + 4);
          u32x4 o; o.x = pk2(a[0], a[1]); o.y = pk2(a[2], a[3]); o.z = pk2(b[0], b[1]); o.w = pk2(b[2], b[3]); *(u32x4*)(WUKB + i * 8) = o; }
      for (size_t i = gt; i < 65536; i += gs) { const int c8 = (int)(i & 31), d = (int)(i >> 5) & 127, h = (int)(i >> 12);
          const float* src = w_uv + (size_t)(c8 * 8) * 2048 + h * 128 + d;
          u32x4 o; o.x = pk2(src[0], src[2048]); o.y = pk2(src[2 * 2048], src[3 * 2048]); o.z = pk2(src[4 * 2048], src[5 * 2048]); o.w = pk2(src[6 * 2048], src[7 * 2048]); *(u32x4*)(WUVT + i * 8) = o; } }
}

__device__ __forceinline__ f32x4 part_sum4(const float* PART, int tile, size_t off) { const size_t pl = (size_t)NTOK * 256; const float* p = PART + (size_t)tile * pl + off;
    return (*(const f32x4*)p + *(const f32x4*)(p + 2 * pl)) + (*(const f32x4*)(p + 4 * pl) + *(const f32x4*)(p + 6 * pl)); }
__device__ __forceinline__ float log_sigmoid(float z) { return fminf(z, 0.f) - log1pf(__expf(-fabsf(z))); }
__device__ __forceinline__ void p2_small(Frame& F) {
    const int gw = F.bid * NWAVES + F.wave, NGW = F.G * NWAVES, lane = F.lane;
    { const float* PART = WSP(float, WS_PART); bf16* CKVN = WSP(bf16, WS_CKVN); const f32x4 g = *(const f32x4*)(INP(I_GLAT) + 4 * lane);
      for (int t = gw; t < NTOK; t += NGW) { const f32x4 v = part_sum4(PART, 0, (size_t)t * 256 + 4 * lane);
          const float ss = wave_sum(v[0] * v[0] + v[1] * v[1] + v[2] * v[2] + v[3] * v[3]); const float r = 1.0f / sqrtf(ss * (1.0f / 256.0f) + LN_EPS);
          u32x2 o; o.x = pk2(v[0] * r * g[0], v[1] * r * g[1]); o.y = pk2(v[2] * r * g[2], v[3] * r * g[3]); *(u32x2*)(CKVN + (size_t)t * 256 + 4 * lane) = o; } }
    { const float* PART = WSP(float, WS_PART); float* CUML = WSP(float, WS_CUM); float* SEGT = WSP(float, WS_CUM + 512 * 1024); const float* bfp = INP(I_BFORGET);
      for (int it = gw; it < BATCH * (SEQ / 64); it += NGW) { const int b = it / (SEQ / 64), seg = it % (SEQ / 64), pos = seg * 64 + lane;
          f32x4 f[4];
#pragma unroll
          for (int q = 0; q < 4; ++q) f[q] = part_sum4(PART, 1, (size_t)(b * SEQ + pos) * 256 + 96 + 4 * q);
#pragma unroll
          for (int h = 0; h < B_HEADS; ++h) { float v = log_sigmoid(f[h >> 2][h & 3] + bfp[h]);
#pragma unroll
              for (int o = 1; o < 64; o <<= 1) { const float t = __shfl_up(v, o); if (lane >= o) v += t; }
              CUML[(size_t)(b * B_HEADS + h) * SEQ + pos] = v; if (lane == 63) SEGT[(b * B_HEADS + h) * (SEQ / 64) + seg] = v; } } }
    { const bf16* QA = WSP(bf16, WS_QA); bf16* QLAT = WSP(bf16, WS_QLAT); const bf16* WUKB = WSP(bf16, WS_WUKB);
      for (int it = gw; it < (NTOK / 64) * A_HEADS * 4; it += NGW) { const int ct = it & 3, h = (it >> 2) & 15, tt = it >> 6;
          small_gemm_tile<128>(QA + (size_t)tt * 64 * 2048 + h * 128, 2048, WUKB + (size_t)(h * 256 + ct * 64) * 128, 128, QLAT + (size_t)tt * 64 * 4096 + h * 256 + ct * 64, 4096, lane, nullptr, 1.0f, F.lds + F.wave * 16384); } }
    { const float* PART = WSP(float, WS_PART); bf16* KIDXB = WSP(bf16, WS_KIDXB); float* WIDX = WSP(float, WS_WIDX); const size_t gt = (size_t)F.bid * NTHREADS + F.tid, gs = (size_t)F.G * NTHREADS;
      for (size_t i = gt; i < (size_t)NTOK * 8; i += gs) { const size_t t = i >> 3; const int q = (int)(i & 7); *(f32x4*)(WIDX + t * 32 + 4 * q) = part_sum4(PART, 1, t * 256 + 64 + 4 * q); }
      for (size_t i = gt; i < (size_t)NTOK * 8; i += gs) { const size_t t = i >> 3; const int c8 = (int)(i & 7); const f32x4 a = part_sum4(PART, 1, t * 256 + c8 * 8), b = part_sum4(PART, 1, t * 256 + c8 * 8 + 4);
          u32x4 o; o.x = pk2(a[0], a[1]); o.y = pk2(a[2], a[3]); o.z = pk2(b[0], b[1]); o.w = pk2(b[2], b[3]);
          const size_t tl = t & (SEQ - 1); *(u32x4*)(KIDXB + (t - tl) * 64 + (tl >> 5) * 2048 + (c8 >> 1) * 512 + (tl & 31) * 16 + (c8 & 1) * 8) = o; } }
}

__device__ __forceinline__ unsigned f2key(float f) { const unsigned b = __builtin_bit_cast(unsigned, f); return (b & 0x80000000u) ? ~b : (b | 0x80000000u); }
__device__ __forceinline__ int lanes_below(unsigned long long m) { return (int)__builtin_amdgcn_mbcnt_hi((unsigned)(m >> 32), __builtin_amdgcn_mbcnt_lo((unsigned)m, 0u)); }
__device__ __forceinline__ void p4_oa(Frame& F) {
    const int gw = F.bid * NWAVES + F.wave, NGW = F.G * NWAVES, lane = F.lane;
    const bf16* OLAT = WSP(bf16, WS_OLAT); bf16* OA = WSP(bf16, WS_QA); const bf16* WUVT = WSP(bf16, WS_WUVT);
    for (int it = gw; it < (NTOK / 64) * A_HEADS * 2; it += NGW) { const int dt = it & 1, h = (it >> 1) & 15, tt = it >> 5;
        small_gemm_tile<256>(OLAT + (size_t)tt * 64 * 4096 + h * 256, 4096, WUVT + (size_t)(h * 128 + dt * 64) * 256, 256, nullptr, 2048, lane, (unsigned char*)OA + (size_t)tt * 64 * 2048 + h * 128 + dt * 64, Q8_O, F.lds + F.wave * 16384); }
}
__device__ __forceinline__ void p7_ln1(Frame& F) {
    const int gw = F.bid * NWAVES + F.wave, NGW = F.G * NWAVES, lane = F.lane;
    const bf16* Y1 = WSP(bf16, WS_E); bf16* H1B = WSP(bf16, WS_XB); unsigned char* H18 = WSP(unsigned char, WS_X8); const float* g = INP(I_LN1G); const float* bb = INP(I_LN1B);
    for (int t = gw; t < NTOK; t += NGW) { const bf16* yr = Y1 + (size_t)t * 4096;
        f32x4 v[16]; float s = 0.f;
#pragma unroll
        for (int j = 0; j < 8; ++j) { const u32x4 w = *(const u32x4*)(yr + (j * 64 + lane) * 8); v[2 * j] = (f32x4){bflo(w.x), bfhi(w.x), bflo(w.y), bfhi(w.y)}; v[2 * j + 1] = (f32x4){bflo(w.z), bfhi(w.z), bflo(w.w), bfhi(w.w)};
            s += (v[2 * j][0] + v[2 * j][1]) + (v[2 * j][2] + v[2 * j][3]) + (v[2 * j + 1][0] + v[2 * j + 1][1]) + (v[2 * j + 1][2] + v[2 * j + 1][3]); }
        const float mean = wave_sum(s) * (1.0f / 4096.0f); float q = 0.f;
#pragma unroll
        for (int j = 0; j < 16; ++j) { v[j] = v[j] - mean; q += (v[j][0] * v[j][0] + v[j][1] * v[j][1]) + (v[j][2] * v[j][2] + v[j][3] * v[j][3]); }
        const float rstd = 1.0f / sqrtf(wave_sum(q) * (1.0f / 4096.0f) + LN_EPS);
#pragma unroll
        for (int j = 0; j < 8; ++j) { const int off = (j * 64 + lane) * 8; const f32x4 g0 = *(const f32x4*)(g + off), g1 = *(const f32x4*)(g + off + 4), b0 = *(const f32x4*)(bb + off), b1 = *(const f32x4*)(bb + off + 4);
            const f32x4 o0 = v[2 * j] * rstd * g0 + b0, o1 = v[2 * j + 1] * rstd * g1 + b1;
            u32x4 w; w.x = pk2(o0[0], o0[1]); w.y = pk2(o0[2], o0[3]); w.z = pk2(o1[0], o1[1]); w.w = pk2(o1[2], o1[3]); *(u32x4*)(H1B + (size_t)t * 4096 + off) = w;
            u32x2 q8; q8.x = pk_q8x4(o0[0], o0[1], o0[2], o0[3], Q8_ACT); q8.y = pk_q8x4(o1[0], o1[1], o1[2], o1[3], Q8_ACT); *(u32x2*)(H18 + (size_t)t * 4096 + off) = q8; } }
}
constexpr int FOX_KP = 272, FOX_VP = 320, FOX_VOFF = 17408, FOX_COFF = 37888;
__device__ __forceinline__ void fox_unit(Frame& F, int b, int h, int qb) {
    const int tid = F.tid, lane = F.lane, w = F.wave, r = lane & 31, hh = lane >> 5;
    LAS unsigned char* Ks = F.lds; LAS unsigned char* Vs = F.lds + FOX_VOFF; LAS float* cks = (LAS float*)(F.lds + FOX_COFF);
    const bf16* QB = WSP(bf16, WS_QB); const bf16* KB = WSP(bf16, WS_KB); const bf16* VB = WSP(bf16, WS_VB); bf16* OB = WSP(bf16, WS_OB);
    const float* cum = WSP(float, WS_CUM) + (size_t)(b * B_HEADS + h) * SEQ;
    LAS float* segp = (LAS float*)(F.lds + FOX_COFF + 256);
    const int Q0 = qb * 256, q0 = Q0 + 32 * w, ntiles = (Q0 + 256) / 64, tl = (q0 + 31) / 64;
    const float SC = 0.12751741614123135f, LOG2E = 1.4426950408889634f;
    bf16x8 qf[8];
    { const bf16* qp = QB + ((size_t)b * SEQ + q0 + r) * 2048 + h * 128 + 8 * hh;
#pragma unroll
      for (int s = 0; s < 8; ++s) qf[s] = *(const bf16x8*)(qp + 16 * s); }
    f32x16 o[4];
#pragma unroll
    for (int dt = 0; dt < 4; ++dt)
#pragma unroll
        for (int i = 0; i < 16; ++i) o[dt][i] = 0.f;
    float m = -1e30f, l = 0.f;
    const int pk0 = tid >> 4, pc0 = tid & 15;
    const bf16* kg = KB + ((size_t)b * SEQ + pk0) * 2048 + h * 128 + 8 * pc0; const bf16* vg = VB + ((size_t)b * SEQ + pk0) * 2048 + h * 128 + 8 * pc0;
    u32x4 kr0, kr1, vr0, vr1; float cr = 0.f;
#define FOX_LOAD(kt) do { const size_t go = (size_t)(kt) * 64 * 2048; kr0 = *(const u32x4*)(kg + go); kr1 = *(const u32x4*)(kg + go + 32 * 2048); vr0 = *(const u32x4*)(vg + go); vr1 = *(const u32x4*)(vg + go + 32 * 2048); \
        if (tid < 64) cr = (cum[(kt) * 64 + tid] + segp[(kt)]) * LOG2E; } while (0)
    if (tid < 64) { float v = (lane < 32) ? WSP(float, WS_CUM + 512 * 1024)[(b * B_HEADS + h) * (SEQ / 64) + lane] : 0.f; const float own = v;
#pragma unroll
        for (int o = 1; o < 32; o <<= 1) { const float t = __shfl_up(v, o); if (lane >= o) v += t; }
        if (lane < 32) segp[lane] = v - own;
        CFENCE(); LDS_WAIT(); }
    FOX_LOAD(0);
    const int ka_off = r * FOX_KP + 16 * hh;
    const int vt_off = (4 * hh + ((lane & 15) >> 2)) * FOX_VP + (16 * ((lane >> 4) & 1) + 4 * (lane & 3)) * 2;
    const int ck_off = 4 * hh;
    for (int kt = 0; kt < ntiles; ++kt) {
        __syncthreads();
        *(LAS u32x4*)(Ks + pk0 * FOX_KP + pc0 * 16) = kr0; *(LAS u32x4*)(Ks + (pk0 + 32) * FOX_KP + pc0 * 16) = kr1;
        *(LAS u32x4*)(Vs + pk0 * FOX_VP + pc0 * 16) = vr0; *(LAS u32x4*)(Vs + (pk0 + 32) * FOX_VP + pc0 * 16) = vr1;
        if (tid < 64) cks[tid] = cr;
        __syncthreads();
        if (kt + 1 < ntiles) FOX_LOAD(kt + 1);
        if (kt <= tl) {
            f32x16 s0, s1;
#pragma unroll
            for (int i = 0; i < 16; ++i) { s0[i] = 0.f; s1[i] = 0.f; }
#pragma unroll
            for (int s = 0; s < 8; ++s) { const bf16x8 a0 = *(const LAS bf16x8*)(Ks + ka_off + 32 * s), a1 = *(const LAS bf16x8*)(Ks + ka_off + 32 * FOX_KP + 32 * s);
                s0 = __builtin_amdgcn_mfma_f32_32x32x16_bf16(a0, qf[s], s0, 0, 0, 0); s1 = __builtin_amdgcn_mfma_f32_32x32x16_bf16(a1, qf[s], s1, 0, 0, 0); }
            const bool diag = (64 * kt + 63 > q0); const int qme = q0 + r - 64 * kt;
            float mx = m;
#pragma unroll
            for (int g4 = 0; g4 < 4; ++g4) { const f32x4 c0 = *(const LAS f32x4*)(cks + ck_off + 8 * g4), c1 = *(const LAS f32x4*)(cks + ck_off + 32 + 8 * g4);
#pragma unroll
                for (int i = 0; i < 4; ++i) { const int kl = 8 * g4 + 4 * hh + i; float t0 = s0[4 * g4 + i] * SC - c0[i], t1 = s1[4 * g4 + i] * SC - c1[i];
                    if (diag) { if (kl > qme) t0 = -INFINITY; if (kl + 32 > qme) t1 = -INFINITY; }
                    s0[4 * g4 + i] = t0; s1[4 * g4 + i] = t1; mx = fmaxf(mx, fmaxf(t0, t1)); } }
            mx = fmaxf(mx, __shfl_xor(mx, 32));
            if (__any(mx > m + 8.0f)) {
                const float alpha = __builtin_amdgcn_exp2f(m - mx); m = mx; l *= alpha;
#pragma unroll
                for (int dt = 0; dt < 4; ++dt)
#pragma unroll
                    for (int i = 0; i < 16; ++i) o[dt][i] *= alpha; }
            float ls = 0.f;
            union { bf16x8 v; unsigned u[4]; } pf[4];
#pragma unroll
            for (int ks = 0; ks < 2; ++ks)
#pragma unroll
                for (int j = 0; j < 4; ++j) { const float a0 = __builtin_amdgcn_exp2f(s0[8 * ks + 2 * j] - m), a1 = __builtin_amdgcn_exp2f(s0[8 * ks + 2 * j + 1] - m);
                    const float b0 = __builtin_amdgcn_exp2f(s1[8 * ks + 2 * j] - m), b1 = __builtin_amdgcn_exp2f(s1[8 * ks + 2 * j + 1] - m);
                    ls += (a0 + a1) + (b0 + b1); pf[ks].u[j] = pk2(a0, a1); pf[2 + ks].u[j] = pk2(b0, b1); }
            l += ls;
#pragma unroll
            for (int f = 0; f < 4; ++f) {
                const int vb = vt_off + 16 * f * FOX_VP;
#pragma unroll
                for (int dt = 0; dt < 4; ++dt) {
                    const s16x4 x0 = __builtin_amdgcn_ds_read_tr16_b64_v4i16((LAS s16x4*)(Vs + vb + 64 * dt)), x1 = __builtin_amdgcn_ds_read_tr16_b64_v4i16((LAS s16x4*)(Vs + vb + 8 * FOX_VP + 64 * dt));
                    const bf16x8 af = {x0[0], x0[1], x0[2], x0[3], x1[0], x1[1], x1[2], x1[3]};
                    o[dt] = __builtin_amdgcn_mfma_f32_32x32x16_bf16(af, pf[f].v, o[dt], 0, 0, 0); }
                __builtin_amdgcn_sched_barrier(0);
            }
        }
    }
#undef FOX_LOAD
    l += __shfl_xor(l, 32);
    const float inv = 1.0f / l;
    LAS unsigned char* stg = F.lds + 40960 + w * 4096;
    const int ln = fresh_lane(), rs = ln & 31, hs = ln >> 5;
#pragma unroll
    for (int dt = 0; dt < 4; ++dt)
#pragma unroll
        for (int g4 = 0; g4 < 4; ++g4) { const int cb = 32 * dt + 8 * g4 + 4 * hs;
            *(LAS unsigned*)(stg + rs * 128 + (((cb >> 4) ^ (rs & 7)) << 4) + (cb & 15)) = pk_q8x4(o[dt][4 * g4] * inv, o[dt][4 * g4 + 1] * inv, o[dt][4 * g4 + 2] * inv, o[dt][4 * g4 + 3] * inv, Q8_O); }
    CFENCE(); LDS_WAIT();
#pragma unroll
    for (int k = 0; k < 4; ++k) { const int n = k * 64 + ln, row = n >> 3, u = n & 7;
        *(u32x4*)((unsigned char*)OB + ((size_t)b * SEQ + q0 + row) * 2048 + h * 128 + u * 16) = *(const LAS u32x4*)(stg + row * 128 + ((u ^ (row & 7)) << 4)); }
    CFENCE(); LDS_WAIT();
}
__device__ __forceinline__ void p3_fox(Frame& F) {
    for (int pr = F.bid; pr < BATCH * B_HEADS * 4; pr += F.G) { const int bh = pr >> 2, j = pr & 3, b = bh >> 4, h = bh & 15;
        fox_unit(F, b, h, 7 - j);
        fox_unit(F, b, h, j); }
}
constexpr int DSA_WLDS = 16896;
__device__ __forceinline__ void p3_dsa(Frame& F, int flags) {
    const int gw = F.bid * NWAVES + F.wave, NGW = F.G * NWAVES;
    LAS unsigned char* wb = F.lds + F.wave * DSA_WLDS;
    LAS float* SCb2 = (LAS float*)wb; LAS unsigned short* IDX = (LAS unsigned short*)(wb + 16384);
    const bf16* QIDX = WSP(bf16, WS_QIDX); const bf16* KIDXB = WSP(bf16, WS_KIDXB); const float* WIDX = WSP(float, WS_WIDX); const bf16* CKVN = WSP(bf16, WS_CKVN); const bf16* QLAT = WSP(bf16, WS_QLAT); bf16* OLAT = WSP(bf16, WS_OLAT);
    const float idx_scale = 0.022097086912079608f, SCL = 0.12751741614123135f  ;
    for (int ip = gw; ip < NTOK / 2; ip += NGW) {
        const int b = (2 * ip) / SEQ, ttp = (2 * ip) % SEQ, tp0 = (b & 2) ? (SEQ - 2 - ttp) : ttp;
         const size_t rowp = (size_t)b * SEQ + tp0; const int chunk_end = (tp0 / CHUNK + 1) * CHUNK;
        {
        const int lane = fresh_lane(), r32 = lane & 31, hh = lane >> 5;
        if (!(flags & 4)) {
            bf16x8 qi[2][4]; f32x4 wv[2][4];
#pragma unroll
            for (int q2 = 0; q2 < 2; ++q2) {
#pragma unroll
                for (int s = 0; s < 4; ++s) qi[q2][s] = *(const bf16x8*)(QIDX + (rowp + q2) * 2048 + r32 * 64 + 16 * s + 8 * hh);
#pragma unroll
                for (int g4 = 0; g4 < 4; ++g4) wv[q2][g4] = *(const f32x4*)(WIDX + (rowp + q2) * 32 + 8 * g4 + 4 * hh); }
            const bf16* kp = KIDXB + (size_t)b * SEQ * 64 + r32 * 16 + 8 * hh;
            bf16x8 kb[8][4];
#define DSA_SCORE(kbt, tile, q2) do { f32x16 acc; _Pragma("unroll") for (int i = 0; i < 16; ++i) acc[i] = 0.f; \
                _Pragma("unroll") for (int s = 0; s < 4; ++s) acc = __builtin_amdgcn_mfma_f32_32x32x16_bf16(qi[q2][s], kbt[s], acc, 0, 0, 0); \
                float sc = 0.f; _Pragma("unroll") for (int g4 = 0; g4 < 4; ++g4) _Pragma("unroll") for (int i = 0; i < 4; ++i) sc += fmaxf(acc[4 * g4 + i], 0.f) * wv[q2][g4][i]; \
                sc += __shfl_xor(sc, 32); if (lane < 32) SCb2[(q2) * 2048 + (tile) * 32 + lane] = sc * idx_scale; } while (0)
            const int ntile8 = ((chunk_end + 255) >> 8) << 3;
            for (int t0 = 0; t0 < ntile8; t0 += 8) {
#pragma unroll
                for (int u = 0; u < 8; ++u)
#pragma unroll
                    for (int s = 0; s < 4; ++s) kb[u][s] = *(const bf16x8*)(kp + (size_t)(t0 + u) * 2048 + 512 * s);
#pragma unroll
                for (int u = 0; u < 8; ++u) { DSA_SCORE(kb[u], t0 + u, 0); DSA_SCORE(kb[u], t0 + u, 1); __builtin_amdgcn_sched_barrier(0); }
            }
#undef DSA_SCORE
        }
        }
        CFENCE(); LDS_WAIT();
#pragma unroll 1
        for (int q2 = 0; q2 < 2; ++q2) {
        const int lane = fresh_lane(), r16 = lane & 15, g = lane >> 4;
        const int t = tp0 + q2; const size_t row = rowp + q2; LAS float* SCb = SCb2 + q2 * 2048;
        const int nsel = chunk_end < TOPK ? chunk_end : TOPK;
        if (chunk_end <= TOPK || (flags & 8)) { for (int s = lane; s < nsel; s += 64) IDX[s] = (unsigned short)s; }
        else {
            unsigned key[32]; const int nreg = chunk_end >> 6;
#pragma unroll
            for (int i = 0; i < 32; ++i) key[i] = (i < nreg) ? f2key(SCb[i * 64 + lane]) : 0u;
            unsigned T = 0u; int cntT = 0;
            for (int bit = 31; bit >= 0; --bit) { const unsigned cand = T | (1u << bit); int c = 0;
#pragma unroll
                for (int i = 0; i < 32; ++i) c += (key[i] >= cand) ? 1 : 0;
                const int cnt = wave_sum_iu(c);
                if (cnt >= TOPK) { T = cand; cntT = cnt; if (cnt == TOPK) break; } }
            if (cntT == TOPK) {
                int n = 0;
#pragma unroll
                for (int i = 0; i < 32; ++i) n += (key[i] >= T) ? 1 : 0;
                int pos = n;
#pragma unroll
                for (int o = 1; o < 64; o <<= 1) { const int t_ = __shfl_up(pos, o); if (lane >= o) pos += t_; }
                pos -= n;
#pragma unroll
                for (int i = 0; i < 32; ++i) if (key[i] >= T) { IDX[pos] = (unsigned short)(i * 64 + lane); ++pos; }
            } else {
            int cgt = 0;
#pragma unroll
            for (int i = 0; i < 32; ++i) cgt += __builtin_popcountll(__ballot(key[i] > T));
            int rem = TOPK - cgt, base = 0;
#pragma unroll
            for (int i = 0; i < 32; ++i) { const bool gt = key[i] > T, eq = key[i] == T; const unsigned long long meq = __ballot(eq); const bool take = gt || (eq && lanes_below(meq) < rem);
                const unsigned long long msel = __ballot(take); if (take) IDX[base + lanes_below(msel)] = (unsigned short)(i * 64 + lane);
                base += __builtin_popcountll(msel); const int ne = __builtin_popcountll(meq); rem -= (ne < rem ? ne : rem); }
            }
        }
        CFENCE(); LDS_WAIT();
        if (!(flags & 16)) {
            int r16l = r16; asm volatile("" : "+v"(r16l));
            union { bf16x8 v; unsigned short e[8]; } sel0, sel1;
#pragma unroll
            for (int j = 0; j < 8; ++j) { sel0.e[j] = (8 * g + j == r16l) ? 0x3F80 : 0; sel1.e[j] = (8 * g + j == 16 + r16l) ? 0x3F80 : 0; }
            const float slope2 = exp2f(-0.5f * (float)(r16l + 1)) * 1.4426950408889634f;
            bf16x8 ql[8];
#pragma unroll
            for (int s = 0; s < 8; ++s) ql[s] = *(const bf16x8*)(QLAT + row * 4096 + r16 * 256 + 32 * s + 8 * g);
            f32x4 o[16];
#pragma unroll
            for (int ct = 0; ct < 16; ++ct) o[ct] = (f32x4){0.f, 0.f, 0.f, 0.f};
            float m = -1e30f, l = 0.f;
            const bf16* cbase = CKVN + (size_t)b * SEQ * 256 + 8 * g;
            const int nstep = nsel >> 5;
            for (int st = 0; st < nstep; ++st) {
                const int ia = IDX[32 * st + r16], ib = IDX[32 * st + 16 + r16];
                bf16x8 ca[8], cb[8];
#pragma unroll
                for (int s = 0; s < 8; ++s) { ca[s] = *(const bf16x8*)(cbase + (size_t)ia * 256 + 32 * s); cb[s] = *(const bf16x8*)(cbase + (size_t)ib * 256 + 32 * s); }
                f32x4 sa = (f32x4){0.f, 0.f, 0.f, 0.f}, sb = sa;
#pragma unroll
                for (int s = 0; s < 8; ++s) { sa = __builtin_amdgcn_mfma_f32_16x16x32_bf16(ca[s], ql[s], sa, 0, 0, 0); sb = __builtin_amdgcn_mfma_f32_16x16x32_bf16(cb[s], ql[s], sb, 0, 0, 0); }
                const u32x2 ja = *(const LAS u32x2*)(IDX + 32 * st + 4 * g), jb = *(const LAS u32x2*)(IDX + 32 * st + 16 + 4 * g);
                const int da0 = t - (int)(ja.x & 0xffff), da1 = t - (int)(ja.x >> 16), da2 = t - (int)(ja.y & 0xffff), da3 = t - (int)(ja.y >> 16);
                const int db0 = t - (int)(jb.x & 0xffff), db1 = t - (int)(jb.x >> 16), db2 = t - (int)(jb.y & 0xffff), db3 = t - (int)(jb.y >> 16);
                sa[0] = sa[0] * SCL - slope2 * (float)(da0 < 0 ? -da0 : da0); sa[1] = sa[1] * SCL - slope2 * (float)(da1 < 0 ? -da1 : da1);
                sa[2] = sa[2] * SCL - slope2 * (float)(da2 < 0 ? -da2 : da2); sa[3] = sa[3] * SCL - slope2 * (float)(da3 < 0 ? -da3 : da3);
                sb[0] = sb[0] * SCL - slope2 * (float)(db0 < 0 ? -db0 : db0); sb[1] = sb[1] * SCL - slope2 * (float)(db1 < 0 ? -db1 : db1);
                sb[2] = sb[2] * SCL - slope2 * (float)(db2 < 0 ? -db2 : db2); sb[3] = sb[3] * SCL - slope2 * (float)(db3 < 0 ? -db3 : db3);
                float mx = fmaxf(fmaxf(fmaxf(sa[0], sa[1]), fmaxf(sa[2], sa[3])), fmaxf(fmaxf(sb[0], sb[1]), fmaxf(sb[2], sb[3])));
                mx = fmaxf(mx, __shfl_xor(mx, 16)); mx = fmaxf(mx, __shfl_xor(mx, 32));
                float alpha = 1.0f;
                if (__any(mx > m + 8.0f)) { mx = fmaxf(mx, m); alpha = __builtin_amdgcn_exp2f(m - mx); m = mx;
#pragma unroll
                    for (int ct = 0; ct < 16; ++ct) o[ct] *= alpha; }
#pragma unroll
                for (int i = 0; i < 4; ++i) { sa[i] = __builtin_amdgcn_exp2f(sa[i] - m); sb[i] = __builtin_amdgcn_exp2f(sb[i] - m); }
                l = l * alpha + ((sa[0] + sa[1]) + (sa[2] + sa[3])) + ((sb[0] + sb[1]) + (sb[2] + sb[3]));
                union { bf16x8 v; unsigned u[4]; } pf;
                pf.u[0] = pk2(sa[0], sa[1]); pf.u[1] = pk2(sa[2], sa[3]); pf.u[2] = pk2(sb[0], sb[1]); pf.u[3] = pk2(sb[2], sb[3]);
#pragma unroll
                for (int s = 0; s < 8; ++s) {
                    const f32x4 z = (f32x4){0.f, 0.f, 0.f, 0.f};
                    const f32x4 ta0 = __builtin_amdgcn_mfma_f32_16x16x32_bf16(ca[s], sel0.v, z, 0, 0, 0), ta1 = __builtin_amdgcn_mfma_f32_16x16x32_bf16(ca[s], sel1.v, z, 0, 0, 0);
                    const f32x4 tb0 = __builtin_amdgcn_mfma_f32_16x16x32_bf16(cb[s], sel0.v, z, 0, 0, 0), tb1 = __builtin_amdgcn_mfma_f32_16x16x32_bf16(cb[s], sel1.v, z, 0, 0, 0);
                    union { bf16x8 v; unsigned u[4]; } v0, v1;
                    v0.u[0] = pk2(ta0[0], ta0[1]); v0.u[1] = pk2(ta0[2], ta0[3]); v0.u[2] = pk2(tb0[0], tb0[1]); v0.u[3] = pk2(tb0[2], tb0[3]);
                    v1.u[0] = pk2(ta1[0], ta1[1]); v1.u[1] = pk2(ta1[2], ta1[3]); v1.u[2] = pk2(tb1[0], tb1[1]); v1.u[3] = pk2(tb1[2], tb1[3]);
                    o[2 * s] = __builtin_amdgcn_mfma_f32_16x16x32_bf16(v0.v, pf.v, o[2 * s], 0, 0, 0);
                    o[2 * s + 1] = __builtin_amdgcn_mfma_f32_16x16x32_bf16(v1.v, pf.v, o[2 * s + 1], 0, 0, 0);
                }
            }
            l += __shfl_xor(l, 16); l += __shfl_xor(l, 32);
            const float inv = 1.0f / l;
            LAS unsigned char* ob = (LAS unsigned char*)SCb;
#pragma unroll
            for (int ct = 0; ct < 16; ++ct) { u32x2 wv; wv.x = pk2(o[ct][0] * inv, o[ct][1] * inv); wv.y = pk2(o[ct][2] * inv, o[ct][3] * inv);
                *(LAS u32x2*)(ob + r16 * 512 + (((4 * ct + g) ^ (r16 << 2)) << 3)) = wv; }
            CFENCE(); LDS_WAIT();
#pragma unroll
            for (int j8 = 0; j8 < 8; ++j8) { const int n = j8 * 64 + lane, h = n >> 5, j = n & 31;
                const u32x4 v = *(const LAS u32x4*)(ob + h * 512 + ((j ^ (h << 1)) << 4));
                *(u32x4*)(OLAT + row * 4096 + h * 256 + j * 8) = v; }
        }
        CFENCE(); LDS_WAIT();
        }
    }
}
constexpr int PEER_WLDS = 2048 + 8192;
typedef int i32x8 __attribute__((ext_vector_type(8)));
typedef __bf16 bf16x2_d __attribute__((ext_vector_type(2)));
__device__ __forceinline__ float dot2bf(unsigned a, unsigned b, float c) { return __builtin_amdgcn_fdot2_f32_bf16(__builtin_bit_cast(bf16x2_d, a), __builtin_bit_cast(bf16x2_d, b), c, false); }
__device__ __forceinline__ f32x4 fp8x4(unsigned w) { const f32x2 lo = __builtin_amdgcn_cvt_pk_f32_fp8((int)w, false), hi = __builtin_amdgcn_cvt_pk_f32_fp8((int)w, true); return (f32x4){lo[0], lo[1], hi[0], hi[1]}; }
__device__ __forceinline__ float fp8dot4(unsigned w, f32x4 x) { const f32x4 f = fp8x4(w); return (f[0] * x[0] + f[1] * x[1]) + (f[2] * x[2] + f[3] * x[3]); }
#define DPPF(v, ctrl, rmask) __builtin_bit_cast(float, __builtin_amdgcn_update_dpp(0, __builtin_bit_cast(int, (v)), (ctrl), (rmask), 0xf, false))
__device__ __forceinline__ float wave_sum_u(float v) {
    v += DPPF(v, 0xB1, 0xf); v += DPPF(v, 0x4E, 0xf); v += DPPF(v, 0x141, 0xf); v += DPPF(v, 0x140, 0xf);
    v += DPPF(v, 0x142, 0xa); v += DPPF(v, 0x143, 0xc);
    return __builtin_bit_cast(float, __builtin_amdgcn_readlane(__builtin_bit_cast(int, v), 63));
}
template <int NV>
__device__ __forceinline__ void select16(const unsigned (&key)[NV], bool (&sel)[NV], int (&pos)[NV]) {
    unsigned T = 0u;
    for (int bit = 31; bit >= 0; --bit) { const unsigned cand = T | (1u << bit); int cnt = 0;
#pragma unroll
        for (int r = 0; r < NV; ++r) cnt += __builtin_popcountll(__ballot(key[r] >= cand));
        if (cnt >= PEER_TOPK) { T = cand; if (cnt == PEER_TOPK) break; } }
    int cgt = 0;
#pragma unroll
    for (int r = 0; r < NV; ++r) cgt += __builtin_popcountll(__ballot(key[r] > T));
    int rem = PEER_TOPK - cgt, base = 0;
#pragma unroll
    for (int r = 0; r < NV; ++r) { const bool gt = key[r] > T, eq = key[r] == T; const unsigned long long meq = __ballot(eq); const bool take = gt || (eq && lanes_below(meq) < rem);
        const unsigned long long msel = __ballot(take); sel[r] = take; pos[r] = base + lanes_below(msel);
        base += __builtin_popcountll(msel); const int ne = __builtin_popcountll(meq); rem -= (ne < rem ? ne : rem); }
}
__device__ __forceinline__ void p9_peer(Frame& F) {
    const int gw = F.bid * NWAVES + F.wave, NGW = F.G * NWAVES, lane = F.lane;
    LAS unsigned char* wb = F.lds + F.wave * PEER_WLDS;
    LAS float* tv = (LAS float*)wb; LAS int* ti = (LAS int*)(wb + 128); LAS float* cv = (LAS float*)(wb + 256); LAS int* cc = (LAS int*)(wb + 320); LAS int* eidx = (LAS int*)(wb + 512); LAS float* coef = (LAS float*)(wb + 1024); LAS float* su = (LAS float*)(wb + 1536);
    const float* S = WSP(float, WS_E); const bf16* H1B = WSP(bf16, WS_XB); const bf16* PLE = WSP(bf16, WS_PL); const unsigned char* UB = WSP(unsigned char, WS_UB); const unsigned char* VT = WSP(unsigned char, WS_VT); const float* SCL = WSP(float, WS_SCL);
    const float* g2 = INP(I_LN2G); const float* b2 = INP(I_LN2B);
    for (int tok = gw; tok < NTOK; tok += NGW) {
        const float* srow = S + (size_t)tok * 2048;
        LAS float* sl = (LAS float*)(wb + 2048);
#pragma unroll
        for (int j = 0; j < 8; ++j) *(LAS f32x4*)(sl + (j * 64 + lane) * 4) = *(const f32x4*)(srow + (j * 64 + lane) * 4);
        CFENCE(); LDS_WAIT();
        {
            u32x4 hb[2][3];
            u32x4 hx[2][4]; float mx = 0.f;
#pragma unroll
            for (int jj = 0; jj < 2; ++jj)
#pragma unroll
                for (int i = 0; i < 4; ++i) { hx[jj][i] = *(const u32x4*)(H1B + (size_t)tok * 4096 + (jj * 64 + lane) * 32 + 8 * i);
#pragma unroll
                    for (int k = 0; k < 4; ++k) mx = fmaxf(mx, fmaxf(fabsf(bflo(hx[jj][i][k])), fabsf(bfhi(hx[jj][i][k])))); }
            mx = wave_max(mx) * (1.0f / 6.0f);
            int eb = (int)((__builtin_bit_cast(unsigned, mx) + 0x007fffffu) >> 23); eb = eb < 1 ? 1 : (eb > 253 ? 253 : eb);
            const float sup = __builtin_bit_cast(float, (unsigned)(254 - eb) << 23), sdn = __builtin_bit_cast(float, (unsigned)eb << 23);
#pragma unroll
            for (int jj = 0; jj < 2; ++jj)
#pragma unroll
                for (int i = 0; i < 4; ++i) { unsigned w0 = 0u, w1 = 0u, w2 = 0u;
#define HDIG(k) { float x0 = bflo(hx[jj][i][k]) * sup, x1 = bfhi(hx[jj][i][k]) * sup; \
                      w0 = __builtin_amdgcn_cvt_scalef32_pk_fp4_f32(w0, x0, x1, 1.0f, k); f32x2 dq = __builtin_amdgcn_cvt_scalef32_pk_f32_fp4(w0, 1.0f, k); x0 = (x0 - dq[0]) * 4.0f; x1 = (x1 - dq[1]) * 4.0f; \
                      w1 = __builtin_amdgcn_cvt_scalef32_pk_fp4_f32(w1, x0, x1, 1.0f, k); dq = __builtin_amdgcn_cvt_scalef32_pk_f32_fp4(w1, 1.0f, k); x0 = (x0 - dq[0]) * 8.0f; x1 = (x1 - dq[1]) * 8.0f; \
                      w2 = __builtin_amdgcn_cvt_scalef32_pk_fp4_f32(w2, x0, x1, 1.0f, k); }
                    HDIG(0) HDIG(1) HDIG(2) HDIG(3)
#undef HDIG
                    hb[jj][0][i] = w0; hb[jj][1][i] = w1; hb[jj][2][i] = w2; }
            const int dsel = ((lane >> 4) == ((lane & 15) >> 2)) ? (lane & 3) : 4;
#define U_LOAD(R, SU, SV, MB) { _Pragma("unroll") for (int q = 0; q < 8; ++q) { const int e_ = __builtin_amdgcn_readfirstlane(eidx[8 * (MB) + q]); const u32x4* p = (const u32x4*)(UB + (size_t)e_ * 2048) + lane; R[q][0] = p[0]; R[q][1] = p[64]; } \
                { const int el_ = eidx[8 * (MB) + (lane & 7)]; SU = SCL[el_]; SV = SCL[N_EXPERTS + el_]; } }
#define HB8(d) (i32x8){(int)hb[jj][d].x, (int)hb[jj][d].y, (int)hb[jj][d].z, (int)hb[jj][d].w, 0, 0, 0, 0}
#define U_COMP(R, SU, SV, MB) { float a[8]; \
                _Pragma("unroll") for (int q = 0; q < 8; ++q) { f32x4 c = (f32x4){0.f, 0.f, 0.f, 0.f}; \
                    _Pragma("unroll") for (int jj = 0; jj < 2; ++jj) { const i32x8 av = (i32x8){(int)R[q][jj].x, (int)R[q][jj].y, (int)R[q][jj].z, (int)R[q][jj].w, 0, 0, 0, 0}; \
                        c = __builtin_amdgcn_mfma_scale_f32_16x16x128_f8f6f4(av, HB8(0), c, 4, 4, 0, 0x7f7f7f7f, 0, 0x7f7f7f7f);     \
                        c = __builtin_amdgcn_mfma_scale_f32_16x16x128_f8f6f4(av, HB8(1), c, 4, 4, 0, 0x7f7f7f7f, 0, 0x7d7d7d7d);     \
                        c = __builtin_amdgcn_mfma_scale_f32_16x16x128_f8f6f4(av, HB8(2), c, 4, 4, 0, 0x7f7f7f7f, 0, 0x7a7a7a7a); }   \
                    float d = (dsel == 0) ? c[0] : 0.f; d = (dsel == 1) ? c[1] : d; d = (dsel == 2) ? c[2] : d; d = (dsel == 3) ? c[3] : d; \
                    a[q] = wave_sum_u(d); } \
                float z = a[0]; \
                _Pragma("unroll") for (int q = 1; q < 8; ++q) z = (lane == q) ? a[q] : z; \
                z *= sdn * SU; \
                const float act = 0.5f * z * (1.0f + erff(z * 0.70710678118654752f)); \
                if (lane < 8) coef[8 * (MB) + lane] *= act * SV; }
            u32x4 ra[8][2], rb[8][2]; float sua, sva, sub, svb;
#define ROUTE_HEAD(h) { \
            _Pragma("unroll") \
            for (int side = 0; side < 2; ++side) { const float v0 = sl[(2 * h + side) * 128 + lane], v1 = sl[(2 * h + side) * 128 + 64 + lane]; \
                const unsigned key[2] = {f2key(v0), f2key(v1)}; bool sel[2]; int pos[2]; select16<2>(key, sel, pos); \
                if (sel[0]) { tv[side * 16 + pos[0]] = v0; ti[side * 16 + pos[0]] = lane; } \
                if (sel[1]) { tv[side * 16 + pos[1]] = v1; ti[side * 16 + pos[1]] = lane + 64; } } \
            CFENCE(); LDS_WAIT(); \
            { const int i0 = lane >> 4, j = lane & 15; const float vj = tv[16 + j]; \
              const float c0 = tv[i0] + vj, c1 = tv[i0 + 4] + vj, c2 = tv[i0 + 8] + vj, c3 = tv[i0 + 12] + vj; \
              const unsigned key[4] = {f2key(c0), f2key(c1), f2key(c2), f2key(c3)}; bool sel[4]; int pos[4]; select16<4>(key, sel, pos); \
              if (sel[0]) { cv[pos[0]] = c0; cc[pos[0]] = lane; } if (sel[1]) { cv[pos[1]] = c1; cc[pos[1]] = lane + 64; } \
              if (sel[2]) { cv[pos[2]] = c2; cc[pos[2]] = lane + 128; } if (sel[3]) { cv[pos[3]] = c3; cc[pos[3]] = lane + 192; } } \
            CFENCE(); LDS_WAIT(); \
            { const float val = cv[lane & 15]; const int ci = cc[lane & 15]; float mx = val; \
            _Pragma("unroll") \
              for (int o = 1; o < 16; o <<= 1) mx = fmaxf(mx, __shfl_xor(mx, o)); \
              const float e = __expf(val - mx); float sm = e; \
            _Pragma("unroll") \
              for (int o = 1; o < 16; o <<= 1) sm += __shfl_xor(sm, o); \
              if (lane < 16) { eidx[h * 16 + lane] = ti[ci >> 4] * 128 + ti[16 + (ci & 15)]; coef[h * 16 + lane] = e / sm; } } \
            CFENCE(); LDS_WAIT(); }
            ROUTE_HEAD(0)
            __builtin_amdgcn_sched_barrier(0);
            U_LOAD(ra, sua, sva, 0)
            U_LOAD(rb, sub, svb, 1)
#pragma unroll 1
            for (int h = 1; h < PEER_HEADS; ++h) {
                __builtin_amdgcn_sched_barrier(0);
                ROUTE_HEAD(h)
                __builtin_amdgcn_sched_barrier(0);
                U_COMP(ra, sua, sva, 2 * h - 2)
                __builtin_amdgcn_sched_barrier(0);
                U_LOAD(ra, sua, sva, 2 * h)
                __builtin_amdgcn_sched_barrier(0);
                U_COMP(rb, sub, svb, 2 * h - 1)
                __builtin_amdgcn_sched_barrier(0);
                U_LOAD(rb, sub, svb, 2 * h + 1)
            }
            __builtin_amdgcn_sched_barrier(0);
            U_COMP(ra, sua, sva, PEER_M / 8 - 2)
            __builtin_amdgcn_sched_barrier(0);
            U_COMP(rb, sub, svb, PEER_M / 8 - 1)
#undef ROUTE_HEAD
#undef U_LOAD
#undef U_COMP
#undef HB8
        }
        CFENCE(); LDS_WAIT();
        f32x2 y[32];
#pragma unroll
        for (int i = 0; i < 32; ++i) y[i] = (f32x2){0.f, 0.f};
#pragma unroll 1
        for (int mb = 0; mb < PEER_M / 8; ++mb) {
            u32x4 r[8][2]; float c[8];
#pragma unroll
            for (int q = 0; q < 8; ++q) { const int e = __builtin_amdgcn_readfirstlane(eidx[8 * mb + q]); c[q] = coef[8 * mb + q];
                const u32x4* p = (const u32x4*)(VT + (size_t)e * 2048) + lane; r[q][0] = p[0]; r[q][1] = p[64]; }
#pragma unroll
            for (int q = 0; q < 8; ++q)
#pragma unroll
                for (int jj = 0; jj < 2; ++jj)
#pragma unroll
                    for (int i = 0; i < 4; ++i) { const unsigned w = r[q][jj][i];
                        y[(4 * jj + i) * 4 + 0] += __builtin_amdgcn_cvt_scalef32_pk_f32_fp4(w, 1.0f, 0) * c[q]; y[(4 * jj + i) * 4 + 1] += __builtin_amdgcn_cvt_scalef32_pk_f32_fp4(w, 1.0f, 1) * c[q];
                        y[(4 * jj + i) * 4 + 2] += __builtin_amdgcn_cvt_scalef32_pk_f32_fp4(w, 1.0f, 2) * c[q]; y[(4 * jj + i) * 4 + 3] += __builtin_amdgcn_cvt_scalef32_pk_f32_fp4(w, 1.0f, 3) * c[q]; }
        }
        { const bf16* hr = H1B + (size_t)tok * 4096; const bf16* pr = PLE + (size_t)tok * 4096; float s = 0.f;
          u32x4 hwv[8], pwv[8];
          { const int lq = fresh_lane(); LAS unsigned char* sb = wb + 2048;
#pragma unroll
            for (int j = 0; j < 8; ++j) { hwv[j] = *(const u32x4*)(hr + (j * 64 + lq) * 8); pwv[j] = *(const u32x4*)(pr + (j * 64 + lq) * 8); }
#pragma unroll
            for (int j = 0; j < 8; ++j) { const int n = j * 64 + lq, L = (n >> 2) & 63; *(LAS u32x4*)(sb + (((n & ~3) | ((n & 3) ^ (L & 3) ^ ((L >> 2) & 3))) << 4)) = hwv[j]; }
            CFENCE(); LDS_WAIT();
#pragma unroll
            for (int q = 0; q < 8; ++q) { const int n = (q >> 2) * 256 + lq * 4; hwv[q] = *(const LAS u32x4*)(sb + ((n | ((q & 3) ^ (lq & 3) ^ ((lq >> 2) & 3))) << 4)); }
            CFENCE(); LDS_WAIT();
#pragma unroll
            for (int j = 0; j < 8; ++j) { const int n = j * 64 + lq, L = (n >> 2) & 63; *(LAS u32x4*)(sb + (((n & ~3) | ((n & 3) ^ (L & 3) ^ ((L >> 2) & 3))) << 4)) = pwv[j]; }
            CFENCE(); LDS_WAIT();
#pragma unroll
            for (int q = 0; q < 8; ++q) { const int n = (q >> 2) * 256 + lq * 4; pwv[q] = *(const LAS u32x4*)(sb + ((n | ((q & 3) ^ (lq & 3) ^ ((lq >> 2) & 3))) << 4)); }
            CFENCE(); LDS_WAIT(); }
#pragma unroll
          for (int jj = 0; jj < 2; ++jj) {
#pragma unroll
              for (int i = 0; i < 4; ++i) { const int off = (jj * 64 + lane) * 32 + 8 * i; const int yb = (4 * jj + i) * 4;
                  const u32x4 hw = hwv[4 * jj + i], pw = pwv[4 * jj + i]; const f32x4 h0 = (f32x4){bflo(hw.x), bfhi(hw.x), bflo(hw.y), bfhi(hw.y)}, h1 = (f32x4){bflo(hw.z), bfhi(hw.z), bflo(hw.w), bfhi(hw.w)}, p0 = (f32x4){bflo(pw.x), bfhi(pw.x), bflo(pw.y), bfhi(pw.y)}, p1 = (f32x4){bflo(pw.z), bfhi(pw.z), bflo(pw.w), bfhi(pw.w)};
                  y[yb][0] += h0[0] * ALPHA + p0[0]; y[yb][1] += h0[1] * ALPHA + p0[1]; y[yb + 1][0] += h0[2] * ALPHA + p0[2]; y[yb + 1][1] += h0[3] * ALPHA + p0[3];
                  y[yb + 2][0] += h1[0] * ALPHA + p1[0]; y[yb + 2][1] += h1[1] * ALPHA + p1[1]; y[yb + 3][0] += h1[2] * ALPHA + p1[2]; y[yb + 3][1] += h1[3] * ALPHA + p1[3];
                  s += (y[yb][0] + y[yb][1]) + (y[yb + 1][0] + y[yb + 1][1]) + (y[yb + 2][0] + y[yb + 2][1]) + (y[yb + 3][0] + y[yb + 3][1]); }
              CFENCE(); }
          const float mean = wave_sum(s) * (1.0f / 4096.0f); float q = 0.f;
#pragma unroll
          for (int i = 0; i < 32; ++i) { y[i] = y[i] - mean; q += y[i][0] * y[i][0] + y[i][1] * y[i][1]; }
          const float rstd = 1.0f / sqrtf(wave_sum(q) * (1.0f / 4096.0f) + LN_EPS);
          float* orow = OUTP() + (size_t)tok * 4096;
          LAS f32x4* st = (LAS f32x4*)(wb + 2048);
          const int ln = fresh_lane();
#pragma unroll
          for (int jj = 0; jj < 2; ++jj) {
#pragma unroll
              for (int c4 = 0; c4 < 8; ++c4) { const int yb = (4 * jj + (c4 >> 1)) * 4 + 2 * (c4 & 1);
                  st[ln * 8 + ((c4 + ln) & 7)] = (f32x4){y[yb][0] * rstd, y[yb][1] * rstd, y[yb + 1][0] * rstd, y[yb + 1][1] * rstd}; }
              CFENCE(); LDS_WAIT();
#pragma unroll
              for (int j0 = 0; j0 < 8; j0 += 4) {
#pragma unroll
                  for (int j = j0; j < j0 + 4; ++j) { const int n = j * 64 + ln, L = n >> 3, c = n & 7; const f32x4 v = st[L * 8 + ((c + L) & 7)];
                      const int gi = jj * 2048 + n * 4; const f32x4 gg = *(const f32x4*)(g2 + gi), bb = *(const f32x4*)(b2 + gi);
                      *(f32x4*)(orow + gi) = v * gg + bb; }
                  CFENCE(); }
              CFENCE(); LDS_WAIT(); } }
        CFENCE(); LDS_WAIT();
    }
}
#ifndef DBG_OUT
#define DBG_OUT 0
#endif
__device__ __forceinline__ void dbg_copy(Frame& F, int which) {
    const size_t gt = (size_t)F.bid * NTHREADS + F.tid, gs = (size_t)F.G * NTHREADS, n = (size_t)NTOK * 4096;
    for (size_t i = gt; i < n; i += gs) { const size_t t = i >> 12; const int c = (int)(i & 4095); float v = 0.f;
        if (which == 1) v = WSP(float, WS_F)[i];
        else if (which == 2) v = WSP(float, WS_E)[i];
        else if (which == 3) v = bf2f(WSP(bf16, WS_XB)[i]);
        else if (which == 4) v = (c < 2048) ? bf2f(WSP(bf16, WS_QA)[t * 2048 + c]) : bf2f(WSP(bf16, WS_OB)[t * 2048 + c - 2048]);
        else if (which == 5) v = bf2f(WSP(bf16, WS_OLAT)[i]);
        else if (which == 6) v = bf2f(WSP(bf16, WS_QLAT)[i]);
        else if (which == 7) v = (c < 2048) ? bf2f(WSP(bf16, WS_QIDX)[t * 2048 + c]) : bf2f(WSP(bf16, WS_KB)[t * 2048 + c - 2048]);
        else if (which == 8) v = bf2f(WSP(bf16, WS_F)[t * 8192 + c]);
        else if (which == 9) v = (c < 2048) ? WSP(float, WS_E)[t * 2048 + c] : bf2f(WSP(bf16, WS_PL)[t * 4096 + c]);
        OUTP()[i] = v; }
}

constexpr int N_PHASES = 10;
__global__ void __launch_bounds__(NTHREADS, 2) mk_fwd(Args args) {
    extern __shared__ __attribute__((aligned(16))) unsigned char lds_raw[];
    Frame F;
    F.lds = (LAS unsigned char*)lds_raw; F.tid = threadIdx.x; F.lane = F.tid & 63; F.wave = __builtin_amdgcn_readfirstlane(F.tid >> 6); F.G = gridDim.x; F.bid = blockIdx.x;
    unsigned* ctl = (unsigned*)(WSB() + WS_CTL);
    if (F.tid < 64) ((LAS unsigned*)(F.lds + LDSCTL_OFF))[F.tid] = 0u;
    __syncthreads();
    XcdBarrier bar; bar.bar = ctl + CW_BAR; bar.x = 0; bar.st = nullptr; bar.wave = F.wave;
    if (MK_N_LAUNCHES == 1) bar = xcd_barrier_post(ctl + CW_BAR, (volatile LAS unsigned*)(F.lds + LDSCTL_OFF));
    const int lo = args.ph_lo, hi = args.ph_hi;
#ifndef PROBE_DUP
#define PROBE_DUP -1
#endif
#define IN(k) (lo <= (k) && (k) < hi)
#define REP(k) for (int rep_ = 0; rep_ < ((k) == PROBE_DUP ? 2 : 1); ++rep_)
#define SEAM(k) do { if (IN(k) && IN((k) + 1)) xcd_barrier(bar); } while (0)
    LAS unsigned char* const ldsg = F.lds;
#define RELANE() do { const int l_ = fresh_lane(); F.lane = l_; F.tid = F.wave * 64 + l_; } while (0)

    if (IN(0)) { RELANE(); REP(0) p0_prologue(F); SEAM(0); }
    if (IN(1)) {
        { pg8::Gemm g{WSP(bf16, WS_X8), WSP(bf16, WS_W18), NTOK, N1M, D_MODEL / 2, D_MODEL / 2}; pg8::StaticOrder S; S.init(NTOK, N1M, F.G, F.bid);
          pg8::Epi1 E{WSP(bf16, WS_QA), WSP(bf16, WS_QIDX), WSP(bf16, WS_QB), WSP(bf16, WS_KB), WSP(bf16, WS_VB), WSP(bf16, WS_F), INP(I_BGATE), 0};
          pg8::gemm_phase<pg8::Epi1, pg8::StaticOrder, true, true, true>(ldsg, g, S, E, F.wave); }
        if (F.bid < 256) {
          const int ks = F.bid & 3, sp = (F.bid >> 2) & 1, spm = F.bid >> 3;
          pg8::Gemm g{WSP(bf16, WS_X8) + ks * 512, WSP(bf16, WS_W18) + (size_t)N1M * (D_MODEL / 2) + ks * 512, NTOK, 512, 512, D_MODEL / 2}; pg8::OneUnit S{spm, sp};
          pg8::EpiPart E{WSP(float, WS_PART) + (size_t)(ks * 2 + sp) * NTOK * 256, 1.0f / (Q8_ACT * Q8_W)};
          pg8::gemm_phase<pg8::EpiPart, pg8::OneUnit, true, true, true>(ldsg, g, S, E, F.wave); }
        { pg8::Gemm g{WSP(bf16, WS_PB), WSP(bf16, WS_WPLT), NTOK, D_MODEL, D_PLE, D_PLE}; pg8::StaticOrder S; S.init(NTOK, D_MODEL, F.G, F.bid);
          pg8::EpiBf16P E{WSP(bf16, WS_PL), D_MODEL};
          pg8::gemm_phase<pg8::EpiBf16P, pg8::StaticOrder, true, true>(ldsg, g, S, E, F.wave); }
        SEAM(1);
    }
    if (IN(2)) { RELANE(); REP(2) p2_small(F); SEAM(2); }
    if (IN(3)) { REP(3) { if (!(args.pad & 2)) p3_fox(F); __syncthreads(); if (!(args.pad & 1)) p3_dsa(F, args.pad); __syncthreads(); } SEAM(3); }
    if (IN(4)) { RELANE(); REP(4) p4_oa(F); SEAM(4); }
    if (IN(5)) {
        { pg8::Gemm g{WSP(bf16, WS_QA), WSP(bf16, WS_WBAT), NTOK, D_MODEL, 1024, 1024}; pg8::StaticOrder S; S.init(NTOK, D_MODEL, F.G, F.bid);
          pg8::Epi2a E{WSP(bf16, WS_F), WSP(bf16, WS_E), 1.0f / (Q8_O * Q8_WB)};
          pg8::gemm_phase<pg8::Epi2a, pg8::StaticOrder, true, true, true>(ldsg, g, S, E, F.wave); }
        { pg8::Gemm g{WSP(bf16, WS_OB), WSP(bf16, WS_WBBT), NTOK, D_MODEL, 1024, 1024}; pg8::StaticOrder S; S.init(NTOK, D_MODEL, F.G, F.bid);
          pg8::Epi2b E{WSP(bf16, WS_F), WSP(bf16, WS_E), WSP(bf16, WS_XB), 1.0f / (Q8_O * Q8_WB)};
          pg8::gemm_phase<pg8::Epi2b, pg8::StaticOrder, true, true, true>(ldsg, g, S, E, F.wave); }
        SEAM(5);
    }
    if (IN(6)) {
        pg8::Gemm g{WSP(bf16, WS_XB), WSP(bf16, WS_WOT), NTOK, D_MODEL, D_MODEL / 2, D_MODEL / 2}; pg8::StaticOrder S; S.init(NTOK, D_MODEL, F.G, F.bid);
        pg8::Epi3 E{INP(I_X), WSP(bf16, WS_E), ALPHA, 1.0f / (Q8_MG * Q8_WO)};
        pg8::gemm_phase<pg8::Epi3, pg8::StaticOrder, true, true, true>(ldsg, g, S, E, F.wave);
        SEAM(6);
    }
    if (IN(7)) { RELANE(); REP(7) p7_ln1(F); SEAM(7); }
    if (IN(8)) {
        { pg8::Gemm g{WSP(bf16, WS_X8), WSP(bf16, WS_W48), NTOK, N4, D_MODEL / 2, D_MODEL / 2}; pg8::StaticOrder S; S.init(NTOK, N4, F.G, F.bid);
          pg8::Epi4 E{WSP(float, WS_E), WSP(bf16, WS_PL), INP(I_BPG), 0};
          pg8::gemm_phase<pg8::Epi4, pg8::StaticOrder, true, true, true>(ldsg, g, S, E, F.wave); }
        SEAM(8);
    }
    if (IN(9)) { if (DBG_OUT) dbg_copy(F, DBG_OUT); else { RELANE(); REP(9) p9_peer(F); } }
#undef IN
#undef SEAM
}

extern "C" void kernel_launch(void* const* d_in, const int* in_sizes, int n_in, void* d_out, int out_size, void* d_ws, size_t ws_size, hipStream_t stream) {
    static int grid = 0;
    if (grid == 0) {
        if (n_in != 23 || out_size != NTOK * D_MODEL || ws_size < WS_END) { fprintf(stderr, "kernel_launch: unexpected problem (n_in %d, out %d, ws %zu); nothing launched\n", n_in, out_size, ws_size); grid = -1; return; }
        int dev = 0, cus = 0, per_cu = 0;
        if (hipGetDevice(&dev) != hipSuccess || hipDeviceGetAttribute(&cus, hipDeviceAttributeMultiprocessorCount, dev) != hipSuccess) { grid = -1; return; }
        if (hipFuncSetAttribute((const void*)mk_fwd, hipFuncAttributeMaxDynamicSharedMemorySize, LDS_BYTES) != hipSuccess) { fprintf(stderr, "kernel_launch: hipFuncSetAttribute failed\n"); grid = -1; return; }
        if (hipOccupancyMaxActiveBlocksPerMultiprocessor(&per_cu, (const void*)mk_fwd, NTHREADS, LDS_BYTES) != hipSuccess || per_cu < 1) { fprintf(stderr, "kernel_launch: occupancy query says %d\n", per_cu); (void)hipGetLastError(); grid = -1; return; }
        grid = cus;
    }
    if (grid < 0) return;
    if (hipMemsetAsync((char*)d_ws + WS_CTL, 0, CTL_ZERO_BYTES, stream) != hipSuccess) return;
    Args a{};
    for (int i = 0; i < 23; ++i) a.in[i] = (const float*)d_in[i];
    a.out = (float*)d_out; a.ws = (unsigned char*)d_ws;
    for (int li = 0; li < MK_N_LAUNCHES; ++li) {
#if DBG_OUT
        { const int lastp[10] = {9, 7, 6, 5, 4, 3, 2, 1, 1, 8}; if (MK_N_LAUNCHES > 1 && li > lastp[DBG_OUT] && li != 9) continue; }
#endif
        a.ph_lo = (MK_N_LAUNCHES == 1) ? 0 : li; a.ph_hi = (MK_N_LAUNCHES == 1) ? N_PHASES : li + 1; a.li = li; a.pad = 0;
#ifdef HOST_DUP
        if (MK_N_LAUNCHES > 1 && li == HOST_DUP) {
#ifdef HOST_DUP_PAD
            a.pad = HOST_DUP_PAD;
#endif
            hipLaunchKernelGGL(mk_fwd, dim3(grid), dim3(NTHREADS), LDS_BYTES, stream, a); a.pad = 0; }
#endif
        hipLaunchKernelGGL(mk_fwd, dim3(grid), dim3(NTHREADS), LDS_BYTES, stream, a);
    }
}
```
